# Optimizing an MI355X kernel written in HIP

```python
import math
import jax, jax.numpy as jnp
from jax import lax
import numpy as np

D_MODEL = 1024
BATCH = 16
SEQ = 2048
DEPTH = 1

N_META = 16
D_MIX = 2 * D_MODEL
SSD_HEAD_DIM = 64
SSD_HEADS = 24
D_SSD = SSD_HEADS * SSD_HEAD_DIM
SSD_GROUPS = 4
SSD_STATE = 128
SSD_CONV = 4
SSD_CHUNK = 128
D_XBC = D_SSD + 2 * SSD_GROUPS * SSD_STATE
D_SC = D_MIX - D_SSD
SC_CONV = 3
D_IN = D_SSD + D_XBC + SSD_HEADS + 3 * D_SC
PEER_HEADS = 8
PEER_KEYS = 128
PEER_EXPERTS = PEER_KEYS * PEER_KEYS
PEER_TOPK = 16
PEER_QDIM = 256
PEER_HALF = PEER_QDIM // 2
PEER_BLOCK = 512
EPS = 1e-6

kernel_name = "hymba_ssd_shortconv_peer_layer"


def rmsnorm(x, g):
    xf = x.astype(jnp.float32)
    xf = xf * lax.rsqrt(jnp.mean(xf * xf, axis=-1, keepdims=True) + EPS)
    return (xf * g.astype(jnp.float32)).astype(x.dtype)


def causal_dwconv(x, w):
    width, ch = w.shape
    return lax.conv_general_dilated(
        x, w[:, None, :].astype(x.dtype), window_strides=(1,), padding=[(width - 1, 0)],
        dimension_numbers=('NWC', 'WIO', 'NWC'), feature_group_count=ch)


def segsum(a):
    t = a.shape[-1]
    ar = jnp.broadcast_to(a[..., None], a.shape + (t,))
    ar = jnp.where(jnp.tril(jnp.ones((t, t), bool), -1), ar, 0.0)
    cs = jnp.cumsum(ar, axis=-2)
    return jnp.where(jnp.tril(jnp.ones((t, t), bool), 0), cs, -jnp.inf)


def ssd_scan(x, dt, A, Bm, Cm):
    b, l, h, p = x.shape
    g, n = Bm.shape[2], Bm.shape[3]
    r, q = h // g, SSD_CHUNK
    c = l // q
    xc = x.reshape(b, c, q, g, r, p)
    Bc = Bm.reshape(b, c, q, g, n)
    Cc = Cm.reshape(b, c, q, g, n)
    dtc = dt.reshape(b, c, q, g, r)
    a = (dtc * A.reshape(g, r)).transpose(0, 3, 4, 1, 2)
    x_dt = xc * dtc[..., None]
    a_cs = jnp.cumsum(a, axis=-1)
    decay_in = jnp.exp(segsum(a))
    cb = jnp.einsum('bclgn,bcsgn->bgcls', Cc, Bc)
    y_diag = jnp.einsum('bgcls,bgrcls,bcsgrp->bclgrp', cb, decay_in, x_dt)
    decay_states = jnp.exp(a_cs[..., -1:] - a_cs)
    states = jnp.einsum('bcsgn,bgrcs,bcsgrp->bcgrpn', Bc, decay_states, x_dt)
    states = jnp.concatenate([jnp.zeros_like(states[:, :1]), states], axis=1)
    chunk_a = jnp.pad(a_cs[..., -1], ((0, 0), (0, 0), (0, 0), (1, 0)))
    decay_chunk = jnp.exp(segsum(chunk_a))
    new_states = jnp.einsum('bgrzc,bcgrpn->bzgrpn', decay_chunk, states)
    prev_states = new_states[:, :-1]
    y_off = jnp.einsum('bclgn,bcgrpn,bgrcl->bclgrp', Cc, prev_states, jnp.exp(a_cs))
    return (y_diag + y_off).reshape(b, l, h, p)


def hybrid_mixer(n, w_in, conv_ssd_w, conv_ssd_b, dt_bias, a_log, d_skip, ssd_norm_w,
                 conv_sc_w, w_out):
    bsz, L, _ = n.shape
    proj = n @ w_in.astype(n.dtype)
    s1 = D_SSD
    s2 = s1 + D_XBC
    s3 = s2 + SSD_HEADS
    s4 = s3 + D_SC
    s5 = s4 + D_SC
    z, xbc, dt_raw, sc_b, sc_c, sc_x = jnp.split(proj, [s1, s2, s3, s4, s5], axis=-1)

    xbc = jax.nn.silu(causal_dwconv(xbc, conv_ssd_w) + conv_ssd_b.astype(n.dtype))
    xs, Bm, Cm = jnp.split(xbc, [D_SSD, D_SSD + SSD_GROUPS * SSD_STATE], axis=-1)
    xs_h = xs.reshape(bsz, L, SSD_HEADS, SSD_HEAD_DIM)
    dt = jax.nn.softplus(dt_raw.astype(jnp.float32) + dt_bias.astype(jnp.float32))
    A = -jnp.exp(a_log.astype(jnp.float32))
    pad_len = SSD_CHUNK - N_META

    def lpad(t):
        return jnp.pad(t, ((0, 0), (pad_len, 0)) + ((0, 0),) * (t.ndim - 2))

    y = ssd_scan(lpad(xs_h.astype(jnp.float32)), lpad(dt), A,
                 lpad(Bm.reshape(bsz, L, SSD_GROUPS, SSD_STATE).astype(jnp.float32)),
                 lpad(Cm.reshape(bsz, L, SSD_GROUPS, SSD_STATE).astype(jnp.float32)))
    y = y[:, pad_len:] + d_skip.astype(jnp.float32)[:, None] * xs_h.astype(jnp.float32)
    y = y.reshape(bsz, L, D_SSD) * jax.nn.silu(z.astype(jnp.float32))
    y_ssd = rmsnorm(y.reshape(bsz, L, SSD_GROUPS, D_SSD // SSD_GROUPS),
                    ssd_norm_w.reshape(SSD_GROUPS, D_SSD // SSD_GROUPS))
    y_ssd = y_ssd.reshape(bsz, L, D_SSD).astype(n.dtype)

    y_sc = sc_b * causal_dwconv(sc_c * sc_x, conv_sc_w)

    return jnp.concatenate([y_ssd, y_sc], axis=-1) @ w_out.astype(n.dtype)


def peer_ffn(n, w_q, sub_keys, expert_u, expert_v):
    bsz, L, d = n.shape
    t = n.reshape(-1, d)
    T = t.shape[0]
    q = (t @ w_q.astype(n.dtype)).reshape(T, PEER_HEADS, 2, PEER_HALF)
    s = jnp.einsum('thsd,hskd->thsk', q, sub_keys.astype(n.dtype)).astype(jnp.float32)
    v_half, i_half = lax.top_k(s, PEER_TOPK)
    cand = (v_half[:, :, 0, :, None] + v_half[:, :, 1, None, :]).reshape(T, PEER_HEADS, PEER_TOPK * PEER_TOPK)
    best, pos = lax.top_k(cand, PEER_TOPK)
    i1 = jnp.take_along_axis(i_half[:, :, 0], pos // PEER_TOPK, axis=-1)
    i2 = jnp.take_along_axis(i_half[:, :, 1], pos % PEER_TOPK, axis=-1)
    experts = (i1 * PEER_KEYS + i2).reshape(T, PEER_HEADS * PEER_TOPK)
    gates = jax.nn.softmax(best, axis=-1).reshape(T, PEER_HEADS * PEER_TOPK).astype(n.dtype)

    nb = -(-T // PEER_BLOCK)
    padT = nb * PEER_BLOCK - T
    tp = jnp.pad(t, ((0, padT), (0, 0))).reshape(nb, PEER_BLOCK, d)
    ep = jnp.pad(experts, ((0, padT), (0, 0))).reshape(nb, PEER_BLOCK, -1)
    gp = jnp.pad(gates, ((0, padT), (0, 0))).reshape(nb, PEER_BLOCK, -1)

    def block(args):
        xb, eb, gb = args
        u = expert_u[eb].astype(xb.dtype)
        act = jax.nn.gelu(jnp.einsum('td,tkd->tk', xb, u), approximate=False) * gb
        return jnp.einsum('tk,tkd->td', act, expert_v[eb].astype(xb.dtype))

    out = lax.map(block, (tp, ep, gp))
    return out.reshape(-1, d)[:T].reshape(bsz, L, d)


def setup_inputs(seed: int = 0) -> dict:
    key = jax.random.key(seed)
    ks = jax.random.split(key, 20)

    def nrm(k, shape, scale):
        return jax.random.normal(k, shape, jnp.float32) * scale

    x = nrm(ks[0], (BATCH, SEQ, D_MODEL), 1.0)
    meta_tokens = nrm(ks[1], (N_META, D_MODEL), 1.0)
    g_mix = 1.0 + nrm(ks[2], (DEPTH, D_MODEL), 0.05)
    w_in = nrm(ks[3], (DEPTH, D_MODEL, D_IN), D_MODEL ** -0.5)
    conv_ssd_w = nrm(ks[4], (DEPTH, SSD_CONV, D_XBC), SSD_CONV ** -0.5)
    conv_ssd_b = nrm(ks[5], (DEPTH, D_XBC), 0.02)
    dt0 = jnp.exp(jax.random.uniform(ks[6], (DEPTH, SSD_HEADS), jnp.float32,
                                     minval=math.log(1e-3), maxval=math.log(1e-1)))
    dt_bias = dt0 + jnp.log(-jnp.expm1(-dt0))
    a_log = jnp.log(jax.random.uniform(ks[7], (DEPTH, SSD_HEADS), jnp.float32, minval=1.0, maxval=16.0))
    d_skip = 1.0 + nrm(ks[8], (DEPTH, SSD_HEADS), 0.05)
    ssd_norm_w = 1.0 + nrm(ks[9], (DEPTH, D_SSD), 0.05)
    conv_sc_w = nrm(ks[10], (DEPTH, SC_CONV, D_SC), SC_CONV ** -0.5)
    w_out = nrm(ks[11], (DEPTH, D_MIX, D_MODEL), D_MIX ** -0.5)
    g_ffn = 1.0 + nrm(ks[12], (DEPTH, D_MODEL), 0.05)
    w_q = nrm(ks[13], (DEPTH, D_MODEL, PEER_HEADS * PEER_QDIM), D_MODEL ** -0.5)
    sub_keys = nrm(ks[14], (DEPTH, PEER_HEADS, 2, PEER_KEYS, PEER_HALF), PEER_HALF ** -0.5)
    expert_u = nrm(ks[15], (DEPTH, PEER_EXPERTS, D_MODEL), D_MODEL ** -0.5)
    expert_v = nrm(ks[16], (DEPTH, PEER_EXPERTS, D_MODEL), PEER_HEADS ** -0.5)
    g_final = 1.0 + nrm(ks[17], (D_MODEL,), 0.05)
    return {"x": x, "meta_tokens": meta_tokens, "g_mix": g_mix, "w_in": w_in,
            "conv_ssd_w": conv_ssd_w, "conv_ssd_b": conv_ssd_b, "dt_bias": dt_bias,
            "a_log": a_log, "d_skip": d_skip, "ssd_norm_w": ssd_norm_w,
            "conv_sc_w": conv_sc_w, "w_out": w_out, "g_ffn": g_ffn, "w_q": w_q,
            "sub_keys": sub_keys, "expert_u": expert_u, "expert_v": expert_v,
            "g_final": g_final}


def reference(x, meta_tokens, g_mix, w_in, conv_ssd_w, conv_ssd_b, dt_bias, a_log, d_skip,
              ssd_norm_w, conv_sc_w, w_out, g_ffn, w_q, sub_keys, expert_u, expert_v, g_final):
    bsz = x.shape[0]
    meta = jnp.broadcast_to(meta_tokens[None].astype(x.dtype), (bsz, N_META, D_MODEL))
    h = jnp.concatenate([meta, x], axis=1)
    for l in range(DEPTH):
        h = h + hybrid_mixer(rmsnorm(h, g_mix[l]), w_in[l], conv_ssd_w[l], conv_ssd_b[l],
                             dt_bias[l], a_log[l], d_skip[l], ssd_norm_w[l], conv_sc_w[l], w_out[l])
        h = h + peer_ffn(rmsnorm(h, g_ffn[l]), w_q[l], sub_keys[l], expert_u[l], expert_v[l])
    h = rmsnorm(h, g_final)
    return h[:, N_META:]
```

```cpp
#include <hip/hip_runtime.h>
#include <cstdio>
#include <cstdint>

#define GAS __attribute__((address_space(1)))
#define LAS __attribute__((address_space(3)))
typedef unsigned short bf16_t;
typedef short bf16x8 __attribute__((ext_vector_type(8)));
typedef float f32x4 __attribute__((ext_vector_type(4)));
typedef float f32x2 __attribute__((ext_vector_type(2)));
typedef unsigned u32x4 __attribute__((ext_vector_type(4)));
typedef unsigned u32x2 __attribute__((ext_vector_type(2)));

constexpr int D = 1024, BATCH = 16, SEQ = 2048, NMETA = 16, LSEQ = SEQ + NMETA;
constexpr int TR = BATCH * SEQ;
constexpr int ROWS_A = 33024;
constexpr int D_SSD = 1536, HEADS = 24, HD = 64, NG = 4, NS = 128, D_XBC = 2560, D_SC = 512, D_IN = 5656, D_MIX = 2048;
constexpr int LDP = 5888;
constexpr int C_Z = 0, C_SCB = 1536, C_XBC = 2048, C_SCC = 4608, C_SCX = 5120, C_DT = 5632;
constexpr int PH = 8, PK = 128, PTOP = 16, PQ = 2048;
constexpr float EPS = 1e-6f;

__host__ __device__ constexpr int proj_src_col(int j) {
    return j < 1536 ? j : j < 2048 ? 4120 + (j - 1536) : j < 4608 ? 1536 + (j - 2048) : j < 5120 ? 4632 + (j - 4608) : j < 5632 ? 5144 + (j - 5120) : j < 5656 ? 4096 + (j - 5632) : -1;
}

constexpr size_t MiB = 1u << 20;
constexpr size_t WS_CTL = 0, CTL_ZERO_BYTES = 1 * MiB;
constexpr size_t WS_WIN = 1 * MiB;
constexpr size_t WS_WOUT = 13 * MiB;
constexpr size_t WS_WQ = 17 * MiB;
constexpr size_t WS_XN = 22 * MiB;
constexpr size_t WS_PROJ = 88 * MiB;
constexpr size_t WS_Q = WS_PROJ;
constexpr size_t WS_EIDX = WS_PROJ + 128 * MiB;
constexpr size_t WS_GATE = WS_PROJ + 144 * MiB;
constexpr size_t WS_UB = WS_PROJ + 160 * MiB;
constexpr size_t WS_U8 = WS_PROJ + 160 * MiB;
constexpr size_t WS_V8 = WS_PROJ + 192 * MiB;
constexpr size_t WS_ACT = WS_PROJ + 208 * MiB;
constexpr size_t WS_SU = WS_PROJ + 224 * MiB;
constexpr size_t WS_SV = WS_PROJ + 224 * MiB + 65536;
constexpr size_t WS_U8F = WS_PROJ + 226 * MiB;
constexpr size_t WS_VB = WS_PROJ + 192 * MiB;
constexpr size_t WS_END = WS_PROJ + (size_t)ROWS_A * LDP * 2;
static_assert(WS_VB + 32 * MiB <= WS_END, "ws map");
static_assert(WS_XN + (size_t)ROWS_A * D * 2 <= WS_PROJ, "ws map");
static_assert(WS_END <= 512 * MiB, "ws map");

__device__ __forceinline__ unsigned f2bf(float f) { unsigned u = __builtin_bit_cast(unsigned, f); return (u + 0x7fffu + ((u >> 16) & 1u)) >> 16; }
__device__ __forceinline__ unsigned pk2(float lo, float hi) { return f2bf(lo) | (f2bf(hi) << 16); }
__device__ __forceinline__ float bf2f(unsigned short b) { return __builtin_bit_cast(float, ((unsigned)b) << 16); }
__device__ __forceinline__ float bflo(unsigned w) { return __builtin_bit_cast(float, w << 16); }
__device__ __forceinline__ float bfhi(unsigned w) { return __builtin_bit_cast(float, w & 0xffff0000u); }
template <int CTRL> __device__ __forceinline__ float dppf0(float x) { return __builtin_bit_cast(float, __builtin_amdgcn_update_dpp(0, __builtin_bit_cast(int, x), CTRL, 0xF, 0xF, true)); }
__device__ __forceinline__ void swap32_self(unsigned u, unsigned& lo_lo, unsigned& hi_hi) { unsigned u2 = u; asm volatile("" : "+v"(u2)); auto r = __builtin_amdgcn_permlane32_swap(u, u2, false, false); lo_lo = r[0]; hi_hi = r[1]; }
__device__ __forceinline__ void swap16_self(unsigned u, unsigned& even2, unsigned& odd2) { unsigned u2 = u; asm volatile("" : "+v"(u2)); auto r = __builtin_amdgcn_permlane16_swap(u, u2, false, false); even2 = r[0]; odd2 = r[1]; }
__device__ __forceinline__ float wave_sum(float v) {
    v += dppf0<0xB1>(v); v += dppf0<0x4E>(v); v += dppf0<0x141>(v); v += dppf0<0x140>(v);
    unsigned p, q; swap16_self(__builtin_bit_cast(unsigned, v), p, q); v = __builtin_bit_cast(float, p) + __builtin_bit_cast(float, q);
    swap32_self(__builtin_bit_cast(unsigned, v), p, q); v = __builtin_bit_cast(float, p) + __builtin_bit_cast(float, q);
    return v;
}
__device__ __forceinline__ int row_of(int b, int pos) { return pos < NMETA ? TR + pos : b * SEQ + (pos - NMETA); }

namespace pg8 {
#define PG8_LAS __attribute__((address_space(3)))
constexpr int BM = 256, BK = 64, HALF = 128, HTB = HALF * BK * 2  , STAGE_BYTES = 8 * HTB, NXCD = 8, WGM = 8;
__host__ __device__ __forceinline__ int perm32(int rho) { const int n = rho >> 4, i = rho & 15; return 8 * (i >> 2) + 4 * n + (i & 3); }
__host__ __device__ __forceinline__ int lds_byte(int r, int c) { const int st = (r >> 4) * 2 + (c >> 5), rr = r & 15, cc = c & 31, ob = rr * 64 + cc * 2; return st * 1024 + (ob ^ (((ob >> 9) & 1) << 5)); }
__host__ __device__ __forceinline__ void stage_rc(int b, int& R, int& C) { const int st = b / 1024, sb = b % 1024, swz = sb ^ (((sb >> 9) & 1) << 5); R = (st >> 1) * 16 + swz / 64; C = (st & 1) * 32 + (swz % 64) / 2; }
struct Unit { int pm, pn; };
struct Gemm { const bf16_t* A; const bf16_t* Bt; int M, N, K, lda, ldb; };
struct StaticOrder {
    int nM, nN, nwg, G, c;
    __host__ __device__ void init(int M, int N, int G_, int c_) { nM = M / BM; nN = N / BM; nwg = nM * nN; G = G_; c = c_; }
    __host__ __device__ bool next(int i, Unit& u) const {
        const long L = (long)i * G + c; if (L >= nwg) return false;
        int wgid = (int)L; { const int q = nwg / NXCD, r = nwg % NXCD, xcd = wgid % NXCD, off = wgid / NXCD; wgid = (xcd < r ? xcd * (q + 1) : r * (q + 1) + (xcd - r) * q) + off; }
        const int nig = WGM * nN, gid = wgid / nig, fm = gid * WGM, gsz = (nM - fm) < WGM ? (nM - fm) : WGM;
        u.pm = fm + ((wgid % nig) % gsz); u.pn = (wgid % nig) / gsz; return true;
    }
    __device__ __forceinline__ void a_ready(const Unit&) const {}
    __device__ __forceinline__ void done(const Unit&) const {}
};
struct EpiBf16 {
    static constexpr bool PERM = true, AFTER_DRAIN = false;
    bf16_t* O; int ldc;
    __device__ __forceinline__ void operator()(const f32x4 (&acc)[2][2][4][2], const Unit& u, int wr, int wc, int fr, int fq) const {
        const int row0 = u.pm * BM + wr * 64 + fr, col0 = u.pn * BM + wc * 32 + 8 * fq;
#pragma unroll
        for (int ai = 0; ai < 2; ++ai)
#pragma unroll
            for (int m = 0; m < 4; ++m) { bf16_t* rowp = O + (size_t)(row0 + ai * HALF + m * 16) * ldc + col0;
#pragma unroll
                for (int bj = 0; bj < 2; ++bj) { const f32x4 v0 = acc[ai][bj][m][0], v1 = acc[ai][bj][m][1];
                    u32x4 w; w.x = pk2(v0[0], v0[1]); w.y = pk2(v0[2], v0[3]); w.z = pk2(v1[0], v1[1]); w.w = pk2(v1[2], v1[3]);
                    *(u32x4*)(rowp + bj * HALF) = w; } }
    }
};
struct EpiResF32 {
    static constexpr bool PERM = false, AFTER_DRAIN = false;
    const float* base; float* C; int ldc;
    __device__ __forceinline__ void operator()(const f32x4 (&acc)[2][2][4][2], const Unit& u, int wr, int wc, int fr, int fq) const {
        const int row0 = u.pm * BM + wr * 64 + fr, col0 = u.pn * BM + wc * 32 + 4 * fq;
#pragma unroll
        for (int ai = 0; ai < 2; ++ai)
#pragma unroll
            for (int m = 0; m < 4; ++m) { const size_t off = (size_t)(row0 + ai * HALF + m * 16) * ldc + col0;
#pragma unroll
                for (int bj = 0; bj < 2; ++bj)
#pragma unroll
                    for (int n = 0; n < 2; ++n) { const f32x4 bs = *(const f32x4*)(base + off + bj * HALF + n * 16); *(f32x4*)(C + off + bj * HALF + n * 16) = bs + acc[ai][bj][m][n]; } }
    }
};
template <class Epi, class Sched, bool ALIGN_EPI = false, bool SP2 = false>
__device__ __forceinline__ void gemm_phase(PG8_LAS unsigned char* lds, const Gemm g, const Sched& S, const Epi& E) {
    const int tid = threadIdx.x, wid = __builtin_amdgcn_readfirstlane(tid >> 6), lane = tid & 63, wr = wid >> 2, wc = wid & 3, fr = lane & 15, fq = lane >> 4;
    const int K = g.K, nt = K / BK;
    unsigned voffA[2], voffB[2];
#pragma unroll
    for (int i = 0; i < 2; ++i) { int R, C; stage_rc(tid * 16 + i * 8192, R, C); const int Rb = Epi::PERM ? ((R & ~31) + perm32(R & 31)) : R;
        voffA[i] = (unsigned)(R * g.lda + C) * 2u; voffB[i] = (unsigned)(Rb * g.ldb + C) * 2u; }
    const size_t kstep = (size_t)(BK * 2);
    const size_t hstepA = (size_t)HALF * g.lda * 2, hstepB = (size_t)HALF * g.ldb * 2;
    const size_t tstepA = 2 * hstepA, tstepB = 2 * hstepB;
    const unsigned ldsw = (unsigned)wid * 1024u;
    const int aoff = lds_byte(wr * 64 + fr, fq * 8), boff = lds_byte(wc * 32 + fr, fq * 8);
#define PG8_SA(b, h) (((b) * 2 + (h)) * HTB)
#define PG8_SB(b, h) ((4 + (b) * 2 + (h)) * HTB)
#define PG8_STAGE(bufoff, gbase, voff) do { _Pragma("unroll") for (int _i = 0; _i < 2; ++_i) \
        __builtin_amdgcn_global_load_lds((const unsigned*)((const char*)(gbase) + (voff)[_i]), (PG8_LAS unsigned*)(lds + (bufoff) + ldsw + _i * 8192), 16, 0, 0); } while (0)
#define PG8_LDA(dst, b, h) do { _Pragma("unroll") for (int m = 0; m < 4; ++m) _Pragma("unroll") for (int k = 0; k < 2; ++k) dst[m][k] = *(const PG8_LAS bf16x8*)(lds + PG8_SA(b, h) + aoff + m * 2048 + k * 1024); } while (0)
#define PG8_LDB(dst, b, h) do { _Pragma("unroll") for (int n = 0; n < 2; ++n) _Pragma("unroll") for (int k = 0; k < 2; ++k) dst[n][k] = *(const PG8_LAS bf16x8*)(lds + PG8_SB(b, h) + boff + n * 2048 + k * 1024); } while (0)
#define PG8_MMA(ai, bj, At, Bt) do { __builtin_amdgcn_s_setprio(1); _Pragma("unroll") for (int m = 0; m < 4; ++m) _Pragma("unroll") for (int n = 0; n < 2; ++n) _Pragma("unroll") for (int k = 0; k < 2; ++k) \
        acc[ai][bj][m][n] = __builtin_amdgcn_mfma_f32_16x16x32_bf16(Bt[n][k], At[m][k], acc[ai][bj][m][n], 0, 0, 0); __builtin_amdgcn_s_setprio(0); } while (0)
#define PG8_WAIT_V(n) asm volatile("s_waitcnt vmcnt(" #n ")" ::: "memory")
#define PG8_WAIT_L(n) asm volatile("s_waitcnt lgkmcnt(" #n ")" ::: "memory")
#define PG8_BAR __builtin_amdgcn_s_barrier()
#define PG8_SCHED __builtin_amdgcn_sched_barrier(0)
    Unit cur, nxt; int ui = 0;
    if (!S.next(0, cur)) return;
    f32x4 acc[2][2][4][2];
#pragma unroll
    for (int a = 0; a < 2; ++a)
#pragma unroll
        for (int b = 0; b < 2; ++b)
#pragma unroll
            for (int m = 0; m < 4; ++m)
#pragma unroll
                for (int n = 0; n < 2; ++n) acc[a][b][m][n] = (f32x4){0.f, 0.f, 0.f, 0.f};
    bf16x8 At[4][2], B0[2][2], B1[2][2];
    const char* cA = (const char*)g.A + (size_t)cur.pm * tstepA; const char* cB = (const char*)g.Bt + (size_t)cur.pn * tstepB;
    S.a_ready(cur);
    if constexpr (SP2) {
        PG8_STAGE(PG8_SB(0, 0), cB, voffB); PG8_STAGE(PG8_SB(0, 1), cB + hstepB, voffB); PG8_STAGE(PG8_SA(0, 0), cA, voffA); PG8_STAGE(PG8_SA(0, 1), cA + hstepA, voffA);
        if (wr == 1) PG8_BAR;
        PG8_WAIT_V(2); PG8_BAR;
        PG8_STAGE(PG8_SB(1, 0), cB + kstep, voffB); PG8_STAGE(PG8_SA(1, 0), cA + kstep, voffA); PG8_STAGE(PG8_SB(1, 1), cB + hstepB + kstep, voffB);
        PG8_WAIT_V(6); PG8_BAR;
    } else {
        PG8_STAGE(PG8_SB(0, 0), cB, voffB); PG8_STAGE(PG8_SA(0, 0), cA, voffA); PG8_STAGE(PG8_SB(0, 1), cB + hstepB, voffB); PG8_STAGE(PG8_SA(0, 1), cA + hstepA, voffA);
        if (wr == 1) PG8_BAR;
        PG8_WAIT_V(4); PG8_BAR;
        PG8_STAGE(PG8_SB(1, 0), cB + kstep, voffB); PG8_STAGE(PG8_SA(1, 0), cA + kstep, voffA); PG8_STAGE(PG8_SB(1, 1), cB + hstepB + kstep, voffB);
        PG8_WAIT_V(6); PG8_BAR;
    }
    for (;;) {
        const bool has_next = S.next(ui + 1, nxt);
        const char* nA = has_next ? (const char*)g.A + (size_t)nxt.pm * tstepA : cA; const char* nB = has_next ? (const char*)g.Bt + (size_t)nxt.pn * tstepB : cB;
        for (int t = 0; t < nt; t += 2) {
            const bool last = (t == nt - 2);
            const char* a1 = cA + (size_t)(t + 1) * kstep;
            const char* a2 = last ? nA : cA + (size_t)(t + 2) * kstep; const char* b2 = last ? nB : cB + (size_t)(t + 2) * kstep;
            const char* a3 = a2 + kstep; const char* b3 = b2 + kstep;
            if (last && has_next) S.a_ready(nxt);
            if constexpr (SP2) {
            PG8_LDB(B0, 0, 0); PG8_LDB(B1, 0, 1); PG8_SCHED; PG8_LDA(At, 0, 0); PG8_STAGE(PG8_SA(1, 1), a1 + hstepA, voffA);
            PG8_WAIT_V(8); PG8_WAIT_L(0); PG8_BAR; PG8_MMA(0, 0, At, B0); PG8_MMA(0, 1, At, B1); PG8_BAR; PG8_SCHED;
            PG8_LDA(At, 0, 1); PG8_STAGE(PG8_SB(0, 0), b2, voffB); PG8_STAGE(PG8_SB(0, 1), b2 + hstepB, voffB); PG8_STAGE(PG8_SA(0, 0), a2, voffA);
            PG8_WAIT_V(8); PG8_WAIT_L(0); PG8_BAR; PG8_MMA(1, 0, At, B0); PG8_MMA(1, 1, At, B1); PG8_BAR; PG8_SCHED;
            PG8_LDB(B0, 1, 0); PG8_LDB(B1, 1, 1); PG8_SCHED; PG8_LDA(At, 1, 0); PG8_STAGE(PG8_SA(0, 1), a2 + hstepA, voffA);
            PG8_WAIT_V(8); PG8_WAIT_L(0); PG8_BAR; PG8_MMA(0, 0, At, B0); PG8_MMA(0, 1, At, B1); PG8_BAR; PG8_SCHED;
            PG8_LDA(At, 1, 1); PG8_STAGE(PG8_SB(1, 0), b3, voffB); PG8_STAGE(PG8_SB(1, 1), b3 + hstepB, voffB); PG8_STAGE(PG8_SA(1, 0), a3, voffA);
            PG8_WAIT_V(8); PG8_WAIT_L(0); PG8_BAR; PG8_MMA(1, 0, At, B0); PG8_MMA(1, 1, At, B1); PG8_BAR; PG8_SCHED;
            } else {
            PG8_LDB(B0, 0, 0); PG8_SCHED; PG8_LDA(At, 0, 0); PG8_STAGE(PG8_SA(1, 1), a1 + hstepA, voffA);
            PG8_WAIT_L(8); PG8_BAR; PG8_WAIT_L(0); PG8_MMA(0, 0, At, B0); PG8_BAR; PG8_SCHED;
            PG8_LDB(B1, 0, 1); PG8_STAGE(PG8_SB(0, 0), b2, voffB);
            PG8_BAR; PG8_WAIT_L(0); PG8_MMA(0, 1, At, B1); PG8_BAR;
            PG8_LDA(At, 0, 1); PG8_STAGE(PG8_SA(0, 0), a2, voffA);
            PG8_BAR; PG8_WAIT_L(0); PG8_MMA(1, 0, At, B0); PG8_BAR; PG8_SCHED;
            PG8_STAGE(PG8_SB(0, 1), b2 + hstepB, voffB);
            PG8_WAIT_V(6); PG8_BAR; PG8_MMA(1, 1, At, B1); PG8_BAR;
            PG8_LDB(B0, 1, 0); PG8_SCHED; PG8_LDA(At, 1, 0); PG8_STAGE(PG8_SA(0, 1), a2 + hstepA, voffA);
            PG8_WAIT_L(8); PG8_BAR; PG8_WAIT_L(0); PG8_MMA(0, 0, At, B0); PG8_BAR; PG8_SCHED;
            PG8_LDB(B1, 1, 1); PG8_STAGE(PG8_SB(1, 0), b3, voffB);
            PG8_BAR; PG8_WAIT_L(0); PG8_MMA(0, 1, At, B1); PG8_BAR;
            PG8_LDA(At, 1, 1); PG8_STAGE(PG8_SA(1, 0), a3, voffA);
            PG8_BAR; PG8_WAIT_L(0); PG8_MMA(1, 0, At, B0); PG8_BAR; PG8_SCHED;
            PG8_STAGE(PG8_SB(1, 1), b3 + hstepB, voffB);
            PG8_WAIT_V(6); PG8_BAR; PG8_MMA(1, 1, At, B1); PG8_BAR;
            }
        }
        if constexpr (ALIGN_EPI) { if (wr == 0) PG8_BAR; }
        if constexpr (!Epi::AFTER_DRAIN) { E(acc, cur, wr, wc, fr, fq); S.done(cur); }
        if (!has_next) break;
#pragma unroll
        for (int a = 0; a < 2; ++a)
#pragma unroll
            for (int b = 0; b < 2; ++b)
#pragma unroll
                for (int m = 0; m < 4; ++m)
#pragma unroll
                    for (int n = 0; n < 2; ++n) acc[a][b][m][n] = (f32x4){0.f, 0.f, 0.f, 0.f};
        cur = nxt; cA = nA; cB = nB; ++ui;
        if constexpr (ALIGN_EPI) { if (wr == 1) PG8_BAR; }
    }
    PG8_WAIT_V(0);
    if constexpr (!ALIGN_EPI) { if (wr == 0) PG8_BAR; }
    PG8_BAR;
    if constexpr (Epi::AFTER_DRAIN) { E.fused(acc, cur, wr, wc, fr, fq, lds, wid, lane); S.done(cur); }
#undef PG8_SA
#undef PG8_SB
#undef PG8_STAGE
#undef PG8_LDA
#undef PG8_LDB
#undef PG8_MMA
#undef PG8_WAIT_V
#undef PG8_WAIT_L
#undef PG8_BAR
#undef PG8_SCHED
}

template <class Epi>
__device__ __forceinline__ void gemm_simple(const Gemm g, const StaticOrder& S, const Epi& E) {
    const int tid = threadIdx.x, wid = __builtin_amdgcn_readfirstlane(tid >> 6), lane = tid & 63, wr = wid >> 2, wc = wid & 3, fr = lane & 15, fq = lane >> 4;
    Unit u;
    for (int i = 0; S.next(i, u); ++i) {
        f32x4 acc[2][2][4][2];
#pragma unroll
        for (int a = 0; a < 2; ++a)
#pragma unroll
            for (int b = 0; b < 2; ++b)
#pragma unroll
                for (int m = 0; m < 4; ++m)
#pragma unroll
                    for (int n = 0; n < 2; ++n) acc[a][b][m][n] = (f32x4){0.f, 0.f, 0.f, 0.f};
        const bf16_t* Ab = g.A + (size_t)(u.pm * BM + wr * 64 + fr) * g.lda + fq * 8;
        const bf16_t* Bb = g.Bt + (size_t)(u.pn * BM + wc * 32) * g.ldb + fq * 8;
        int brow[2];
#pragma unroll
        for (int n = 0; n < 2; ++n) brow[n] = Epi::PERM ? perm32(16 * n + fr) : (16 * n + fr);
        for (int k0 = 0; k0 < g.K; k0 += 32) {
            bf16x8 Af[2][4], Bf[2][2];
#pragma unroll
            for (int ai = 0; ai < 2; ++ai)
#pragma unroll
                for (int m = 0; m < 4; ++m) Af[ai][m] = *(const bf16x8*)(Ab + (size_t)(ai * HALF + m * 16) * g.lda + k0);
#pragma unroll
            for (int bj = 0; bj < 2; ++bj)
#pragma unroll
                for (int n = 0; n < 2; ++n) Bf[bj][n] = *(const bf16x8*)(Bb + (size_t)(bj * HALF + brow[n]) * g.ldb + k0);
#pragma unroll
            for (int ai = 0; ai < 2; ++ai)
#pragma unroll
                for (int bj = 0; bj < 2; ++bj)
#pragma unroll
                    for (int m = 0; m < 4; ++m)
#pragma unroll
                        for (int n = 0; n < 2; ++n) acc[ai][bj][m][n] = __builtin_amdgcn_mfma_f32_16x16x32_bf16(Bf[bj][n], Af[ai][m], acc[ai][bj][m][n], 0, 0, 0);
        }
        E(acc, u, wr, wc, fr, fq);
    }
}
}

#define XB_TMO      128
#define XB_XCNT(j)  (256  + 64 * (j))
#define XB_XSUB(j)  (1280 + 64 * (j))
#define XB_XGEN(j)  (2304 + 64 * (j))
#define XB_TOP      3328
#define XB_TOPGEN   3392
#define XCD_BAR_WORDS 3456
#define XB_SPIN_CAP (1u << 18)
__device__ __forceinline__ unsigned xb_ld(unsigned* p)              { return __hip_atomic_load(p, __ATOMIC_RELAXED, __HIP_MEMORY_SCOPE_AGENT); }
__device__ __forceinline__ unsigned xb_add(unsigned* p, unsigned v) { return __hip_atomic_fetch_add(p, v, __ATOMIC_RELAXED, __HIP_MEMORY_SCOPE_AGENT); }
__device__ __forceinline__ unsigned xb_xcc_id() { return (unsigned)__builtin_amdgcn_s_getreg((3 << 11) | 20) & 0xFu; }
#define XB_SPIN(cond, bar) do { unsigned _sp = 0; while (cond) { __builtin_amdgcn_s_sleep(1); \
    if ((++_sp & 255u) == 0u) { if (xb_ld(&(bar)[XB_TMO])) break; if (_sp > XB_SPIN_CAP) { atomicAdd(&(bar)[XB_TMO], 1u); break; } } } } while (0)
struct XcdBarrier { unsigned* bar; unsigned x; volatile LAS unsigned* st; };
__device__ __forceinline__ XcdBarrier xcd_barrier_post(unsigned* bar, volatile LAS unsigned* st) {
    XcdBarrier b; b.bar = bar; b.x = xb_xcc_id(); b.st = st;
    if (threadIdx.x == 0) (void)xb_add(&bar[XB_XCNT(b.x)], 1u);
    return b;
}
__device__ __forceinline__ void xcd_barrier_complete(unsigned* bar, unsigned x, unsigned& nloc, unsigned& nx) {
    const unsigned G = gridDim.x * gridDim.y * gridDim.z;
    unsigned sum, cnt, mine, sp = 0u;
    for (;;) {
        sum = 0u; cnt = 0u; mine = 0u;
#pragma unroll
        for (unsigned j = 0; j < 16; ++j) { const unsigned c = xb_ld(&bar[XB_XCNT(j)]); sum += c; cnt += (c > 0u) ? 1u : 0u; mine = (j == x) ? c : mine; }
        if (sum == G) break;
        __builtin_amdgcn_s_sleep(1);
        if ((++sp & 255u) == 0u) { if (xb_ld(&bar[XB_TMO])) break; if (sp > XB_SPIN_CAP) { atomicAdd(&bar[XB_TMO], 1u); break; } }
    }
    nloc = mine > 0u ? mine : 1u; nx = cnt > 0u ? cnt : 1u;
}
__device__ __forceinline__ void xcd_barrier(const XcdBarrier& b) {
    asm volatile("s_waitcnt vmcnt(0)" ::: "memory");
    __syncthreads();
    if (threadIdx.x == 0) {
        unsigned* bar = b.bar;
        __builtin_amdgcn_s_waitcnt(0);
        unsigned nloc = b.st[0], nx = b.st[1];
        if (nloc == 0u) { xcd_barrier_complete(bar, b.x, nloc, nx); b.st[0] = nloc; b.st[1] = nx; }
        const unsigned old = xb_add(&bar[XB_XSUB(b.x)], 1u);
        const unsigned gen = old / nloc;
        if (old + 1u == (gen + 1u) * nloc) {
            __builtin_amdgcn_fence(__ATOMIC_RELEASE, "agent");
            asm volatile("s_waitcnt vmcnt(0)" ::: "memory");
            const unsigned og = xb_add(&bar[XB_TOP], 1u);
            const unsigned tg = og / nx;
            if (og + 1u == (tg + 1u) * nx) xb_add(&bar[XB_TOPGEN], 1u);
            else XB_SPIN(xb_ld(&bar[XB_TOPGEN]) == tg, bar);
            __builtin_amdgcn_fence(__ATOMIC_ACQUIRE, "agent");
            xb_add(&bar[XB_XGEN(b.x)], 1u);
            asm volatile("s_waitcnt vmcnt(0)" ::: "memory");
        } else {
            XB_SPIN(xb_ld(&bar[XB_XGEN(b.x)]) == gen, bar);
            __builtin_amdgcn_fence(__ATOMIC_ACQUIRE, "agent");
            asm volatile("s_waitcnt vmcnt(0)" ::: "memory");
        }
    }
    __syncthreads();
}

#ifndef PROBE_S3
#define PROBE_S3 0
#endif
#ifndef PROBE_P9
#define PROBE_P9 0
#endif
#ifndef PEER_SLICED
#define PEER_SLICED 4
#endif
#ifndef P9_ALIGN
#define P9_ALIGN 0
#endif
#ifndef USE_PG8
#define USE_PG8 1
#endif
constexpr int NWAVES = 8, NTHREADS = 512;
constexpr int NPHASE = 10;
#ifndef MK_N_LAUNCHES
#define MK_N_LAUNCHES 1
#endif
constexpr int N_LAUNCHES = MK_N_LAUNCHES;
constexpr int RING_BYTES = 131072, LDS_BYTES = 163840, LDSCTL_OFF = LDS_BYTES - 256;
constexpr int CW_BAR = 4096;

struct Args {
    const float *x, *meta, *g_mix, *w_in, *conv_ssd_w, *conv_ssd_b, *dt_bias, *a_log, *d_skip, *ssd_norm_w, *conv_sc_w, *w_out, *g_ffn, *w_q, *sub_keys, *expert_u, *expert_v, *g_final;
    float* out; unsigned char* ws; int ph_lo, ph_hi;
};
struct Frame { LAS unsigned char* lds; int tid, lane, wave, G, vcu; };

template <class ColMap>
__device__ __forceinline__ void p0_transpose_item(const float* W, int K, int N, bf16_t* WT, int nblk, LAS float* scr, int item, int lane, ColMap cm) {
    const int kb = item / nblk, nb = item % nblk, k0 = 64 * kb, n0 = 32 * nb;
    const int sc = cm(n0 + (lane & 31));
#pragma unroll 8
    for (int i = 0; i < 32; ++i) { const int kk = 2 * i + (lane >> 5); scr[kk * 33 + (lane & 31)] = sc >= 0 ? W[(size_t)(k0 + kk) * N + sc] : 0.f; }
    asm volatile("s_waitcnt lgkmcnt(0)" ::: "memory");
    const int c = lane & 7;
#pragma unroll
    for (int j = 0; j < 4; ++j) { const int n = (lane >> 3) + 8 * j; const LAS float* s = scr + (8 * c) * 33 + n;
        u32x4 o; o.x = pk2(s[0 * 33], s[1 * 33]); o.y = pk2(s[2 * 33], s[3 * 33]); o.z = pk2(s[4 * 33], s[5 * 33]); o.w = pk2(s[6 * 33], s[7 * 33]);
        *(u32x4*)(WT + (size_t)(n0 + n) * K + k0 + 8 * c) = o; }
    asm volatile("s_waitcnt lgkmcnt(0)" ::: "memory");
}
__device__ __forceinline__ void p0_prologue(const Frame& F, const Args& a) {
    LAS float* scr = (LAS float*)(F.lds + F.wave * 16384);
    const int gw = F.vcu * NWAVES + F.wave, NGW = F.G * NWAVES;
    bf16_t* WinT = (bf16_t*)(a.ws + WS_WIN); bf16_t* WoutT = (bf16_t*)(a.ws + WS_WOUT); bf16_t* WqT = (bf16_t*)(a.ws + WS_WQ); bf16_t* XN = (bf16_t*)(a.ws + WS_XN);
    constexpr int I_IN = (D / 64) * (LDP / 32), I_OUT = (D_MIX / 64) * (D / 32), I_Q = (D / 64) * (PQ / 32);
    for (int it = gw; it < I_IN + I_OUT + I_Q; it += NGW) {
        int r = it;
        if (r < I_IN) { p0_transpose_item(a.w_in, D, D_IN, WinT, LDP / 32, scr, r, F.lane, [](int j) { return proj_src_col(j); }); continue; } r -= I_IN;
        if (r < I_OUT) { p0_transpose_item(a.w_out, D_MIX, D, WoutT, D / 32, scr, r, F.lane, [](int j) { return j; }); continue; } r -= I_OUT;
        p0_transpose_item(a.w_q, D, PQ, WqT, PQ / 32, scr, r, F.lane, [](int j) { return j; });
    }
    for (int m = gw; m < ROWS_A; m += NGW) {
        u32x2* o8 = (u32x2*)(XN + (size_t)m * D) + F.lane;
        if (m >= TR + NMETA) {
#pragma unroll
            for (int j = 0; j < 4; ++j) o8[64 * j] = (u32x2){0u, 0u};
            continue; }
        const float* src = m < TR ? a.x + (size_t)m * D : a.meta + (size_t)(m - TR) * D;
        const f32x4* xr = (const f32x4*)src + F.lane; const f32x4* gr = (const f32x4*)a.g_mix + F.lane;
        f32x4 v[4]; float s = 0.f;
#pragma unroll
        for (int j = 0; j < 4; ++j) { v[j] = xr[64 * j]; s += (v[j].x * v[j].x + v[j].y * v[j].y) + (v[j].z * v[j].z + v[j].w * v[j].w); }
        const float rstd = 1.0f / sqrtf(wave_sum(s) * (1.f / D) + EPS);
#pragma unroll
        for (int j = 0; j < 4; ++j) { const f32x4 gg = gr[64 * j]; o8[64 * j] = (u32x2){pk2(v[j].x * rstd * gg.x, v[j].y * rstd * gg.y), pk2(v[j].z * rstd * gg.z, v[j].w * rstd * gg.w)}; }
    }
}

typedef float f32x16 __attribute__((ext_vector_type(16)));
constexpr int PITCH = 136;
constexpr int SL_C = 0, SL_B = 34816, SL_M0 = 69632, SL_X = 104448, SL_DT = 139264, SL_ACS = 142336;
constexpr int YPITCH = 396;
static_assert(SL_B + 128 * YPITCH * 2 <= SL_DT, "staging fits below dt/acs");
constexpr size_t WS_DAT = WS_XN;
constexpr size_t WS_SMETA = WS_XN + 65536;

__device__ __forceinline__ f32x16 mfma32(bf16x8 a, bf16x8 b, f32x16 c) { return __builtin_amdgcn_mfma_f32_32x32x16_bf16(a, b, c, 0, 0, 0); }
__device__ __forceinline__ float silu_f(float v) { return v / (1.f + __expf(-v)); }

struct ConvIn { unsigned raw[11]; };
__device__ __forceinline__ void conv8x2_load(ConvIn& ci, const bf16_t* PROJ, const Args& a, int b, int pos0, int ch) {
#pragma unroll
    for (int i = 0; i < 11; ++i) { const int pos = pos0 - 3 + i; unsigned v = 0u;
        if (pos >= 0) v = *(const unsigned*)(PROJ + (size_t)row_of(b, pos) * LDP + C_XBC + ch);
        ci.raw[i] = v; }
}
__device__ __forceinline__ void conv8x2_calc(const ConvIn& ci, const Args& a, int ch, float (&o)[8][2]) {
    float w[4][2], cb[2];
#pragma unroll
    for (int j = 0; j < 2; ++j) { cb[j] = a.conv_ssd_b[ch + j];
#pragma unroll
        for (int wi = 0; wi < 4; ++wi) w[wi][j] = a.conv_ssd_w[wi * D_XBC + ch + j]; }
#pragma unroll
    for (int s = 0; s < 8; ++s) {
        o[s][0] = silu_f(cb[0] + w[0][0] * bflo(ci.raw[s]) + w[1][0] * bflo(ci.raw[s + 1]) + w[2][0] * bflo(ci.raw[s + 2]) + w[3][0] * bflo(ci.raw[s + 3]));
        o[s][1] = silu_f(cb[1] + w[0][1] * bfhi(ci.raw[s]) + w[1][1] * bfhi(ci.raw[s + 1]) + w[2][1] * bfhi(ci.raw[s + 2]) + w[3][1] * bfhi(ci.raw[s + 3])); }
}
__device__ __forceinline__ void conv8x2(const bf16_t* PROJ, const Args& a, int b, int pos0, int ch, float (&o)[8][2]) { ConvIn ci; conv8x2_load(ci, PROJ, a, b, pos0, ch); conv8x2_calc(ci, a, ch, o); }

template <int NP> struct ConvW { u32x4 raw[NP + 3]; };
template <int NP> __device__ __forceinline__ void convw_load(ConvW<NP>& ci, const bf16_t* PROJ, int b, int pos0, int ch) {
#pragma unroll
    for (int i = 0; i < NP + 3; ++i) { const int pos = pos0 - 3 + i; u32x4 v = (u32x4){0u, 0u, 0u, 0u};
        if (pos >= 0) v = *(const u32x4*)(PROJ + (size_t)row_of(b, pos) * LDP + C_XBC + ch);
        ci.raw[i] = v; }
}
struct ConvWt { f32x4 w[4][2], cb[2]; };
__device__ __forceinline__ void convw_weights(ConvWt& cw, const Args& a, int ch) {
    cw.cb[0] = *(const f32x4*)(a.conv_ssd_b + ch); cw.cb[1] = *(const f32x4*)(a.conv_ssd_b + ch + 4);
#pragma unroll
    for (int wi = 0; wi < 4; ++wi) { cw.w[wi][0] = *(const f32x4*)(a.conv_ssd_w + wi * D_XBC + ch); cw.w[wi][1] = *(const f32x4*)(a.conv_ssd_w + wi * D_XBC + ch + 4); }
}
__device__ __forceinline__ float bfel(const u32x4& v, int c) { const unsigned w = (c >> 1) == 0 ? v.x : (c >> 1) == 1 ? v.y : (c >> 1) == 2 ? v.z : v.w; return (c & 1) ? bfhi(w) : bflo(w); }
template <int NP> __device__ __forceinline__ void convw_pos(const ConvW<NP>& ci, const ConvWt& cw, int s, float (&o)[8]) {
#pragma unroll
    for (int c = 0; c < 8; ++c) { const int q = c >> 2, e = c & 3;
        o[c] = silu_f(cw.cb[q][e] + cw.w[0][q][e] * bfel(ci.raw[s], c) + cw.w[1][q][e] * bfel(ci.raw[s + 1], c) + cw.w[2][q][e] * bfel(ci.raw[s + 2], c) + cw.w[3][q][e] * bfel(ci.raw[s + 3], c)); }
}
__device__ __forceinline__ u32x4 pack8(const float (&o)[8][2], int j) { u32x4 r; r.x = pk2(o[0][j], o[1][j]); r.y = pk2(o[2][j], o[3][j]); r.z = pk2(o[4][j], o[5][j]); r.w = pk2(o[6][j], o[7][j]); return r; }
__device__ __forceinline__ void ssd_dt_acs(const Frame& F_, const Args& a, const bf16_t* PROJ, int b, int p0, int g, float* dat  ) {
    const Frame& F0 = F_;
    if (F0.wave < 6) {
        int lane_ = F0.lane; asm volatile("" : "+v"(lane_));
        Frame Fl = F0; Fl.lane = lane_;
        const Frame& F = Fl;
        const int h = g * 6 + F.wave; const float A = -__expf(a.a_log[h]), dtb = a.dt_bias[h];
        LAS float* dtL = (LAS float*)(F.lds + SL_DT) + F.wave * 128; LAS float* acL = (LAS float*)(F.lds + SL_ACS) + F.wave * 128;
        float dv[2], av[2];
#pragma unroll
        for (int hf = 0; hf < 2; ++hf) { const int pos = p0 + F.lane + 64 * hf; float d = 0.f;
            if (pos >= 0) { const float v = bf2f(PROJ[(size_t)row_of(b, pos) * LDP + C_DT + h]) + dtb, t = __expf(-fabsf(v));
                d = fmaxf(v, 0.f) + (t < 1e-3f ? t * (1.f - 0.5f * t) : __logf(1.f + t)); }
            dv[hf] = d; av[hf] = d * A; }
#pragma unroll
        for (int o = 1; o < 64; o <<= 1) { const float t0 = __shfl_up(av[0], o), t1 = __shfl_up(av[1], o); if (F.lane >= o) { av[0] += t0; av[1] += t1; } }
        av[1] += __shfl(av[0], 63);
        dtL[F.lane] = dv[0]; dtL[F.lane + 64] = dv[1]; acL[F.lane] = av[0]; acL[F.lane + 64] = av[1];
        if (dat && F.lane == 63) dat[h] = __expf(av[1]);
    }
}

__device__ __forceinline__ void ssd_s1_unit(const Frame& F, const Args& a, int b, int c, int g) {
    const bf16_t* PROJ = (const bf16_t*)(a.ws + WS_PROJ);
    const int p0 = c == 0 ? -112 : NMETA + 128 * (c - 1), lr = F.lane & 31, hf = F.lane >> 5;
    __syncthreads();
    ssd_dt_acs(F, a, PROJ, b, p0, g, (float*)(a.ws + WS_DAT) + (size_t)(b * 17 + c) * HEADS);
    if (F.tid < 256) { const int chg = F.tid & 15, sr = F.tid >> 4, ch = D_SSD + g * 128 + 8 * chg;
        ConvW<8> ci; convw_load<8>(ci, PROJ, b, p0 + 8 * sr, ch); ConvWt cw; convw_weights(cw, a, ch);
        unsigned pk[8][4];
#pragma unroll
        for (int s2 = 0; s2 < 4; ++s2) { float o0[8], o1[8]; convw_pos<8>(ci, cw, 2 * s2, o0); convw_pos<8>(ci, cw, 2 * s2 + 1, o1);
#pragma unroll
            for (int c = 0; c < 8; ++c) pk[c][s2] = pk2(o0[c], o1[c]); }
#pragma unroll
        for (int c = 0; c < 8; ++c) *(LAS u32x4*)(F.lds + SL_C + ((8 * chg + c) * PITCH + 8 * sr) * 2) = (u32x4){pk[c][0], pk[c][1], pk[c][2], pk[c][3]}; }
    __syncthreads();
    ConvW<2> cin; convw_load<2>(cin, PROJ, b, p0 + 2 * (F.tid >> 3), (g * 6) * 64 + 8 * (F.tid & 7));
#pragma unroll 1
    for (int hh = 0; hh < 6; ++hh) {
        const int h = g * 6 + hh, buf = hh & 1;
        {
            const int chg = F.tid & 7, sp = F.tid >> 3, ch = h * 64 + 8 * chg;
            const ConvW<2> ci = cin; ConvWt cw; convw_weights(cw, a, ch);
            if (hh < 5) convw_load<2>(cin, PROJ, b, p0 + 2 * sp, ch + 64);
            const LAS float* dtL = (const LAS float*)(F.lds + SL_DT) + hh * 128; const LAS float* acL = (const LAS float*)(F.lds + SL_ACS) + hh * 128;
            const float aend = acL[127], w0 = dtL[2 * sp] * __expf(aend - acL[2 * sp]), w1 = dtL[2 * sp + 1] * __expf(aend - acL[2 * sp + 1]);
            float o0[8], o1[8]; convw_pos<2>(ci, cw, 0, o0); convw_pos<2>(ci, cw, 1, o1);
#pragma unroll
            for (int c = 0; c < 8; ++c) *(LAS unsigned*)(F.lds + SL_X + buf * 17408 + ((8 * chg + c) * PITCH + 2 * sp) * 2) = pk2(o0[c] * w0, o1[c] * w1);
        }
        __syncthreads();
        const int pb = F.wave >> 2, nb = F.wave & 3;
        f32x16 acc;
#pragma unroll
        for (int r = 0; r < 16; ++r) acc[r] = 0.f;
#pragma unroll
        for (int ks = 0; ks < 8; ++ks) {
            const bf16x8 af = *(const LAS bf16x8*)(F.lds + SL_C + ((32 * nb + lr) * PITCH + 16 * ks + 8 * hf) * 2);
            const bf16x8 bf = *(const LAS bf16x8*)(F.lds + SL_X + buf * 17408 + ((32 * pb + lr) * PITCH + 16 * ks + 8 * hf) * 2);
            acc = mfma32(af, bf, acc);
        }
        bf16_t* dst = c == 0 ? (bf16_t*)(a.ws + WS_SMETA) + (size_t)h * 8192 : (bf16_t*)a.out + ((size_t)(b * 16 + (c - 1)) * HEADS + h) * 8192;
        u32x4* d4 = (u32x4*)(dst + ((size_t)(pb * 4 + nb) * 64 + F.lane) * 16);
        u32x4 w0, w1; w0.x = pk2(acc[0], acc[1]); w0.y = pk2(acc[2], acc[3]); w0.z = pk2(acc[4], acc[5]); w0.w = pk2(acc[6], acc[7]);
        w1.x = pk2(acc[8], acc[9]); w1.y = pk2(acc[10], acc[11]); w1.z = pk2(acc[12], acc[13]); w1.w = pk2(acc[14], acc[15]);
        d4[0] = w0; d4[1] = w1;
    }
}
__device__ __forceinline__ void short_conv_all(const Frame& F, const Args& a) {
    bf16_t* PROJ = (bf16_t*)(a.ws + WS_PROJ);
    const size_t gt = (size_t)F.vcu * NTHREADS + F.tid, NT = (size_t)F.G * NTHREADS;
    for (size_t it = gt; it < (size_t)TR * (D_SC / 8); it += NT) {
        const int r = (int)(it / (D_SC / 8)), c0 = (int)(it % (D_SC / 8)) * 8, b = r / SEQ, pos = r % SEQ + NMETA;
        float accv[8];
#pragma unroll
        for (int j = 0; j < 8; ++j) accv[j] = 0.f;
#pragma unroll
        for (int w = 0; w < 3; ++w) { const int rr = row_of(b, pos - 2 + w);
            const u32x4 cc = *(const u32x4*)(PROJ + (size_t)rr * LDP + C_SCC + c0), xx = *(const u32x4*)(PROJ + (size_t)rr * LDP + C_SCX + c0);
            const unsigned cw[4] = {cc.x, cc.y, cc.z, cc.w}, xw[4] = {xx.x, xx.y, xx.z, xx.w};
#pragma unroll
            for (int j = 0; j < 4; ++j) { accv[2 * j] += a.conv_sc_w[w * D_SC + c0 + 2 * j] * (bflo(cw[j]) * bflo(xw[j])); accv[2 * j + 1] += a.conv_sc_w[w * D_SC + c0 + 2 * j + 1] * (bfhi(cw[j]) * bfhi(xw[j])); } }
        const u32x4 bb = *(const u32x4*)(PROJ + (size_t)r * LDP + C_SCB + c0); const unsigned bw[4] = {bb.x, bb.y, bb.z, bb.w};
        u32x4 o; unsigned ow[4];
#pragma unroll
        for (int j = 0; j < 4; ++j) ow[j] = pk2(bflo(bw[j]) * accv[2 * j], bfhi(bw[j]) * accv[2 * j + 1]);
        o.x = ow[0]; o.y = ow[1]; o.z = ow[2]; o.w = ow[3];
        *(u32x4*)(PROJ + (size_t)r * LDP + C_SCB + c0) = o;
    }
}
__device__ __forceinline__ void p2_ssd_states(const Frame& F, const Args& a, bool dryrun) {
    if (!dryrun) short_conv_all(F, a);
    for (int u = F.vcu; u < 4 + BATCH * 15 * NG; u += F.G) {
        if (u < 4) ssd_s1_unit(F, a, 0, 0, u);
        else { const int v = u - 4; ssd_s1_unit(F, a, v / (15 * NG), 1 + (v / NG) % 15, v % NG); }
    }
}
__device__ __forceinline__ void p3_ssd_recur(const Frame& F, const Args& a) {
    const float* dat = (const float*)(a.ws + WS_DAT); const bf16_t* SM = (const bf16_t*)(a.ws + WS_SMETA); bf16_t* SF = (bf16_t*)a.out;
    for (int it = F.vcu; it < BATCH * HEADS * 1024 / NTHREADS; it += F.G) {
        const int idx = it * NTHREADS + F.tid, bh = idx >> 10, e8 = idx & 1023, b = bh / HEADS, h = bh % HEADS;
        u32x4 ld[15];
#pragma unroll
        for (int c = 1; c <= 15; ++c) ld[c - 1] = *(const u32x4*)(SF + ((size_t)(b * 16 + (c - 1)) * HEADS + h) * 8192 + e8 * 8);
        const u32x4 m = *(const u32x4*)(SM + (size_t)h * 8192 + e8 * 8);
        float cy[8] = {bflo(m.x), bfhi(m.x), bflo(m.y), bfhi(m.y), bflo(m.z), bfhi(m.z), bflo(m.w), bfhi(m.w)};
#pragma unroll
        for (int c = 1; c <= 16; ++c) {
            u32x4 o; o.x = pk2(cy[0], cy[1]); o.y = pk2(cy[2], cy[3]); o.z = pk2(cy[4], cy[5]); o.w = pk2(cy[6], cy[7]);
            *(u32x4*)(SF + ((size_t)(b * 16 + (c - 1)) * HEADS + h) * 8192 + e8 * 8) = o;
            if (c <= 15) { const float dA = dat[(size_t)(b * 17 + c) * HEADS + h]; const u32x4 t = ld[c - 1];
                cy[0] = cy[0] * dA + bflo(t.x); cy[1] = cy[1] * dA + bfhi(t.x); cy[2] = cy[2] * dA + bflo(t.y); cy[3] = cy[3] * dA + bfhi(t.y);
                cy[4] = cy[4] * dA + bflo(t.z); cy[5] = cy[5] * dA + bfhi(t.z); cy[6] = cy[6] * dA + bflo(t.w); cy[7] = cy[7] * dA + bfhi(t.w); }
        }
    }
}
template <bool DRY> __device__ __forceinline__ void ssd_s3_unit(const Frame& F, const Args& a, int b, int c, int g) {
    bf16_t* PROJ = (bf16_t*)(a.ws + WS_PROJ);
    const int p0 = NMETA + 128 * (c - 1), row0 = b * SEQ + 128 * (c - 1), lr = F.lane & 31, hf = F.lane >> 5;
    __syncthreads();
    ssd_dt_acs(F, a, PROJ, b, p0, g, nullptr);
#if PROBE_S3 == 1
    for (int rep = 0; rep < 2; ++rep)
#endif
    {   const int mat = F.tid >> 8, it = F.tid & 255, chg = it & 15, sr = it >> 4, ch = D_SSD + (mat ? 0 : 512) + g * 128 + 8 * chg;
        ConvW<8> ci; convw_load<8>(ci, PROJ, b, p0 + 8 * sr, ch); ConvWt cw; convw_weights(cw, a, ch);
#pragma unroll
        for (int s = 0; s < 8; ++s) { float o[8]; convw_pos<8>(ci, cw, s, o);
            *(LAS u32x4*)(F.lds + (mat ? SL_B : SL_C) + ((8 * sr + s) * PITCH + 8 * chg) * 2) = (u32x4){pk2(o[0], o[1]), pk2(o[2], o[3]), pk2(o[4], o[5]), pk2(o[6], o[7])}; } }
    __syncthreads();
    constexpr unsigned SI_P = 0u | (0u << 2) | (1u << 4) | (0u << 6) | (1u << 8) | (2u << 10) | (0u << 12) | (1u << 14) | (2u << 16) | (3u << 18);
    constexpr unsigned LI_P = 0u | (1u << 2) | (1u << 4) | (2u << 6) | (2u << 8) | (2u << 10) | (3u << 12) | (3u << 14) | (3u << 16) | (3u << 18);
    const int nslot = F.wave < 2 ? 2 : 1;
    f32x16 cb[2];
#pragma unroll
    for (int sl = 0; sl < 2; ++sl) {
#pragma unroll
        for (int r = 0; r < 16; ++r) cb[sl][r] = 0.f;
        if (sl < nslot) { const int ti = F.wave + 8 * sl, si = (SI_P >> (2 * ti)) & 3, li = (LI_P >> (2 * ti)) & 3;
#pragma unroll
            for (int ks = 0; ks < 8; ++ks) {
                const bf16x8 af = *(const LAS bf16x8*)(F.lds + SL_B + ((32 * si + lr) * PITCH + 16 * ks + 8 * hf) * 2);
                const bf16x8 bf = *(const LAS bf16x8*)(F.lds + SL_C + ((32 * li + lr) * PITCH + 16 * ks + 8 * hf) * 2);
                cb[sl] = mfma32(af, bf, cb[sl]); } }
    }
    __syncthreads();
    const int pb = F.wave & 1, lio = F.wave >> 1;
    unsigned ypk[6][8];
#pragma unroll
    for (int i = 0; i < 6; ++i)
#pragma unroll
        for (int r = 0; r < 8; ++r) ypk[i][r] = 0u;
#pragma unroll 1
    for (int hh = 0; hh < 6; ++hh) {
        const int h = g * 6 + hh, buf = hh & 1, mofs = buf ? SL_B : SL_M0;
        const LAS float* dtL = (const LAS float*)(F.lds + SL_DT) + hh * 128; const LAS float* acL = (const LAS float*)(F.lds + SL_ACS) + hh * 128;
        const bf16_t* sp = (const bf16_t*)a.out + ((size_t)(b * 16 + (c - 1)) * HEADS + h) * 8192;
#if PROBE_S3 == 2
        for (int rep = 0; rep < 2; ++rep)
#endif
        {
            const int chg = F.tid & 7, spp = F.tid >> 3, ch = h * 64 + 8 * chg;
            ConvW<2> ci; convw_load<2>(ci, PROJ, b, p0 + 2 * spp, ch); ConvWt cw; convw_weights(cw, a, ch);
            float o0[8], o1[8]; convw_pos<2>(ci, cw, 0, o0); convw_pos<2>(ci, cw, 1, o1);
#pragma unroll
            for (int cc = 0; cc < 8; ++cc) *(LAS unsigned*)(F.lds + SL_X + buf * 17408 + ((8 * chg + cc) * PITCH + 2 * spp) * 2) = pk2(o0[cc], o1[cc]);
        }
        u32x4 sf[4][2];
#pragma unroll
        for (int nb = 0; nb < 4; ++nb) { const u32x4* s4 = (const u32x4*)(sp + ((size_t)(pb * 4 + nb) * 64 + F.lane) * 16); sf[nb][0] = s4[0]; sf[nb][1] = s4[1]; }
#if PROBE_S3 == 3
        for (int rep = 0; rep < 2; ++rep)
#endif
        {
            const float Dh = a.d_skip[h];
#pragma unroll
            for (int sl = 0; sl < 2; ++sl) if (sl < nslot) { const int ti = F.wave + 8 * sl, si = (SI_P >> (2 * ti)) & 3, li = (LI_P >> (2 * ti)) & 3;
                const int l = 32 * li + lr; const float acl = acL[l];
#pragma unroll
                for (int q = 0; q < 4; ++q) { const int s0 = 32 * si + 8 * q + 4 * hf;
                    const f32x4 d4 = *(const LAS f32x4*)(dtL + s0), a4 = *(const LAS f32x4*)(acL + s0); float v[4];
#pragma unroll
                    for (int i = 0; i < 4; ++i) { const int s = s0 + i; float t = s <= l ? cb[sl][4 * q + i] * __expf(acl - a4[i]) * d4[i] : 0.f; if (s == l) t += Dh; v[i] = t; }
                    *(LAS u32x2*)(F.lds + mofs + (l * PITCH + s0) * 2) = (u32x2){pk2(v[0], v[1]), pk2(v[2], v[3])}; } }
        }
        f32x16 acc;
#pragma unroll
        for (int r = 0; r < 16; ++r) acc[r] = 0.f;
        {
#pragma unroll
            for (int nb = 0; nb < 4; ++nb) {
#pragma unroll
                for (int qp = 0; qp < 2; ++qp) { const LAS unsigned char* cp_ = F.lds + SL_C + ((32 * lio + lr) * PITCH + 32 * nb + 16 * qp + 4 * hf) * 2;
                    const u32x2 c0 = *(const LAS u32x2*)cp_, c1 = *(const LAS u32x2*)(cp_ + 16);
                    const u32x4 bfr = (u32x4){c0.x, c0.y, c1.x, c1.y};
                    acc = mfma32(__builtin_bit_cast(bf16x8, sf[nb][qp]), __builtin_bit_cast(bf16x8, bfr), acc); } }
            const float sc = __expf(acL[32 * lio + lr]);
#pragma unroll
            for (int r = 0; r < 16; ++r) acc[r] *= sc;
        }
        __syncthreads();
        for (int ks = 0; ks < 2 * (lio + 1); ++ks) {
            const bf16x8 af = *(const LAS bf16x8*)(F.lds + SL_X + buf * 17408 + ((32 * pb + lr) * PITCH + 16 * ks + 8 * hf) * 2);
            const bf16x8 bf = *(const LAS bf16x8*)(F.lds + mofs + ((32 * lio + lr) * PITCH + 16 * ks + 8 * hf) * 2);
            acc = mfma32(af, bf, acc);
        }
#pragma unroll
        for (int i = 0; i < 5; ++i)
#pragma unroll
            for (int r = 0; r < 8; ++r) ypk[i][r] = ypk[i + 1][r];
#pragma unroll
        for (int r = 0; r < 8; ++r) ypk[5][r] = pk2(acc[2 * r], acc[2 * r + 1]);
    }
    __syncthreads();
#pragma unroll
    for (int hh = 0; hh < 6; ++hh)
#pragma unroll
        for (int q = 0; q < 4; ++q) *(LAS u32x2*)(F.lds + SL_B + ((32 * lio + lr) * YPITCH + hh * 64 + 32 * pb + 8 * q + 4 * hf) * 2) = (u32x2){ypk[hh][2 * q], ypk[hh][2 * q + 1]};
    __syncthreads();
#pragma unroll
    for (int pass = 0; pass < 4; ++pass) {
        const int l = pass * 32 + F.wave * 4 + (F.lane >> 4), sub = F.lane & 15; bf16_t* zr = PROJ + (size_t)(row0 + l) * LDP + C_Z + g * 384;
        float v[6][4]; float ss = 0.f;
#pragma unroll
        for (int k = 0; k < 6; ++k) { const int c0 = 4 * (sub + 16 * k); const u32x2 y2 = *(const LAS u32x2*)(F.lds + SL_B + (l * YPITCH + c0) * 2), z2 = *(const u32x2*)(zr + c0);
            const float yy[4] = {bflo(y2.x), bfhi(y2.x), bflo(y2.y), bfhi(y2.y)}, zz[4] = {bflo(z2.x), bfhi(z2.x), bflo(z2.y), bfhi(z2.y)};
#pragma unroll
            for (int i = 0; i < 4; ++i) { v[k][i] = yy[i] * silu_f(zz[i]); ss += v[k][i] * v[k][i]; } }
        ss += __shfl_xor(ss, 1); ss += __shfl_xor(ss, 2); ss += __shfl_xor(ss, 4); ss += __shfl_xor(ss, 8);
        const float rstd = 1.0f / sqrtf(ss * (1.f / 384.f) + EPS);
#pragma unroll
        for (int k = 0; k < 6; ++k) { const int c0 = 4 * (sub + 16 * k); const f32x4 nw = *(const f32x4*)(a.ssd_norm_w + g * 384 + c0);
            bf16_t* zo = DRY ? (bf16_t*)(a.ws + WS_END) + ((size_t)F.vcu * 128 + l) * 384 : zr;
            *(u32x2*)(zo + c0) = (u32x2){pk2(v[k][0] * rstd * nw.x, v[k][1] * rstd * nw.y), pk2(v[k][2] * rstd * nw.z, v[k][3] * rstd * nw.w)}; }
    }
}
template <bool DRY> __device__ __forceinline__ void p4_ssd_out(const Frame& F, const Args& a) {
    for (int u = F.vcu; u < BATCH * 16 * NG; u += F.G) ssd_s3_unit<DRY>(F, a, u / (16 * NG), 1 + (u / NG) % 16, u % NG);
}

__device__ __forceinline__ void p5_norm2(const Frame& F, const Args& a) {
    const float* H2 = a.out; bf16_t* N2 = (bf16_t*)(a.ws + WS_XN);
    const int gw = F.vcu * NWAVES + F.wave, NGW = F.G * NWAVES;
    {
        unsigned char* U8 = a.ws + WS_U8; unsigned char* V8 = a.ws + WS_V8; float* SU = (float*)(a.ws + WS_SU); float* SV = (float*)(a.ws + WS_SV);
        for (int r = gw; r < 2 * PK * PK; r += NGW) {
            const bool isv = r >= PK * PK; const int e = isv ? r - PK * PK : r;
            const f32x4* src = (const f32x4*)((isv ? a.expert_v : a.expert_u) + (size_t)e * D) + 4 * F.lane;
            f32x4 v[4]; float amax = 0.f;
#pragma unroll
            for (int j = 0; j < 4; ++j) { v[j] = src[j]; amax = fmaxf(amax, fmaxf(fmaxf(fabsf(v[j].x), fabsf(v[j].y)), fmaxf(fabsf(v[j].z), fabsf(v[j].w)))); }
#pragma unroll
            for (int o = 1; o < 64; o <<= 1) amax = fmaxf(amax, __shfl_xor(amax, o));
            const float sc = amax > 0.f ? amax * (1.0f / 440.0f) : 1.0f, inv = 1.0f / sc;
            u32x4 o4; unsigned ow[4];
#pragma unroll
            for (int j = 0; j < 4; ++j) { int p = 0; p = __builtin_amdgcn_cvt_pk_fp8_f32(v[j].x * inv, v[j].y * inv, p, false); p = __builtin_amdgcn_cvt_pk_fp8_f32(v[j].z * inv, v[j].w * inv, p, true); ow[j] = (unsigned)p; }
            o4.x = ow[0]; o4.y = ow[1]; o4.z = ow[2]; o4.w = ow[3];
            if (isv) { *(u32x4*)(V8 + ((size_t)(F.lane >> 2) * (PK * PK) + e) * 64 + 16 * (F.lane & 3)) = o4; if (F.lane == 0) SV[e] = sc; }
            else if (PEER_SLICED == 5) { *(u32x4*)(a.ws + WS_U8F + (size_t)e * D + 16 * F.lane) = o4; if (F.lane == 0) SU[e] = sc; }
            else if (PEER_SLICED >= 3) { u32x4* ub = (u32x4*)((bf16_t*)(a.ws + WS_UB) + (size_t)e * D) + 2 * F.lane;
                u32x4 b0, b1; b0.x = pk2(v[0].x, v[0].y); b0.y = pk2(v[0].z, v[0].w); b0.z = pk2(v[1].x, v[1].y); b0.w = pk2(v[1].z, v[1].w); b1.x = pk2(v[2].x, v[2].y); b1.y = pk2(v[2].z, v[2].w); b1.z = pk2(v[3].x, v[3].y); b1.w = pk2(v[3].z, v[3].w);
                ub[0] = b0; ub[1] = b1; }
            else { *(u32x4*)(U8 + (size_t)e * D + 16 * F.lane) = o4; if (F.lane == 0) SU[e] = sc; }
        }
    }
    for (int m = gw; m < TR; m += NGW) {
        const f32x4* xr = (const f32x4*)(H2 + (size_t)m * D) + F.lane; const f32x4* gr = (const f32x4*)a.g_ffn + F.lane; u32x2* o8 = (u32x2*)(N2 + (size_t)m * D) + F.lane;
        f32x4 v[4]; float s = 0.f;
#pragma unroll
        for (int j = 0; j < 4; ++j) { v[j] = xr[64 * j]; s += (v[j].x * v[j].x + v[j].y * v[j].y) + (v[j].z * v[j].z + v[j].w * v[j].w); }
        const float rstd = 1.0f / sqrtf(wave_sum(s) * (1.f / D) + EPS);
#pragma unroll
        for (int j = 0; j < 4; ++j) { const f32x4 gg = gr[64 * j]; o8[64 * j] = (u32x2){pk2(v[j].x * rstd * gg.x, v[j].y * rstd * gg.y), pk2(v[j].z * rstd * gg.z, v[j].w * rstd * gg.w)}; }
    }
}

__device__ __forceinline__ unsigned ord_bits(float f) { const unsigned u = __builtin_bit_cast(unsigned, f); return u ^ ((u >> 31) ? 0xffffffffu : 0x80000000u); }
__device__ __forceinline__ float ord_val(unsigned o) { const unsigned u = (o & 0x80000000u) ? (o ^ 0x80000000u) : ~o; return __builtin_bit_cast(float, u); }
__device__ __forceinline__ void p7_topk(const Frame& F, const Args& a) {
    const bf16_t* Q = (const bf16_t*)(a.ws + WS_Q); int* EIDX = (int*)(a.ws + WS_EIDX); float* GATE = (float*)(a.ws + WS_GATE);
    for (int it = F.vcu; it < (TR / NTHREADS) * PH; it += F.G) {
        const int h = __builtin_amdgcn_readfirstlane(it % PH), t = (it / PH) * NTHREADS + F.tid;
        unsigned L0[16], L1[16];
#pragma unroll
        for (int s = 0; s < 2; ++s) {
            float q[128];
            const u32x4* qp = (const u32x4*)(Q + (size_t)t * PQ + h * 256 + s * 128);
#pragma unroll
            for (int j = 0; j < 16; ++j) { const u32x4 w = qp[j]; q[8 * j] = bflo(w.x); q[8 * j + 1] = bfhi(w.x); q[8 * j + 2] = bflo(w.y); q[8 * j + 3] = bfhi(w.y); q[8 * j + 4] = bflo(w.z); q[8 * j + 5] = bfhi(w.z); q[8 * j + 6] = bflo(w.w); q[8 * j + 7] = bfhi(w.w); }
            unsigned Ls[16];
#pragma unroll
            for (int i = 0; i < 16; ++i) Ls[i] = 0u;
            const float* kb = a.sub_keys + (size_t)(h * 2 + s) * PK * 128;
            for (int k = 0; k < PK; ++k) {
                const float* kr = kb + k * 128; float d0 = 0.f, d1 = 0.f, d2 = 0.f, d3 = 0.f;
#pragma unroll
                for (int d = 0; d < 128; d += 4) { d0 += q[d] * kr[d]; d1 += q[d + 1] * kr[d + 1]; d2 += q[d + 2] * kr[d + 2]; d3 += q[d + 3] * kr[d + 3]; }
                unsigned e = (ord_bits((d0 + d1) + (d2 + d3)) & ~127u) | (unsigned)(127 - k);
#pragma unroll
                for (int i = 0; i < 16; ++i) { const unsigned hi = Ls[i] > e ? Ls[i] : e; e = Ls[i] > e ? e : Ls[i]; Ls[i] = hi; }
            }
#pragma unroll
            for (int i = 0; i < 16; ++i) { if (s == 0) L0[i] = Ls[i]; else L1[i] = Ls[i]; }
        }
        unsigned T[16];
#pragma unroll
        for (int i = 0; i < 16; ++i) T[i] = 0u;
#pragma unroll
        for (int i = 0; i < 16; ++i)
#pragma unroll
            for (int j = 0; j < 16; ++j) if ((i + 1) * (j + 1) <= 16) {
                const float sum = ord_val(L0[i] & ~127u) + ord_val(L1[j] & ~127u);
                unsigned e = (ord_bits(sum) & ~255u) | (unsigned)(255 - (i * 16 + j));
#pragma unroll
                for (int k = 0; k < 16; ++k) { const unsigned hi = T[k] > e ? T[k] : e; e = T[k] > e ? e : T[k]; T[k] = hi; }
            }
        float best[16]; int eid[16];
#pragma unroll
        for (int k = 0; k < 16; ++k) {
            best[k] = ord_val(T[k] & ~255u); const int pos = 255 - (int)(T[k] & 255u), pi = pos >> 4, pj = pos & 15;
            unsigned a0 = 0u, a1 = 0u;
#pragma unroll
            for (int i = 0; i < 16; ++i) { a0 = (pi == i) ? L0[i] : a0; a1 = (pj == i) ? L1[i] : a1; }
            eid[k] = (127 - (int)(a0 & 127u)) * PK + (127 - (int)(a1 & 127u));
        }
        float se = 0.f, ex[16];
#pragma unroll
        for (int k = 0; k < 16; ++k) { ex[k] = expf(best[k] - best[0]); se += ex[k]; }
        const float inv = 1.f / se;
        int* ep = EIDX + (size_t)t * 128 + h * 16; float* gp = GATE + (size_t)t * 128 + h * 16;
#pragma unroll
        for (int k = 0; k < 16; k += 4) { *(int4*)(ep + k) = make_int4(eid[k], eid[k + 1], eid[k + 2], eid[k + 3]); *(f32x4*)(gp + k) = (f32x4){ex[k] * inv, ex[k + 1] * inv, ex[k + 2] * inv, ex[k + 3] * inv}; }
    }
}

__device__ __forceinline__ void cex_desc(unsigned& x, unsigned& y) { const unsigned hi = x > y ? x : y, lo = x > y ? y : x; x = hi; y = lo; }
__device__ __forceinline__ void sort16_desc(unsigned (&v)[16]) {
#pragma unroll
    for (int k = 2; k <= 16; k <<= 1)
#pragma unroll
        for (int j = k >> 1; j > 0; j >>= 1)
#pragma unroll
            for (int i = 0; i < 16; ++i) { const int l = i ^ j; if (l > i) { if ((i & k) == 0) cex_desc(v[i], v[l]); else cex_desc(v[l], v[i]); } }
}
__device__ __forceinline__ void bitonic_merge16_desc(unsigned (&v)[16]) {
#pragma unroll
    for (int j = 8; j > 0; j >>= 1)
#pragma unroll
        for (int i = 0; i < 16; ++i) { const int l = i ^ j; if (l > i) cex_desc(v[i], v[l]); }
}
__device__ __forceinline__ void top16_merge(unsigned (&T)[16], const unsigned (&B)[16]) {
#pragma unroll
    for (int i = 0; i < 16; ++i) T[i] = T[i] > B[15 - i] ? T[i] : B[15 - i];
    bitonic_merge16_desc(T);
}
__device__ __forceinline__ void p8_topk_mfma(const Frame& F, const Args& a) {
    const bf16_t* Q = (const bf16_t*)(a.ws + WS_Q); int* EIDX = (int*)(a.ws + WS_EIDX); float* GATE = (float*)(a.ws + WS_GATE);
    const int lane = F.lane, lr = lane & 31, hf = lane >> 5;
    for (int task = F.vcu; task < PH * (TR / 1024); task += F.G) {
        const int h = task % PH, rng = task / PH;
        __syncthreads();
        {
            const f32x4* kp = (const f32x4*)(a.sub_keys + (size_t)h * 2 * PK * 128);
            for (int i = F.tid; i < 2 * PK * 128 / 4; i += NTHREADS) { const f32x4 v = kp[i]; const int row = i >> 5, c4 = (i & 31) * 4;
                *(LAS u32x2*)(F.lds + (row * PITCH + c4) * 2) = (u32x2){pk2(v.x, v.y), pk2(v.z, v.w)}; }
        }
        __syncthreads();
        for (int tile = F.wave; tile < 16; tile += NWAVES) {
            const int t0 = rng * 1024 + tile * 64;
            unsigned L0[16], L1[16];
#pragma unroll
            for (int i = 0; i < 16; ++i) { L0[i] = 0u; L1[i] = 0u; }
#pragma unroll 1
            for (int s = 0; s < 2; ++s) {
                unsigned TA[16], R[16];
#pragma unroll
                for (int i = 0; i < 16; ++i) { TA[i] = 0u; R[i] = 0u; }
#pragma unroll 1
                for (int th = 0; th < 2; ++th) {
                    bf16x8 qf[8];
                    const bf16_t* qp = Q + (size_t)(t0 + 32 * th + lr) * PQ + h * 256 + s * 128 + 8 * hf;
#pragma unroll
                    for (int ks = 0; ks < 8; ++ks) qf[ks] = *(const bf16x8*)(qp + 16 * ks);
                    unsigned T[16];
#pragma unroll
                    for (int i = 0; i < 16; ++i) T[i] = 0u;
#pragma unroll 1
                    for (int kb = 0; kb < 4; ++kb) {
                        f32x16 acc;
#pragma unroll
                        for (int r = 0; r < 16; ++r) acc[r] = 0.f;
#pragma unroll
                        for (int ks = 0; ks < 8; ++ks) { const bf16x8 af = *(const LAS bf16x8*)(F.lds + ((s * PK + 32 * kb + lr) * PITCH + 16 * ks + 8 * hf) * 2); acc = mfma32(af, qf[ks], acc); }
                        unsigned B[16];
#pragma unroll
                        for (int r = 0; r < 16; ++r) { const int k = 32 * kb + 8 * (r >> 2) + 4 * hf + (r & 3); B[r] = (ord_bits(acc[r]) & ~127u) | (unsigned)(127 - k); }
                        sort16_desc(B);
                        top16_merge(T, B);
                    }
                    unsigned P[16];
#pragma unroll
                    for (int i = 0; i < 16; ++i) { unsigned lo2, hi2; swap32_self(T[i], lo2, hi2); P[i] = hf ? lo2 : hi2; }
                    top16_merge(T, P);
#pragma unroll
                    for (int i = 0; i < 16; ++i) { R[i] = hf ? T[i] : TA[i]; TA[i] = T[i]; }
                }
#pragma unroll
                for (int i = 0; i < 16; ++i) { L0[i] = L1[i]; L1[i] = R[i]; }
            }
            const int t = t0 + lane;
            unsigned T[16];
            const float v00 = ord_val(L0[0] & ~127u);
#pragma unroll
            for (int j = 0; j < 16; ++j) T[j] = (ord_bits(v00 + ord_val(L1[j] & ~127u)) & ~255u) | (unsigned)(255 - j);
#pragma unroll
            for (int i = 1; i < 16; ++i)
#pragma unroll
                for (int j = 0; j < 16; ++j) if ((i + 1) * (j + 1) <= 16) {
                    const float sum = ord_val(L0[i] & ~127u) + ord_val(L1[j] & ~127u);
                    unsigned e = (ord_bits(sum) & ~255u) | (unsigned)(255 - (i * 16 + j));
#pragma unroll
                    for (int k = 0; k < 16; ++k) { const unsigned hi = T[k] > e ? T[k] : e; e = T[k] > e ? e : T[k]; T[k] = hi; }
                }
            float best[16]; int eid[16];
#pragma unroll
            for (int k = 0; k < 16; ++k) {
                best[k] = ord_val(T[k] & ~255u); const int pos = 255 - (int)(T[k] & 255u), pi = pos >> 4, pj = pos & 15;
                unsigned a0 = 0u, a1 = 0u;
#pragma unroll
                for (int i = 0; i < 16; ++i) { a0 = (pi == i) ? L0[i] : a0; a1 = (pj == i) ? L1[i] : a1; }
                eid[k] = (127 - (int)(a0 & 127u)) * PK + (127 - (int)(a1 & 127u));
            }
            float se = 0.f, ex[16];
#pragma unroll
            for (int k = 0; k < 16; ++k) { ex[k] = __expf(best[k] - best[0]); se += ex[k]; }
            const float inv = 1.f / se;
            int* ep = EIDX + (size_t)t * 128 + h * 16; float* gp = GATE + (size_t)t * 128 + h * 16;
#pragma unroll
            for (int k = 0; k < 16; k += 4) { *(int4*)(ep + k) = make_int4(eid[k], eid[k + 1], eid[k + 2], eid[k + 3]); *(f32x4*)(gp + k) = (f32x4){ex[k] * inv, ex[k + 1] * inv, ex[k + 2] * inv, ex[k + 3] * inv}; }
        }
    }
}

typedef __bf16 bf16x2_t __attribute__((ext_vector_type(2)));
__device__ __forceinline__ float dot2bf(unsigned w, unsigned x, float acc) { return __builtin_amdgcn_fdot2_f32_bf16(__builtin_bit_cast(bf16x2_t, w), __builtin_bit_cast(bf16x2_t, x), acc, false); }
__device__ __forceinline__ float gelu_erf(float d) { return 0.5f * d * (1.0f + erff(d * 0.70710678f)); }
__device__ __forceinline__ void p8_peer_eval(const Frame& F, const Args& a, float* dst) {
    float* H2 = a.out; const int* EIDX = (const int*)(a.ws + WS_EIDX); const float* GATE = (const float*)(a.ws + WS_GATE);
    const bf16_t* Ub = (const bf16_t*)(a.ws + WS_UB); const bf16_t* Vb = (const bf16_t*)(a.ws + WS_VB);
    const int gw = F.vcu * NWAVES + F.wave, NGW = F.G * NWAVES;
    for (int t = gw; t < TR; t += NGW) {
        f32x4 hv[4], acc[4]; unsigned xp[8]; float s = 0.f;
        const f32x4* hr = (const f32x4*)(H2 + (size_t)t * D) + 4 * F.lane; const f32x4* gr = (const f32x4*)a.g_ffn + 4 * F.lane;
#pragma unroll
        for (int j = 0; j < 4; ++j) { hv[j] = hr[j]; s += (hv[j].x * hv[j].x + hv[j].y * hv[j].y) + (hv[j].z * hv[j].z + hv[j].w * hv[j].w); acc[j] = (f32x4){0.f, 0.f, 0.f, 0.f}; }
        const float rstd = 1.0f / sqrtf(wave_sum(s) * (1.f / D) + EPS);
#pragma unroll
        for (int j = 0; j < 4; ++j) { const f32x4 xv = hv[j] * rstd * gr[j]; xp[2 * j] = pk2(xv.x, xv.y); xp[2 * j + 1] = pk2(xv.z, xv.w); }
        const int myE0 = EIDX[(size_t)t * 128 + F.lane], myE1 = EIDX[(size_t)t * 128 + 64 + F.lane];
        const float myG0 = GATE[(size_t)t * 128 + F.lane], myG1 = GATE[(size_t)t * 128 + 64 + F.lane];
#pragma unroll
        for (int half = 0; half < 2; ++half) {
            const int myE = half ? myE1 : myE0; const float myG = half ? myG1 : myG0;
            for (int k0 = 0; k0 < 64; k0 += 8) {
                u32x4 uu[8][2], vv[8][2]; float gt[8];
#pragma unroll
                for (int k = 0; k < 8; ++k) {
                    const int e = __builtin_amdgcn_readlane(myE, k0 + k); gt[k] = __builtin_bit_cast(float, __builtin_amdgcn_readlane(__builtin_bit_cast(int, myG), k0 + k));
                    const u32x4* ur = (const u32x4*)(Ub + (size_t)e * D) + 2 * F.lane; const u32x4* vr = (const u32x4*)(Vb + (size_t)e * D) + 2 * F.lane;
                    uu[k][0] = ur[0]; uu[k][1] = ur[1]; vv[k][0] = vr[0]; vv[k][1] = vr[1];
                }
#pragma unroll
                for (int k = 0; k < 8; ++k) {
                    float d0 = 0.f, d1 = 0.f;
                    d0 = dot2bf(uu[k][0].x, xp[0], d0); d1 = dot2bf(uu[k][0].y, xp[1], d1); d0 = dot2bf(uu[k][0].z, xp[2], d0); d1 = dot2bf(uu[k][0].w, xp[3], d1);
                    d0 = dot2bf(uu[k][1].x, xp[4], d0); d1 = dot2bf(uu[k][1].y, xp[5], d1); d0 = dot2bf(uu[k][1].z, xp[6], d0); d1 = dot2bf(uu[k][1].w, xp[7], d1);
                    const float d = wave_sum(d0 + d1);
                    const float act = gelu_erf(d) * gt[k];
                    acc[0].x += act * bflo(vv[k][0].x); acc[0].y += act * bfhi(vv[k][0].x); acc[0].z += act * bflo(vv[k][0].y); acc[0].w += act * bfhi(vv[k][0].y);
                    acc[1].x += act * bflo(vv[k][0].z); acc[1].y += act * bfhi(vv[k][0].z); acc[1].z += act * bflo(vv[k][0].w); acc[1].w += act * bfhi(vv[k][0].w);
                    acc[2].x += act * bflo(vv[k][1].x); acc[2].y += act * bfhi(vv[k][1].x); acc[2].z += act * bflo(vv[k][1].y); acc[2].w += act * bfhi(vv[k][1].y);
                    acc[3].x += act * bflo(vv[k][1].z); acc[3].y += act * bfhi(vv[k][1].z); acc[3].z += act * bflo(vv[k][1].w); acc[3].w += act * bfhi(vv[k][1].w);
                }
            }
        }
        float s2 = 0.f;
#pragma unroll
        for (int j = 0; j < 4; ++j) { hv[j] += acc[j]; s2 += (hv[j].x * hv[j].x + hv[j].y * hv[j].y) + (hv[j].z * hv[j].z + hv[j].w * hv[j].w); }
        const float rstd2 = 1.0f / sqrtf(wave_sum(s2) * (1.f / D) + EPS);
        f32x4* orow = (f32x4*)(dst + (size_t)t * D) + 4 * F.lane; const f32x4* gf = (const f32x4*)a.g_final + 4 * F.lane;
#pragma unroll
        for (int j = 0; j < 4; ++j) orow[j] = hv[j] * rstd2 * gf[j];
    }
}


__device__ __forceinline__ float shx32(float x, int lane) { unsigned a, b; swap32_self(__builtin_bit_cast(unsigned, x), a, b); return __builtin_bit_cast(float, (lane & 32) ? a : b); }
__device__ __forceinline__ float shx16(float x, int lane) { unsigned a, b; swap16_self(__builtin_bit_cast(unsigned, x), a, b); return __builtin_bit_cast(float, (lane & 16) ? a : b); }
template <int CTRL> __device__ __forceinline__ float dppf(float x) { return __builtin_bit_cast(float, __builtin_amdgcn_update_dpp(0, __builtin_bit_cast(int, x), CTRL, 0xF, 0xF, true)); }
__device__ __forceinline__ float shx8(float x) { return dppf<0x128>(x); }
__device__ __forceinline__ float shx4(float x, int) { return dppf<0x1B>(dppf<0x141>(x)); }
__device__ __forceinline__ float row_sum16(float x) { x += dppf<0xB1>(x); x += dppf<0x4E>(x); x += dppf<0x141>(x); x += dppf<0x140>(x); return x; }
__device__ __forceinline__ float gelu_as(float v) {
    const float av = __builtin_fabsf(v), t = __builtin_amdgcn_rcpf(av * 0.2316418882f + 1.0f);
    float q = t * 0.5307027145f + (-0.7265760135f); q = q * t + 0.7107068705f; q = q * t + (-0.142248368f); q = q * t + 0.127414796f; q = q * t;
    const float e = __builtin_amdgcn_exp2f((v * v) * (-0.72134752044f));
    const float m = v * (q * e);
    return v < 0.f ? m : v - m;
}
__device__ __forceinline__ unsigned cvt_pk_bf16(float lo, float hi) { unsigned r; asm volatile("v_cvt_pk_bf16_f32 %0, %1, %2" : "=v"(r) : "v"(lo), "v"(hi)); return r; }
__device__ __forceinline__ int rdlane(int v, int l) { return __builtin_amdgcn_readlane(v, l); }
__device__ __forceinline__ float rdlanef(float v, int l) { return __builtin_bit_cast(float, __builtin_amdgcn_readlane(__builtin_bit_cast(int, v), l)); }

struct PeerBatch { int l0, l1, l2, l3; u32x4 r[4][2]; };
__device__ __forceinline__ void peerA_take(unsigned long long& m, PeerBatch& B, const bf16_t* Ub, int lane, int ev) {
    B.l0 = __builtin_ctzll(m); m &= m - 1; B.l1 = B.l0; B.l2 = B.l0; B.l3 = B.l0;
    if (m) { B.l1 = __builtin_ctzll(m); m &= m - 1; if (m) { B.l2 = __builtin_ctzll(m); m &= m - 1; if (m) { B.l3 = __builtin_ctzll(m); m &= m - 1; } } }
    const int e0 = rdlane(ev, B.l0), e1 = rdlane(ev, B.l1), e2 = rdlane(ev, B.l2), e3 = rdlane(ev, B.l3);
    const u32x4* r0 = (const u32x4*)(Ub + (size_t)e0 * D) + 2 * lane; const u32x4* r1 = (const u32x4*)(Ub + (size_t)e1 * D) + 2 * lane;
    const u32x4* r2 = (const u32x4*)(Ub + (size_t)e2 * D) + 2 * lane; const u32x4* r3 = (const u32x4*)(Ub + (size_t)e3 * D) + 2 * lane;
    B.r[0][0] = r0[0]; B.r[0][1] = r0[1]; B.r[1][0] = r1[0]; B.r[1][1] = r1[1]; B.r[2][0] = r2[0]; B.r[2][1] = r2[1]; B.r[3][0] = r3[0]; B.r[3][1] = r3[1];
}
__device__ __forceinline__ void peerA_finish(const PeerBatch& B, int lane, int& agv, const unsigned (&xp)[8]) {
#define DOT16(lo, hi) (dot2bf((hi).w, xp[7], dot2bf((hi).z, xp[6], dot2bf((hi).y, xp[5], dot2bf((hi).x, xp[4], 0.f)))) + dot2bf((lo).w, xp[3], dot2bf((lo).z, xp[2], dot2bf((lo).y, xp[1], dot2bf((lo).x, xp[0], 0.f)))))
    const float p0 = DOT16(B.r[0][0], B.r[0][1]), p1 = DOT16(B.r[1][0], B.r[1][1]), p2 = DOT16(B.r[2][0], B.r[2][1]), p3 = DOT16(B.r[3][0], B.r[3][1]);
#undef DOT16
    const bool hi5 = lane & 32, hi4 = lane & 16;
    const float k0 = hi5 ? p2 : p0, s0 = hi5 ? p0 : p2, k1 = hi5 ? p3 : p1, s1 = hi5 ? p1 : p3;
    const float t0 = k0 + shx32(s0, lane), t1 = k1 + shx32(s1, lane);
    const float k2 = hi4 ? t1 : t0, s2 = hi4 ? t0 : t1;
    const float d = row_sum16(k2 + shx16(s2, lane));
    const float agf = __builtin_bit_cast(float, agv);
    const float g0 = rdlanef(agf, B.l0), g1 = rdlanef(agf, B.l1), g2 = rdlanef(agf, B.l2), g3 = rdlanef(agf, B.l3);
    const float gq = hi5 ? (hi4 ? g3 : g2) : (hi4 ? g1 : g0);
    const int ai = __builtin_bit_cast(int, gelu_as(d) * gq);
    const int w0 = rdlane(ai, 0), w1 = rdlane(ai, 16), w2 = rdlane(ai, 32), w3 = rdlane(ai, 48);
    agv = lane == B.l0 ? w0 : agv; agv = lane == B.l1 ? w1 : agv; agv = lane == B.l2 ? w2 : agv; agv = lane == B.l3 ? w3 : agv;
}
#ifndef P9_ALIGN
#define P9_ALIGN 1
#endif
#ifndef ASHIFT
#define ASHIFT 11
#endif
__device__ __forceinline__ void peerA_token(const bf16_t* Ub, int lane, int s, int elo, int ehi, int& aglo, int& aghi, const unsigned (&xp)[8]) {
    unsigned long long m0 = __ballot((elo >> ASHIFT) == s), m1 = __ballot((ehi >> ASHIFT) == s);
    while (m0 | m1) {
        const bool h0 = m0 != 0ull, h1 = m1 != 0ull;
        PeerBatch B0, B1;
        if (h0) peerA_take(m0, B0, Ub, lane, elo);
        if (h1) peerA_take(m1, B1, Ub, lane, ehi);
        if (h0) peerA_finish(B0, lane, aglo, xp);
        if (h1) peerA_finish(B1, lane, aghi, xp);
    }
}
struct PeerGather { u32x4 vv[16]; unsigned pa[8]; };
__device__ __forceinline__ void peerB_gather(PeerGather& G, const bf16_t* Vb, int lane, int cs, int elo, int ehi, int aglo, int aghi) {
    const int rg = lane >> 3, cl = lane & 7;
    float aw[16];
#pragma unroll
    for (int j = 0; j < 16; ++j) { const int src = 8 * (j & 7) + rg; const int e = __shfl(j < 8 ? elo : ehi, src); aw[j] = __builtin_bit_cast(float, __shfl(j < 8 ? aglo : aghi, src));
        G.vv[j] = *(const u32x4*)((const char*)Vb + (((unsigned)(cs * PK * PK) + (unsigned)e) * 128u + (unsigned)(cl * 16))); }
#pragma unroll
    for (int j = 0; j < 8; ++j) G.pa[j] = cvt_pk_bf16(aw[2 * j], aw[2 * j + 1]);
}
__device__ __forceinline__ float peerB_reduce(const PeerGather& G, int lane) {
    float acc[8];
#pragma unroll
    for (int c = 0; c < 8; ++c) acc[c] = 0.f;
#pragma unroll
    for (int j = 0; j < 16; ++j) { const unsigned pw = G.pa[j >> 1], plo = (j & 1) ? pw >> 16 : pw & 0xffffu, phi = (j & 1) ? pw & 0xffff0000u : pw << 16;
        acc[0] = dot2bf(G.vv[j].x, plo, acc[0]); acc[1] = dot2bf(G.vv[j].x, phi, acc[1]); acc[2] = dot2bf(G.vv[j].y, plo, acc[2]); acc[3] = dot2bf(G.vv[j].y, phi, acc[3]);
        acc[4] = dot2bf(G.vv[j].z, plo, acc[4]); acc[5] = dot2bf(G.vv[j].z, phi, acc[5]); acc[6] = dot2bf(G.vv[j].w, plo, acc[6]); acc[7] = dot2bf(G.vv[j].w, phi, acc[7]); }
    const bool b5 = lane & 32, b4 = lane & 16, b3 = lane & 8;
    float r4[4], r2[2];
#pragma unroll
    for (int c = 0; c < 4; ++c) { const float keep = b5 ? acc[c + 4] : acc[c], send = b5 ? acc[c] : acc[c + 4]; r4[c] = keep + __shfl_xor(send, 32); }
#pragma unroll
    for (int c = 0; c < 2; ++c) { const float keep = b4 ? r4[c + 2] : r4[c], send = b4 ? r4[c] : r4[c + 2]; r2[c] = keep + __shfl_xor(send, 16); }
    const float keep = b3 ? r2[1] : r2[0], send = b3 ? r2[0] : r2[1];
    return keep + __shfl_xor(send, 8);
}
__device__ __forceinline__ float peerB_token(const bf16_t* Vb, int lane, int cs, int elo, int ehi, int aglo, int aghi) {
    PeerGather G; peerB_gather(G, Vb, lane, cs, elo, ehi, aglo, aghi); return peerB_reduce(G, lane);
}
__device__ __forceinline__ void p9_peer_sliced(const Frame& F, const Args& a, float* dst, const XcdBarrier& bar) {
    float* H2 = a.out; const int* EIDX = (const int*)(a.ws + WS_EIDX); const float* GATE = (const float*)(a.ws + WS_GATE);
    const bf16_t* Ub = (const bf16_t*)(a.ws + WS_UB); const bf16_t* Vb = (const bf16_t*)(a.ws + WS_VB);
    const int gw = F.vcu * NWAVES + F.wave, lane = F.lane;
    for (int round = 0; round < 2; ++round) {
        const int tok0 = gw * 16 + round * 8;
        unsigned xp[8][8]; int elo[8], ehi[8], aglo[8], aghi[8];
#pragma unroll
        for (int i = 0; i < 8; ++i) {
            const int t = tok0 + i;
            const f32x4* hr = (const f32x4*)(H2 + (size_t)t * D) + 4 * lane; const f32x4* gr = (const f32x4*)a.g_ffn + 4 * lane;
            f32x4 hv[4]; float s = 0.f;
#pragma unroll
            for (int j = 0; j < 4; ++j) { hv[j] = hr[j]; s += (hv[j].x * hv[j].x + hv[j].y * hv[j].y) + (hv[j].z * hv[j].z + hv[j].w * hv[j].w); }
            const float rstd = 1.0f / sqrtf(wave_sum(s) * (1.f / D) + EPS);
#pragma unroll
            for (int j = 0; j < 4; ++j) { const f32x4 xv = hv[j] * rstd * gr[j]; xp[i][2 * j] = pk2(xv.x, xv.y); xp[i][2 * j + 1] = pk2(xv.z, xv.w); }
            elo[i] = EIDX[(size_t)t * 128 + lane]; ehi[i] = EIDX[(size_t)t * 128 + 64 + lane];
            aglo[i] = __builtin_bit_cast(int, GATE[(size_t)t * 128 + lane]); aghi[i] = __builtin_bit_cast(int, GATE[(size_t)t * 128 + 64 + lane]);
        }
#if P9_ALIGN >= 2
        if (round) xcd_barrier(bar);
#endif
#if PROBE_P9 == 1
        {   int dlo[8], dhi[8];
#pragma unroll
            for (int i = 0; i < 8; ++i) { dlo[i] = aglo[i]; dhi[i] = aghi[i]; }
#pragma unroll 1
            for (int s = 0; s < 16; ++s) {
#pragma unroll
                for (int i = 0; i < 8; ++i) peerA_token(Ub, lane, s, elo[i], ehi[i], dlo[i], dhi[i], xp[i]); }
#pragma unroll
            for (int i = 0; i < 8; ++i) asm volatile("" :: "v"(dlo[i]), "v"(dhi[i]));
        }
#endif
#pragma unroll 1
        for (int s = 0; s < (16384 >> ASHIFT); ++s) {
#pragma unroll
            for (int i = 0; i < 8; ++i) peerA_token(Ub, lane, s, elo[i], ehi[i], aglo[i], aghi[i], xp[i]);
        }
#if P9_ALIGN
        xcd_barrier(bar);
#endif
        const int col = 8 * (lane & 7) + (lane >> 3);
#if PROBE_P9 == 2
#pragma unroll 1
        for (int cs = 0; cs < 16; ++cs) {
#pragma unroll
            for (int i = 0; i < 8; ++i) { const float v = peerB_token(Vb, lane, cs, elo[i], ehi[i], aglo[i], aghi[i]); const float* hp = H2 + (size_t)(tok0 + i) * D + cs * 64 + col; const float h3 = *hp + v; asm volatile("" :: "v"(h3)); } }
#endif
#pragma unroll 1
        for (int cs = 0; cs < 16; ++cs) {
#if P9_ALIGN >= 2
            if (cs == 8) xcd_barrier(bar);
#endif
            PeerGather G0, G1;
            peerB_gather(G0, Vb, lane, cs, elo[0], ehi[0], aglo[0], aghi[0]);
#pragma unroll
            for (int i = 0; i < 8; ++i) {
                float* hp = H2 + (size_t)(tok0 + i) * D + cs * 64 + col; const float hold = *hp;
                if (i + 1 < 8) { if (i & 1) peerB_gather(G0, Vb, lane, cs, elo[i + 1], ehi[i + 1], aglo[i + 1], aghi[i + 1]); else peerB_gather(G1, Vb, lane, cs, elo[i + 1], ehi[i + 1], aglo[i + 1], aghi[i + 1]); }
                const float v = (i & 1) ? peerB_reduce(G1, lane) : peerB_reduce(G0, lane);
                *hp = hold + v;
            }
        }
        asm volatile("s_waitcnt vmcnt(0)" ::: "memory");
        __builtin_amdgcn_fence(__ATOMIC_RELEASE, "workgroup"); __builtin_amdgcn_fence(__ATOMIC_ACQUIRE, "workgroup");
#pragma unroll
        for (int i = 0; i < 8; ++i) {
            const f32x4* hr = (const f32x4*)(H2 + (size_t)(tok0 + i) * D) + 4 * lane; f32x4* orow = (f32x4*)(dst + (size_t)(tok0 + i) * D) + 4 * lane; const f32x4* gf = (const f32x4*)a.g_final + 4 * lane;
            f32x4 hv[4]; float s2 = 0.f;
#pragma unroll
            for (int j = 0; j < 4; ++j) { hv[j] = hr[j]; s2 += (hv[j].x * hv[j].x + hv[j].y * hv[j].y) + (hv[j].z * hv[j].z + hv[j].w * hv[j].w); }
            const float rstd2 = 1.0f / sqrtf(wave_sum(s2) * (1.f / D) + EPS);
#pragma unroll
            for (int j = 0; j < 4; ++j) orow[j] = hv[j] * rstd2 * gf[j];
        }
    }
}

struct PeerBatch8 { int l[8]; u32x4 r[8]; };
__device__ __forceinline__ void peerA8_take(unsigned long long& m, PeerBatch8& B, const unsigned char* U8, int lane, int ev) {
    B.l[0] = __builtin_ctzll(m); m &= m - 1;
#pragma unroll
    for (int j = 1; j < 8; ++j) { B.l[j] = m ? __builtin_ctzll(m) : B.l[0]; m &= m - 1; }
#pragma unroll
    for (int j = 0; j < 8; ++j) { const int e = rdlane(ev, B.l[j]); B.r[j] = *(const u32x4*)(U8 + (size_t)e * D + 16 * lane); }
}
__device__ __forceinline__ float dot16_fp8(const u32x4& w, const unsigned (&xp)[8]) {
    float d0 = 0.f, d1 = 0.f; const unsigned ww[4] = {w.x, w.y, w.z, w.w};
#pragma unroll
    for (int m = 0; m < 4; ++m) {
        const bf16x2_t lo = __builtin_amdgcn_cvt_scalef32_pk_bf16_fp8(ww[m], 1.0f, false), hi = __builtin_amdgcn_cvt_scalef32_pk_bf16_fp8(ww[m], 1.0f, true);
        d0 = __builtin_amdgcn_fdot2_f32_bf16(lo, __builtin_bit_cast(bf16x2_t, xp[2 * m]), d0, false); d1 = __builtin_amdgcn_fdot2_f32_bf16(hi, __builtin_bit_cast(bf16x2_t, xp[2 * m + 1]), d1, false); }
    return d0 + d1;
}
__device__ __forceinline__ void peerA8_finish(const PeerBatch8& B, int lane, int ev, int& agv, const unsigned (&xp)[8], const float* SU, const float* SV) {
    float p[8];
#pragma unroll
    for (int j = 0; j < 8; ++j) p[j] = dot16_fp8(B.r[j], xp);
    const bool b5 = lane & 32, b4 = lane & 16, b3 = lane & 8;
    float q4[4], q2[2];
#pragma unroll
    for (int c = 0; c < 4; ++c) { const float keep = b5 ? p[c + 4] : p[c], send = b5 ? p[c] : p[c + 4]; q4[c] = keep + __shfl_xor(send, 32); }
#pragma unroll
    for (int c = 0; c < 2; ++c) { const float keep = b4 ? q4[c + 2] : q4[c], send = b4 ? q4[c] : q4[c + 2]; q2[c] = keep + __shfl_xor(send, 16); }
    float d = (b3 ? q2[1] : q2[0]) + __shfl_xor(b3 ? q2[0] : q2[1], 8);
    d += __shfl_xor(d, 4); d += __shfl_xor(d, 2); d += __shfl_xor(d, 1);
    const float agf = __builtin_bit_cast(float, agv);
    float c1[8], c2[8];
#pragma unroll
    for (int j = 0; j < 8; ++j) { const int e = rdlane(ev, B.l[j]); c1[j] = SU[e]; c2[j] = rdlanef(agf, B.l[j]) * SV[e]; }
    const float s1 = b5 ? (b4 ? (b3 ? c1[7] : c1[6]) : (b3 ? c1[5] : c1[4])) : (b4 ? (b3 ? c1[3] : c1[2]) : (b3 ? c1[1] : c1[0]));
    const float s2 = b5 ? (b4 ? (b3 ? c2[7] : c2[6]) : (b3 ? c2[5] : c2[4])) : (b4 ? (b3 ? c2[3] : c2[2]) : (b3 ? c2[1] : c2[0]));
    const int ai = __builtin_bit_cast(int, gelu_as(d * s1) * s2);
#pragma unroll
    for (int j = 0; j < 8; ++j) { const int w = rdlane(ai, 8 * j); agv = lane == B.l[j] ? w : agv; }
}
__device__ __forceinline__ void peerA8_token(const unsigned char* U8, const float* SU, const float* SV, int lane, int s, int elo, int ehi, int& aglo, int& aghi, const unsigned (&xp)[8]) {
    unsigned long long m0 = __ballot((elo >> 11) == s), m1 = __ballot((ehi >> 11) == s);
    while (m0 | m1) {
        const bool h0 = m0 != 0ull, h1 = m1 != 0ull;
        PeerBatch8 B0, B1;
        if (h0) peerA8_take(m0, B0, U8, lane, elo);
        if (h1) peerA8_take(m1, B1, U8, lane, ehi);
        if (h0) peerA8_finish(B0, lane, elo, aglo, xp, SU, SV);
        if (h1) peerA8_finish(B1, lane, ehi, aghi, xp, SU, SV);
    }
}
struct PeerGather8 { u32x4 vv[8]; float aw[8]; };
__device__ __forceinline__ void peerB8_gather(PeerGather8& G, const unsigned char* V8, int lane, int cs, const LAS int* ELt, const LAS float* ALt) {
    const int rg = lane >> 2, cl = lane & 3;
#pragma unroll
    for (int j = 0; j < 8; ++j) { const int e = ELt[16 * j + rg]; G.aw[j] = ALt[16 * j + rg];
        G.vv[j] = *(const u32x4*)(V8 + (((unsigned)(cs * PK * PK) + (unsigned)e) * 64u + (unsigned)(cl * 16))); }
}
__device__ __forceinline__ float peerB8_reduce(const PeerGather8& G, int lane) {
    f32x2 acc[8];
#pragma unroll
    for (int c = 0; c < 8; ++c) acc[c] = (f32x2){0.f, 0.f};
#pragma unroll
    for (int j = 0; j < 8; ++j) { const unsigned ww[4] = {G.vv[j].x, G.vv[j].y, G.vv[j].z, G.vv[j].w}; const f32x2 a2 = (f32x2){G.aw[j], G.aw[j]};
#pragma unroll
        for (int m = 0; m < 4; ++m) { acc[2 * m] += __builtin_amdgcn_cvt_pk_f32_fp8(ww[m], false) * a2; acc[2 * m + 1] += __builtin_amdgcn_cvt_pk_f32_fp8(ww[m], true) * a2; } }
    const bool b5 = lane & 32, b4 = lane & 16, b3 = lane & 8, b2 = lane & 4;
    float v8[8], v4[4], v2[2];
#pragma unroll
    for (int c = 0; c < 8; ++c) { const float lo = (c & 1) ? acc[c >> 1].y : acc[c >> 1].x, hi = (c & 1) ? acc[4 + (c >> 1)].y : acc[4 + (c >> 1)].x;
        v8[c] = (b5 ? hi : lo) + shx32(b5 ? lo : hi, lane); }
#pragma unroll
    for (int c = 0; c < 4; ++c) v4[c] = (b4 ? v8[c + 4] : v8[c]) + shx16(b4 ? v8[c] : v8[c + 4], lane);
#pragma unroll
    for (int c = 0; c < 2; ++c) v2[c] = (b3 ? v4[c + 2] : v4[c]) + shx8(b3 ? v4[c] : v4[c + 2]);
    return (b2 ? v2[1] : v2[0]) + shx4(b2 ? v2[0] : v2[1], lane);
}
__device__ __forceinline__ void p9_peer_fp8(const Frame& F, const Args& a, float* dst) {
    XcdBarrier bar; bar.bar = (unsigned*)(a.ws + WS_CTL) + CW_BAR; bar.x = xb_xcc_id(); bar.st = (volatile LAS unsigned*)(F.lds + LDSCTL_OFF) + 8;
    float* H2 = a.out; const int* EIDX = (const int*)(a.ws + WS_EIDX); const float* GATE = (const float*)(a.ws + WS_GATE);
    const unsigned char* U8 = a.ws + WS_U8; const unsigned char* V8 = a.ws + WS_V8; const float* SU = (const float*)(a.ws + WS_SU); const float* SV = (const float*)(a.ws + WS_SV);
    const int gw = F.vcu * NWAVES + F.wave, lane = F.lane, tokb = gw * 16;
    LAS int* EL = (LAS int*)(F.lds + F.wave * 16384); LAS float* AL = (LAS float*)(F.lds + F.wave * 16384 + 8192);
#pragma unroll 4
    for (int ti = 0; ti < 16; ++ti) { const size_t o = (size_t)(tokb + ti) * 128;
        EL[ti * 128 + lane] = EIDX[o + lane]; EL[ti * 128 + 64 + lane] = EIDX[o + 64 + lane]; AL[ti * 128 + lane] = GATE[o + lane]; AL[ti * 128 + 64 + lane] = GATE[o + 64 + lane]; }
#pragma unroll 1
    for (int sub = 0; sub < 2; ++sub) {
        unsigned xp[8][8];
#pragma unroll
        for (int i = 0; i < 8; ++i) {
            const int t = tokb + sub * 8 + i;
            const f32x4* hr = (const f32x4*)(H2 + (size_t)t * D) + 4 * lane; const f32x4* gr = (const f32x4*)a.g_ffn + 4 * lane;
            f32x4 hv[4]; float s = 0.f;
#pragma unroll
            for (int j = 0; j < 4; ++j) { hv[j] = hr[j]; s += (hv[j].x * hv[j].x + hv[j].y * hv[j].y) + (hv[j].z * hv[j].z + hv[j].w * hv[j].w); }
            const float rstd = 1.0f / sqrtf(wave_sum(s) * (1.f / D) + EPS);
#pragma unroll
            for (int j = 0; j < 4; ++j) { const f32x4 xv = hv[j] * rstd * gr[j]; xp[i][2 * j] = pk2(xv.x, xv.y); xp[i][2 * j + 1] = pk2(xv.z, xv.w); }
        }
        if (P9_ALIGN && sub) xcd_barrier(bar);
#pragma unroll 1
        for (int s = 0; s < 8; ++s) {
#pragma unroll
            for (int i = 0; i < 8; ++i) { const int o = (sub * 8 + i) * 128;
                const int elo = EL[o + lane], ehi = EL[o + 64 + lane]; int aglo = __builtin_bit_cast(int, AL[o + lane]), aghi = __builtin_bit_cast(int, AL[o + 64 + lane]);
                peerA8_token(U8, SU, SV, lane, s, elo, ehi, aglo, aghi, xp[i]);
                AL[o + lane] = __builtin_bit_cast(float, aglo); AL[o + 64 + lane] = __builtin_bit_cast(float, aghi); }
        }
#if PROBE_P9 == 1
#pragma unroll 1
        for (int s = 0; s < 8; ++s) {
#pragma unroll
            for (int i = 0; i < 8; ++i) { const int o = (sub * 8 + i) * 128;
                const int elo = EL[o + lane], ehi = EL[o + 64 + lane]; int aglo = __builtin_bit_cast(int, AL[o + lane]), aghi = __builtin_bit_cast(int, AL[o + 64 + lane]);
                peerA8_token(U8, SU, SV, lane, s, elo, ehi, aglo, aghi, xp[i]);
                asm volatile("" :: "v"(aglo), "v"(aghi)); }
        }
#endif
    }
    if (P9_ALIGN) xcd_barrier(bar);
    const int col = 16 * (lane & 3) + ((lane >> 5) & 1) * 8 + ((lane >> 4) & 1) * 4 + ((lane >> 3) & 1) * 2 + ((lane >> 2) & 1);
#pragma unroll 1
    for (int cs = 0; cs < 16; ++cs) {
        if (P9_ALIGN >= 2 && cs == 8) xcd_barrier(bar);
        PeerGather8 G0, G1, G2;
        peerB8_gather(G0, V8, lane, cs, EL, AL); peerB8_gather(G1, V8, lane, cs, EL + 128, AL + 128);
#pragma unroll 1
        for (int ti = 0; ti < 15; ti += 3) {
            float* hp0 = H2 + (size_t)(tokb + ti) * D + cs * 64 + col; float* hp1 = hp0 + D; float* hp2 = hp1 + D; const float h0 = *hp0, h1 = *hp1, h2 = *hp2;
            peerB8_gather(G2, V8, lane, cs, EL + (ti + 2) * 128, AL + (ti + 2) * 128);
            *hp0 = h0 + peerB8_reduce(G0, lane);
            peerB8_gather(G0, V8, lane, cs, EL + (ti + 3) * 128, AL + (ti + 3) * 128);
            *hp1 = h1 + peerB8_reduce(G1, lane);
            if (ti + 4 < 16) peerB8_gather(G1, V8, lane, cs, EL + (ti + 4) * 128, AL + (ti + 4) * 128);
            *hp2 = h2 + peerB8_reduce(G2, lane);
        }
        { float* hp = H2 + (size_t)(tokb + 15) * D + cs * 64 + col; *hp = *hp + peerB8_reduce(G0, lane); }
    }
#if PROBE_P9 == 2
#pragma unroll 1
    for (int cs = 0; cs < 16; ++cs) {
        PeerGather8 G0, G1;
        peerB8_gather(G0, V8, lane, cs, EL, AL);
#pragma unroll 1
        for (int ti = 0; ti < 16; ti += 2) {
            float* hp0 = H2 + (size_t)(tokb + ti) * D + cs * 64 + col; float* hp1 = hp0 + D; const float h0 = *hp0, h1 = *hp1;
            peerB8_gather(G1, V8, lane, cs, EL + (ti + 1) * 128, AL + (ti + 1) * 128);
            const float r0 = h0 + peerB8_reduce(G0, lane);
            if (ti + 2 < 16) peerB8_gather(G0, V8, lane, cs, EL + (ti + 2) * 128, AL + (ti + 2) * 128);
            const float r1 = h1 + peerB8_reduce(G1, lane);
            asm volatile("" :: "v"(r0), "v"(r1));
        }
    }
#endif
    asm volatile("s_waitcnt vmcnt(0)" ::: "memory");
    __builtin_amdgcn_fence(__ATOMIC_RELEASE, "workgroup"); __builtin_amdgcn_fence(__ATOMIC_ACQUIRE, "workgroup");
#pragma unroll 2
    for (int ti = 0; ti < 16; ++ti) {
        const f32x4* hr = (const f32x4*)(H2 + (size_t)(tokb + ti) * D) + 4 * lane; f32x4* orow = (f32x4*)(dst + (size_t)(tokb + ti) * D) + 4 * lane; const f32x4* gf = (const f32x4*)a.g_final + 4 * lane;
        f32x4 hv[4]; float s2 = 0.f;
#pragma unroll
        for (int j = 0; j < 4; ++j) { hv[j] = hr[j]; s2 += (hv[j].x * hv[j].x + hv[j].y * hv[j].y) + (hv[j].z * hv[j].z + hv[j].w * hv[j].w); }
        const float rstd2 = 1.0f / sqrtf(wave_sum(s2) * (1.f / D) + EPS);
#pragma unroll
        for (int j = 0; j < 4; ++j) orow[j] = hv[j] * rstd2 * gf[j];
    }
}

constexpr int XPITCH = 2064, PA_CAP = 384, PA_STRIDE = 8 * XPITCH + 2 * PA_CAP * 4;
static_assert(PA_STRIDE % 16 == 0 && 8 * PA_STRIDE <= LDSCTL_OFF, "P9 step A LDS map");
typedef float f32x4v __attribute__((ext_vector_type(4)));
__device__ __forceinline__ int lane_rank(unsigned long long m) { return (int)__builtin_amdgcn_mbcnt_hi((unsigned)(m >> 32), __builtin_amdgcn_mbcnt_lo((unsigned)m, 0u)); }
#ifndef MSHIFT
#define MSHIFT 10
#endif
__device__ __forceinline__ void p9_peer_mfma(const Frame& F, const Args& a, float* dst) {
    XcdBarrier bar; bar.bar = (unsigned*)(a.ws + WS_CTL) + CW_BAR; bar.x = xb_xcc_id(); bar.st = (volatile LAS unsigned*)(F.lds + LDSCTL_OFF) + 8;
    float* H2 = a.out; const int* EIDX = (const int*)(a.ws + WS_EIDX); const float* GATE = (const float*)(a.ws + WS_GATE); float* ACT = (float*)(a.ws + WS_ACT);
    const bf16_t* Ub = (const bf16_t*)(a.ws + WS_UB); const unsigned char* V8 = a.ws + WS_V8; const float* SV = (const float*)(a.ws + WS_SV);
    const int gw = F.vcu * NWAVES + F.wave, lane = F.lane, tokb = gw * 16, n16 = lane & 15, kg = lane >> 4;
    LAS unsigned char* wl = F.lds + F.wave * PA_STRIDE;
    LAS unsigned* rowl = (LAS unsigned*)(wl + 8 * XPITCH); LAS float* dl = (LAS float*)(wl + 8 * XPITCH + PA_CAP * 4);
#pragma unroll 1
    for (int sub = 0; sub < 2; ++sub) {
        int elo[8], ehi[8]; float glo[8], ghi[8];
#pragma unroll
        for (int i = 0; i < 8; ++i) {
            const int t = tokb + sub * 8 + i;
            const f32x4* hr = (const f32x4*)(H2 + (size_t)t * D) + 4 * lane; const f32x4* gr = (const f32x4*)a.g_ffn + 4 * lane;
            f32x4 hv[4]; float s = 0.f;
#pragma unroll
            for (int j = 0; j < 4; ++j) { hv[j] = hr[j]; s += (hv[j].x * hv[j].x + hv[j].y * hv[j].y) + (hv[j].z * hv[j].z + hv[j].w * hv[j].w); }
            const float rstd = 1.0f / sqrtf(wave_sum(s) * (1.f / D) + EPS);
            u32x4 w0, w1; f32x4 x0 = hv[0] * rstd * gr[0], x1 = hv[1] * rstd * gr[1], x2 = hv[2] * rstd * gr[2], x3 = hv[3] * rstd * gr[3];
            w0.x = pk2(x0.x, x0.y); w0.y = pk2(x0.z, x0.w); w0.z = pk2(x1.x, x1.y); w0.w = pk2(x1.z, x1.w); w1.x = pk2(x2.x, x2.y); w1.y = pk2(x2.z, x2.w); w1.z = pk2(x3.x, x3.y); w1.w = pk2(x3.z, x3.w);
            *(LAS u32x4*)(wl + i * XPITCH + 32 * lane) = w0; *(LAS u32x4*)(wl + i * XPITCH + 32 * lane + 16) = w1;
            elo[i] = EIDX[(size_t)t * 128 + lane]; ehi[i] = EIDX[(size_t)t * 128 + 64 + lane]; glo[i] = GATE[(size_t)t * 128 + lane]; ghi[i] = GATE[(size_t)t * 128 + 64 + lane];
        }
        if (P9_ALIGN && sub) xcd_barrier(bar);
#if PROBE_P9 == 3
        float sglo[8], sghi[8];
#pragma unroll
        for (int i = 0; i < 8; ++i) { sglo[i] = glo[i]; sghi[i] = ghi[i]; }
#pragma unroll 1
        for (int rep = 0; rep < 2; ++rep) {
        if (rep) {
#pragma unroll
            for (int i = 0; i < 8; ++i) { glo[i] = sglo[i]; ghi[i] = sghi[i]; } }
#endif
#pragma unroll 1
        for (int s = 0; s < (16384 >> MSHIFT); ++s) {
#pragma unroll 1
            for (int wb = 0;; wb += PA_CAP) {
                int cnt = 0;
#pragma unroll
                for (int i = 0; i < 8; ++i)
#pragma unroll
                    for (int hf = 0; hf < 2; ++hf) { const int ev = hf ? ehi[i] : elo[i]; const bool in = (ev >> MSHIFT) == s; const unsigned long long m = __ballot(in);
                        const int rk = cnt + lane_rank(m) - wb; if (in && rk >= 0 && rk < PA_CAP) rowl[rk] = (unsigned)ev | ((unsigned)i << 14); cnt += __builtin_popcountll(m); }
                const int nW = (cnt - wb) < PA_CAP ? (cnt - wb) : PA_CAP;
                for (int g = 0; g * 16 < nW; ++g) {
                    const int r = 16 * g + n16; const unsigned ent = rowl[r < nW ? r : nW - 1];
                    const char* ap = (const char*)Ub + ((size_t)(ent & 0x3fffu) * (D * 2) + 32 * kg);
                    const LAS unsigned char* xb = wl + (n16 & 7) * XPITCH + 32 * kg;
                    bf16x8 af[32];
#pragma unroll
                    for (int st = 0; st < 32; ++st) af[st] = *(const bf16x8*)(ap + 128 * (st >> 1) + 16 * (st & 1));
                    __builtin_amdgcn_sched_barrier(0);
                    f32x4v acc = (f32x4v){0.f, 0.f, 0.f, 0.f};
#pragma unroll
                    for (int st = 0; st < 32; ++st) acc = __builtin_amdgcn_mfma_f32_16x16x32_bf16(af[st], *(const LAS bf16x8*)(xb + 128 * (st >> 1) + 16 * (st & 1)), acc, 0, 0, 0);
                    const u32x4 e4 = *(const LAS u32x4*)(rowl + 16 * g + 4 * kg); const unsigned ee[4] = {e4.x, e4.y, e4.z, e4.w};
#pragma unroll
                    for (int q = 0; q < 4; ++q) { const int row = 16 * g + 4 * kg + q; if (row < nW && (int)((ee[q] >> 14) & 7u) == n16) dl[row] = acc[q]; }
                }
                int c2 = 0;
#pragma unroll
                for (int i = 0; i < 8; ++i)
#pragma unroll
                    for (int hf = 0; hf < 2; ++hf) { const int ev = hf ? ehi[i] : elo[i]; const bool in = (ev >> MSHIFT) == s; const unsigned long long m = __ballot(in);
                        const int rk = c2 + lane_rank(m) - wb; const bool ok = in && rk >= 0 && rk < PA_CAP; const float d = dl[ok ? rk : 0];
                        const float gold = hf ? ghi[i] : glo[i], gnew = ok ? gelu_as(d) * gold : gold; if (hf) ghi[i] = gnew; else glo[i] = gnew; c2 += __builtin_popcountll(m); }
                if (cnt - wb <= PA_CAP) break;
            }
        }
#if PROBE_P9 == 3
        }
#endif
#pragma unroll
        for (int i = 0; i < 8; ++i) { const size_t o = (size_t)(tokb + sub * 8 + i) * 128; ACT[o + lane] = glo[i] * SV[elo[i]]; ACT[o + 64 + lane] = ghi[i] * SV[ehi[i]]; }
    }
    asm volatile("s_waitcnt vmcnt(0)" ::: "memory");
    if (P9_ALIGN) xcd_barrier(bar); else __syncthreads();
    LAS int* EL = (LAS int*)(F.lds + F.wave * 16384); LAS float* AL = (LAS float*)(F.lds + F.wave * 16384 + 8192);
#pragma unroll 4
    for (int ti = 0; ti < 16; ++ti) { const size_t o = (size_t)(tokb + ti) * 128;
        EL[ti * 128 + lane] = EIDX[o + lane]; EL[ti * 128 + 64 + lane] = EIDX[o + 64 + lane]; AL[ti * 128 + lane] = ACT[o + lane]; AL[ti * 128 + 64 + lane] = ACT[o + 64 + lane]; }
    const int col = 16 * (lane & 3) + ((lane >> 5) & 1) * 8 + ((lane >> 4) & 1) * 4 + ((lane >> 3) & 1) * 2 + ((lane >> 2) & 1);
#pragma unroll 1
    for (int cs = 0; cs < 16; ++cs) {
        if (P9_ALIGN >= 2 && cs == 8) xcd_barrier(bar);
        PeerGather8 G0, G1, G2;
        peerB8_gather(G0, V8, lane, cs, EL, AL); peerB8_gather(G1, V8, lane, cs, EL + 128, AL + 128);
#pragma unroll 1
        for (int ti = 0; ti < 15; ti += 3) {
            float* hp0 = H2 + (size_t)(tokb + ti) * D + cs * 64 + col; float* hp1 = hp0 + D; float* hp2 = hp1 + D; const float h0 = *hp0, h1 = *hp1, h2 = *hp2;
            peerB8_gather(G2, V8, lane, cs, EL + (ti + 2) * 128, AL + (ti + 2) * 128);
            *hp0 = h0 + peerB8_reduce(G0, lane);
            peerB8_gather(G0, V8, lane, cs, EL + (ti + 3) * 128, AL + (ti + 3) * 128);
            *hp1 = h1 + peerB8_reduce(G1, lane);
            if (ti + 4 < 16) peerB8_gather(G1, V8, lane, cs, EL + (ti + 4) * 128, AL + (ti + 4) * 128);
            *hp2 = h2 + peerB8_reduce(G2, lane);
        }
        { float* hp = H2 + (size_t)(tokb + 15) * D + cs * 64 + col; *hp = *hp + peerB8_reduce(G0, lane); }
    }
    asm volatile("s_waitcnt vmcnt(0)" ::: "memory");
    __builtin_amdgcn_fence(__ATOMIC_RELEASE, "workgroup"); __builtin_amdgcn_fence(__ATOMIC_ACQUIRE, "workgroup");
#pragma unroll 2
    for (int ti = 0; ti < 16; ++ti) {
        const f32x4* hr = (const f32x4*)(H2 + (size_t)(tokb + ti) * D) + 4 * lane; f32x4* orow = (f32x4*)(dst + (size_t)(tokb + ti) * D) + 4 * lane; const f32x4* gf = (const f32x4*)a.g_final + 4 * lane;
        f32x4 hv[4]; float s2 = 0.f;
#pragma unroll
        for (int j = 0; j < 4; ++j) { hv[j] = hr[j]; s2 += (hv[j].x * hv[j].x + hv[j].y * hv[j].y) + (hv[j].z * hv[j].z + hv[j].w * hv[j].w); }
        const float rstd2 = 1.0f / sqrtf(wave_sum(s2) * (1.f / D) + EPS);
#pragma unroll
        for (int j = 0; j < 4; ++j) orow[j] = hv[j] * rstd2 * gf[j];
    }
}

__device__ __forceinline__ void peerA_finish_sv(const PeerBatch& B, int lane, int ev, int& agv, const unsigned (&xp)[8], const float* SV) {
#define DOT16(lo, hi) (dot2bf((hi).w, xp[7], dot2bf((hi).z, xp[6], dot2bf((hi).y, xp[5], dot2bf((hi).x, xp[4], 0.f)))) + dot2bf((lo).w, xp[3], dot2bf((lo).z, xp[2], dot2bf((lo).y, xp[1], dot2bf((lo).x, xp[0], 0.f)))))
    const float p0 = DOT16(B.r[0][0], B.r[0][1]), p1 = DOT16(B.r[1][0], B.r[1][1]), p2 = DOT16(B.r[2][0], B.r[2][1]), p3 = DOT16(B.r[3][0], B.r[3][1]);
#undef DOT16
    const bool hi5 = lane & 32, hi4 = lane & 16;
    const float k0 = hi5 ? p2 : p0, s0 = hi5 ? p0 : p2, k1 = hi5 ? p3 : p1, s1 = hi5 ? p1 : p3;
    const float t0 = k0 + __shfl_xor(s0, 32), t1 = k1 + __shfl_xor(s1, 32);
    const float k2 = hi4 ? t1 : t0, s2 = hi4 ? t0 : t1;
    float d = k2 + __shfl_xor(s2, 16);
    d += __shfl_xor(d, 8); d += __shfl_xor(d, 4); d += __shfl_xor(d, 2); d += __shfl_xor(d, 1);
    const float agf = __builtin_bit_cast(float, agv);
    const float g0 = rdlanef(agf, B.l0) * SV[rdlane(ev, B.l0)], g1 = rdlanef(agf, B.l1) * SV[rdlane(ev, B.l1)], g2 = rdlanef(agf, B.l2) * SV[rdlane(ev, B.l2)], g3 = rdlanef(agf, B.l3) * SV[rdlane(ev, B.l3)];
    const float gq = hi5 ? (hi4 ? g3 : g2) : (hi4 ? g1 : g0);
    const int ai = __builtin_bit_cast(int, gelu_as(d) * gq);
    const int w0 = rdlane(ai, 0), w1 = rdlane(ai, 16), w2 = rdlane(ai, 32), w3 = rdlane(ai, 48);
    agv = lane == B.l0 ? w0 : agv; agv = lane == B.l1 ? w1 : agv; agv = lane == B.l2 ? w2 : agv; agv = lane == B.l3 ? w3 : agv;
}
#ifndef HSHIFT
#define HSHIFT 11
#endif
#ifndef PEER_A8
#define PEER_A8 0
#endif
__device__ __forceinline__ void peerA_token2(const bf16_t* Ub, const float* SV, int lane, int s, int e0lo, int e0hi, int& a0lo, int& a0hi, const unsigned (&xp0)[8],
                                             int e1lo, int e1hi, int& a1lo, int& a1hi, const unsigned (&xp1)[8]) {
    unsigned long long m0 = __ballot((e0lo >> HSHIFT) == s), m1 = __ballot((e0hi >> HSHIFT) == s), m2 = __ballot((e1lo >> HSHIFT) == s), m3 = __ballot((e1hi >> HSHIFT) == s);
    while (m0 | m1 | m2 | m3) {
        const bool h0 = m0 != 0ull, h1 = m1 != 0ull, h2 = m2 != 0ull, h3 = m3 != 0ull;
        PeerBatch B0, B1, B2, B3;
        if (h0) peerA_take(m0, B0, Ub, lane, e0lo);
        if (h1) peerA_take(m1, B1, Ub, lane, e0hi);
        if (h2) peerA_take(m2, B2, Ub, lane, e1lo);
        if (h3) peerA_take(m3, B3, Ub, lane, e1hi);
        if (h0) peerA_finish(B0, lane, a0lo, xp0);
        if (h1) peerA_finish(B1, lane, a0hi, xp0);
        if (h2) peerA_finish(B2, lane, a1lo, xp1);
        if (h3) peerA_finish(B3, lane, a1hi, xp1);
    }
}

__device__ __forceinline__ void peerA8_finish_v(const PeerBatch8& B, int lane, float suv, int& agv, const unsigned (&xp)[8]) {
    float p[8];
#pragma unroll
    for (int j = 0; j < 8; ++j) p[j] = dot16_fp8(B.r[j], xp);
    const bool b5 = lane & 32, b4 = lane & 16, b3 = lane & 8;
    float q4[4], q2[2];
#pragma unroll
    for (int c = 0; c < 4; ++c) { const float keep = b5 ? p[c + 4] : p[c], send = b5 ? p[c] : p[c + 4]; q4[c] = keep + __shfl_xor(send, 32); }
#pragma unroll
    for (int c = 0; c < 2; ++c) { const float keep = b4 ? q4[c + 2] : q4[c], send = b4 ? q4[c] : q4[c + 2]; q2[c] = keep + __shfl_xor(send, 16); }
    float d = (b3 ? q2[1] : q2[0]) + __shfl_xor(b3 ? q2[0] : q2[1], 8);
    d += __shfl_xor(d, 4); d += __shfl_xor(d, 2); d += __shfl_xor(d, 1);
    const float agf = __builtin_bit_cast(float, agv);
    float c1[8], c2[8];
#pragma unroll
    for (int j = 0; j < 8; ++j) { c1[j] = rdlanef(suv, B.l[j]); c2[j] = rdlanef(agf, B.l[j]); }
    const float s1 = b5 ? (b4 ? (b3 ? c1[7] : c1[6]) : (b3 ? c1[5] : c1[4])) : (b4 ? (b3 ? c1[3] : c1[2]) : (b3 ? c1[1] : c1[0]));
    const float s2 = b5 ? (b4 ? (b3 ? c2[7] : c2[6]) : (b3 ? c2[5] : c2[4])) : (b4 ? (b3 ? c2[3] : c2[2]) : (b3 ? c2[1] : c2[0]));
    const int ai = __builtin_bit_cast(int, gelu_as(d * s1) * s2);
#pragma unroll
    for (int j = 0; j < 8; ++j) { const int w = rdlane(ai, 8 * j); agv = lane == B.l[j] ? w : agv; }
}
__device__ __forceinline__ void peerA8_token2(const unsigned char* U8, const float* SU, int lane, int s, int e0lo, int e0hi, int& a0lo, int& a0hi, const unsigned (&xp0)[8],
                                              int e1lo, int e1hi, int& a1lo, int& a1hi, const unsigned (&xp1)[8]) {
    unsigned long long m0 = __ballot((e0lo >> 11) == s), m1 = __ballot((e0hi >> 11) == s), m2 = __ballot((e1lo >> 11) == s), m3 = __ballot((e1hi >> 11) == s);
    const float su0 = SU[e0lo], su1 = SU[e0hi], su2 = SU[e1lo], su3 = SU[e1hi];
    while (m0 | m1 | m2 | m3) {
        const bool h0 = m0 != 0ull, h1 = m1 != 0ull, h2 = m2 != 0ull, h3 = m3 != 0ull;
        PeerBatch8 B0, B1, B2, B3;
        if (h0) peerA8_take(m0, B0, U8, lane, e0lo);
        if (h1) peerA8_take(m1, B1, U8, lane, e0hi);
        if (h2) peerA8_take(m2, B2, U8, lane, e1lo);
        if (h3) peerA8_take(m3, B3, U8, lane, e1hi);
        if (h0) peerA8_finish_v(B0, lane, su0, a0lo, xp0);
        if (h1) peerA8_finish_v(B1, lane, su1, a0hi, xp0);
        if (h2) peerA8_finish_v(B2, lane, su2, a1lo, xp1);
        if (h3) peerA8_finish_v(B3, lane, su3, a1hi, xp1);
    }
}

struct PeerBatchB8 { int l[8]; u32x4 r[8][2]; };
__device__ __forceinline__ void peerAB8_take(unsigned long long& m, PeerBatchB8& B, const bf16_t* Ub, int lane, int ev) {
    B.l[0] = __builtin_ctzll(m); m &= m - 1;
#pragma unroll
    for (int j = 1; j < 8; ++j) { B.l[j] = m ? __builtin_ctzll(m) : B.l[0]; m &= m - 1; }
#pragma unroll
    for (int j = 0; j < 8; ++j) { const int e = rdlane(ev, B.l[j]); const u32x4* rp = (const u32x4*)(Ub + (size_t)e * D) + 2 * lane; B.r[j][0] = rp[0]; B.r[j][1] = rp[1]; }
}
__device__ __forceinline__ void peerAB8_finish(const PeerBatchB8& B, int lane, int& agv, const unsigned (&xp)[8]) {
    float p[8];
#define DOT16(lo, hi) (dot2bf((hi).w, xp[7], dot2bf((hi).z, xp[6], dot2bf((hi).y, xp[5], dot2bf((hi).x, xp[4], 0.f)))) + dot2bf((lo).w, xp[3], dot2bf((lo).z, xp[2], dot2bf((lo).y, xp[1], dot2bf((lo).x, xp[0], 0.f)))))
#pragma unroll
    for (int j = 0; j < 8; ++j) p[j] = DOT16(B.r[j][0], B.r[j][1]);
#undef DOT16
    const bool b5 = lane & 32, b4 = lane & 16, b3 = lane & 8;
    float q4[4], q2[2];
#pragma unroll
    for (int c = 0; c < 4; ++c) q4[c] = (b5 ? p[c + 4] : p[c]) + shx32(b5 ? p[c] : p[c + 4], lane);
#pragma unroll
    for (int c = 0; c < 2; ++c) q2[c] = (b4 ? q4[c + 2] : q4[c]) + shx16(b4 ? q4[c] : q4[c + 2], lane);
    float d = (b3 ? q2[1] : q2[0]) + shx8(b3 ? q2[0] : q2[1]);
    d += dppf<0xB1>(d); d += dppf<0x4E>(d); d += dppf<0x141>(d);
    const float agf = __builtin_bit_cast(float, agv);
    float g8[8];
#pragma unroll
    for (int j = 0; j < 8; ++j) g8[j] = rdlanef(agf, B.l[j]);
    const float gq = b5 ? (b4 ? (b3 ? g8[7] : g8[6]) : (b3 ? g8[5] : g8[4])) : (b4 ? (b3 ? g8[3] : g8[2]) : (b3 ? g8[1] : g8[0]));
    const int ai = __builtin_bit_cast(int, gelu_as(d) * gq);
#pragma unroll
    for (int j = 0; j < 8; ++j) { const int w = rdlane(ai, 8 * j); agv = lane == B.l[j] ? w : agv; }
}
__device__ __forceinline__ void peerAB8_token(const bf16_t* Ub, int lane, int s, int elo, int ehi, int& aglo, int& aghi, const unsigned (&xp)[8]) {
    unsigned long long m0 = __ballot((elo >> HSHIFT) == s), m1 = __ballot((ehi >> HSHIFT) == s);
    while (m0 | m1) {
        const bool h0 = m0 != 0ull, h1 = m1 != 0ull;
        PeerBatchB8 B0, B1;
        if (h0) peerAB8_take(m0, B0, Ub, lane, elo);
        if (h1) peerAB8_take(m1, B1, Ub, lane, ehi);
        if (h0) peerAB8_finish(B0, lane, aglo, xp);
        if (h1) peerAB8_finish(B1, lane, aghi, xp);
    }
}
__device__ __forceinline__ void p9_peer_hybrid(const Frame& F, const Args& a, float* dst) {
    XcdBarrier bar; bar.bar = (unsigned*)(a.ws + WS_CTL) + CW_BAR; bar.x = xb_xcc_id(); bar.st = (volatile LAS unsigned*)(F.lds + LDSCTL_OFF) + 8;
    float* H2 = a.out; const int* EIDX = (const int*)(a.ws + WS_EIDX); const float* GATE = (const float*)(a.ws + WS_GATE);
    const bf16_t* Ub = (const bf16_t*)(a.ws + WS_UB); const unsigned char* V8 = a.ws + WS_V8; const float* SV = (const float*)(a.ws + WS_SV);
    const int gw = F.vcu * NWAVES + F.wave, lane = F.lane, tokb = gw * 16;
    LAS int* EL = (LAS int*)(F.lds + F.wave * 16384); LAS float* AL = (LAS float*)(F.lds + F.wave * 16384 + 8192);
#pragma unroll 4
    for (int ti = 0; ti < 16; ++ti) { const size_t o = (size_t)(tokb + ti) * 128;
        EL[ti * 128 + lane] = EIDX[o + lane]; EL[ti * 128 + 64 + lane] = EIDX[o + 64 + lane]; AL[ti * 128 + lane] = GATE[o + lane]; AL[ti * 128 + 64 + lane] = GATE[o + 64 + lane]; }
    const bf16_t* N2 = (const bf16_t*)(a.ws + WS_XN);
#pragma unroll 1
    for (int s = 0; s < (16384 >> HSHIFT); ++s) {
        if (P9_ALIGN >= 2 && s == (8192 >> HSHIFT)) xcd_barrier(bar);
#if PEER_A8
#pragma unroll 1
        for (int i = 0; i < 16; ++i) { const int o = i * 128;
            const u32x4* x0 = (const u32x4*)(N2 + (size_t)(tokb + i) * D) + 2 * lane; const u32x4 xa = x0[0], xb = x0[1];
            const unsigned xp0[8] = {xa.x, xa.y, xa.z, xa.w, xb.x, xb.y, xb.z, xb.w};
            const int e0lo = EL[o + lane], e0hi = EL[o + 64 + lane]; int a0lo = __builtin_bit_cast(int, AL[o + lane]), a0hi = __builtin_bit_cast(int, AL[o + 64 + lane]);
            peerAB8_token(Ub, lane, s, e0lo, e0hi, a0lo, a0hi, xp0);
            AL[o + lane] = __builtin_bit_cast(float, a0lo); AL[o + 64 + lane] = __builtin_bit_cast(float, a0hi); }
#else
#pragma unroll 1
        for (int i = 0; i < 16; i += 2) { const int o = i * 128;
            const u32x4* x0 = (const u32x4*)(N2 + (size_t)(tokb + i) * D) + 2 * lane; const u32x4* x1 = x0 + D / 8;
            const u32x4 xa = x0[0], xb = x0[1], xc = x1[0], xd = x1[1];
            const unsigned xp0[8] = {xa.x, xa.y, xa.z, xa.w, xb.x, xb.y, xb.z, xb.w}, xp1[8] = {xc.x, xc.y, xc.z, xc.w, xd.x, xd.y, xd.z, xd.w};
            const int e0lo = EL[o + lane], e0hi = EL[o + 64 + lane], e1lo = EL[o + 128 + lane], e1hi = EL[o + 192 + lane];
            int a0lo = __builtin_bit_cast(int, AL[o + lane]), a0hi = __builtin_bit_cast(int, AL[o + 64 + lane]), a1lo = __builtin_bit_cast(int, AL[o + 128 + lane]), a1hi = __builtin_bit_cast(int, AL[o + 192 + lane]);
            if (PEER_SLICED == 5) peerA8_token2(a.ws + WS_U8F, (const float*)(a.ws + WS_SU), lane, s, e0lo, e0hi, a0lo, a0hi, xp0, e1lo, e1hi, a1lo, a1hi, xp1);
            else peerA_token2(Ub, SV, lane, s, e0lo, e0hi, a0lo, a0hi, xp0, e1lo, e1hi, a1lo, a1hi, xp1);
            AL[o + lane] = __builtin_bit_cast(float, a0lo); AL[o + 64 + lane] = __builtin_bit_cast(float, a0hi); AL[o + 128 + lane] = __builtin_bit_cast(float, a1lo); AL[o + 192 + lane] = __builtin_bit_cast(float, a1hi); }
#endif
    }
#pragma unroll 4
    for (int ti = 0; ti < 16; ++ti) { AL[ti * 128 + lane] *= SV[EL[ti * 128 + lane]]; AL[ti * 128 + 64 + lane] *= SV[EL[ti * 128 + 64 + lane]]; }
    if (P9_ALIGN) xcd_barrier(bar);
    const int col = 16 * (lane & 3) + ((lane >> 5) & 1) * 8 + ((lane >> 4) & 1) * 4 + ((lane >> 3) & 1) * 2 + ((lane >> 2) & 1);
#pragma unroll 1
    for (int cs = 0; cs < 16; ++cs) {
        if (P9_ALIGN >= 2 && cs == 8) xcd_barrier(bar);
        PeerGather8 G0, G1, G2;
        peerB8_gather(G0, V8, lane, cs, EL, AL); peerB8_gather(G1, V8, lane, cs, EL + 128, AL + 128);
#pragma unroll 1
        for (int ti = 0; ti < 15; ti += 3) {
            float* hp0 = H2 + (size_t)(tokb + ti) * D + cs * 64 + col; float* hp1 = hp0 + D; float* hp2 = hp1 + D; const float h0 = *hp0, h1 = *hp1, h2 = *hp2;
            peerB8_gather(G2, V8, lane, cs, EL + (ti + 2) * 128, AL + (ti + 2) * 128);
            *hp0 = h0 + peerB8_reduce(G0, lane);
            peerB8_gather(G0, V8, lane, cs, EL + (ti + 3) * 128, AL + (ti + 3) * 128);
            *hp1 = h1 + peerB8_reduce(G1, lane);
            if (ti + 4 < 16) peerB8_gather(G1, V8, lane, cs, EL + (ti + 4) * 128, AL + (ti + 4) * 128);
            *hp2 = h2 + peerB8_reduce(G2, lane);
        }
        { float* hp = H2 + (size_t)(tokb + 15) * D + cs * 64 + col; *hp = *hp + peerB8_reduce(G0, lane); }
    }
    asm volatile("s_waitcnt vmcnt(0)" ::: "memory");
    __builtin_amdgcn_fence(__ATOMIC_RELEASE, "workgroup"); __builtin_amdgcn_fence(__ATOMIC_ACQUIRE, "workgroup");
#pragma unroll 2
    for (int ti = 0; ti < 16; ++ti) {
        const f32x4* hr = (const f32x4*)(H2 + (size_t)(tokb + ti) * D) + 4 * lane; f32x4* orow = (f32x4*)(dst + (size_t)(tokb + ti) * D) + 4 * lane; const f32x4* gf = (const f32x4*)a.g_final + 4 * lane;
        f32x4 hv[4]; float s2 = 0.f;
#pragma unroll
        for (int j = 0; j < 4; ++j) { hv[j] = hr[j]; s2 += (hv[j].x * hv[j].x + hv[j].y * hv[j].y) + (hv[j].z * hv[j].z + hv[j].w * hv[j].w); }
        const float rstd2 = 1.0f / sqrtf(wave_sum(s2) * (1.f / D) + EPS);
#pragma unroll
        for (int j = 0; j < 4; ++j) orow[j] = hv[j] * rstd2 * gf[j];
    }
}

__global__ void __launch_bounds__(NTHREADS, 2) fwd(Args a) {
    extern __shared__ __attribute__((aligned(16))) unsigned char lds[];
    Frame F; F.lds = (LAS unsigned char*)lds; F.tid = threadIdx.x; F.lane = F.tid & 63; F.wave = __builtin_amdgcn_readfirstlane(F.tid >> 6);
    F.G = gridDim.x; { const int bx = blockIdx.x; F.vcu = (F.G % 8 == 0) ? (bx % 8) * (F.G / 8) + bx / 8 : bx; }
    volatile LAS unsigned* MISC = (volatile LAS unsigned*)(F.lds + LDSCTL_OFF);
    for (int u = F.tid; u < (LDS_BYTES - LDSCTL_OFF) / 4; u += NTHREADS) ((LAS unsigned*)(F.lds + LDSCTL_OFF))[u] = 0u;
    __syncthreads();
    XcdBarrier bar; bar.bar = (unsigned*)(a.ws + WS_CTL) + CW_BAR; bar.x = 0; bar.st = nullptr;
    if (N_LAUNCHES == 1) bar = xcd_barrier_post((unsigned*)(a.ws + WS_CTL) + CW_BAR, MISC + 8);
    const int lo = a.ph_lo, hi = a.ph_hi;
#ifndef PHASE_MASK
#define PHASE_MASK 0xFFFF
#endif
#define IN(k) (((PHASE_MASK >> (k)) & 1) && lo <= (k) && (k) < hi)
#if USE_PG8
#define GEMM_CALL(EPI) pg8::gemm_phase<EPI, pg8::StaticOrder, true, true>(F.lds, g, S, E)
#else
#define GEMM_CALL(EPI) pg8::gemm_simple(g, S, E)
#endif
#define SEAM(k) do { if (IN(k) && IN((k) + 1)) xcd_barrier(bar); } while (0)
    bf16_t* PROJ = (bf16_t*)(a.ws + WS_PROJ);
#ifndef PROBE_REP
#define PROBE_REP 0
#endif
#define REPK(k) ((PROBE_REP >> (k)) & 1)
#define GEMM_P1 { pg8::Gemm g{(const bf16_t*)(a.ws + WS_XN), (const bf16_t*)(a.ws + WS_WIN), ROWS_A, LDP, D, D, D}; pg8::StaticOrder S; S.init(ROWS_A, LDP, F.G, (int)blockIdx.x); pg8::EpiBf16 E{PROJ, LDP}; GEMM_CALL(pg8::EpiBf16); }
#define GEMM_P5 { pg8::Gemm g{PROJ, (const bf16_t*)(a.ws + WS_WOUT), TR, D, D_MIX, LDP, D_MIX}; pg8::StaticOrder S; S.init(TR, D, F.G, (int)blockIdx.x); pg8::EpiResF32 E{a.x, a.out, D}; GEMM_CALL(pg8::EpiResF32); }
#define GEMM_P7 { pg8::Gemm g{(const bf16_t*)(a.ws + WS_XN), (const bf16_t*)(a.ws + WS_WQ), TR, PQ, D, D, D}; pg8::StaticOrder S; S.init(TR, PQ, F.G, (int)blockIdx.x); pg8::EpiBf16 E{(bf16_t*)(a.ws + WS_Q), PQ}; GEMM_CALL(pg8::EpiBf16); }
    if (IN(0)) { if (REPK(0)) p0_prologue(F, a); p0_prologue(F, a); } SEAM(0);
    if (IN(1)) { if (REPK(1)) GEMM_P1 GEMM_P1 } SEAM(1);
    if (IN(2)) { if (REPK(2)) p2_ssd_states(F, a, true); p2_ssd_states(F, a, false); } SEAM(2);
    if (IN(3)) { p3_ssd_recur(F, a); } SEAM(3);
    if (IN(4)) { if (REPK(4)) p4_ssd_out<true>(F, a); p4_ssd_out<false>(F, a); } SEAM(4);
    if (IN(5)) { if (REPK(5)) GEMM_P5 GEMM_P5 } SEAM(5);
    if (IN(6)) { if (REPK(6)) p5_norm2(F, a); p5_norm2(F, a); } SEAM(6);
    if (IN(7)) { if (REPK(7)) GEMM_P7 GEMM_P7 } SEAM(7);
    #ifndef TOPK_MFMA
#define TOPK_MFMA 1
#endif
    if (IN(8)) { if (TOPK_MFMA) { if (REPK(8)) p8_topk_mfma(F, a); p8_topk_mfma(F, a); } else { if (REPK(8)) p7_topk(F, a); p7_topk(F, a); } } SEAM(8);
    #ifndef PROBE_P9
#define PROBE_P9 0
#endif
#ifndef PEER_SLICED
#define PEER_SLICED 3
#endif
    if (IN(9)) { if (PEER_SLICED >= 4) p9_peer_hybrid(F, a, a.out); else if (PEER_SLICED == 3) p9_peer_mfma(F, a, a.out); else if (PEER_SLICED == 2) p9_peer_fp8(F, a, a.out); else if (PEER_SLICED) p9_peer_sliced(F, a, a.out, bar); else { if (REPK(9)) p8_peer_eval(F, a, (float*)(a.ws + WS_Q)); p8_peer_eval(F, a, a.out); } }
#undef IN
#undef SEAM
}

extern "C" void kernel_launch(void* const* d_in, const int* in_sizes, int n_in, void* d_out, int out_size, void* d_ws, size_t ws_size, hipStream_t stream) {
    static int grid = 0;
    if (grid == 0) {
        if (n_in != 18 || out_size != TR * D || ws_size < WS_END) { fprintf(stderr, "kernel_launch: unexpected problem (n_in %d out %d ws %zu)\n", n_in, out_size, ws_size); grid = -1; return; }
        int dev = 0, cus = 0, per_cu = 0;
        if (hipGetDevice(&dev) != hipSuccess || hipDeviceGetAttribute(&cus, hipDeviceAttributeMultiprocessorCount, dev) != hipSuccess) { grid = -1; return; }
        if (hipFuncSetAttribute((const void*)fwd, hipFuncAttributeMaxDynamicSharedMemorySize, LDS_BYTES) != hipSuccess) { fprintf(stderr, "kernel_launch: hipFuncSetAttribute failed\n"); grid = -1; return; }
        if (hipOccupancyMaxActiveBlocksPerMultiprocessor(&per_cu, (const void*)fwd, NTHREADS, LDS_BYTES) != hipSuccess || per_cu < 1) fprintf(stderr, "kernel_launch: occupancy query says %d\n", per_cu);
        (void)hipGetLastError();
        grid = cus;
    }
    if (grid < 0) return;
    if (hipMemsetAsync((char*)d_ws + WS_CTL, 0, CTL_ZERO_BYTES, stream) != hipSuccess) return;
    Args a{};
    a.x = (const float*)d_in[0]; a.meta = (const float*)d_in[1]; a.g_mix = (const float*)d_in[2]; a.w_in = (const float*)d_in[3]; a.conv_ssd_w = (const float*)d_in[4]; a.conv_ssd_b = (const float*)d_in[5];
    a.dt_bias = (const float*)d_in[6]; a.a_log = (const float*)d_in[7]; a.d_skip = (const float*)d_in[8]; a.ssd_norm_w = (const float*)d_in[9]; a.conv_sc_w = (const float*)d_in[10]; a.w_out = (const float*)d_in[11];
    a.g_ffn = (const float*)d_in[12]; a.w_q = (const float*)d_in[13]; a.sub_keys = (const float*)d_in[14]; a.expert_u = (const float*)d_in[15]; a.expert_v = (const float*)d_in[16]; a.g_final = (const float*)d_in[17];
    a.out = (float*)d_out; a.ws = (unsigned char*)d_ws;
    if (N_LAUNCHES == 1) { a.ph_lo = 0; a.ph_hi = NPHASE; hipLaunchKernelGGL(fwd, dim3(grid), dim3(NTHREADS), LDS_BYTES, stream, a); }
    else for (int p = 0; p < NPHASE; ++p) { a.ph_lo = p; a.ph_hi = p + 1; hipLaunchKernelGGL(fwd, dim3(grid), dim3(NTHREADS), LDS_BYTES, stream, a); }
}
```

```cpp
#include <hip/hip_runtime.h>
#include <cstdio>
#include <cstdint>

#define GAS __attribute__((address_space(1)))
#define LAS __attribute__((address_space(3)))
typedef unsigned short bf16_t;
typedef short bf16x8 __attribute__((ext_vector_type(8)));
typedef float f32x4 __attribute__((ext_vector_type(4)));
typedef float f32x2 __attribute__((ext_vector_type(2)));
typedef unsigned u32x4 __attribute__((ext_vector_type(4)));
typedef unsigned u32x2 __attribute__((ext_vector_type(2)));

constexpr int D = 1024, BATCH = 16, SEQ = 2048, NMETA = 16, LSEQ = SEQ + NMETA;
constexpr int TR = BATCH * SEQ;
constexpr int ROWS_A = 33024;
constexpr int D_SSD = 1536, HEADS = 24, HD = 64, NG = 4, NS = 128, D_XBC = 2560, D_SC = 512, D_IN = 5656, D_MIX = 2048;
constexpr int LDP = 5888;
constexpr int C_Z = 0, C_SCB = 1536, C_XBC = 2048, C_SCC = 4608, C_SCX = 5120, C_DT = 5632;
constexpr int P_ZS = 2048, P_XG = 640, P_SC = 1024, P_DT = 32;
constexpr size_t ZS_OFF = 0, XG_OFF = (size_t)ROWS_A * P_ZS, XG_STRIDE = (size_t)ROWS_A * P_XG, SC_OFF = XG_OFF + 4 * XG_STRIDE, DT_OFF = SC_OFF + (size_t)ROWS_A * P_SC, PANELS_END = DT_OFF + (size_t)ROWS_A * P_DT;
static_assert(PANELS_END <= (size_t)ROWS_A * LDP, "panels fit the PROJ region");
__host__ __device__ __forceinline__ size_t proj_dst(int j, int& pitch) {
    if (j < 2048) { pitch = P_ZS; return ZS_OFF + j; }
    if (j < 4608) { const int ch = j - 2048; pitch = P_XG;
        if (ch < 1536) { const int g = ch / 384; return XG_OFF + g * XG_STRIDE + (ch - 384 * g); }
        if (ch < 2048) { const int r = ch - 1536; return XG_OFF + (r >> 7) * XG_STRIDE + 384 + (r & 127); }
        const int r = ch - 2048; return XG_OFF + (r >> 7) * XG_STRIDE + 512 + (r & 127); }
    if (j < 5632) { pitch = P_SC; return SC_OFF + (j - 4608); }
    if (j < 5664) { pitch = P_DT; return DT_OFF + (j - 5632); }
    pitch = 0; return 0;
}
constexpr int PH = 8, PK = 128, PTOP = 16, PQ = 2048;
constexpr float EPS = 1e-6f;

__host__ __device__ constexpr int proj_src_col(int j) {
    return j < 1536 ? j : j < 2048 ? 4120 + (j - 1536) : j < 4608 ? 1536 + (j - 2048) : j < 5120 ? 4632 + (j - 4608) : j < 5632 ? 5144 + (j - 5120) : j < 5656 ? 4096 + (j - 5632) : -1;
}

constexpr size_t MiB = 1u << 20;
constexpr size_t WS_CTL = 0, CTL_ZERO_BYTES = 1 * MiB;
constexpr size_t WS_WIN = 1 * MiB;
constexpr size_t WS_WOUT = 13 * MiB;
constexpr size_t WS_WQ = 17 * MiB;
constexpr size_t WS_XN = 22 * MiB;
constexpr size_t WS_PROJ = 88 * MiB;
constexpr size_t WS_Q = WS_PROJ;
constexpr size_t WS_EIDX = WS_PROJ + 128 * MiB;
constexpr size_t WS_GATE = WS_PROJ + 144 * MiB;
constexpr size_t WS_UB = WS_PROJ + 160 * MiB;
constexpr size_t WS_U8 = WS_PROJ + 160 * MiB;
constexpr size_t WS_V8 = WS_PROJ + 192 * MiB;
constexpr size_t WS_ACT = WS_PROJ + 208 * MiB;
constexpr size_t WS_SU = WS_PROJ + 224 * MiB;
constexpr size_t WS_SV = WS_PROJ + 224 * MiB + 65536;
constexpr size_t WS_RSTD = WS_PROJ + 225 * MiB;
constexpr size_t WS_U8F = WS_PROJ + 226 * MiB;
constexpr size_t WS_VB = WS_PROJ + 192 * MiB;
constexpr size_t WS_END = WS_PROJ + (size_t)ROWS_A * LDP * 2;
static_assert(WS_VB + 32 * MiB <= WS_END, "ws map");
static_assert(WS_XN + (size_t)ROWS_A * D * 2 <= WS_PROJ, "ws map");
static_assert(WS_END <= 512 * MiB, "ws map");

typedef __bf16 bf16x2h_t __attribute__((ext_vector_type(2)));
__device__ __forceinline__ unsigned f2bf(float f) { return (unsigned)__builtin_bit_cast(unsigned short, (__bf16)f); }
__device__ __forceinline__ unsigned pk2(float lo, float hi) { bf16x2h_t v; v.x = (__bf16)lo; v.y = (__bf16)hi; return __builtin_bit_cast(unsigned, v); }
__device__ __forceinline__ float bf2f(unsigned short b) { return __builtin_bit_cast(float, ((unsigned)b) << 16); }
__device__ __forceinline__ float bflo(unsigned w) { return __builtin_bit_cast(float, w << 16); }
__device__ __forceinline__ float bfhi(unsigned w) { return __builtin_bit_cast(float, w & 0xffff0000u); }
template <int CTRL> __device__ __forceinline__ float dppf0(float x) { return __builtin_bit_cast(float, __builtin_amdgcn_update_dpp(0, __builtin_bit_cast(int, x), CTRL, 0xF, 0xF, true)); }
__device__ __forceinline__ void swap32_self(unsigned u, unsigned& lo_lo, unsigned& hi_hi) { unsigned u2 = u; asm volatile("" : "+v"(u2)); auto r = __builtin_amdgcn_permlane32_swap(u, u2, false, false); lo_lo = r[0]; hi_hi = r[1]; }
__device__ __forceinline__ void swap16_self(unsigned u, unsigned& even2, unsigned& odd2) { unsigned u2 = u; asm volatile("" : "+v"(u2)); auto r = __builtin_amdgcn_permlane16_swap(u, u2, false, false); even2 = r[0]; odd2 = r[1]; }
__device__ __forceinline__ float wave_sum(float v) {
    v += dppf0<0xB1>(v); v += dppf0<0x4E>(v); v += dppf0<0x141>(v); v += dppf0<0x140>(v);
    unsigned p, q; swap16_self(__builtin_bit_cast(unsigned, v), p, q); v = __builtin_bit_cast(float, p) + __builtin_bit_cast(float, q);
    swap32_self(__builtin_bit_cast(unsigned, v), p, q); v = __builtin_bit_cast(float, p) + __builtin_bit_cast(float, q);
    return v;
}
__device__ __forceinline__ float row_sum16(float x) { x += dppf0<0xB1>(x); x += dppf0<0x4E>(x); x += dppf0<0x141>(x); x += dppf0<0x140>(x); return x; }
__device__ __forceinline__ int row_of(int b, int pos) { return pos < NMETA ? TR + pos : b * SEQ + (pos - NMETA); }

namespace pg8 {
#define PG8_LAS __attribute__((address_space(3)))
constexpr int BM = 256, BK = 64, HALF = 128, HTB = HALF * BK * 2  , STAGE_BYTES = 8 * HTB, NXCD = 8, WGM = 8;
__host__ __device__ __forceinline__ int perm32(int rho) { const int n = rho >> 4, i = rho & 15; return 8 * (i >> 2) + 4 * n + (i & 3); }
__host__ __device__ __forceinline__ int lds_byte(int r, int c) { const int st = (r >> 4) * 2 + (c >> 5), rr = r & 15, cc = c & 31, ob = rr * 64 + cc * 2; return st * 1024 + (ob ^ (((ob >> 9) & 1) << 5)); }
__host__ __device__ __forceinline__ void stage_rc(int b, int& R, int& C) { const int st = b / 1024, sb = b % 1024, swz = sb ^ (((sb >> 9) & 1) << 5); R = (st >> 1) * 16 + swz / 64; C = (st & 1) * 32 + (swz % 64) / 2; }
struct Unit { int pm, pn; };
struct Gemm { const bf16_t* A; const bf16_t* Bt; int M, N, K, lda, ldb; };
struct StaticOrder {
    int nM, nN, nwg, G, c;
    __host__ __device__ void init(int M, int N, int G_, int c_) { nM = M / BM; nN = N / BM; nwg = nM * nN; G = G_; c = c_; }
    __host__ __device__ bool next(int i, Unit& u) const {
        const long L = (long)i * G + c; if (L >= nwg) return false;
        int wgid = (int)L; { const int q = nwg / NXCD, r = nwg % NXCD, xcd = wgid % NXCD, off = wgid / NXCD; wgid = (xcd < r ? xcd * (q + 1) : r * (q + 1) + (xcd - r) * q) + off; }
        const int nig = WGM * nN, gid = wgid / nig, fm = gid * WGM, gsz = (nM - fm) < WGM ? (nM - fm) : WGM;
        u.pm = fm + ((wgid % nig) % gsz); u.pn = (wgid % nig) / gsz; return true;
    }
    __device__ __forceinline__ void a_ready(const Unit&) const {}
    __device__ __forceinline__ void done(const Unit&) const {}
};
struct EpiBf16 {
    static constexpr bool PERM = true, AFTER_DRAIN = false;
    bf16_t* O; int ldc;
    __device__ __forceinline__ void operator()(const f32x4 (&acc)[2][2][4][2], const Unit& u, int wr, int wc, int fr, int fq) const {
        const int row0 = u.pm * BM + wr * 64 + fr, col0 = u.pn * BM + wc * 32 + 8 * fq;
#pragma unroll
        for (int ai = 0; ai < 2; ++ai)
#pragma unroll
            for (int m = 0; m < 4; ++m) { bf16_t* rowp = O + (size_t)(row0 + ai * HALF + m * 16) * ldc + col0;
#pragma unroll
                for (int bj = 0; bj < 2; ++bj) { const f32x4 v0 = acc[ai][bj][m][0], v1 = acc[ai][bj][m][1];
                    u32x4 w; w.x = pk2(v0[0], v0[1]); w.y = pk2(v0[2], v0[3]); w.z = pk2(v1[0], v1[1]); w.w = pk2(v1[2], v1[3]);
                    *(u32x4*)(rowp + bj * HALF) = w; } }
    }
};
struct EpiPanels {
    static constexpr bool PERM = true, AFTER_DRAIN = false;
    bf16_t* P;
    __device__ __forceinline__ void operator()(const f32x4 (&acc)[2][2][4][2], const Unit& u, int wr, int wc, int fr, int fq) const {
        const int row0 = u.pm * BM + wr * 64 + fr, col0 = u.pn * BM + wc * 32 + 8 * fq;
#pragma unroll
        for (int bj = 0; bj < 2; ++bj) { int pitch; const size_t off = proj_dst(col0 + bj * HALF, pitch); if (pitch == 0) continue;
#pragma unroll
            for (int ai = 0; ai < 2; ++ai)
#pragma unroll
                for (int m = 0; m < 4; ++m) { const f32x4 v0 = acc[ai][bj][m][0], v1 = acc[ai][bj][m][1];
                    u32x4 w; w.x = pk2(v0[0], v0[1]); w.y = pk2(v0[2], v0[3]); w.z = pk2(v1[0], v1[1]); w.w = pk2(v1[2], v1[3]);
                    *(u32x4*)(P + off + (size_t)(row0 + ai * HALF + m * 16) * pitch) = w; } }
    }
};
struct EpiResBf16 {
    static constexpr bool PERM = true, AFTER_DRAIN = false;
    const float* base; bf16_t* O; int ldc;
    __device__ __forceinline__ void operator()(const f32x4 (&acc)[2][2][4][2], const Unit& u, int wr, int wc, int fr, int fq) const {
        const int row0 = u.pm * BM + wr * 64 + fr, col0 = u.pn * BM + wc * 32 + 8 * fq;
#pragma unroll
        for (int ai = 0; ai < 2; ++ai)
#pragma unroll
            for (int m = 0; m < 4; ++m) { const size_t off = (size_t)(row0 + ai * HALF + m * 16) * ldc + col0;
#pragma unroll
                for (int bj = 0; bj < 2; ++bj) { const f32x4 b0 = *(const f32x4*)(base + off + bj * HALF), b1 = *(const f32x4*)(base + off + bj * HALF + 4);
                    const f32x4 v0 = acc[ai][bj][m][0] + b0, v1 = acc[ai][bj][m][1] + b1;
                    u32x4 w; w.x = pk2(v0[0], v0[1]); w.y = pk2(v0[2], v0[3]); w.z = pk2(v1[0], v1[1]); w.w = pk2(v1[2], v1[3]);
                    *(u32x4*)(O + off + bj * HALF) = w; } }
    }
};
struct EpiResF32 {
    static constexpr bool PERM = false, AFTER_DRAIN = false;
    const float* base; float* C; int ldc;
    __device__ __forceinline__ void operator()(const f32x4 (&acc)[2][2][4][2], const Unit& u, int wr, int wc, int fr, int fq) const {
        const int row0 = u.pm * BM + wr * 64 + fr, col0 = u.pn * BM + wc * 32 + 4 * fq;
#pragma unroll
        for (int ai = 0; ai < 2; ++ai)
#pragma unroll
            for (int m = 0; m < 4; ++m) { const size_t off = (size_t)(row0 + ai * HALF + m * 16) * ldc + col0;
#pragma unroll
                for (int bj = 0; bj < 2; ++bj)
#pragma unroll
                    for (int n = 0; n < 2; ++n) { const f32x4 bs = *(const f32x4*)(base + off + bj * HALF + n * 16); *(f32x4*)(C + off + bj * HALF + n * 16) = bs + acc[ai][bj][m][n]; } }
    }
};
template <class Epi, class Sched, bool ALIGN_EPI = false, bool SP2 = false>
__device__ __forceinline__ void gemm_phase(PG8_LAS unsigned char* lds, const Gemm g, const Sched& S, const Epi& E) {
    const int tid = threadIdx.x, wid = __builtin_amdgcn_readfirstlane(tid >> 6), lane = tid & 63, wr = wid >> 2, wc = wid & 3, fr = lane & 15, fq = lane >> 4;
    const int K = g.K, nt = K / BK;
    unsigned voffA[2], voffB[2];
#pragma unroll
    for (int i = 0; i < 2; ++i) { int R, C; stage_rc(tid * 16 + i * 8192, R, C); const int Rb = Epi::PERM ? ((R & ~31) + perm32(R & 31)) : R;
        voffA[i] = (unsigned)(R * g.lda + C) * 2u; voffB[i] = (unsigned)(Rb * g.ldb + C) * 2u; }
    const size_t kstep = (size_t)(BK * 2);
    const size_t hstepA = (size_t)HALF * g.lda * 2, hstepB = (size_t)HALF * g.ldb * 2;
    const size_t tstepA = 2 * hstepA, tstepB = 2 * hstepB;
    const unsigned ldsw = (unsigned)wid * 1024u;
    const int aoff = lds_byte(wr * 64 + fr, fq * 8), boff = lds_byte(wc * 32 + fr, fq * 8);
#define PG8_SA(b, h) (((b) * 2 + (h)) * HTB)
#define PG8_SB(b, h) ((4 + (b) * 2 + (h)) * HTB)
#define PG8_STAGE(bufoff, gbase, voff) do { _Pragma("unroll") for (int _i = 0; _i < 2; ++_i) \
        __builtin_amdgcn_global_load_lds((const unsigned*)((const char*)(gbase) + (voff)[_i]), (PG8_LAS unsigned*)(lds + (bufoff) + ldsw + _i * 8192), 16, 0, 0); } while (0)
#define PG8_LDA(dst, b, h) do { _Pragma("unroll") for (int m = 0; m < 4; ++m) _Pragma("unroll") for (int k = 0; k < 2; ++k) dst[m][k] = *(const PG8_LAS bf16x8*)(lds + PG8_SA(b, h) + aoff + m * 2048 + k * 1024); } while (0)
#define PG8_LDB(dst, b, h) do { _Pragma("unroll") for (int n = 0; n < 2; ++n) _Pragma("unroll") for (int k = 0; k < 2; ++k) dst[n][k] = *(const PG8_LAS bf16x8*)(lds + PG8_SB(b, h) + boff + n * 2048 + k * 1024); } while (0)
#define PG8_MMA(ai, bj, At, Bt) do { __builtin_amdgcn_s_setprio(1); _Pragma("unroll") for (int m = 0; m < 4; ++m) _Pragma("unroll") for (int n = 0; n < 2; ++n) _Pragma("unroll") for (int k = 0; k < 2; ++k) \
        acc[ai][bj][m][n] = __builtin_amdgcn_mfma_f32_16x16x32_bf16(Bt[n][k], At[m][k], acc[ai][bj][m][n], 0, 0, 0); __builtin_amdgcn_s_setprio(0); } while (0)
#define PG8_WAIT_V(n) asm volatile("s_waitcnt vmcnt(" #n ")" ::: "memory")
#define PG8_WAIT_L(n) asm volatile("s_waitcnt lgkmcnt(" #n ")" ::: "memory")
#define PG8_BAR __builtin_amdgcn_s_barrier()
#define PG8_SCHED __builtin_amdgcn_sched_barrier(0)
    Unit cur, nxt; int ui = 0;
    if (!S.next(0, cur)) return;
    f32x4 acc[2][2][4][2];
#pragma unroll
    for (int a = 0; a < 2; ++a)
#pragma unroll
        for (int b = 0; b < 2; ++b)
#pragma unroll
            for (int m = 0; m < 4; ++m)
#pragma unroll
                for (int n = 0; n < 2; ++n) acc[a][b][m][n] = (f32x4){0.f, 0.f, 0.f, 0.f};
    bf16x8 At[4][2], B0[2][2], B1[2][2];
    const char* cA = (const char*)g.A + (size_t)cur.pm * tstepA; const char* cB = (const char*)g.Bt + (size_t)cur.pn * tstepB;
    S.a_ready(cur);
    if constexpr (SP2) {
        PG8_STAGE(PG8_SB(0, 0), cB, voffB); PG8_STAGE(PG8_SB(0, 1), cB + hstepB, voffB); PG8_STAGE(PG8_SA(0, 0), cA, voffA); PG8_STAGE(PG8_SA(0, 1), cA + hstepA, voffA);
        if (wr == 1) PG8_BAR;
        PG8_WAIT_V(2); PG8_BAR;
        PG8_STAGE(PG8_SB(1, 0), cB + kstep, voffB); PG8_STAGE(PG8_SA(1, 0), cA + kstep, voffA); PG8_STAGE(PG8_SB(1, 1), cB + hstepB + kstep, voffB);
        PG8_WAIT_V(6); PG8_BAR;
    } else {
        PG8_STAGE(PG8_SB(0, 0), cB, voffB); PG8_STAGE(PG8_SA(0, 0), cA, voffA); PG8_STAGE(PG8_SB(0, 1), cB + hstepB, voffB); PG8_STAGE(PG8_SA(0, 1), cA + hstepA, voffA);
        if (wr == 1) PG8_BAR;
        PG8_WAIT_V(4); PG8_BAR;
        PG8_STAGE(PG8_SB(1, 0), cB + kstep, voffB); PG8_STAGE(PG8_SA(1, 0), cA + kstep, voffA); PG8_STAGE(PG8_SB(1, 1), cB + hstepB + kstep, voffB);
        PG8_WAIT_V(6); PG8_BAR;
    }
    for (;;) {
        const bool has_next = S.next(ui + 1, nxt);
        const char* nA = has_next ? (const char*)g.A + (size_t)nxt.pm * tstepA : cA; const char* nB = has_next ? (const char*)g.Bt + (size_t)nxt.pn * tstepB : cB;
        for (int t = 0; t < nt; t += 2) {
            const bool last = (t == nt - 2);
            const char* a1 = cA + (size_t)(t + 1) * kstep;
            const char* a2 = last ? nA : cA + (size_t)(t + 2) * kstep; const char* b2 = last ? nB : cB + (size_t)(t + 2) * kstep;
            const char* a3 = a2 + kstep; const char* b3 = b2 + kstep;
            if (last && has_next) S.a_ready(nxt);
            if constexpr (SP2) {
            PG8_LDB(B0, 0, 0); PG8_LDB(B1, 0, 1); PG8_SCHED; PG8_LDA(At, 0, 0); PG8_STAGE(PG8_SA(1, 1), a1 + hstepA, voffA);
            PG8_WAIT_V(8); PG8_WAIT_L(0); PG8_BAR; PG8_MMA(0, 0, At, B0); PG8_MMA(0, 1, At, B1); PG8_BAR; PG8_SCHED;
            PG8_LDA(At, 0, 1); PG8_STAGE(PG8_SB(0, 0), b2, voffB); PG8_STAGE(PG8_SB(0, 1), b2 + hstepB, voffB); PG8_STAGE(PG8_SA(0, 0), a2, voffA);
            PG8_WAIT_V(8); PG8_WAIT_L(0); PG8_BAR; PG8_MMA(1, 0, At, B0); PG8_MMA(1, 1, At, B1); PG8_BAR; PG8_SCHED;
            PG8_LDB(B0, 1, 0); PG8_LDB(B1, 1, 1); PG8_SCHED; PG8_LDA(At, 1, 0); PG8_STAGE(PG8_SA(0, 1), a2 + hstepA, voffA);
            PG8_WAIT_V(8); PG8_WAIT_L(0); PG8_BAR; PG8_MMA(0, 0, At, B0); PG8_MMA(0, 1, At, B1); PG8_BAR; PG8_SCHED;
            PG8_LDA(At, 1, 1); PG8_STAGE(PG8_SB(1, 0), b3, voffB); PG8_STAGE(PG8_SB(1, 1), b3 + hstepB, voffB); PG8_STAGE(PG8_SA(1, 0), a3, voffA);
            PG8_WAIT_V(8); PG8_WAIT_L(0); PG8_BAR; PG8_MMA(1, 0, At, B0); PG8_MMA(1, 1, At, B1); PG8_BAR; PG8_SCHED;
            } else {
            PG8_LDB(B0, 0, 0); PG8_SCHED; PG8_LDA(At, 0, 0); PG8_STAGE(PG8_SA(1, 1), a1 + hstepA, voffA);
            PG8_WAIT_L(8); PG8_BAR; PG8_WAIT_L(0); PG8_MMA(0, 0, At, B0); PG8_BAR; PG8_SCHED;
            PG8_LDB(B1, 0, 1); PG8_STAGE(PG8_SB(0, 0), b2, voffB);
            PG8_BAR; PG8_WAIT_L(0); PG8_MMA(0, 1, At, B1); PG8_BAR;
            PG8_LDA(At, 0, 1); PG8_STAGE(PG8_SA(0, 0), a2, voffA);
            PG8_BAR; PG8_WAIT_L(0); PG8_MMA(1, 0, At, B0); PG8_BAR; PG8_SCHED;
            PG8_STAGE(PG8_SB(0, 1), b2 + hstepB, voffB);
            PG8_WAIT_V(6); PG8_BAR; PG8_MMA(1, 1, At, B1); PG8_BAR;
            PG8_LDB(B0, 1, 0); PG8_SCHED; PG8_LDA(At, 1, 0); PG8_STAGE(PG8_SA(0, 1), a2 + hstepA, voffA);
            PG8_WAIT_L(8); PG8_BAR; PG8_WAIT_L(0); PG8_MMA(0, 0, At, B0); PG8_BAR; PG8_SCHED;
            PG8_LDB(B1, 1, 1); PG8_STAGE(PG8_SB(1, 0), b3, voffB);
            PG8_BAR; PG8_WAIT_L(0); PG8_MMA(0, 1, At, B1); PG8_BAR;
            PG8_LDA(At, 1, 1); PG8_STAGE(PG8_SA(1, 0), a3, voffA);
            PG8_BAR; PG8_WAIT_L(0); PG8_MMA(1, 0, At, B0); PG8_BAR; PG8_SCHED;
            PG8_STAGE(PG8_SB(1, 1), b3 + hstepB, voffB);
            PG8_WAIT_V(6); PG8_BAR; PG8_MMA(1, 1, At, B1); PG8_BAR;
            }
        }
        if constexpr (ALIGN_EPI) { if (wr == 0) PG8_BAR; }
        if constexpr (!Epi::AFTER_DRAIN) { E(acc, cur, wr, wc, fr, fq); S.done(cur); }
        if (!has_next) break;
#pragma unroll
        for (int a = 0; a < 2; ++a)
#pragma unroll
            for (int b = 0; b < 2; ++b)
#pragma unroll
                for (int m = 0; m < 4; ++m)
#pragma unroll
                    for (int n = 0; n < 2; ++n) acc[a][b][m][n] = (f32x4){0.f, 0.f, 0.f, 0.f};
        cur = nxt; cA = nA; cB = nB; ++ui;
        if constexpr (ALIGN_EPI) { if (wr == 1) PG8_BAR; }
    }
    PG8_WAIT_V(0);
    if constexpr (!ALIGN_EPI) { if (wr == 0) PG8_BAR; }
    PG8_BAR;
    if constexpr (Epi::AFTER_DRAIN) { E.fused(acc, cur, wr, wc, fr, fq, lds, wid, lane); S.done(cur); }
#undef PG8_SA
#undef PG8_SB
#undef PG8_STAGE
#undef PG8_LDA
#undef PG8_LDB
#undef PG8_MMA
#undef PG8_WAIT_V
#undef PG8_WAIT_L
#undef PG8_BAR
#undef PG8_SCHED
}

template <class Epi>
__device__ __forceinline__ void gemm_simple(const Gemm g, const StaticOrder& S, const Epi& E) {
    const int tid = threadIdx.x, wid = __builtin_amdgcn_readfirstlane(tid >> 6), lane = tid & 63, wr = wid >> 2, wc = wid & 3, fr = lane & 15, fq = lane >> 4;
    Unit u;
    for (int i = 0; S.next(i, u); ++i) {
        f32x4 acc[2][2][4][2];
#pragma unroll
        for (int a = 0; a < 2; ++a)
#pragma unroll
            for (int b = 0; b < 2; ++b)
#pragma unroll
                for (int m = 0; m < 4; ++m)
#pragma unroll
                    for (int n = 0; n < 2; ++n) acc[a][b][m][n] = (f32x4){0.f, 0.f, 0.f, 0.f};
        const bf16_t* Ab = g.A + (size_t)(u.pm * BM + wr * 64 + fr) * g.lda + fq * 8;
        const bf16_t* Bb = g.Bt + (size_t)(u.pn * BM + wc * 32) * g.ldb + fq * 8;
        int brow[2];
#pragma unroll
        for (int n = 0; n < 2; ++n) brow[n] = Epi::PERM ? perm32(16 * n + fr) : (16 * n + fr);
        for (int k0 = 0; k0 < g.K; k0 += 32) {
            bf16x8 Af[2][4], Bf[2][2];
#pragma unroll
            for (int ai = 0; ai < 2; ++ai)
#pragma unroll
                for (int m = 0; m < 4; ++m) Af[ai][m] = *(const bf16x8*)(Ab + (size_t)(ai * HALF + m * 16) * g.lda + k0);
#pragma unroll
            for (int bj = 0; bj < 2; ++bj)
#pragma unroll
                for (int n = 0; n < 2; ++n) Bf[bj][n] = *(const bf16x8*)(Bb + (size_t)(bj * HALF + brow[n]) * g.ldb + k0);
#pragma unroll
            for (int ai = 0; ai < 2; ++ai)
#pragma unroll
                for (int bj = 0; bj < 2; ++bj)
#pragma unroll
                    for (int m = 0; m < 4; ++m)
#pragma unroll
                        for (int n = 0; n < 2; ++n) acc[ai][bj][m][n] = __builtin_amdgcn_mfma_f32_16x16x32_bf16(Bf[bj][n], Af[ai][m], acc[ai][bj][m][n], 0, 0, 0);
        }
        E(acc, u, wr, wc, fr, fq);
    }
}
}

#define XB_TMO      128
#define XB_XCNT(j)  (256  + 64 * (j))
#define XB_XSUB(j)  (1280 + 64 * (j))
#define XB_XGEN(j)  (2304 + 64 * (j))
#define XB_TOP      3328
#define XB_TOPGEN   3392
#define XCD_BAR_WORDS 3456
#define XB_SPIN_CAP (1u << 18)
__device__ __forceinline__ unsigned xb_ld(unsigned* p)              { return __hip_atomic_load(p, __ATOMIC_RELAXED, __HIP_MEMORY_SCOPE_AGENT); }
__device__ __forceinline__ unsigned xb_add(unsigned* p, unsigned v) { return __hip_atomic_fetch_add(p, v, __ATOMIC_RELAXED, __HIP_MEMORY_SCOPE_AGENT); }
__device__ __forceinline__ unsigned xb_xcc_id() { return (unsigned)__builtin_amdgcn_s_getreg((3 << 11) | 20) & 0xFu; }
#define XB_SPIN(cond, bar) do { unsigned _sp = 0; while (cond) { __builtin_amdgcn_s_sleep(1); \
    if ((++_sp & 255u) == 0u) { if (xb_ld(&(bar)[XB_TMO])) break; if (_sp > XB_SPIN_CAP) { atomicAdd(&(bar)[XB_TMO], 1u); break; } } } } while (0)
struct XcdBarrier { unsigned* bar; unsigned x; volatile LAS unsigned* st; };
__device__ __forceinline__ XcdBarrier xcd_barrier_post(unsigned* bar, volatile LAS unsigned* st) {
    XcdBarrier b; b.bar = bar; b.x = xb_xcc_id(); b.st = st;
    if (threadIdx.x == 0) (void)xb_add(&bar[XB_XCNT(b.x)], 1u);
    return b;
}
__device__ __forceinline__ void xcd_barrier_complete(unsigned* bar, unsigned x, unsigned& nloc, unsigned& nx) {
    const unsigned G = gridDim.x * gridDim.y * gridDim.z;
    unsigned sum, cnt, mine, sp = 0u;
    for (;;) {
        sum = 0u; cnt = 0u; mine = 0u;
#pragma unroll
        for (unsigned j = 0; j < 16; ++j) { const unsigned c = xb_ld(&bar[XB_XCNT(j)]); sum += c; cnt += (c > 0u) ? 1u : 0u; mine = (j == x) ? c : mine; }
        if (sum == G) break;
        __builtin_amdgcn_s_sleep(1);
        if ((++sp & 255u) == 0u) { if (xb_ld(&bar[XB_TMO])) break; if (sp > XB_SPIN_CAP) { atomicAdd(&bar[XB_TMO], 1u); break; } }
    }
    nloc = mine > 0u ? mine : 1u; nx = cnt > 0u ? cnt : 1u;
}
__device__ __forceinline__ void xcd_barrier(const XcdBarrier& b) {
    asm volatile("s_waitcnt vmcnt(0)" ::: "memory");
    __syncthreads();
    if (threadIdx.x == 0) {
        unsigned* bar = b.bar;
        __builtin_amdgcn_s_waitcnt(0);
        unsigned nloc = b.st[0], nx = b.st[1];
        if (nloc == 0u) { xcd_barrier_complete(bar, b.x, nloc, nx); b.st[0] = nloc; b.st[1] = nx; }
        const unsigned old = xb_add(&bar[XB_XSUB(b.x)], 1u);
        const unsigned gen = old / nloc;
        if (old + 1u == (gen + 1u) * nloc) {
            __builtin_amdgcn_fence(__ATOMIC_RELEASE, "agent");
            asm volatile("s_waitcnt vmcnt(0)" ::: "memory");
            const unsigned og = xb_add(&bar[XB_TOP], 1u);
            const unsigned tg = og / nx;
            if (og + 1u == (tg + 1u) * nx) xb_add(&bar[XB_TOPGEN], 1u);
            else XB_SPIN(xb_ld(&bar[XB_TOPGEN]) == tg, bar);
            __builtin_amdgcn_fence(__ATOMIC_ACQUIRE, "agent");
            xb_add(&bar[XB_XGEN(b.x)], 1u);
            asm volatile("s_waitcnt vmcnt(0)" ::: "memory");
        } else {
            XB_SPIN(xb_ld(&bar[XB_XGEN(b.x)]) == gen, bar);
            __builtin_amdgcn_fence(__ATOMIC_ACQUIRE, "agent");
            asm volatile("s_waitcnt vmcnt(0)" ::: "memory");
        }
    }
    __syncthreads();
}

#ifndef PROBE_S3
#define PROBE_S3 0
#endif
#ifndef PROBE_P9
#define PROBE_P9 0
#endif
#ifndef PEER_SLICED
#define PEER_SLICED 4
#endif
#ifndef P9_ALIGN
#define P9_ALIGN 0
#endif
#ifndef USE_PG8
#define USE_PG8 1
#endif
constexpr int NWAVES = 8, NTHREADS = 512;
constexpr int NPHASE = 10;
#ifndef MK_N_LAUNCHES
#define MK_N_LAUNCHES 1
#endif
constexpr int N_LAUNCHES = MK_N_LAUNCHES;
constexpr int RING_BYTES = 131072, LDS_BYTES = 163840, LDSCTL_OFF = LDS_BYTES - 256;
constexpr int CW_BAR = 4096;

struct Args {
    const float *x, *meta, *g_mix, *w_in, *conv_ssd_w, *conv_ssd_b, *dt_bias, *a_log, *d_skip, *ssd_norm_w, *conv_sc_w, *w_out, *g_ffn, *w_q, *sub_keys, *expert_u, *expert_v, *g_final;
    float* out; unsigned char* ws; int ph_lo, ph_hi;
};
struct Frame { LAS unsigned char* lds; int tid, lane, wave, G, vcu; };

template <class ColMap>
__device__ __forceinline__ void p0_transpose_item(const float* W, int K, int N, bf16_t* WT, int nblk, LAS float* scr, int item, int lane, ColMap cm, const float* kscale = nullptr) {
    const int kb = item / nblk, nb = item % nblk, k0 = 64 * kb, n0 = 32 * nb;
    const int sc = cm(n0 + (lane & 31));
#pragma unroll 8
    for (int i = 0; i < 32; ++i) { const int kk = 2 * i + (lane >> 5); scr[kk * 33 + (lane & 31)] = sc >= 0 ? W[(size_t)(k0 + kk) * N + sc] * (kscale ? kscale[k0 + kk] : 1.f) : 0.f; }
    asm volatile("s_waitcnt lgkmcnt(0)" ::: "memory");
    const int c = lane & 7;
#pragma unroll
    for (int j = 0; j < 4; ++j) { const int n = (lane >> 3) + 8 * j; const LAS float* s = scr + (8 * c) * 33 + n;
        u32x4 o; o.x = pk2(s[0 * 33], s[1 * 33]); o.y = pk2(s[2 * 33], s[3 * 33]); o.z = pk2(s[4 * 33], s[5 * 33]); o.w = pk2(s[6 * 33], s[7 * 33]);
        *(u32x4*)(WT + (size_t)(n0 + n) * K + k0 + 8 * c) = o; }
    asm volatile("s_waitcnt lgkmcnt(0)" ::: "memory");
}
__device__ __forceinline__ void p0_prologue(const Frame& F, const Args& a) {
    LAS float* scr = (LAS float*)(F.lds + F.wave * 16384);
    const int gw = F.vcu * NWAVES + F.wave, NGW = F.G * NWAVES;
    bf16_t* WinT = (bf16_t*)(a.ws + WS_WIN); bf16_t* WoutT = (bf16_t*)(a.ws + WS_WOUT); bf16_t* WqT = (bf16_t*)(a.ws + WS_WQ); bf16_t* XN = (bf16_t*)(a.ws + WS_XN);
    constexpr int I_IN = (D / 64) * (LDP / 32), I_OUT = (D_MIX / 64) * (D / 32), I_Q = (D / 64) * (PQ / 32);
    for (int it = gw; it < I_IN + I_OUT + I_Q; it += NGW) {
        int r = it;
        if (r < I_IN) { p0_transpose_item(a.w_in, D, D_IN, WinT, LDP / 32, scr, r, F.lane, [](int j) { return proj_src_col(j); }); continue; } r -= I_IN;
        if (r < I_OUT) { p0_transpose_item(a.w_out, D_MIX, D, WoutT, D / 32, scr, r, F.lane, [](int j) { return j; }); continue; } r -= I_OUT;
        p0_transpose_item(a.w_q, D, PQ, WqT, PQ / 32, scr, r, F.lane, [](int j) { return j; }, a.g_ffn);
    }
    for (int m = gw; m < ROWS_A; m += NGW) {
        u32x2* o8 = (u32x2*)(XN + (size_t)m * D) + F.lane;
        if (m >= TR + NMETA) {
#pragma unroll
            for (int j = 0; j < 4; ++j) o8[64 * j] = (u32x2){0u, 0u};
            continue; }
        const float* src = m < TR ? a.x + (size_t)m * D : a.meta + (size_t)(m - TR) * D;
        const f32x4* xr = (const f32x4*)src + F.lane; const f32x4* gr = (const f32x4*)a.g_mix + F.lane;
        f32x4 v[4]; float s = 0.f;
#pragma unroll
        for (int j = 0; j < 4; ++j) { v[j] = xr[64 * j]; s += (v[j].x * v[j].x + v[j].y * v[j].y) + (v[j].z * v[j].z + v[j].w * v[j].w); }
        const float rstd = 1.0f / sqrtf(wave_sum(s) * (1.f / D) + EPS);
#pragma unroll
        for (int j = 0; j < 4; ++j) { const f32x4 gg = gr[64 * j]; o8[64 * j] = (u32x2){pk2(v[j].x * rstd * gg.x, v[j].y * rstd * gg.y), pk2(v[j].z * rstd * gg.z, v[j].w * rstd * gg.w)}; }
    }
}

typedef float f32x16 __attribute__((ext_vector_type(16)));
constexpr int PITCH = 136;
constexpr int SL_C = 0, SL_B = 34816, SL_M0 = 69632, SL_X = 104448, SL_DT = 139264, SL_ACS = 142336;
constexpr int YPITCH = 396;
static_assert(SL_B + 128 * YPITCH * 2 <= SL_DT, "staging fits below dt/acs");
constexpr size_t WS_DAT = WS_XN;
constexpr size_t WS_SMETA = WS_XN + 65536;

__device__ __forceinline__ f32x16 mfma32(bf16x8 a, bf16x8 b, f32x16 c) { return __builtin_amdgcn_mfma_f32_32x32x16_bf16(a, b, c, 0, 0, 0); }
__device__ __forceinline__ float silu_f(float v) { return v / (1.f + __expf(-v)); }

template <int NP> struct ConvW { u32x4 raw[NP + 3]; };
template <int NP> __device__ __forceinline__ void convw_load(ConvW<NP>& ci, const bf16_t* xgc  , int b, int pos0) {
#pragma unroll
    for (int i = 0; i < NP + 3; ++i) { const int pos = pos0 - 3 + i; u32x4 v = (u32x4){0u, 0u, 0u, 0u};
        if (pos >= 0) v = *(const u32x4*)(xgc + (size_t)row_of(b, pos) * P_XG);
        ci.raw[i] = v; }
}
struct ConvWt { f32x4 w[4][2], cb[2]; };
__device__ __forceinline__ void convw_weights(ConvWt& cw, const Args& a, int ch) {
    cw.cb[0] = *(const f32x4*)(a.conv_ssd_b + ch); cw.cb[1] = *(const f32x4*)(a.conv_ssd_b + ch + 4);
#pragma unroll
    for (int wi = 0; wi < 4; ++wi) { cw.w[wi][0] = *(const f32x4*)(a.conv_ssd_w + wi * D_XBC + ch); cw.w[wi][1] = *(const f32x4*)(a.conv_ssd_w + wi * D_XBC + ch + 4); }
}
__device__ __forceinline__ float bfel(const u32x4& v, int c) { const unsigned w = (c >> 1) == 0 ? v.x : (c >> 1) == 1 ? v.y : (c >> 1) == 2 ? v.z : v.w; return (c & 1) ? bfhi(w) : bflo(w); }
template <int NP> __device__ __forceinline__ void convw_pos(const ConvW<NP>& ci, const ConvWt& cw, int s, float (&o)[8]) {
#pragma unroll
    for (int c = 0; c < 8; ++c) { const int q = c >> 2, e = c & 3;
        o[c] = silu_f(cw.cb[q][e] + cw.w[0][q][e] * bfel(ci.raw[s], c) + cw.w[1][q][e] * bfel(ci.raw[s + 1], c) + cw.w[2][q][e] * bfel(ci.raw[s + 2], c) + cw.w[3][q][e] * bfel(ci.raw[s + 3], c)); }
}
__device__ __forceinline__ u32x4 pack8(const float (&o)[8][2], int j) { u32x4 r; r.x = pk2(o[0][j], o[1][j]); r.y = pk2(o[2][j], o[3][j]); r.z = pk2(o[4][j], o[5][j]); r.w = pk2(o[6][j], o[7][j]); return r; }
__device__ __forceinline__ void ssd_dt_acs(const Frame& F_, const Args& a, const bf16_t* PROJ, int b, int p0, int g, float* dat  ) {
    const Frame& F0 = F_;
    if (F0.wave < 6) {
        int lane_ = F0.lane; asm volatile("" : "+v"(lane_));
        Frame Fl = F0; Fl.lane = lane_;
        const Frame& F = Fl;
        const int h = g * 6 + F.wave; const float A = -__expf(a.a_log[h]), dtb = a.dt_bias[h];
        LAS float* dtL = (LAS float*)(F.lds + SL_DT) + F.wave * 128; LAS float* acL = (LAS float*)(F.lds + SL_ACS) + F.wave * 128;
        float dv[2], av[2];
#pragma unroll
        for (int hf = 0; hf < 2; ++hf) { const int pos = p0 + F.lane + 64 * hf; float d = 0.f;
            if (pos >= 0) { const float v = bf2f(PROJ[DT_OFF + (size_t)row_of(b, pos) * P_DT + h]) + dtb, t = __expf(-fabsf(v));
                d = fmaxf(v, 0.f) + (t < 1e-3f ? t * (1.f - 0.5f * t) : __logf(1.f + t)); }
            dv[hf] = d; av[hf] = d * A; }
#pragma unroll
        for (int o = 1; o < 64; o <<= 1) { const float t0 = __shfl_up(av[0], o), t1 = __shfl_up(av[1], o); if (F.lane >= o) { av[0] += t0; av[1] += t1; } }
        av[1] += __shfl(av[0], 63);
        dtL[F.lane] = dv[0]; dtL[F.lane + 64] = dv[1]; acL[F.lane] = av[0]; acL[F.lane + 64] = av[1];
        if (dat && F.lane == 63) dat[h] = __expf(av[1]);
    }
}

__device__ __forceinline__ void ssd_s1_unit(const Frame& F, const Args& a, int b, int c, int g) {
    const bf16_t* PROJ = (const bf16_t*)(a.ws + WS_PROJ);
    const int p0 = c == 0 ? -112 : NMETA + 128 * (c - 1), lr = F.lane & 31, hf = F.lane >> 5;
    __syncthreads();
    ssd_dt_acs(F, a, PROJ, b, p0, g, (float*)(a.ws + WS_DAT) + (size_t)(b * 17 + c) * HEADS);
    if (F.tid < 256) { const int chg = F.tid & 15, sr = F.tid >> 4, ch = D_SSD + g * 128 + 8 * chg;
        ConvW<8> ci; convw_load<8>(ci, PROJ + XG_OFF + g * XG_STRIDE + 384 + 8 * chg, b, p0 + 8 * sr); ConvWt cw; convw_weights(cw, a, ch);
        unsigned pk[8][4];
#pragma unroll
        for (int s2 = 0; s2 < 4; ++s2) { float o0[8], o1[8]; convw_pos<8>(ci, cw, 2 * s2, o0); convw_pos<8>(ci, cw, 2 * s2 + 1, o1);
#pragma unroll
            for (int c = 0; c < 8; ++c) pk[c][s2] = pk2(o0[c], o1[c]); }
#pragma unroll
        for (int c = 0; c < 8; ++c) *(LAS u32x4*)(F.lds + SL_C + ((8 * chg + c) * PITCH + 8 * sr) * 2) = (u32x4){pk[c][0], pk[c][1], pk[c][2], pk[c][3]}; }
    __syncthreads();
    const bf16_t* xg1 = PROJ + XG_OFF + g * XG_STRIDE + 8 * (F.tid & 7);
    ConvW<2> cin; convw_load<2>(cin, xg1, b, p0 + 2 * (F.tid >> 3));
#pragma unroll 1
    for (int hh = 0; hh < 6; ++hh) {
        const int h = g * 6 + hh, buf = hh & 1;
        {
            const int chg = F.tid & 7, sp = F.tid >> 3, ch = h * 64 + 8 * chg;
            const ConvW<2> ci = cin; ConvWt cw; convw_weights(cw, a, ch);
            if (hh < 5) convw_load<2>(cin, xg1 + (hh + 1) * 64, b, p0 + 2 * sp);
            const LAS float* dtL = (const LAS float*)(F.lds + SL_DT) + hh * 128; const LAS float* acL = (const LAS float*)(F.lds + SL_ACS) + hh * 128;
            const float aend = acL[127], w0 = dtL[2 * sp] * __expf(aend - acL[2 * sp]), w1 = dtL[2 * sp + 1] * __expf(aend - acL[2 * sp + 1]);
            float o0[8], o1[8]; convw_pos<2>(ci, cw, 0, o0); convw_pos<2>(ci, cw, 1, o1);
#pragma unroll
            for (int c = 0; c < 8; ++c) *(LAS unsigned*)(F.lds + SL_X + buf * 17408 + ((8 * chg + c) * PITCH + 2 * sp) * 2) = pk2(o0[c] * w0, o1[c] * w1);
        }
        __syncthreads();
        const int pb = F.wave >> 2, nb = F.wave & 3;
        f32x16 acc;
#pragma unroll
        for (int r = 0; r < 16; ++r) acc[r] = 0.f;
#pragma unroll
        for (int ks = 0; ks < 8; ++ks) {
            const bf16x8 af = *(const LAS bf16x8*)(F.lds + SL_C + ((32 * nb + lr) * PITCH + 16 * ks + 8 * hf) * 2);
            const bf16x8 bf = *(const LAS bf16x8*)(F.lds + SL_X + buf * 17408 + ((32 * pb + lr) * PITCH + 16 * ks + 8 * hf) * 2);
            acc = mfma32(af, bf, acc);
        }
        bf16_t* dst = c == 0 ? (bf16_t*)(a.ws + WS_SMETA) + (size_t)h * 8192 : (bf16_t*)a.out + ((size_t)(b * 16 + (c - 1)) * HEADS + h) * 8192;
        u32x4* d4 = (u32x4*)(dst + ((size_t)(pb * 4 + nb) * 64 + F.lane) * 16);
        u32x4 w0, w1; w0.x = pk2(acc[0], acc[1]); w0.y = pk2(acc[2], acc[3]); w0.z = pk2(acc[4], acc[5]); w0.w = pk2(acc[6], acc[7]);
        w1.x = pk2(acc[8], acc[9]); w1.y = pk2(acc[10], acc[11]); w1.z = pk2(acc[12], acc[13]); w1.w = pk2(acc[14], acc[15]);
        d4[0] = w0; d4[1] = w1;
    }
}
__device__ __forceinline__ void short_conv_all(const Frame& F, const Args& a) {
    bf16_t* PROJ = (bf16_t*)(a.ws + WS_PROJ);
    const size_t gt = (size_t)F.vcu * NTHREADS + F.tid, NT = (size_t)F.G * NTHREADS;
    for (size_t it = gt; it < (size_t)TR * (D_SC / 8); it += NT) {
        const int r = (int)(it / (D_SC / 8)), c0 = (int)(it % (D_SC / 8)) * 8, b = r / SEQ, pos = r % SEQ + NMETA;
        float accv[8];
#pragma unroll
        for (int j = 0; j < 8; ++j) accv[j] = 0.f;
#pragma unroll
        for (int w = 0; w < 3; ++w) { const int rr = row_of(b, pos - 2 + w);
            const u32x4 cc = *(const u32x4*)(PROJ + SC_OFF + (size_t)rr * P_SC + c0), xx = *(const u32x4*)(PROJ + SC_OFF + (size_t)rr * P_SC + 512 + c0);
            const unsigned cw[4] = {cc.x, cc.y, cc.z, cc.w}, xw[4] = {xx.x, xx.y, xx.z, xx.w};
#pragma unroll
            for (int j = 0; j < 4; ++j) { accv[2 * j] += a.conv_sc_w[w * D_SC + c0 + 2 * j] * (bflo(cw[j]) * bflo(xw[j])); accv[2 * j + 1] += a.conv_sc_w[w * D_SC + c0 + 2 * j + 1] * (bfhi(cw[j]) * bfhi(xw[j])); } }
        const u32x4 bb = *(const u32x4*)(PROJ + ZS_OFF + (size_t)r * P_ZS + 1536 + c0); const unsigned bw[4] = {bb.x, bb.y, bb.z, bb.w};
        u32x4 o; unsigned ow[4];
#pragma unroll
        for (int j = 0; j < 4; ++j) ow[j] = pk2(bflo(bw[j]) * accv[2 * j], bfhi(bw[j]) * accv[2 * j + 1]);
        o.x = ow[0]; o.y = ow[1]; o.z = ow[2]; o.w = ow[3];
        *(u32x4*)(PROJ + ZS_OFF + (size_t)r * P_ZS + 1536 + c0) = o;
    }
}
__device__ __forceinline__ void p2_ssd_states(const Frame& F, const Args& a, bool dryrun) {
    if (!dryrun) short_conv_all(F, a);
    for (int u = F.vcu; u < 4 + BATCH * 15 * NG; u += F.G) {
        if (u < 4) ssd_s1_unit(F, a, 0, 0, u);
        else { const int v = u - 4; ssd_s1_unit(F, a, v / (15 * NG), 1 + (v / NG) % 15, v % NG); }
    }
}
__device__ __forceinline__ void p3_ssd_recur(const Frame& F, const Args& a) {
    const float* dat = (const float*)(a.ws + WS_DAT); const bf16_t* SM = (const bf16_t*)(a.ws + WS_SMETA); bf16_t* SF = (bf16_t*)a.out;
    for (int it = F.vcu; it < BATCH * HEADS * 1024 / NTHREADS; it += F.G) {
        const int idx = it * NTHREADS + F.tid, bh = idx >> 10, e8 = idx & 1023, b = bh / HEADS, h = bh % HEADS;
        u32x4 ld[15];
#pragma unroll
        for (int c = 1; c <= 15; ++c) ld[c - 1] = *(const u32x4*)(SF + ((size_t)(b * 16 + (c - 1)) * HEADS + h) * 8192 + e8 * 8);
        const u32x4 m = *(const u32x4*)(SM + (size_t)h * 8192 + e8 * 8);
        float cy[8] = {bflo(m.x), bfhi(m.x), bflo(m.y), bfhi(m.y), bflo(m.z), bfhi(m.z), bflo(m.w), bfhi(m.w)};
#pragma unroll
        for (int c = 1; c <= 16; ++c) {
            u32x4 o; o.x = pk2(cy[0], cy[1]); o.y = pk2(cy[2], cy[3]); o.z = pk2(cy[4], cy[5]); o.w = pk2(cy[6], cy[7]);
            *(u32x4*)(SF + ((size_t)(b * 16 + (c - 1)) * HEADS + h) * 8192 + e8 * 8) = o;
            if (c <= 15) { const float dA = dat[(size_t)(b * 17 + c) * HEADS + h]; const u32x4 t = ld[c - 1];
                cy[0] = cy[0] * dA + bflo(t.x); cy[1] = cy[1] * dA + bfhi(t.x); cy[2] = cy[2] * dA + bflo(t.y); cy[3] = cy[3] * dA + bfhi(t.y);
                cy[4] = cy[4] * dA + bflo(t.z); cy[5] = cy[5] * dA + bfhi(t.z); cy[6] = cy[6] * dA + bflo(t.w); cy[7] = cy[7] * dA + bfhi(t.w); }
        }
    }
}
template <bool DRY> __device__ __forceinline__ void ssd_s3_unit(const Frame& F, const Args& a, int b, int c, int g) {
    bf16_t* PROJ = (bf16_t*)(a.ws + WS_PROJ);
    const int p0 = NMETA + 128 * (c - 1), row0 = b * SEQ + 128 * (c - 1), lr = F.lane & 31, hf = F.lane >> 5;
    __syncthreads();
    ssd_dt_acs(F, a, PROJ, b, p0, g, nullptr);
#if PROBE_S3 == 1
    for (int rep = 0; rep < 2; ++rep)
#endif
    {   const int mat = F.tid >> 8, it = F.tid & 255, chg = it & 15, sr = it >> 4, ch = D_SSD + (mat ? 0 : 512) + g * 128 + 8 * chg;
        ConvW<8> ci; convw_load<8>(ci, PROJ + XG_OFF + g * XG_STRIDE + (mat ? 384 : 512) + 8 * chg, b, p0 + 8 * sr); ConvWt cw; convw_weights(cw, a, ch);
#pragma unroll
        for (int s = 0; s < 8; ++s) { float o[8]; convw_pos<8>(ci, cw, s, o);
            *(LAS u32x4*)(F.lds + (mat ? SL_B : SL_C) + ((8 * sr + s) * PITCH + 8 * chg) * 2) = (u32x4){pk2(o[0], o[1]), pk2(o[2], o[3]), pk2(o[4], o[5]), pk2(o[6], o[7])}; } }
    __syncthreads();
    constexpr unsigned SI_P = 0u | (0u << 2) | (1u << 4) | (0u << 6) | (1u << 8) | (2u << 10) | (0u << 12) | (1u << 14) | (2u << 16) | (3u << 18);
    constexpr unsigned LI_P = 0u | (1u << 2) | (1u << 4) | (2u << 6) | (2u << 8) | (2u << 10) | (3u << 12) | (3u << 14) | (3u << 16) | (3u << 18);
    const int nslot = F.wave < 2 ? 2 : 1;
    f32x16 cb[2];
#pragma unroll
    for (int sl = 0; sl < 2; ++sl) {
#pragma unroll
        for (int r = 0; r < 16; ++r) cb[sl][r] = 0.f;
        if (sl < nslot) { const int ti = F.wave + 8 * sl, si = (SI_P >> (2 * ti)) & 3, li = (LI_P >> (2 * ti)) & 3;
#pragma unroll
            for (int ks = 0; ks < 8; ++ks) {
                const bf16x8 af = *(const LAS bf16x8*)(F.lds + SL_B + ((32 * si + lr) * PITCH + 16 * ks + 8 * hf) * 2);
                const bf16x8 bf = *(const LAS bf16x8*)(F.lds + SL_C + ((32 * li + lr) * PITCH + 16 * ks + 8 * hf) * 2);
                cb[sl] = mfma32(af, bf, cb[sl]); } }
    }
    __syncthreads();
    const int pb = F.wave & 1, lio = F.wave >> 1;
    unsigned ypk[6][8];
#pragma unroll
    for (int i = 0; i < 6; ++i)
#pragma unroll
        for (int r = 0; r < 8; ++r) ypk[i][r] = 0u;
#if PROBE_S3 == 4
#pragma unroll 1
    for (int rep = 0; rep < 2; ++rep)
#endif
#pragma unroll 1
    for (int hh = 0; hh < 6; ++hh) {
        const int h = g * 6 + hh, buf = hh & 1, mofs = buf ? SL_B : SL_M0;
        const LAS float* dtL = (const LAS float*)(F.lds + SL_DT) + hh * 128; const LAS float* acL = (const LAS float*)(F.lds + SL_ACS) + hh * 128;
        const bf16_t* sp = (const bf16_t*)a.out + ((size_t)(b * 16 + (c - 1)) * HEADS + h) * 8192;
#if PROBE_S3 == 2
        for (int rep = 0; rep < 2; ++rep)
#endif
        {
            const int chg = F.tid & 7, spp = F.tid >> 3, ch = h * 64 + 8 * chg;
            ConvW<2> ci; convw_load<2>(ci, PROJ + XG_OFF + g * XG_STRIDE + hh * 64 + 8 * chg, b, p0 + 2 * spp); ConvWt cw; convw_weights(cw, a, ch);
            float o0[8], o1[8]; convw_pos<2>(ci, cw, 0, o0); convw_pos<2>(ci, cw, 1, o1);
#pragma unroll
            for (int cc = 0; cc < 8; ++cc) *(LAS unsigned*)(F.lds + SL_X + buf * 17408 + ((8 * chg + cc) * PITCH + 2 * spp) * 2) = pk2(o0[cc], o1[cc]);
        }
        u32x4 sf[4][2];
#pragma unroll
        for (int nb = 0; nb < 4; ++nb) { const u32x4* s4 = (const u32x4*)(sp + ((size_t)(pb * 4 + nb) * 64 + F.lane) * 16); sf[nb][0] = s4[0]; sf[nb][1] = s4[1]; }
#if PROBE_S3 == 3
        for (int rep = 0; rep < 2; ++rep)
#endif
        {
            const float Dh = a.d_skip[h];
#pragma unroll
            for (int sl = 0; sl < 2; ++sl) if (sl < nslot) { const int ti = F.wave + 8 * sl, si = (SI_P >> (2 * ti)) & 3, li = (LI_P >> (2 * ti)) & 3;
                const int l = 32 * li + lr; const float acl = acL[l];
#pragma unroll
                for (int q = 0; q < 4; ++q) { const int s0 = 32 * si + 8 * q + 4 * hf;
                    const f32x4 d4 = *(const LAS f32x4*)(dtL + s0), a4 = *(const LAS f32x4*)(acL + s0); float v[4];
#pragma unroll
                    for (int i = 0; i < 4; ++i) { const int s = s0 + i; float t = s <= l ? cb[sl][4 * q + i] * __expf(acl - a4[i]) * d4[i] : 0.f; if (s == l) t += Dh; v[i] = t; }
                    *(LAS u32x2*)(F.lds + mofs + (l * PITCH + s0) * 2) = (u32x2){pk2(v[0], v[1]), pk2(v[2], v[3])}; } }
        }
        f32x16 acc;
#pragma unroll
        for (int r = 0; r < 16; ++r) acc[r] = 0.f;
        {
#pragma unroll
            for (int nb = 0; nb < 4; ++nb) {
#pragma unroll
                for (int qp = 0; qp < 2; ++qp) { const LAS unsigned char* cp_ = F.lds + SL_C + ((32 * lio + lr) * PITCH + 32 * nb + 16 * qp + 4 * hf) * 2;
                    const u32x2 c0 = *(const LAS u32x2*)cp_, c1 = *(const LAS u32x2*)(cp_ + 16);
                    const u32x4 bfr = (u32x4){c0.x, c0.y, c1.x, c1.y};
                    acc = mfma32(__builtin_bit_cast(bf16x8, sf[nb][qp]), __builtin_bit_cast(bf16x8, bfr), acc); } }
            const float sc = __expf(acL[32 * lio + lr]);
#pragma unroll
            for (int r = 0; r < 16; ++r) acc[r] *= sc;
        }
        __syncthreads();
        for (int ks = 0; ks < 2 * (lio + 1); ++ks) {
            const bf16x8 af = *(const LAS bf16x8*)(F.lds + SL_X + buf * 17408 + ((32 * pb + lr) * PITCH + 16 * ks + 8 * hf) * 2);
            const bf16x8 bf = *(const LAS bf16x8*)(F.lds + mofs + ((32 * lio + lr) * PITCH + 16 * ks + 8 * hf) * 2);
            acc = mfma32(af, bf, acc);
        }
#pragma unroll
        for (int i = 0; i < 5; ++i)
#pragma unroll
            for (int r = 0; r < 8; ++r) ypk[i][r] = ypk[i + 1][r];
#pragma unroll
        for (int r = 0; r < 8; ++r) ypk[5][r] = pk2(acc[2 * r], acc[2 * r + 1]);
    }
    __syncthreads();
#pragma unroll
    for (int hh = 0; hh < 6; ++hh)
#pragma unroll
        for (int q = 0; q < 4; ++q) *(LAS u32x2*)(F.lds + SL_B + ((32 * lio + lr) * YPITCH + hh * 64 + 32 * pb + 8 * q + 4 * hf) * 2) = (u32x2){ypk[hh][2 * q], ypk[hh][2 * q + 1]};
    u32x2 zz2[4][6];
#pragma unroll
    for (int pass = 0; pass < 4; ++pass) { const int l = pass * 32 + F.wave * 4 + (F.lane >> 4), sub = F.lane & 15; const bf16_t* zr = PROJ + ZS_OFF + (size_t)(row0 + l) * P_ZS + g * 384;
#pragma unroll
        for (int k = 0; k < 6; ++k) zz2[pass][k] = *(const u32x2*)(zr + 4 * (sub + 16 * k)); }
    __syncthreads();
#pragma unroll
    for (int pass = 0; pass < 4; ++pass) {
        const int l = pass * 32 + F.wave * 4 + (F.lane >> 4), sub = F.lane & 15; bf16_t* zr = PROJ + ZS_OFF + (size_t)(row0 + l) * P_ZS + g * 384;
        float v[6][4]; float ss = 0.f;
#pragma unroll
        for (int k = 0; k < 6; ++k) { const int c0 = 4 * (sub + 16 * k); const u32x2 y2 = *(const LAS u32x2*)(F.lds + SL_B + (l * YPITCH + c0) * 2), z2 = zz2[pass][k];
            const float yy[4] = {bflo(y2.x), bfhi(y2.x), bflo(y2.y), bfhi(y2.y)}, zz[4] = {bflo(z2.x), bfhi(z2.x), bflo(z2.y), bfhi(z2.y)};
#pragma unroll
            for (int i = 0; i < 4; ++i) { v[k][i] = yy[i] * silu_f(zz[i]); ss += v[k][i] * v[k][i]; } }
        ss = row_sum16(ss);
        const float rstd = 1.0f / sqrtf(ss * (1.f / 384.f) + EPS);
#pragma unroll
        for (int k = 0; k < 6; ++k) { const int c0 = 4 * (sub + 16 * k); const f32x4 nw = *(const f32x4*)(a.ssd_norm_w + g * 384 + c0);
            bf16_t* zo = DRY ? (bf16_t*)(a.ws + WS_END) + ((size_t)F.vcu * 128 + l) * 384 : zr;
            *(u32x2*)(zo + c0) = (u32x2){pk2(v[k][0] * rstd * nw.x, v[k][1] * rstd * nw.y), pk2(v[k][2] * rstd * nw.z, v[k][3] * rstd * nw.w)}; }
    }
}
template <bool DRY> __device__ __forceinline__ void p4_ssd_out(const Frame& F, const Args& a) {
    for (int u = F.vcu; u < BATCH * 16 * NG; u += F.G) ssd_s3_unit<DRY>(F, a, u / (16 * NG), 1 + (u / NG) % 16, u % NG);
}

__device__ __forceinline__ void p5_norm2(const Frame& F, const Args& a) {
    const int gw = F.vcu * NWAVES + F.wave, NGW = F.G * NWAVES;
    {
        unsigned char* V8 = a.ws + WS_V8; float* SV = (float*)(a.ws + WS_SV);
        for (int r = gw; r < 2 * PK * PK; r += NGW) {
            const bool isv = r >= PK * PK; const int e = isv ? r - PK * PK : r;
            const f32x4* src = (const f32x4*)((isv ? a.expert_v : a.expert_u) + (size_t)e * D) + 4 * F.lane;
            f32x4 v[4];
#pragma unroll
            for (int j = 0; j < 4; ++j) v[j] = src[j];
            if (isv) {
                float amax = 0.f;
#pragma unroll
                for (int j = 0; j < 4; ++j) amax = fmaxf(amax, fmaxf(fmaxf(fabsf(v[j].x), fabsf(v[j].y)), fmaxf(fabsf(v[j].z), fabsf(v[j].w))));
#pragma unroll
                for (int o = 1; o < 64; o <<= 1) amax = fmaxf(amax, __shfl_xor(amax, o));
                const float sc = amax > 0.f ? amax * (1.0f / 440.0f) : 1.0f, inv = 1.0f / sc;
                u32x4 o4; unsigned ow[4];
#pragma unroll
                for (int j = 0; j < 4; ++j) { int p = 0; p = __builtin_amdgcn_cvt_pk_fp8_f32(v[j].x * inv, v[j].y * inv, p, false); p = __builtin_amdgcn_cvt_pk_fp8_f32(v[j].z * inv, v[j].w * inv, p, true); ow[j] = (unsigned)p; }
                o4.x = ow[0]; o4.y = ow[1]; o4.z = ow[2]; o4.w = ow[3];
                *(u32x4*)(V8 + ((size_t)(F.lane >> 2) * (PK * PK) + e) * 64 + 16 * (F.lane & 3)) = o4; if (F.lane == 0) SV[e] = sc;
            } else {
                const f32x4* gr = (const f32x4*)a.g_ffn + 4 * F.lane;
#pragma unroll
                for (int j = 0; j < 4; ++j) v[j] = v[j] * gr[j];
                u32x4* ub = (u32x4*)((bf16_t*)(a.ws + WS_UB) + (size_t)e * D) + 2 * F.lane;
                u32x4 b0, b1; b0.x = pk2(v[0].x, v[0].y); b0.y = pk2(v[0].z, v[0].w); b0.z = pk2(v[1].x, v[1].y); b0.w = pk2(v[1].z, v[1].w); b1.x = pk2(v[2].x, v[2].y); b1.y = pk2(v[2].z, v[2].w); b1.z = pk2(v[3].x, v[3].y); b1.w = pk2(v[3].z, v[3].w);
                ub[0] = b0; ub[1] = b1;
            }
        }
    }
    const bf16_t* H2b = (const bf16_t*)(a.ws + WS_XN); float* RSTD = (float*)(a.ws + WS_RSTD);
    for (int m = gw; m < TR; m += NGW) {
        const u32x4* xr = (const u32x4*)(H2b + (size_t)m * D) + 2 * F.lane; const u32x4 p = xr[0], q = xr[1]; const unsigned w[8] = {p.x, p.y, p.z, p.w, q.x, q.y, q.z, q.w};
        float s = 0.f;
#pragma unroll
        for (int j = 0; j < 8; ++j) { const float lo = bflo(w[j]), hi = bfhi(w[j]); s += lo * lo + hi * hi; }
        s = wave_sum(s);
        if (F.lane == 0) RSTD[m] = 1.0f / sqrtf(s * (1.f / D) + EPS);
    }
}

__device__ __forceinline__ unsigned ord_bits(float f) { const unsigned u = __builtin_bit_cast(unsigned, f); return u ^ ((u >> 31) ? 0xffffffffu : 0x80000000u); }
__device__ __forceinline__ float ord_val(unsigned o) { const unsigned u = (o & 0x80000000u) ? (o ^ 0x80000000u) : ~o; return __builtin_bit_cast(float, u); }
__device__ __forceinline__ void cex_desc(unsigned& x, unsigned& y) { const unsigned hi = x > y ? x : y, lo = x > y ? y : x; x = hi; y = lo; }
__device__ __forceinline__ void sort16_desc(unsigned (&v)[16]) {
#pragma unroll
    for (int k = 2; k <= 16; k <<= 1)
#pragma unroll
        for (int j = k >> 1; j > 0; j >>= 1)
#pragma unroll
            for (int i = 0; i < 16; ++i) { const int l = i ^ j; if (l > i) { if ((i & k) == 0) cex_desc(v[i], v[l]); else cex_desc(v[l], v[i]); } }
}
__device__ __forceinline__ void bitonic_merge16_desc(unsigned (&v)[16]) {
#pragma unroll
    for (int j = 8; j > 0; j >>= 1)
#pragma unroll
        for (int i = 0; i < 16; ++i) { const int l = i ^ j; if (l > i) cex_desc(v[i], v[l]); }
}
__device__ __forceinline__ void top16_merge(unsigned (&T)[16], const unsigned (&B)[16]) {
#pragma unroll
    for (int i = 0; i < 16; ++i) T[i] = T[i] > B[15 - i] ? T[i] : B[15 - i];
    bitonic_merge16_desc(T);
}
__device__ __forceinline__ void p8_topk_mfma(const Frame& F, const Args& a) {
    const bf16_t* Q = (const bf16_t*)(a.ws + WS_Q); int* EIDX = (int*)(a.ws + WS_EIDX); float* GATE = (float*)(a.ws + WS_GATE);
    const int lane = F.lane, lr = lane & 31, hf = lane >> 5;
    for (int task = F.vcu; task < PH * (TR / 1024); task += F.G) {
        const int h = task % PH, rng = task / PH;
        __syncthreads();
        {
            const f32x4* kp = (const f32x4*)(a.sub_keys + (size_t)h * 2 * PK * 128);
            for (int i = F.tid; i < 2 * PK * 128 / 4; i += NTHREADS) { const f32x4 v = kp[i]; const int row = i >> 5, c4 = (i & 31) * 4;
                *(LAS u32x2*)(F.lds + (row * PITCH + c4) * 2) = (u32x2){pk2(v.x, v.y), pk2(v.z, v.w)}; }
        }
        __syncthreads();
        for (int tile = F.wave; tile < 16; tile += NWAVES) {
            const int t0 = rng * 1024 + tile * 64;
            unsigned L0[16], L1[16];
#pragma unroll
            for (int i = 0; i < 16; ++i) { L0[i] = 0u; L1[i] = 0u; }
#pragma unroll 1
            for (int s = 0; s < 2; ++s) {
                unsigned TA[16], R[16];
#pragma unroll
                for (int i = 0; i < 16; ++i) { TA[i] = 0u; R[i] = 0u; }
#pragma unroll 1
                for (int th = 0; th < 2; ++th) {
                    bf16x8 qf[8];
                    const bf16_t* qp = Q + (size_t)(t0 + 32 * th + lr) * PQ + h * 256 + s * 128 + 8 * hf;
#pragma unroll
                    for (int ks = 0; ks < 8; ++ks) qf[ks] = *(const bf16x8*)(qp + 16 * ks);
                    unsigned T[16];
#pragma unroll
                    for (int i = 0; i < 16; ++i) T[i] = 0u;
#pragma unroll 1
                    for (int kb = 0; kb < 4; ++kb) {
                        f32x16 acc;
#pragma unroll
                        for (int r = 0; r < 16; ++r) acc[r] = 0.f;
#pragma unroll
                        for (int ks = 0; ks < 8; ++ks) { const bf16x8 af = *(const LAS bf16x8*)(F.lds + ((s * PK + 32 * kb + lr) * PITCH + 16 * ks + 8 * hf) * 2); acc = mfma32(af, qf[ks], acc); }
                        unsigned B[16];
#pragma unroll
                        for (int r = 0; r < 16; ++r) { const int k = 32 * kb + 8 * (r >> 2) + 4 * hf + (r & 3); B[r] = (ord_bits(acc[r]) & ~127u) | (unsigned)(127 - k); }
                        sort16_desc(B);
                        top16_merge(T, B);
                    }
                    unsigned P[16];
#pragma unroll
                    for (int i = 0; i < 16; ++i) { unsigned lo2, hi2; swap32_self(T[i], lo2, hi2); P[i] = hf ? lo2 : hi2; }
                    top16_merge(T, P);
#pragma unroll
                    for (int i = 0; i < 16; ++i) { R[i] = hf ? T[i] : TA[i]; TA[i] = T[i]; }
                }
#pragma unroll
                for (int i = 0; i < 16; ++i) { L0[i] = L1[i]; L1[i] = R[i]; }
            }
            const int t = t0 + lane;
            unsigned T[16];
            const float v00 = ord_val(L0[0] & ~127u);
#pragma unroll
            for (int j = 0; j < 16; ++j) T[j] = (ord_bits(v00 + ord_val(L1[j] & ~127u)) & ~255u) | (unsigned)(255 - j);
#pragma unroll
            for (int i = 1; i < 16; ++i)
#pragma unroll
                for (int j = 0; j < 16; ++j) if ((i + 1) * (j + 1) <= 16) {
                    const float sum = ord_val(L0[i] & ~127u) + ord_val(L1[j] & ~127u);
                    unsigned e = (ord_bits(sum) & ~255u) | (unsigned)(255 - (i * 16 + j));
#pragma unroll
                    for (int k = 0; k < 16; ++k) { const unsigned hi = T[k] > e ? T[k] : e; e = T[k] > e ? e : T[k]; T[k] = hi; }
                }
            float best[16]; int eid[16];
#pragma unroll
            for (int k = 0; k < 16; ++k) {
                best[k] = ord_val(T[k] & ~255u); const int pos = 255 - (int)(T[k] & 255u), pi = pos >> 4, pj = pos & 15;
                unsigned a0 = 0u, a1 = 0u;
#pragma unroll
                for (int i = 0; i < 16; ++i) { a0 = (pi == i) ? L0[i] : a0; a1 = (pj == i) ? L1[i] : a1; }
                eid[k] = (127 - (int)(a0 & 127u)) * PK + (127 - (int)(a1 & 127u));
            }
            const float rst = ((const float*)(a.ws + WS_RSTD))[t];
            float se = 0.f, ex[16];
#pragma unroll
            for (int k = 0; k < 16; ++k) { ex[k] = __expf((best[k] - best[0]) * rst); se += ex[k]; }
            const float inv = 1.f / se;
            int* ep = EIDX + (size_t)t * 128 + h * 16; float* gp = GATE + (size_t)t * 128 + h * 16;
#pragma unroll
            for (int k = 0; k < 16; k += 4) { *(int4*)(ep + k) = make_int4(eid[k], eid[k + 1], eid[k + 2], eid[k + 3]); *(f32x4*)(gp + k) = (f32x4){ex[k] * inv, ex[k + 1] * inv, ex[k + 2] * inv, ex[k + 3] * inv}; }
        }
    }
}

typedef __bf16 bf16x2_t __attribute__((ext_vector_type(2)));
__device__ __forceinline__ float dot2bf(unsigned w, unsigned x, float acc) { return __builtin_amdgcn_fdot2_f32_bf16(__builtin_bit_cast(bf16x2_t, w), __builtin_bit_cast(bf16x2_t, x), acc, false); }

__device__ __forceinline__ float shx32(float x, int lane) { unsigned a, b; swap32_self(__builtin_bit_cast(unsigned, x), a, b); return __builtin_bit_cast(float, (lane & 32) ? a : b); }
__device__ __forceinline__ float shx16(float x, int lane) { unsigned a, b; swap16_self(__builtin_bit_cast(unsigned, x), a, b); return __builtin_bit_cast(float, (lane & 16) ? a : b); }
template <int CTRL> __device__ __forceinline__ float dppf(float x) { return __builtin_bit_cast(float, __builtin_amdgcn_update_dpp(0, __builtin_bit_cast(int, x), CTRL, 0xF, 0xF, true)); }
__device__ __forceinline__ float shx8(float x) { return dppf<0x128>(x); }
__device__ __forceinline__ float shx4(float x, int) { return dppf<0x1B>(dppf<0x141>(x)); }

__device__ __forceinline__ float gelu_as(float v) {
    const float av = __builtin_fabsf(v), t = __builtin_amdgcn_rcpf(av * 0.2316418882f + 1.0f);
    float q = t * 0.5307027145f + (-0.7265760135f); q = q * t + 0.7107068705f; q = q * t + (-0.142248368f); q = q * t + 0.127414796f; q = q * t;
    const float e = __builtin_amdgcn_exp2f((v * v) * (-0.72134752044f));
    const float m = v * (q * e);
    return v < 0.f ? m : v - m;
}
__device__ __forceinline__ unsigned cvt_pk_bf16(float lo, float hi) { unsigned r; asm volatile("v_cvt_pk_bf16_f32 %0, %1, %2" : "=v"(r) : "v"(lo), "v"(hi)); return r; }
__device__ __forceinline__ int rdlane(int v, int l) { return __builtin_amdgcn_readlane(v, l); }
__device__ __forceinline__ float rdlanef(float v, int l) { return __builtin_bit_cast(float, __builtin_amdgcn_readlane(__builtin_bit_cast(int, v), l)); }

struct PeerBatch { int l0, l1, l2, l3; u32x4 r[4][2]; };
__device__ __forceinline__ void peerA_take(unsigned long long& m, PeerBatch& B, const bf16_t* Ub, int lane, int ev) {
    B.l0 = __builtin_ctzll(m); m &= m - 1; B.l1 = B.l0; B.l2 = B.l0; B.l3 = B.l0;
    if (m) { B.l1 = __builtin_ctzll(m); m &= m - 1; if (m) { B.l2 = __builtin_ctzll(m); m &= m - 1; if (m) { B.l3 = __builtin_ctzll(m); m &= m - 1; } } }
    const int e0 = rdlane(ev, B.l0), e1 = rdlane(ev, B.l1), e2 = rdlane(ev, B.l2), e3 = rdlane(ev, B.l3);
    const u32x4* r0 = (const u32x4*)(Ub + (size_t)e0 * D) + 2 * lane; const u32x4* r1 = (const u32x4*)(Ub + (size_t)e1 * D) + 2 * lane;
    const u32x4* r2 = (const u32x4*)(Ub + (size_t)e2 * D) + 2 * lane; const u32x4* r3 = (const u32x4*)(Ub + (size_t)e3 * D) + 2 * lane;
    B.r[0][0] = r0[0]; B.r[0][1] = r0[1]; B.r[1][0] = r1[0]; B.r[1][1] = r1[1]; B.r[2][0] = r2[0]; B.r[2][1] = r2[1]; B.r[3][0] = r3[0]; B.r[3][1] = r3[1];
}
__device__ __forceinline__ void peerA_finish(const PeerBatch& B, int lane, int& agv, const unsigned (&xp)[8], float rs) {
#define DOT16(lo, hi) (dot2bf((hi).w, xp[7], dot2bf((hi).z, xp[6], dot2bf((hi).y, xp[5], dot2bf((hi).x, xp[4], 0.f)))) + dot2bf((lo).w, xp[3], dot2bf((lo).z, xp[2], dot2bf((lo).y, xp[1], dot2bf((lo).x, xp[0], 0.f)))))
    const float p0 = DOT16(B.r[0][0], B.r[0][1]), p1 = DOT16(B.r[1][0], B.r[1][1]), p2 = DOT16(B.r[2][0], B.r[2][1]), p3 = DOT16(B.r[3][0], B.r[3][1]);
#undef DOT16
    const bool hi5 = lane & 32, hi4 = lane & 16;
    const float k0 = hi5 ? p2 : p0, s0 = hi5 ? p0 : p2, k1 = hi5 ? p3 : p1, s1 = hi5 ? p1 : p3;
    const float t0 = k0 + shx32(s0, lane), t1 = k1 + shx32(s1, lane);
    const float k2 = hi4 ? t1 : t0, s2 = hi4 ? t0 : t1;
    const float d = row_sum16(k2 + shx16(s2, lane));
    const float agf = __builtin_bit_cast(float, agv);
    const float g0 = rdlanef(agf, B.l0), g1 = rdlanef(agf, B.l1), g2 = rdlanef(agf, B.l2), g3 = rdlanef(agf, B.l3);
    const float gq = hi5 ? (hi4 ? g3 : g2) : (hi4 ? g1 : g0);
    const int ai = __builtin_bit_cast(int, gelu_as(d * rs) * gq);
    const int w0 = rdlane(ai, 0), w1 = rdlane(ai, 16), w2 = rdlane(ai, 32), w3 = rdlane(ai, 48);
    agv = lane == B.l0 ? w0 : agv; agv = lane == B.l1 ? w1 : agv; agv = lane == B.l2 ? w2 : agv; agv = lane == B.l3 ? w3 : agv;
}
struct PeerGather8 { u32x4 vv[8]; float aw[8]; };
__device__ __forceinline__ void peerB8_gather(PeerGather8& G, const unsigned char* V8, int lane, int cs, const LAS int* ELt, const LAS float* ALt) {
    const int rg = lane >> 2, cl = lane & 3;
#pragma unroll
    for (int j = 0; j < 8; ++j) { const int e = ELt[16 * j + rg]; G.aw[j] = ALt[16 * j + rg];
        G.vv[j] = *(const u32x4*)(V8 + (((unsigned)(cs * PK * PK) + (unsigned)e) * 64u + (unsigned)(cl * 16))); }
}
__device__ __forceinline__ float peerB8_reduce(const PeerGather8& G, int lane) {
    f32x2 acc[8];
#pragma unroll
    for (int c = 0; c < 8; ++c) acc[c] = (f32x2){0.f, 0.f};
#pragma unroll
    for (int j = 0; j < 8; ++j) { const unsigned ww[4] = {G.vv[j].x, G.vv[j].y, G.vv[j].z, G.vv[j].w}; const f32x2 a2 = (f32x2){G.aw[j], G.aw[j]};
#pragma unroll
        for (int m = 0; m < 4; ++m) { acc[2 * m] += __builtin_amdgcn_cvt_pk_f32_fp8(ww[m], false) * a2; acc[2 * m + 1] += __builtin_amdgcn_cvt_pk_f32_fp8(ww[m], true) * a2; } }
    const bool b5 = lane & 32, b4 = lane & 16, b3 = lane & 8, b2 = lane & 4;
    float v8[8], v4[4], v2[2];
#pragma unroll
    for (int c = 0; c < 8; ++c) { const float lo = (c & 1) ? acc[c >> 1].y : acc[c >> 1].x, hi = (c & 1) ? acc[4 + (c >> 1)].y : acc[4 + (c >> 1)].x;
        v8[c] = (b5 ? hi : lo) + shx32(b5 ? lo : hi, lane); }
#pragma unroll
    for (int c = 0; c < 4; ++c) v4[c] = (b4 ? v8[c + 4] : v8[c]) + shx16(b4 ? v8[c] : v8[c + 4], lane);
#pragma unroll
    for (int c = 0; c < 2; ++c) v2[c] = (b3 ? v4[c + 2] : v4[c]) + shx8(b3 ? v4[c] : v4[c + 2]);
    return (b2 ? v2[1] : v2[0]) + shx4(b2 ? v2[0] : v2[1], lane);
}
#ifndef HSHIFT
#define HSHIFT 11
#endif
__device__ __forceinline__ void peerA_token2(const bf16_t* Ub, int lane, int s, int e0lo, int e0hi, int& a0lo, int& a0hi, const unsigned (&xp0)[8], float rs0,
                                             int e1lo, int e1hi, int& a1lo, int& a1hi, const unsigned (&xp1)[8], float rs1) {
    unsigned long long m0 = __ballot((e0lo >> HSHIFT) == s), m1 = __ballot((e0hi >> HSHIFT) == s), m2 = __ballot((e1lo >> HSHIFT) == s), m3 = __ballot((e1hi >> HSHIFT) == s);
    while (m0 | m1 | m2 | m3) {
        const bool h0 = m0 != 0ull, h1 = m1 != 0ull, h2 = m2 != 0ull, h3 = m3 != 0ull;
        PeerBatch B0, B1, B2, B3;
        if (h0) peerA_take(m0, B0, Ub, lane, e0lo);
        if (h1) peerA_take(m1, B1, Ub, lane, e0hi);
        if (h2) peerA_take(m2, B2, Ub, lane, e1lo);
        if (h3) peerA_take(m3, B3, Ub, lane, e1hi);
        if (h0) peerA_finish(B0, lane, a0lo, xp0, rs0);
        if (h1) peerA_finish(B1, lane, a0hi, xp0, rs0);
        if (h2) peerA_finish(B2, lane, a1lo, xp1, rs1);
        if (h3) peerA_finish(B3, lane, a1hi, xp1, rs1);
    }
}
__device__ __forceinline__ void p9_peer_hybrid(const Frame& F, const Args& a, float* dst) {
    const int* EIDX = (const int*)(a.ws + WS_EIDX); const float* GATE = (const float*)(a.ws + WS_GATE); const float* RSTD = (const float*)(a.ws + WS_RSTD);
    const bf16_t* Ub = (const bf16_t*)(a.ws + WS_UB); const unsigned char* V8 = a.ws + WS_V8; const float* SV = (const float*)(a.ws + WS_SV);
    const bf16_t* H2b = (const bf16_t*)(a.ws + WS_XN);
    const int gw = F.vcu * NWAVES + F.wave, lane = F.lane, tokb = gw * 16;
    LAS int* EL = (LAS int*)(F.lds + F.wave * 16384); LAS float* AL = (LAS float*)(F.lds + F.wave * 16384 + 8192);
#pragma unroll 4
    for (int ti = 0; ti < 16; ++ti) { const size_t o = (size_t)(tokb + ti) * 128;
        EL[ti * 128 + lane] = EIDX[o + lane]; EL[ti * 128 + 64 + lane] = EIDX[o + 64 + lane]; AL[ti * 128 + lane] = GATE[o + lane]; AL[ti * 128 + 64 + lane] = GATE[o + 64 + lane]; }
    const float myrs = RSTD[tokb + (lane & 15)];
#pragma unroll 1
    for (int s = 0; s < (16384 >> HSHIFT); ++s) {
#pragma unroll 1
        for (int i = 0; i < 16; i += 2) { const int o = i * 128;
            const u32x4* x0 = (const u32x4*)(H2b + (size_t)(tokb + i) * D) + 2 * lane; const u32x4* x1 = x0 + D / 8;
            const u32x4 xa = x0[0], xb = x0[1], xc = x1[0], xd = x1[1];
            const unsigned xp0[8] = {xa.x, xa.y, xa.z, xa.w, xb.x, xb.y, xb.z, xb.w}, xp1[8] = {xc.x, xc.y, xc.z, xc.w, xd.x, xd.y, xd.z, xd.w};
            const float rs0 = rdlanef(myrs, i), rs1 = rdlanef(myrs, i + 1);
            const int e0lo = EL[o + lane], e0hi = EL[o + 64 + lane], e1lo = EL[o + 128 + lane], e1hi = EL[o + 192 + lane];
            int a0lo = __builtin_bit_cast(int, AL[o + lane]), a0hi = __builtin_bit_cast(int, AL[o + 64 + lane]), a1lo = __builtin_bit_cast(int, AL[o + 128 + lane]), a1hi = __builtin_bit_cast(int, AL[o + 192 + lane]);
            peerA_token2(Ub, lane, s, e0lo, e0hi, a0lo, a0hi, xp0, rs0, e1lo, e1hi, a1lo, a1hi, xp1, rs1);
            AL[o + lane] = __builtin_bit_cast(float, a0lo); AL[o + 64 + lane] = __builtin_bit_cast(float, a0hi); AL[o + 128 + lane] = __builtin_bit_cast(float, a1lo); AL[o + 192 + lane] = __builtin_bit_cast(float, a1hi); }
    }
#pragma unroll 4
    for (int ti = 0; ti < 16; ++ti) { AL[ti * 128 + lane] *= SV[EL[ti * 128 + lane]]; AL[ti * 128 + 64 + lane] *= SV[EL[ti * 128 + 64 + lane]]; }
    const int col = 16 * (lane & 3) + ((lane >> 5) & 1) * 8 + ((lane >> 4) & 1) * 4 + ((lane >> 3) & 1) * 2 + ((lane >> 2) & 1);
#pragma unroll 1
    for (int cs = 0; cs < 16; ++cs) {
        PeerGather8 G0, G1, G2;
        peerB8_gather(G0, V8, lane, cs, EL, AL); peerB8_gather(G1, V8, lane, cs, EL + 128, AL + 128);
#pragma unroll 1
        for (int ti = 0; ti < 15; ti += 3) {
            const size_t o0 = (size_t)(tokb + ti) * D + cs * 64 + col; const float h0 = bf2f(H2b[o0]), h1 = bf2f(H2b[o0 + D]), h2 = bf2f(H2b[o0 + 2 * D]);
            peerB8_gather(G2, V8, lane, cs, EL + (ti + 2) * 128, AL + (ti + 2) * 128);
            dst[o0] = h0 + peerB8_reduce(G0, lane);
            peerB8_gather(G0, V8, lane, cs, EL + (ti + 3) * 128, AL + (ti + 3) * 128);
            dst[o0 + D] = h1 + peerB8_reduce(G1, lane);
            if (ti + 4 < 16) peerB8_gather(G1, V8, lane, cs, EL + (ti + 4) * 128, AL + (ti + 4) * 128);
            dst[o0 + 2 * D] = h2 + peerB8_reduce(G2, lane);
        }
        { const size_t o0 = (size_t)(tokb + 15) * D + cs * 64 + col; dst[o0] = bf2f(H2b[o0]) + peerB8_reduce(G0, lane); }
    }
    asm volatile("s_waitcnt vmcnt(0)" ::: "memory");
    __builtin_amdgcn_fence(__ATOMIC_RELEASE, "workgroup"); __builtin_amdgcn_fence(__ATOMIC_ACQUIRE, "workgroup");
#pragma unroll 2
    for (int ti = 0; ti < 16; ++ti) {
        f32x4* orow = (f32x4*)(dst + (size_t)(tokb + ti) * D) + 4 * lane; const f32x4* gf = (const f32x4*)a.g_final + 4 * lane;
        f32x4 hv[4]; float s2 = 0.f;
#pragma unroll
        for (int j = 0; j < 4; ++j) { hv[j] = orow[j]; s2 += (hv[j].x * hv[j].x + hv[j].y * hv[j].y) + (hv[j].z * hv[j].z + hv[j].w * hv[j].w); }
        const float rstd2 = 1.0f / sqrtf(wave_sum(s2) * (1.f / D) + EPS);
#pragma unroll
        for (int j = 0; j < 4; ++j) orow[j] = hv[j] * rstd2 * gf[j];
    }
}

__global__ void __launch_bounds__(NTHREADS, 2) fwd(Args a) {
    extern __shared__ __attribute__((aligned(16))) unsigned char lds[];
    Frame F; F.lds = (LAS unsigned char*)lds; F.tid = threadIdx.x; F.lane = F.tid & 63; F.wave = __builtin_amdgcn_readfirstlane(F.tid >> 6);
    F.G = gridDim.x; { const int bx = blockIdx.x; F.vcu = (F.G % 8 == 0) ? (bx % 8) * (F.G / 8) + bx / 8 : bx; }
    volatile LAS unsigned* MISC = (volatile LAS unsigned*)(F.lds + LDSCTL_OFF);
    for (int u = F.tid; u < (LDS_BYTES - LDSCTL_OFF) / 4; u += NTHREADS) ((LAS unsigned*)(F.lds + LDSCTL_OFF))[u] = 0u;
    __syncthreads();
    XcdBarrier bar; bar.bar = (unsigned*)(a.ws + WS_CTL) + CW_BAR; bar.x = 0; bar.st = nullptr;
    if (N_LAUNCHES == 1) bar = xcd_barrier_post((unsigned*)(a.ws + WS_CTL) + CW_BAR, MISC + 8);
    const int lo = a.ph_lo, hi = a.ph_hi;
#ifndef PHASE_MASK
#define PHASE_MASK 0xFFFF
#endif
#define IN(k) (((PHASE_MASK >> (k)) & 1) && lo <= (k) && (k) < hi)
#if USE_PG8
#define GEMM_CALL(EPI) pg8::gemm_phase<EPI, pg8::StaticOrder, true, true>(F.lds, g, S, E)
#else
#define GEMM_CALL(EPI) pg8::gemm_simple(g, S, E)
#endif
#define SEAM(k) do { if (IN(k) && IN((k) + 1)) xcd_barrier(bar); } while (0)
    bf16_t* PROJ = (bf16_t*)(a.ws + WS_PROJ);
#ifndef PROBE_REP
#define PROBE_REP 0
#endif
#define REPK(k) ((PROBE_REP >> (k)) & 1)
#define GEMM_P1 { pg8::Gemm g{(const bf16_t*)(a.ws + WS_XN), (const bf16_t*)(a.ws + WS_WIN), ROWS_A, LDP, D, D, D}; pg8::StaticOrder S; S.init(ROWS_A, LDP, F.G, (int)blockIdx.x); pg8::EpiPanels E{PROJ}; GEMM_CALL(pg8::EpiPanels); }
#define GEMM_P5 { pg8::Gemm g{PROJ + ZS_OFF, (const bf16_t*)(a.ws + WS_WOUT), TR, D, D_MIX, P_ZS, D_MIX}; pg8::StaticOrder S; S.init(TR, D, F.G, (int)blockIdx.x); pg8::EpiResBf16 E{a.x, (bf16_t*)(a.ws + WS_XN), D}; GEMM_CALL(pg8::EpiResBf16); }
#define GEMM_P7 { pg8::Gemm g{(const bf16_t*)(a.ws + WS_XN), (const bf16_t*)(a.ws + WS_WQ), TR, PQ, D, D, D}; pg8::StaticOrder S; S.init(TR, PQ, F.G, (int)blockIdx.x); pg8::EpiBf16 E{(bf16_t*)(a.ws + WS_Q), PQ}; GEMM_CALL(pg8::EpiBf16); }
    if (IN(0)) { if (REPK(0)) p0_prologue(F, a); p0_prologue(F, a); } SEAM(0);
    if (IN(1)) { if (REPK(1)) GEMM_P1 GEMM_P1 } SEAM(1);
    if (IN(2)) { if (REPK(2)) p2_ssd_states(F, a, true); p2_ssd_states(F, a, false); } SEAM(2);
    if (IN(3)) { p3_ssd_recur(F, a); } SEAM(3);
    if (IN(4)) { if (REPK(4)) p4_ssd_out<true>(F, a); p4_ssd_out<false>(F, a); } SEAM(4);
    if (IN(5)) { if (REPK(5)) GEMM_P5 GEMM_P5 } SEAM(5);
    if (IN(6)) { if (REPK(6)) p5_norm2(F, a); p5_norm2(F, a); } SEAM(6);
    if (IN(7)) { if (REPK(7)) GEMM_P7 GEMM_P7 } SEAM(7);
    if (IN(8)) { if (REPK(8)) p8_topk_mfma(F, a); p8_topk_mfma(F, a); } SEAM(8);
    if (IN(9)) { p9_peer_hybrid(F, a, a.out); }
#undef IN
#undef SEAM
}

extern "C" void kernel_launch(void* const* d_in, const int* in_sizes, int n_in, void* d_out, int out_size, void* d_ws, size_t ws_size, hipStream_t stream) {
    static int grid = 0;
    if (grid == 0) {
        if (n_in != 18 || out_size != TR * D || ws_size < WS_END) { fprintf(stderr, "kernel_launch: unexpected problem (n_in %d out %d ws %zu)\n", n_in, out_size, ws_size); grid = -1; return; }
        int dev = 0, cus = 0, per_cu = 0;
        if (hipGetDevice(&dev) != hipSuccess || hipDeviceGetAttribute(&cus, hipDeviceAttributeMultiprocessorCount, dev) != hipSuccess) { grid = -1; return; }
        if (hipFuncSetAttribute((const void*)fwd, hipFuncAttributeMaxDynamicSharedMemorySize, LDS_BYTES) != hipSuccess) { fprintf(stderr, "kernel_launch: hipFuncSetAttribute failed\n"); grid = -1; return; }
        if (hipOccupancyMaxActiveBlocksPerMultiprocessor(&per_cu, (const void*)fwd, NTHREADS, LDS_BYTES) != hipSuccess || per_cu < 1) fprintf(stderr, "kernel_launch: occupancy query says %d\n", per_cu);
        (void)hipGetLastError();
        grid = cus;
    }
    if (grid < 0) return;
    if (hipMemsetAsync((char*)d_ws + WS_CTL, 0, CTL_ZERO_BYTES, stream) != hipSuccess) return;
    Args a{};
    a.x = (const float*)d_in[0]; a.meta = (const float*)d_in[1]; a.g_mix = (const float*)d_in[2]; a.w_in = (const float*)d_in[3]; a.conv_ssd_w = (const float*)d_in[4]; a.conv_ssd_b = (const float*)d_in[5];
    a.dt_bias = (const float*)d_in[6]; a.a_log = (const float*)d_in[7]; a.d_skip = (const float*)d_in[8]; a.ssd_norm_w = (const float*)d_in[9]; a.conv_sc_w = (const float*)d_in[10]; a.w_out = (const float*)d_in[11];
    a.g_ffn = (const float*)d_in[12]; a.w_q = (const float*)d_in[13]; a.sub_keys = (const float*)d_in[14]; a.expert_u = (const float*)d_in[15]; a.expert_v = (const float*)d_in[16]; a.g_final = (const float*)d_in[17];
    a.out = (float*)d_out; a.ws = (unsigned char*)d_ws;
    if (N_LAUNCHES == 1) { a.ph_lo = 0; a.ph_hi = NPHASE; hipLaunchKernelGGL(fwd, dim3(grid), dim3(NTHREADS), LDS_BYTES, stream, a); }
    else for (int p = 0; p < NPHASE; ++p) { a.ph_lo = p; a.ph_hi = p + 1; hipLaunchKernelGGL(fwd, dim3(grid), dim3(NTHREADS), LDS_BYTES, stream, a); }
}
```

```cpp
#include <hip/hip_runtime.h>
#include <cstdio>
#include <cstdint>

#define GAS __attribute__((address_space(1)))
#define LAS __attribute__((address_space(3)))
typedef unsigned short bf16_t;
typedef short bf16x8 __attribute__((ext_vector_type(8)));
typedef float f32x4 __attribute__((ext_vector_type(4)));
typedef float f32x2 __attribute__((ext_vector_type(2)));
typedef unsigned u32x4 __attribute__((ext_vector_type(4)));
typedef unsigned u32x2 __attribute__((ext_vector_type(2)));

constexpr int D = 1024, BATCH = 16, SEQ = 2048, NMETA = 16, LSEQ = SEQ + NMETA;
constexpr int TR = BATCH * SEQ;
constexpr int ROWS_A = 33024;
constexpr int D_SSD = 1536, HEADS = 24, HD = 64, NG = 4, NS = 128, D_XBC = 2560, D_SC = 512, D_IN = 5656, D_MIX = 2048;
constexpr int LDP = 5888;
constexpr int C_Z = 0, C_SCB = 1536, C_XBC = 2048, C_SCC = 4608, C_SCX = 5120, C_DT = 5632;
constexpr int P_ZS = 2048, P_XG = 640, P_SC = 1024, P_DT = 32;
constexpr size_t ZS_OFF = 0, XG_OFF = (size_t)ROWS_A * P_ZS, XG_STRIDE = (size_t)ROWS_A * P_XG, SC_OFF = XG_OFF + 4 * XG_STRIDE, DT_OFF = SC_OFF + (size_t)ROWS_A * P_SC, PANELS_END = DT_OFF + (size_t)ROWS_A * P_DT;
static_assert(PANELS_END <= (size_t)ROWS_A * LDP, "panels fit the PROJ region");
__host__ __device__ __forceinline__ size_t proj_dst(int j, int& pitch) {
    if (j < 2048) { pitch = P_ZS; return ZS_OFF + j; }
    if (j < 4608) { const int ch = j - 2048; pitch = P_XG;
        if (ch < 1536) { const int g = ch / 384; return XG_OFF + g * XG_STRIDE + (ch - 384 * g); }
        if (ch < 2048) { const int r = ch - 1536; return XG_OFF + (r >> 7) * XG_STRIDE + 384 + (r & 127); }
        const int r = ch - 2048; return XG_OFF + (r >> 7) * XG_STRIDE + 512 + (r & 127); }
    if (j < 5632) { pitch = P_SC; return SC_OFF + (j - 4608); }
    if (j < 5664) { pitch = P_DT; return DT_OFF + (j - 5632); }
    pitch = 0; return 0;
}
constexpr int PH = 8, PK = 128, PTOP = 16, PQ = 2048;
constexpr float EPS = 1e-6f;

__host__ __device__ constexpr int proj_src_col(int j) {
    return j < 1536 ? j : j < 2048 ? 4120 + (j - 1536) : j < 4608 ? 1536 + (j - 2048) : j < 5120 ? 4632 + (j - 4608) : j < 5632 ? 5144 + (j - 5120) : j < 5656 ? 4096 + (j - 5632) : -1;
}

constexpr size_t MiB = 1u << 20;
constexpr size_t WS_CTL = 0, CTL_ZERO_BYTES = 1 * MiB;
constexpr size_t WS_WIN = 1 * MiB;
constexpr size_t WS_WOUT = 13 * MiB;
constexpr size_t WS_WQ = 17 * MiB;
constexpr size_t WS_XN = 22 * MiB;
constexpr size_t WS_PROJ = 88 * MiB;
constexpr size_t WS_Q = WS_PROJ;
constexpr size_t WS_EIDX = WS_PROJ + 128 * MiB;
constexpr size_t WS_GATE = WS_PROJ + 144 * MiB;
constexpr size_t WS_UB = WS_PROJ + 160 * MiB;
constexpr size_t WS_U8 = WS_PROJ + 160 * MiB;
constexpr size_t WS_V8 = WS_PROJ + 192 * MiB;
constexpr size_t WS_ACT = WS_PROJ + 208 * MiB;
constexpr size_t WS_SU = WS_PROJ + 224 * MiB;
constexpr size_t WS_SV = WS_PROJ + 224 * MiB + 65536;
constexpr size_t WS_RSTD = WS_PROJ + 225 * MiB;
constexpr size_t WS_U8F = WS_PROJ + 226 * MiB;
constexpr size_t WS_VB = WS_PROJ + 192 * MiB;
constexpr size_t WS_END = WS_PROJ + (size_t)ROWS_A * LDP * 2;
static_assert(WS_VB + 32 * MiB <= WS_END, "ws map");
static_assert(WS_XN + (size_t)ROWS_A * D * 2 <= WS_PROJ, "ws map");
static_assert(WS_END <= 512 * MiB, "ws map");

typedef __bf16 bf16x2h_t __attribute__((ext_vector_type(2)));
__device__ __forceinline__ unsigned f2bf(float f) { return (unsigned)__builtin_bit_cast(unsigned short, (__bf16)f); }
__device__ __forceinline__ unsigned pk2(float lo, float hi) { bf16x2h_t v; v.x = (__bf16)lo; v.y = (__bf16)hi; return __builtin_bit_cast(unsigned, v); }
__device__ __forceinline__ float bf2f(unsigned short b) { return __builtin_bit_cast(float, ((unsigned)b) << 16); }
__device__ __forceinline__ float bflo(unsigned w) { return __builtin_bit_cast(float, w << 16); }
__device__ __forceinline__ float bfhi(unsigned w) { return __builtin_bit_cast(float, w & 0xffff0000u); }
template <int CTRL> __device__ __forceinline__ float dppf0(float x) { return __builtin_bit_cast(float, __builtin_amdgcn_update_dpp(0, __builtin_bit_cast(int, x), CTRL, 0xF, 0xF, true)); }
__device__ __forceinline__ void swap32_self(unsigned u, unsigned& lo_lo, unsigned& hi_hi) { unsigned u2 = u; asm volatile("" : "+v"(u2)); auto r = __builtin_amdgcn_permlane32_swap(u, u2, false, false); lo_lo = r[0]; hi_hi = r[1]; }
__device__ __forceinline__ void swap16_self(unsigned u, unsigned& even2, unsigned& odd2) { unsigned u2 = u; asm volatile("" : "+v"(u2)); auto r = __builtin_amdgcn_permlane16_swap(u, u2, false, false); even2 = r[0]; odd2 = r[1]; }
__device__ __forceinline__ float wave_sum(float v) {
    v += dppf0<0xB1>(v); v += dppf0<0x4E>(v); v += dppf0<0x141>(v); v += dppf0<0x140>(v);
    unsigned p, q; swap16_self(__builtin_bit_cast(unsigned, v), p, q); v = __builtin_bit_cast(float, p) + __builtin_bit_cast(float, q);
    swap32_self(__builtin_bit_cast(unsigned, v), p, q); v = __builtin_bit_cast(float, p) + __builtin_bit_cast(float, q);
    return v;
}
__device__ __forceinline__ float row_sum16(float x) { x += dppf0<0xB1>(x); x += dppf0<0x4E>(x); x += dppf0<0x141>(x); x += dppf0<0x140>(x); return x; }
__device__ __forceinline__ int row_of(int b, int pos) { return pos < NMETA ? TR + pos : b * SEQ + (pos - NMETA); }

namespace pg8 {
#define PG8_LAS __attribute__((address_space(3)))
constexpr int BM = 256, BK = 64, HALF = 128, HTB = HALF * BK * 2  , STAGE_BYTES = 8 * HTB, NXCD = 8, WGM = 8;
__host__ __device__ __forceinline__ int perm32(int rho) { const int n = rho >> 4, i = rho & 15; return 8 * (i >> 2) + 4 * n + (i & 3); }
__host__ __device__ __forceinline__ int lds_byte(int r, int c) { const int st = (r >> 4) * 2 + (c >> 5), rr = r & 15, cc = c & 31, ob = rr * 64 + cc * 2; return st * 1024 + (ob ^ (((ob >> 9) & 1) << 5)); }
__host__ __device__ __forceinline__ void stage_rc(int b, int& R, int& C) { const int st = b / 1024, sb = b % 1024, swz = sb ^ (((sb >> 9) & 1) << 5); R = (st >> 1) * 16 + swz / 64; C = (st & 1) * 32 + (swz % 64) / 2; }
struct Unit { int pm, pn; };
struct Gemm { const bf16_t* A; const bf16_t* Bt; int M, N, K, lda, ldb; };
struct StaticOrder {
    int nM, nN, nwg, G, c;
    __host__ __device__ void init(int M, int N, int G_, int c_) { nM = M / BM; nN = N / BM; nwg = nM * nN; G = G_; c = c_; }
    __host__ __device__ bool next(int i, Unit& u) const {
        const long L = (long)i * G + c; if (L >= nwg) return false;
        int wgid = (int)L; { const int q = nwg / NXCD, r = nwg % NXCD, xcd = wgid % NXCD, off = wgid / NXCD; wgid = (xcd < r ? xcd * (q + 1) : r * (q + 1) + (xcd - r) * q) + off; }
        const int nig = WGM * nN, gid = wgid / nig, fm = gid * WGM, gsz = (nM - fm) < WGM ? (nM - fm) : WGM;
        u.pm = fm + ((wgid % nig) % gsz); u.pn = (wgid % nig) / gsz; return true;
    }
    __device__ __forceinline__ void a_ready(const Unit&) const {}
    __device__ __forceinline__ void done(const Unit&) const {}
};
struct EpiBf16 {
    static constexpr bool PERM = true, AFTER_DRAIN = false;
    bf16_t* O; int ldc;
    __device__ __forceinline__ void operator()(const f32x4 (&acc)[2][2][4][2], const Unit& u, int wr, int wc, int fr, int fq) const {
        const int row0 = u.pm * BM + wr * 64 + fr, col0 = u.pn * BM + wc * 32 + 8 * fq;
#pragma unroll
        for (int ai = 0; ai < 2; ++ai)
#pragma unroll
            for (int m = 0; m < 4; ++m) { bf16_t* rowp = O + (size_t)(row0 + ai * HALF + m * 16) * ldc + col0;
#pragma unroll
                for (int bj = 0; bj < 2; ++bj) { const f32x4 v0 = acc[ai][bj][m][0], v1 = acc[ai][bj][m][1];
                    u32x4 w; w.x = pk2(v0[0], v0[1]); w.y = pk2(v0[2], v0[3]); w.z = pk2(v1[0], v1[1]); w.w = pk2(v1[2], v1[3]);
                    *(u32x4*)(rowp + bj * HALF) = w; } }
    }
};
struct EpiPanels {
    static constexpr bool PERM = true, AFTER_DRAIN = false;
    bf16_t* P;
    __device__ __forceinline__ void operator()(const f32x4 (&acc)[2][2][4][2], const Unit& u, int wr, int wc, int fr, int fq) const {
        const int row0 = u.pm * BM + wr * 64 + fr, col0 = u.pn * BM + wc * 32 + 8 * fq;
#pragma unroll
        for (int bj = 0; bj < 2; ++bj) { int pitch; const size_t off = proj_dst(col0 + bj * HALF, pitch); if (pitch == 0) continue;
#pragma unroll
            for (int ai = 0; ai < 2; ++ai)
#pragma unroll
                for (int m = 0; m < 4; ++m) { const f32x4 v0 = acc[ai][bj][m][0], v1 = acc[ai][bj][m][1];
                    u32x4 w; w.x = pk2(v0[0], v0[1]); w.y = pk2(v0[2], v0[3]); w.z = pk2(v1[0], v1[1]); w.w = pk2(v1[2], v1[3]);
                    *(u32x4*)(P + off + (size_t)(row0 + ai * HALF + m * 16) * pitch) = w; } }
    }
};
struct EpiResBf16 {
    static constexpr bool PERM = true, AFTER_DRAIN = false;
    const float* base; bf16_t* O; int ldc;
    __device__ __forceinline__ void operator()(const f32x4 (&acc)[2][2][4][2], const Unit& u, int wr, int wc, int fr, int fq) const {
        const int row0 = u.pm * BM + wr * 64 + fr, col0 = u.pn * BM + wc * 32 + 8 * fq;
#pragma unroll
        for (int ai = 0; ai < 2; ++ai)
#pragma unroll
            for (int m = 0; m < 4; ++m) { const size_t off = (size_t)(row0 + ai * HALF + m * 16) * ldc + col0;
#pragma unroll
                for (int bj = 0; bj < 2; ++bj) { const f32x4 b0 = *(const f32x4*)(base + off + bj * HALF), b1 = *(const f32x4*)(base + off + bj * HALF + 4);
                    const f32x4 v0 = acc[ai][bj][m][0] + b0, v1 = acc[ai][bj][m][1] + b1;
                    u32x4 w; w.x = pk2(v0[0], v0[1]); w.y = pk2(v0[2], v0[3]); w.z = pk2(v1[0], v1[1]); w.w = pk2(v1[2], v1[3]);
                    *(u32x4*)(O + off + bj * HALF) = w; } }
    }
};
struct EpiResF32 {
    static constexpr bool PERM = false, AFTER_DRAIN = false;
    const float* base; float* C; int ldc;
    __device__ __forceinline__ void operator()(const f32x4 (&acc)[2][2][4][2], const Unit& u, int wr, int wc, int fr, int fq) const {
        const int row0 = u.pm * BM + wr * 64 + fr, col0 = u.pn * BM + wc * 32 + 4 * fq;
#pragma unroll
        for (int ai = 0; ai < 2; ++ai)
#pragma unroll
            for (int m = 0; m < 4; ++m) { const size_t off = (size_t)(row0 + ai * HALF + m * 16) * ldc + col0;
#pragma unroll
                for (int bj = 0; bj < 2; ++bj)
#pragma unroll
                    for (int n = 0; n < 2; ++n) { const f32x4 bs = *(const f32x4*)(base + off + bj * HALF + n * 16); *(f32x4*)(C + off + bj * HALF + n * 16) = bs + acc[ai][bj][m][n]; } }
    }
};
template <class Epi, class Sched, bool ALIGN_EPI = false, bool SP2 = false>
__device__ __forceinline__ void gemm_phase(PG8_LAS unsigned char* lds, const Gemm g, const Sched& S, const Epi& E) {
    const int tid = threadIdx.x, wid = __builtin_amdgcn_readfirstlane(tid >> 6), lane = tid & 63, wr = wid >> 2, wc = wid & 3, fr = lane & 15, fq = lane >> 4;
    const int K = g.K, nt = K / BK;
    unsigned voffA[2], voffB[2];
#pragma unroll
    for (int i = 0; i < 2; ++i) { int R, C; stage_rc(tid * 16 + i * 8192, R, C); const int Rb = Epi::PERM ? ((R & ~31) + perm32(R & 31)) : R;
        voffA[i] = (unsigned)(R * g.lda + C) * 2u; voffB[i] = (unsigned)(Rb * g.ldb + C) * 2u; }
    const size_t kstep = (size_t)(BK * 2);
    const size_t hstepA = (size_t)HALF * g.lda * 2, hstepB = (size_t)HALF * g.ldb * 2;
    const size_t tstepA = 2 * hstepA, tstepB = 2 * hstepB;
    const unsigned ldsw = (unsigned)wid * 1024u;
    const int aoff = lds_byte(wr * 64 + fr, fq * 8), boff = lds_byte(wc * 32 + fr, fq * 8);
#define PG8_SA(b, h) (((b) * 2 + (h)) * HTB)
#define PG8_SB(b, h) ((4 + (b) * 2 + (h)) * HTB)
#define PG8_STAGE(bufoff, gbase, voff) do { _Pragma("unroll") for (int _i = 0; _i < 2; ++_i) \
        __builtin_amdgcn_global_load_lds((const unsigned*)((const char*)(gbase) + (voff)[_i]), (PG8_LAS unsigned*)(lds + (bufoff) + ldsw + _i * 8192), 16, 0, 0); } while (0)
#define PG8_LDA(dst, b, h) do { _Pragma("unroll") for (int m = 0; m < 4; ++m) _Pragma("unroll") for (int k = 0; k < 2; ++k) dst[m][k] = *(const PG8_LAS bf16x8*)(lds + PG8_SA(b, h) + aoff + m * 2048 + k * 1024); } while (0)
#define PG8_LDB(dst, b, h) do { _Pragma("unroll") for (int n = 0; n < 2; ++n) _Pragma("unroll") for (int k = 0; k < 2; ++k) dst[n][k] = *(const PG8_LAS bf16x8*)(lds + PG8_SB(b, h) + boff + n * 2048 + k * 1024); } while (0)
#define PG8_MMA(ai, bj, At, Bt) do { __builtin_amdgcn_s_setprio(1); _Pragma("unroll") for (int m = 0; m < 4; ++m) _Pragma("unroll") for (int n = 0; n < 2; ++n) _Pragma("unroll") for (int k = 0; k < 2; ++k) \
        acc[ai][bj][m][n] = __builtin_amdgcn_mfma_f32_16x16x32_bf16(Bt[n][k], At[m][k], acc[ai][bj][m][n], 0, 0, 0); __builtin_amdgcn_s_setprio(0); } while (0)
#define PG8_WAIT_V(n) asm volatile("s_waitcnt vmcnt(" #n ")" ::: "memory")
#define PG8_WAIT_L(n) asm volatile("s_waitcnt lgkmcnt(" #n ")" ::: "memory")
#define PG8_BAR __builtin_amdgcn_s_barrier()
#define PG8_SCHED __builtin_amdgcn_sched_barrier(0)
    Unit cur, nxt; int ui = 0;
    if (!S.next(0, cur)) return;
    f32x4 acc[2][2][4][2];
#pragma unroll
    for (int a = 0; a < 2; ++a)
#pragma unroll
        for (int b = 0; b < 2; ++b)
#pragma unroll
            for (int m = 0; m < 4; ++m)
#pragma unroll
                for (int n = 0; n < 2; ++n) acc[a][b][m][n] = (f32x4){0.f, 0.f, 0.f, 0.f};
    bf16x8 At[4][2], B0[2][2], B1[2][2];
    const char* cA = (const char*)g.A + (size_t)cur.pm * tstepA; const char* cB = (const char*)g.Bt + (size_t)cur.pn * tstepB;
    S.a_ready(cur);
    if constexpr (SP2) {
        PG8_STAGE(PG8_SB(0, 0), cB, voffB); PG8_STAGE(PG8_SB(0, 1), cB + hstepB, voffB); PG8_STAGE(PG8_SA(0, 0), cA, voffA); PG8_STAGE(PG8_SA(0, 1), cA + hstepA, voffA);
        if (wr == 1) PG8_BAR;
        PG8_WAIT_V(2); PG8_BAR;
        PG8_STAGE(PG8_SB(1, 0), cB + kstep, voffB); PG8_STAGE(PG8_SA(1, 0), cA + kstep, voffA); PG8_STAGE(PG8_SB(1, 1), cB + hstepB + kstep, voffB);
        PG8_WAIT_V(6); PG8_BAR;
    } else {
        PG8_STAGE(PG8_SB(0, 0), cB, voffB); PG8_STAGE(PG8_SA(0, 0), cA, voffA); PG8_STAGE(PG8_SB(0, 1), cB + hstepB, voffB); PG8_STAGE(PG8_SA(0, 1), cA + hstepA, voffA);
        if (wr == 1) PG8_BAR;
        PG8_WAIT_V(4); PG8_BAR;
        PG8_STAGE(PG8_SB(1, 0), cB + kstep, voffB); PG8_STAGE(PG8_SA(1, 0), cA + kstep, voffA); PG8_STAGE(PG8_SB(1, 1), cB + hstepB + kstep, voffB);
        PG8_WAIT_V(6); PG8_BAR;
    }
    for (;;) {
        const bool has_next = S.next(ui + 1, nxt);
        const char* nA = has_next ? (const char*)g.A + (size_t)nxt.pm * tstepA : cA; const char* nB = has_next ? (const char*)g.Bt + (size_t)nxt.pn * tstepB : cB;
        for (int t = 0; t < nt; t += 2) {
            const bool last = (t == nt - 2);
            const char* a1 = cA + (size_t)(t + 1) * kstep;
            const char* a2 = last ? nA : cA + (size_t)(t + 2) * kstep; const char* b2 = last ? nB : cB + (size_t)(t + 2) * kstep;
            const char* a3 = a2 + kstep; const char* b3 = b2 + kstep;
            if (last && has_next) S.a_ready(nxt);
            if constexpr (SP2) {
            PG8_LDB(B0, 0, 0); PG8_LDB(B1, 0, 1); PG8_SCHED; PG8_LDA(At, 0, 0); PG8_STAGE(PG8_SA(1, 1), a1 + hstepA, voffA);
            PG8_WAIT_V(8); PG8_WAIT_L(0); PG8_BAR; PG8_MMA(0, 0, At, B0); PG8_MMA(0, 1, At, B1); PG8_BAR; PG8_SCHED;
            PG8_LDA(At, 0, 1); PG8_STAGE(PG8_SB(0, 0), b2, voffB); PG8_STAGE(PG8_SB(0, 1), b2 + hstepB, voffB); PG8_STAGE(PG8_SA(0, 0), a2, voffA);
            PG8_WAIT_V(8); PG8_WAIT_L(0); PG8_BAR; PG8_MMA(1, 0, At, B0); PG8_MMA(1, 1, At, B1); PG8_BAR; PG8_SCHED;
            PG8_LDB(B0, 1, 0); PG8_LDB(B1, 1, 1); PG8_SCHED; PG8_LDA(At, 1, 0); PG8_STAGE(PG8_SA(0, 1), a2 + hstepA, voffA);
            PG8_WAIT_V(8); PG8_WAIT_L(0); PG8_BAR; PG8_MMA(0, 0, At, B0); PG8_MMA(0, 1, At, B1); PG8_BAR; PG8_SCHED;
            PG8_LDA(At, 1, 1); PG8_STAGE(PG8_SB(1, 0), b3, voffB); PG8_STAGE(PG8_SB(1, 1), b3 + hstepB, voffB); PG8_STAGE(PG8_SA(1, 0), a3, voffA);
            PG8_WAIT_V(8); PG8_WAIT_L(0); PG8_BAR; PG8_MMA(1, 0, At, B0); PG8_MMA(1, 1, At, B1); PG8_BAR; PG8_SCHED;
            } else {
            PG8_LDB(B0, 0, 0); PG8_SCHED; PG8_LDA(At, 0, 0); PG8_STAGE(PG8_SA(1, 1), a1 + hstepA, voffA);
            PG8_WAIT_L(8); PG8_BAR; PG8_WAIT_L(0); PG8_MMA(0, 0, At, B0); PG8_BAR; PG8_SCHED;
            PG8_LDB(B1, 0, 1); PG8_STAGE(PG8_SB(0, 0), b2, voffB);
            PG8_BAR; PG8_WAIT_L(0); PG8_MMA(0, 1, At, B1); PG8_BAR;
            PG8_LDA(At, 0, 1); PG8_STAGE(PG8_SA(0, 0), a2, voffA);
            PG8_BAR; PG8_WAIT_L(0); PG8_MMA(1, 0, At, B0); PG8_BAR; PG8_SCHED;
            PG8_STAGE(PG8_SB(0, 1), b2 + hstepB, voffB);
            PG8_WAIT_V(6); PG8_BAR; PG8_MMA(1, 1, At, B1); PG8_BAR;
            PG8_LDB(B0, 1, 0); PG8_SCHED; PG8_LDA(At, 1, 0); PG8_STAGE(PG8_SA(0, 1), a2 + hstepA, voffA);
            PG8_WAIT_L(8); PG8_BAR; PG8_WAIT_L(0); PG8_MMA(0, 0, At, B0); PG8_BAR; PG8_SCHED;
            PG8_LDB(B1, 1, 1); PG8_STAGE(PG8_SB(1, 0), b3, voffB);
            PG8_BAR; PG8_WAIT_L(0); PG8_MMA(0, 1, At, B1); PG8_BAR;
            PG8_LDA(At, 1, 1); PG8_STAGE(PG8_SA(1, 0), a3, voffA);
            PG8_BAR; PG8_WAIT_L(0); PG8_MMA(1, 0, At, B0); PG8_BAR; PG8_SCHED;
            PG8_STAGE(PG8_SB(1, 1), b3 + hstepB, voffB);
            PG8_WAIT_V(6); PG8_BAR; PG8_MMA(1, 1, At, B1); PG8_BAR;
            }
        }
        if constexpr (ALIGN_EPI) { if (wr == 0) PG8_BAR; }
        if constexpr (!Epi::AFTER_DRAIN) { E(acc, cur, wr, wc, fr, fq); S.done(cur); }
        if (!has_next) break;
#pragma unroll
        for (int a = 0; a < 2; ++a)
#pragma unroll
            for (int b = 0; b < 2; ++b)
#pragma unroll
                for (int m = 0; m < 4; ++m)
#pragma unroll
                    for (int n = 0; n < 2; ++n) acc[a][b][m][n] = (f32x4){0.f, 0.f, 0.f, 0.f};
        cur = nxt; cA = nA; cB = nB; ++ui;
        if constexpr (ALIGN_EPI) { if (wr == 1) PG8_BAR; }
    }
    PG8_WAIT_V(0);
    if constexpr (!ALIGN_EPI) { if (wr == 0) PG8_BAR; }
    PG8_BAR;
    if constexpr (Epi::AFTER_DRAIN) { E.fused(acc, cur, wr, wc, fr, fq, lds, wid, lane); S.done(cur); }
#undef PG8_SA
#undef PG8_SB
#undef PG8_STAGE
#undef PG8_LDA
#undef PG8_LDB
#undef PG8_MMA
#undef PG8_WAIT_V
#undef PG8_WAIT_L
#undef PG8_BAR
#undef PG8_SCHED
}

template <class Epi>
__device__ __forceinline__ void gemm_simple(const Gemm g, const StaticOrder& S, const Epi& E) {
    const int tid = threadIdx.x, wid = __builtin_amdgcn_readfirstlane(tid >> 6), lane = tid & 63, wr = wid >> 2, wc = wid & 3, fr = lane & 15, fq = lane >> 4;
    Unit u;
    for (int i = 0; S.next(i, u); ++i) {
        f32x4 acc[2][2][4][2];
#pragma unroll
        for (int a = 0; a < 2; ++a)
#pragma unroll
            for (int b = 0; b < 2; ++b)
#pragma unroll
                for (int m = 0; m < 4; ++m)
#pragma unroll
                    for (int n = 0; n < 2; ++n) acc[a][b][m][n] = (f32x4){0.f, 0.f, 0.f, 0.f};
        const bf16_t* Ab = g.A + (size_t)(u.pm * BM + wr * 64 + fr) * g.lda + fq * 8;
        const bf16_t* Bb = g.Bt + (size_t)(u.pn * BM + wc * 32) * g.ldb + fq * 8;
        int brow[2];
#pragma unroll
        for (int n = 0; n < 2; ++n) brow[n] = Epi::PERM ? perm32(16 * n + fr) : (16 * n + fr);
        for (int k0 = 0; k0 < g.K; k0 += 32) {
            bf16x8 Af[2][4], Bf[2][2];
#pragma unroll
            for (int ai = 0; ai < 2; ++ai)
#pragma unroll
                for (int m = 0; m < 4; ++m) Af[ai][m] = *(const bf16x8*)(Ab + (size_t)(ai * HALF + m * 16) * g.lda + k0);
#pragma unroll
            for (int bj = 0; bj < 2; ++bj)
#pragma unroll
                for (int n = 0; n < 2; ++n) Bf[bj][n] = *(const bf16x8*)(Bb + (size_t)(bj * HALF + brow[n]) * g.ldb + k0);
#pragma unroll
            for (int ai = 0; ai < 2; ++ai)
#pragma unroll
                for (int bj = 0; bj < 2; ++bj)
#pragma unroll
                    for (int m = 0; m < 4; ++m)
#pragma unroll
                        for (int n = 0; n < 2; ++n) acc[ai][bj][m][n] = __builtin_amdgcn_mfma_f32_16x16x32_bf16(Bf[bj][n], Af[ai][m], acc[ai][bj][m][n], 0, 0, 0);
        }
        E(acc, u, wr, wc, fr, fq);
    }
}
}

#define XB_TMO      128
#define XB_XCNT(j)  (256  + 64 * (j))
#define XB_XSUB(j)  (1280 + 64 * (j))
#define XB_XGEN(j)  (2304 + 64 * (j))
#define XB_TOP      3328
#define XB_TOPGEN   3392
#define XCD_BAR_WORDS 3456
#define XB_SPIN_CAP (1u << 18)
__device__ __forceinline__ unsigned xb_ld(unsigned* p)              { return __hip_atomic_load(p, __ATOMIC_RELAXED, __HIP_MEMORY_SCOPE_AGENT); }
__device__ __forceinline__ unsigned xb_add(unsigned* p, unsigned v) { return __hip_atomic_fetch_add(p, v, __ATOMIC_RELAXED, __HIP_MEMORY_SCOPE_AGENT); }
__device__ __forceinline__ unsigned xb_xcc_id() { return (unsigned)__builtin_amdgcn_s_getreg((3 << 11) | 20) & 0xFu; }
#define XB_SPIN(cond, bar) do { unsigned _sp = 0; while (cond) { __builtin_amdgcn_s_sleep(1); \
    if ((++_sp & 255u) == 0u) { if (xb_ld(&(bar)[XB_TMO])) break; if (_sp > XB_SPIN_CAP) { atomicAdd(&(bar)[XB_TMO], 1u); break; } } } } while (0)
struct XcdBarrier { unsigned* bar; unsigned x; volatile LAS unsigned* st; };
__device__ __forceinline__ XcdBarrier xcd_barrier_post(unsigned* bar, volatile LAS unsigned* st) {
    XcdBarrier b; b.bar = bar; b.x = xb_xcc_id(); b.st = st;
    if (threadIdx.x == 0) (void)xb_add(&bar[XB_XCNT(b.x)], 1u);
    return b;
}
__device__ __forceinline__ void xcd_barrier_complete(unsigned* bar, unsigned x, unsigned& nloc, unsigned& nx) {
    const unsigned G = gridDim.x * gridDim.y * gridDim.z;
    unsigned sum, cnt, mine, sp = 0u;
    for (;;) {
        sum = 0u; cnt = 0u; mine = 0u;
#pragma unroll
        for (unsigned j = 0; j < 16; ++j) { const unsigned c = xb_ld(&bar[XB_XCNT(j)]); sum += c; cnt += (c > 0u) ? 1u : 0u; mine = (j == x) ? c : mine; }
        if (sum == G) break;
        __builtin_amdgcn_s_sleep(1);
        if ((++sp & 255u) == 0u) { if (xb_ld(&bar[XB_TMO])) break; if (sp > XB_SPIN_CAP) { atomicAdd(&bar[XB_TMO], 1u); break; } }
    }
    nloc = mine > 0u ? mine : 1u; nx = cnt > 0u ? cnt : 1u;
}
__device__ __forceinline__ void xcd_barrier(const XcdBarrier& b) {
    asm volatile("s_waitcnt vmcnt(0)" ::: "memory");
    __syncthreads();
    if (threadIdx.x == 0) {
        unsigned* bar = b.bar;
        __builtin_amdgcn_s_waitcnt(0);
        unsigned nloc = b.st[0], nx = b.st[1];
        if (nloc == 0u) { xcd_barrier_complete(bar, b.x, nloc, nx); b.st[0] = nloc; b.st[1] = nx; }
        const unsigned old = xb_add(&bar[XB_XSUB(b.x)], 1u);
        const unsigned gen = old / nloc;
        if (old + 1u == (gen + 1u) * nloc) {
            __builtin_amdgcn_fence(__ATOMIC_RELEASE, "agent");
            asm volatile("s_waitcnt vmcnt(0)" ::: "memory");
            const unsigned og = xb_add(&bar[XB_TOP], 1u);
            const unsigned tg = og / nx;
            if (og + 1u == (tg + 1u) * nx) xb_add(&bar[XB_TOPGEN], 1u);
            else XB_SPIN(xb_ld(&bar[XB_TOPGEN]) == tg, bar);
            __builtin_amdgcn_fence(__ATOMIC_ACQUIRE, "agent");
            xb_add(&bar[XB_XGEN(b.x)], 1u);
            asm volatile("s_waitcnt vmcnt(0)" ::: "memory");
        } else {
            XB_SPIN(xb_ld(&bar[XB_XGEN(b.x)]) == gen, bar);
            __builtin_amdgcn_fence(__ATOMIC_ACQUIRE, "agent");
            asm volatile("s_waitcnt vmcnt(0)" ::: "memory");
        }
    }
    __syncthreads();
}

#ifndef PROBE_S3
#define PROBE_S3 0
#endif
#ifndef PROBE_P9
#define PROBE_P9 0
#endif
#ifndef PEER_SLICED
#define PEER_SLICED 4
#endif
#ifndef P9_ALIGN
#define P9_ALIGN 0
#endif
#ifndef USE_PG8
#define USE_PG8 1
#endif
constexpr int NWAVES = 8, NTHREADS = 512;
constexpr int NPHASE = 10;
#ifndef MK_N_LAUNCHES
#define MK_N_LAUNCHES 1
#endif
constexpr int N_LAUNCHES = MK_N_LAUNCHES;
constexpr int RING_BYTES = 131072, LDS_BYTES = 163840, LDSCTL_OFF = LDS_BYTES - 256;
constexpr int CW_BAR = 4096;

struct Args {
    const float *x, *meta, *g_mix, *w_in, *conv_ssd_w, *conv_ssd_b, *dt_bias, *a_log, *d_skip, *ssd_norm_w, *conv_sc_w, *w_out, *g_ffn, *w_q, *sub_keys, *expert_u, *expert_v, *g_final;
    float* out; unsigned char* ws; int ph_lo, ph_hi;
};
struct Frame { LAS unsigned char* lds; int tid, lane, wave, G, vcu; };

template <class ColMap>
__device__ __forceinline__ void p0_transpose_item(const float* W, int K, int N, bf16_t* WT, int nblk, LAS float* scr, int item, int lane, ColMap cm, const float* kscale = nullptr) {
    const int kb = item / nblk, nb = item % nblk, k0 = 64 * kb, n0 = 32 * nb;
    const int sc = cm(n0 + (lane & 31));
#pragma unroll 8
    for (int i = 0; i < 32; ++i) { const int kk = 2 * i + (lane >> 5); scr[kk * 33 + (lane & 31)] = sc >= 0 ? W[(size_t)(k0 + kk) * N + sc] * (kscale ? kscale[k0 + kk] : 1.f) : 0.f; }
    asm volatile("s_waitcnt lgkmcnt(0)" ::: "memory");
    const int c = lane & 7;
#pragma unroll
    for (int j = 0; j < 4; ++j) { const int n = (lane >> 3) + 8 * j; const LAS float* s = scr + (8 * c) * 33 + n;
        u32x4 o; o.x = pk2(s[0 * 33], s[1 * 33]); o.y = pk2(s[2 * 33], s[3 * 33]); o.z = pk2(s[4 * 33], s[5 * 33]); o.w = pk2(s[6 * 33], s[7 * 33]);
        *(u32x4*)(WT + (size_t)(n0 + n) * K + k0 + 8 * c) = o; }
    asm volatile("s_waitcnt lgkmcnt(0)" ::: "memory");
}
__device__ __forceinline__ void p0_prologue(const Frame& F, const Args& a) {
    LAS float* scr = (LAS float*)(F.lds + F.wave * 16384);
    const int gw = F.vcu * NWAVES + F.wave, NGW = F.G * NWAVES;
    bf16_t* WinT = (bf16_t*)(a.ws + WS_WIN); bf16_t* WoutT = (bf16_t*)(a.ws + WS_WOUT); bf16_t* WqT = (bf16_t*)(a.ws + WS_WQ); bf16_t* XN = (bf16_t*)(a.ws + WS_XN);
    constexpr int I_IN = (D / 64) * (LDP / 32), I_OUT = (D_MIX / 64) * (D / 32), I_Q = (D / 64) * (PQ / 32);
    for (int it = gw; it < I_IN + I_OUT + I_Q; it += NGW) {
        int r = it;
        if (r < I_IN) { p0_transpose_item(a.w_in, D, D_IN, WinT, LDP / 32, scr, r, F.lane, [](int j) { return proj_src_col(j); }); continue; } r -= I_IN;
        if (r < I_OUT) { p0_transpose_item(a.w_out, D_MIX, D, WoutT, D / 32, scr, r, F.lane, [](int j) { return j; }); continue; } r -= I_OUT;
        p0_transpose_item(a.w_q, D, PQ, WqT, PQ / 32, scr, r, F.lane, [](int j) { return j; }, a.g_ffn);
    }
    for (int m = gw; m < ROWS_A; m += NGW) {
        u32x2* o8 = (u32x2*)(XN + (size_t)m * D) + F.lane;
        if (m >= TR + NMETA) {
#pragma unroll
            for (int j = 0; j < 4; ++j) o8[64 * j] = (u32x2){0u, 0u};
            continue; }
        const float* src = m < TR ? a.x + (size_t)m * D : a.meta + (size_t)(m - TR) * D;
        const f32x4* xr = (const f32x4*)src + F.lane; const f32x4* gr = (const f32x4*)a.g_mix + F.lane;
        f32x4 v[4]; float s = 0.f;
#pragma unroll
        for (int j = 0; j < 4; ++j) { v[j] = xr[64 * j]; s += (v[j].x * v[j].x + v[j].y * v[j].y) + (v[j].z * v[j].z + v[j].w * v[j].w); }
        const float rstd = 1.0f / sqrtf(wave_sum(s) * (1.f / D) + EPS);
#pragma unroll
        for (int j = 0; j < 4; ++j) { const f32x4 gg = gr[64 * j]; o8[64 * j] = (u32x2){pk2(v[j].x * rstd * gg.x, v[j].y * rstd * gg.y), pk2(v[j].z * rstd * gg.z, v[j].w * rstd * gg.w)}; }
    }
}

typedef float f32x16 __attribute__((ext_vector_type(16)));
constexpr int PITCH = 136;
constexpr int SL_C = 0, SL_B = 34816, SL_M0 = 69632, SL_X = 104448, SL_DT = 139264, SL_ACS = 142336;
constexpr int YPITCH = 396;
static_assert(SL_B + 128 * YPITCH * 2 <= SL_DT, "staging fits below dt/acs");
constexpr size_t WS_DAT = WS_XN;
constexpr size_t WS_SMETA = WS_XN + 65536;

__device__ __forceinline__ f32x16 mfma32(bf16x8 a, bf16x8 b, f32x16 c) { return __builtin_amdgcn_mfma_f32_32x32x16_bf16(a, b, c, 0, 0, 0); }
__device__ __forceinline__ float silu_f(float v) { return v / (1.f + __expf(-v)); }

template <int NP> struct ConvW { u32x4 raw[NP + 3]; };
template <int NP> __device__ __forceinline__ void convw_load(ConvW<NP>& ci, const bf16_t* xgc  , int b, int pos0) {
#pragma unroll
    for (int i = 0; i < NP + 3; ++i) { const int pos = pos0 - 3 + i; u32x4 v = (u32x4){0u, 0u, 0u, 0u};
        if (pos >= 0) v = *(const u32x4*)(xgc + (size_t)row_of(b, pos) * P_XG);
        ci.raw[i] = v; }
}
struct ConvWt { f32x4 w[4][2], cb[2]; };
__device__ __forceinline__ void convw_weights(ConvWt& cw, const Args& a, int ch) {
    cw.cb[0] = *(const f32x4*)(a.conv_ssd_b + ch); cw.cb[1] = *(const f32x4*)(a.conv_ssd_b + ch + 4);
#pragma unroll
    for (int wi = 0; wi < 4; ++wi) { cw.w[wi][0] = *(const f32x4*)(a.conv_ssd_w + wi * D_XBC + ch); cw.w[wi][1] = *(const f32x4*)(a.conv_ssd_w + wi * D_XBC + ch + 4); }
}
__device__ __forceinline__ float bfel(const u32x4& v, int c) { const unsigned w = (c >> 1) == 0 ? v.x : (c >> 1) == 1 ? v.y : (c >> 1) == 2 ? v.z : v.w; return (c & 1) ? bfhi(w) : bflo(w); }
template <int NP> __device__ __forceinline__ void convw_pos(const ConvW<NP>& ci, const ConvWt& cw, int s, float (&o)[8]) {
#pragma unroll
    for (int c = 0; c < 8; ++c) { const int q = c >> 2, e = c & 3;
        o[c] = silu_f(cw.cb[q][e] + cw.w[0][q][e] * bfel(ci.raw[s], c) + cw.w[1][q][e] * bfel(ci.raw[s + 1], c) + cw.w[2][q][e] * bfel(ci.raw[s + 2], c) + cw.w[3][q][e] * bfel(ci.raw[s + 3], c)); }
}
__device__ __forceinline__ u32x4 pack8(const float (&o)[8][2], int j) { u32x4 r; r.x = pk2(o[0][j], o[1][j]); r.y = pk2(o[2][j], o[3][j]); r.z = pk2(o[4][j], o[5][j]); r.w = pk2(o[6][j], o[7][j]); return r; }
__device__ __forceinline__ void ssd_dt_acs(const Frame& F_, const Args& a, const bf16_t* PROJ, int b, int p0, int g, float* dat  ) {
    const Frame& F0 = F_;
    if (F0.wave < 6) {
        int lane_ = F0.lane; asm volatile("" : "+v"(lane_));
        Frame Fl = F0; Fl.lane = lane_;
        const Frame& F = Fl;
        const int h = g * 6 + F.wave; const float A = -__expf(a.a_log[h]), dtb = a.dt_bias[h];
        LAS float* dtL = (LAS float*)(F.lds + SL_DT) + F.wave * 128; LAS float* acL = (LAS float*)(F.lds + SL_ACS) + F.wave * 128;
        float dv[2], av[2];
#pragma unroll
        for (int hf = 0; hf < 2; ++hf) { const int pos = p0 + F.lane + 64 * hf; float d = 0.f;
            if (pos >= 0) { const float v = bf2f(PROJ[DT_OFF + (size_t)row_of(b, pos) * P_DT + h]) + dtb, t = __expf(-fabsf(v));
                d = fmaxf(v, 0.f) + (t < 1e-3f ? t * (1.f - 0.5f * t) : __logf(1.f + t)); }
            dv[hf] = d; av[hf] = d * A; }
#pragma unroll
        for (int o = 1; o < 64; o <<= 1) { const float t0 = __shfl_up(av[0], o), t1 = __shfl_up(av[1], o); if (F.lane >= o) { av[0] += t0; av[1] += t1; } }
        av[1] += __shfl(av[0], 63);
        dtL[F.lane] = dv[0]; dtL[F.lane + 64] = dv[1]; acL[F.lane] = av[0]; acL[F.lane + 64] = av[1];
        if (dat && F.lane == 63) dat[h] = __expf(av[1]);
    }
}

__device__ __forceinline__ void ssd_s1_unit(const Frame& F, const Args& a, int b, int c, int g) {
    const bf16_t* PROJ = (const bf16_t*)(a.ws + WS_PROJ);
    const int p0 = c == 0 ? -112 : NMETA + 128 * (c - 1), lr = F.lane & 31, hf = F.lane >> 5;
    __syncthreads();
    ssd_dt_acs(F, a, PROJ, b, p0, g, (float*)(a.ws + WS_DAT) + (size_t)(b * 17 + c) * HEADS);
    if (F.tid < 256) { const int chg = F.tid & 15, sr = F.tid >> 4, ch = D_SSD + g * 128 + 8 * chg;
        ConvW<8> ci; convw_load<8>(ci, PROJ + XG_OFF + g * XG_STRIDE + 384 + 8 * chg, b, p0 + 8 * sr); ConvWt cw; convw_weights(cw, a, ch);
        unsigned pk[8][4];
#pragma unroll
        for (int s2 = 0; s2 < 4; ++s2) { float o0[8], o1[8]; convw_pos<8>(ci, cw, 2 * s2, o0); convw_pos<8>(ci, cw, 2 * s2 + 1, o1);
#pragma unroll
            for (int c = 0; c < 8; ++c) pk[c][s2] = pk2(o0[c], o1[c]); }
#pragma unroll
        for (int c = 0; c < 8; ++c) *(LAS u32x4*)(F.lds + SL_C + ((8 * chg + c) * PITCH + 8 * sr) * 2) = (u32x4){pk[c][0], pk[c][1], pk[c][2], pk[c][3]}; }
    __syncthreads();
    const bf16_t* xg1 = PROJ + XG_OFF + g * XG_STRIDE + 8 * (F.tid & 7);
    ConvW<2> cin; convw_load<2>(cin, xg1, b, p0 + 2 * (F.tid >> 3));
#pragma unroll 1
    for (int hh = 0; hh < 6; ++hh) {
        const int h = g * 6 + hh, buf = hh & 1;
        {
            const int chg = F.tid & 7, sp = F.tid >> 3, ch = h * 64 + 8 * chg;
            const ConvW<2> ci = cin; ConvWt cw; convw_weights(cw, a, ch);
            if (hh < 5) convw_load<2>(cin, xg1 + (hh + 1) * 64, b, p0 + 2 * sp);
            const LAS float* dtL = (const LAS float*)(F.lds + SL_DT) + hh * 128; const LAS float* acL = (const LAS float*)(F.lds + SL_ACS) + hh * 128;
            const float aend = acL[127], w0 = dtL[2 * sp] * __expf(aend - acL[2 * sp]), w1 = dtL[2 * sp + 1] * __expf(aend - acL[2 * sp + 1]);
            float o0[8], o1[8]; convw_pos<2>(ci, cw, 0, o0); convw_pos<2>(ci, cw, 1, o1);
#pragma unroll
            for (int c = 0; c < 8; ++c) *(LAS unsigned*)(F.lds + SL_X + buf * 17408 + ((8 * chg + c) * PITCH + 2 * sp) * 2) = pk2(o0[c] * w0, o1[c] * w1);
        }
        __syncthreads();
        const int pb = F.wave >> 2, nb = F.wave & 3;
        f32x16 acc;
#pragma unroll
        for (int r = 0; r < 16; ++r) acc[r] = 0.f;
#pragma unroll
        for (int ks = 0; ks < 8; ++ks) {
            const bf16x8 af = *(const LAS bf16x8*)(F.lds + SL_C + ((32 * nb + lr) * PITCH + 16 * ks + 8 * hf) * 2);
            const bf16x8 bf = *(const LAS bf16x8*)(F.lds + SL_X + buf * 17408 + ((32 * pb + lr) * PITCH + 16 * ks + 8 * hf) * 2);
            acc = mfma32(af, bf, acc);
        }
        bf16_t* dst = c == 0 ? (bf16_t*)(a.ws + WS_SMETA) + (size_t)h * 8192 : (bf16_t*)a.out + ((size_t)(b * 16 + (c - 1)) * HEADS + h) * 8192;
        u32x4* d4 = (u32x4*)(dst + ((size_t)(pb * 4 + nb) * 64 + F.lane) * 16);
        u32x4 w0, w1; w0.x = pk2(acc[0], acc[1]); w0.y = pk2(acc[2], acc[3]); w0.z = pk2(acc[4], acc[5]); w0.w = pk2(acc[6], acc[7]);
        w1.x = pk2(acc[8], acc[9]); w1.y = pk2(acc[10], acc[11]); w1.z = pk2(acc[12], acc[13]); w1.w = pk2(acc[14], acc[15]);
        d4[0] = w0; d4[1] = w1;
    }
}
__device__ __forceinline__ void short_conv_all(const Frame& F, const Args& a) {
    bf16_t* PROJ = (bf16_t*)(a.ws + WS_PROJ);
    const size_t gt = (size_t)F.vcu * NTHREADS + F.tid, NT = (size_t)F.G * NTHREADS;
    for (size_t it = gt; it < (size_t)TR * (D_SC / 8); it += NT) {
        const int r = (int)(it / (D_SC / 8)), c0 = (int)(it % (D_SC / 8)) * 8, b = r / SEQ, pos = r % SEQ + NMETA;
        float accv[8];
#pragma unroll
        for (int j = 0; j < 8; ++j) accv[j] = 0.f;
#pragma unroll
        for (int w = 0; w < 3; ++w) { const int rr = row_of(b, pos - 2 + w);
            const u32x4 cc = *(const u32x4*)(PROJ + SC_OFF + (size_t)rr * P_SC + c0), xx = *(const u32x4*)(PROJ + SC_OFF + (size_t)rr * P_SC + 512 + c0);
            const unsigned cw[4] = {cc.x, cc.y, cc.z, cc.w}, xw[4] = {xx.x, xx.y, xx.z, xx.w};
#pragma unroll
            for (int j = 0; j < 4; ++j) { accv[2 * j] += a.conv_sc_w[w * D_SC + c0 + 2 * j] * (bflo(cw[j]) * bflo(xw[j])); accv[2 * j + 1] += a.conv_sc_w[w * D_SC + c0 + 2 * j + 1] * (bfhi(cw[j]) * bfhi(xw[j])); } }
        const u32x4 bb = *(const u32x4*)(PROJ + ZS_OFF + (size_t)r * P_ZS + 1536 + c0); const unsigned bw[4] = {bb.x, bb.y, bb.z, bb.w};
        u32x4 o; unsigned ow[4];
#pragma unroll
        for (int j = 0; j < 4; ++j) ow[j] = pk2(bflo(bw[j]) * accv[2 * j], bfhi(bw[j]) * accv[2 * j + 1]);
        o.x = ow[0]; o.y = ow[1]; o.z = ow[2]; o.w = ow[3];
        *(u32x4*)(PROJ + ZS_OFF + (size_t)r * P_ZS + 1536 + c0) = o;
    }
}
__device__ __forceinline__ void p2_ssd_states(const Frame& F, const Args& a, bool dryrun) {
    if (!dryrun) short_conv_all(F, a);
    for (int u = F.vcu; u < 4 + BATCH * 15 * NG; u += F.G) {
        if (u < 4) ssd_s1_unit(F, a, 0, 0, u);
        else { const int v = u - 4; ssd_s1_unit(F, a, v / (15 * NG), 1 + (v / NG) % 15, v % NG); }
    }
}
__device__ __forceinline__ void p3_ssd_recur(const Frame& F, const Args& a) {
    const float* dat = (const float*)(a.ws + WS_DAT); const bf16_t* SM = (const bf16_t*)(a.ws + WS_SMETA); bf16_t* SF = (bf16_t*)a.out;
    for (int it = F.vcu; it < BATCH * HEADS * 1024 / NTHREADS; it += F.G) {
        const int idx = it * NTHREADS + F.tid, bh = idx >> 10, e8 = idx & 1023, b = bh / HEADS, h = bh % HEADS;
        u32x4 ld[15];
#pragma unroll
        for (int c = 1; c <= 15; ++c) ld[c - 1] = *(const u32x4*)(SF + ((size_t)(b * 16 + (c - 1)) * HEADS + h) * 8192 + e8 * 8);
        const u32x4 m = *(const u32x4*)(SM + (size_t)h * 8192 + e8 * 8);
        float cy[8] = {bflo(m.x), bfhi(m.x), bflo(m.y), bfhi(m.y), bflo(m.z), bfhi(m.z), bflo(m.w), bfhi(m.w)};
#pragma unroll
        for (int c = 1; c <= 16; ++c) {
            u32x4 o; o.x = pk2(cy[0], cy[1]); o.y = pk2(cy[2], cy[3]); o.z = pk2(cy[4], cy[5]); o.w = pk2(cy[6], cy[7]);
            *(u32x4*)(SF + ((size_t)(b * 16 + (c - 1)) * HEADS + h) * 8192 + e8 * 8) = o;
            if (c <= 15) { const float dA = dat[(size_t)(b * 17 + c) * HEADS + h]; const u32x4 t = ld[c - 1];
                cy[0] = cy[0] * dA + bflo(t.x); cy[1] = cy[1] * dA + bfhi(t.x); cy[2] = cy[2] * dA + bflo(t.y); cy[3] = cy[3] * dA + bfhi(t.y);
                cy[4] = cy[4] * dA + bflo(t.z); cy[5] = cy[5] * dA + bfhi(t.z); cy[6] = cy[6] * dA + bflo(t.w); cy[7] = cy[7] * dA + bfhi(t.w); }
        }
    }
}
template <bool DRY> __device__ __forceinline__ void ssd_s3_unit(const Frame& F, const Args& a, int b, int c, int g) {
    bf16_t* PROJ = (bf16_t*)(a.ws + WS_PROJ);
    const int p0 = NMETA + 128 * (c - 1), row0 = b * SEQ + 128 * (c - 1), lr = F.lane & 31, hf = F.lane >> 5;
    __syncthreads();
    ssd_dt_acs(F, a, PROJ, b, p0, g, nullptr);
#if PROBE_S3 == 1
    for (int rep = 0; rep < 2; ++rep)
#endif
    {   const int mat = F.tid >> 8, it = F.tid & 255, chg = it & 15, sr = it >> 4, ch = D_SSD + (mat ? 0 : 512) + g * 128 + 8 * chg;
        ConvW<8> ci; convw_load<8>(ci, PROJ + XG_OFF + g * XG_STRIDE + (mat ? 384 : 512) + 8 * chg, b, p0 + 8 * sr); ConvWt cw; convw_weights(cw, a, ch);
#pragma unroll
        for (int s = 0; s < 8; ++s) { float o[8]; convw_pos<8>(ci, cw, s, o);
            *(LAS u32x4*)(F.lds + (mat ? SL_B : SL_C) + ((8 * sr + s) * PITCH + 8 * chg) * 2) = (u32x4){pk2(o[0], o[1]), pk2(o[2], o[3]), pk2(o[4], o[5]), pk2(o[6], o[7])}; } }
    __syncthreads();
    constexpr unsigned SI_P = 0u | (0u << 2) | (1u << 4) | (0u << 6) | (1u << 8) | (2u << 10) | (0u << 12) | (1u << 14) | (2u << 16) | (3u << 18);
    constexpr unsigned LI_P = 0u | (1u << 2) | (1u << 4) | (2u << 6) | (2u << 8) | (2u << 10) | (3u << 12) | (3u << 14) | (3u << 16) | (3u << 18);
    const int nslot = F.wave < 2 ? 2 : 1;
    f32x16 cb[2];
#pragma unroll
    for (int sl = 0; sl < 2; ++sl) {
#pragma unroll
        for (int r = 0; r < 16; ++r) cb[sl][r] = 0.f;
        if (sl < nslot) { const int ti = F.wave + 8 * sl, si = (SI_P >> (2 * ti)) & 3, li = (LI_P >> (2 * ti)) & 3;
#pragma unroll
            for (int ks = 0; ks < 8; ++ks) {
                const bf16x8 af = *(const LAS bf16x8*)(F.lds + SL_B + ((32 * si + lr) * PITCH + 16 * ks + 8 * hf) * 2);
                const bf16x8 bf = *(const LAS bf16x8*)(F.lds + SL_C + ((32 * li + lr) * PITCH + 16 * ks + 8 * hf) * 2);
                cb[sl] = mfma32(af, bf, cb[sl]); } }
    }
    __syncthreads();
    const int pb = F.wave & 1, lio = F.wave >> 1;
    unsigned ypk[6][8];
#pragma unroll
    for (int i = 0; i < 6; ++i)
#pragma unroll
        for (int r = 0; r < 8; ++r) ypk[i][r] = 0u;
#if PROBE_S3 == 4
#pragma unroll 1
    for (int rep = 0; rep < 2; ++rep)
#endif
#pragma unroll 1
    for (int hh = 0; hh < 6; ++hh) {
        const int h = g * 6 + hh, buf = hh & 1, mofs = buf ? SL_B : SL_M0;
        const LAS float* dtL = (const LAS float*)(F.lds + SL_DT) + hh * 128; const LAS float* acL = (const LAS float*)(F.lds + SL_ACS) + hh * 128;
        const bf16_t* sp = (const bf16_t*)a.out + ((size_t)(b * 16 + (c - 1)) * HEADS + h) * 8192;
#if PROBE_S3 == 2
        for (int rep = 0; rep < 2; ++rep)
#endif
        {
            const int chg = F.tid & 7, spp = F.tid >> 3, ch = h * 64 + 8 * chg;
            ConvW<2> ci; convw_load<2>(ci, PROJ + XG_OFF + g * XG_STRIDE + hh * 64 + 8 * chg, b, p0 + 2 * spp); ConvWt cw; convw_weights(cw, a, ch);
            float o0[8], o1[8]; convw_pos<2>(ci, cw, 0, o0); convw_pos<2>(ci, cw, 1, o1);
#pragma unroll
            for (int cc = 0; cc < 8; ++cc) *(LAS unsigned*)(F.lds + SL_X + buf * 17408 + ((8 * chg + cc) * PITCH + 2 * spp) * 2) = pk2(o0[cc], o1[cc]);
        }
        u32x4 sf[4][2];
#pragma unroll
        for (int nb = 0; nb < 4; ++nb) { const u32x4* s4 = (const u32x4*)(sp + ((size_t)(pb * 4 + nb) * 64 + F.lane) * 16); sf[nb][0] = s4[0]; sf[nb][1] = s4[1]; }
#if PROBE_S3 == 3
        for (int rep = 0; rep < 2; ++rep)
#endif
        {
            const float Dh = a.d_skip[h];
#pragma unroll
            for (int sl = 0; sl < 2; ++sl) if (sl < nslot) { const int ti = F.wave + 8 * sl, si = (SI_P >> (2 * ti)) & 3, li = (LI_P >> (2 * ti)) & 3;
                const int l = 32 * li + lr; const float acl = acL[l];
#pragma unroll
                for (int q = 0; q < 4; ++q) { const int s0 = 32 * si + 8 * q + 4 * hf;
                    const f32x4 d4 = *(const LAS f32x4*)(dtL + s0), a4 = *(const LAS f32x4*)(acL + s0); float v[4];
#pragma unroll
                    for (int i = 0; i < 4; ++i) { const int s = s0 + i; float t = s <= l ? cb[sl][4 * q + i] * __expf(acl - a4[i]) * d4[i] : 0.f; if (s == l) t += Dh; v[i] = t; }
                    *(LAS u32x2*)(F.lds + mofs + (l * PITCH + s0) * 2) = (u32x2){pk2(v[0], v[1]), pk2(v[2], v[3])}; } }
        }
        f32x16 acc;
#pragma unroll
        for (int r = 0; r < 16; ++r) acc[r] = 0.f;
        {
#pragma unroll
            for (int nb = 0; nb < 4; ++nb) {
#pragma unroll
                for (int qp = 0; qp < 2; ++qp) { const LAS unsigned char* cp_ = F.lds + SL_C + ((32 * lio + lr) * PITCH + 32 * nb + 16 * qp + 4 * hf) * 2;
                    const u32x2 c0 = *(const LAS u32x2*)cp_, c1 = *(const LAS u32x2*)(cp_ + 16);
                    const u32x4 bfr = (u32x4){c0.x, c0.y, c1.x, c1.y};
                    acc = mfma32(__builtin_bit_cast(bf16x8, sf[nb][qp]), __builtin_bit_cast(bf16x8, bfr), acc); } }
            const float sc = __expf(acL[32 * lio + lr]);
#pragma unroll
            for (int r = 0; r < 16; ++r) acc[r] *= sc;
        }
        __syncthreads();
        for (int ks = 0; ks < 2 * (lio + 1); ++ks) {
            const bf16x8 af = *(const LAS bf16x8*)(F.lds + SL_X + buf * 17408 + ((32 * pb + lr) * PITCH + 16 * ks + 8 * hf) * 2);
            const bf16x8 bf = *(const LAS bf16x8*)(F.lds + mofs + ((32 * lio + lr) * PITCH + 16 * ks + 8 * hf) * 2);
            acc = mfma32(af, bf, acc);
        }
#pragma unroll
        for (int i = 0; i < 5; ++i)
#pragma unroll
            for (int r = 0; r < 8; ++r) ypk[i][r] = ypk[i + 1][r];
#pragma unroll
        for (int r = 0; r < 8; ++r) ypk[5][r] = pk2(acc[2 * r], acc[2 * r + 1]);
    }
    __syncthreads();
#pragma unroll
    for (int hh = 0; hh < 6; ++hh)
#pragma unroll
        for (int q = 0; q < 4; ++q) *(LAS u32x2*)(F.lds + SL_B + ((32 * lio + lr) * YPITCH + hh * 64 + 32 * pb + 8 * q + 4 * hf) * 2) = (u32x2){ypk[hh][2 * q], ypk[hh][2 * q + 1]};
    u32x2 zz2[4][6];
#pragma unroll
    for (int pass = 0; pass < 4; ++pass) { const int l = pass * 32 + F.wave * 4 + (F.lane >> 4), sub = F.lane & 15; const bf16_t* zr = PROJ + ZS_OFF + (size_t)(row0 + l) * P_ZS + g * 384;
#pragma unroll
        for (int k = 0; k < 6; ++k) zz2[pass][k] = *(const u32x2*)(zr + 4 * (sub + 16 * k)); }
    __syncthreads();
#pragma unroll
    for (int pass = 0; pass < 4; ++pass) {
        const int l = pass * 32 + F.wave * 4 + (F.lane >> 4), sub = F.lane & 15; bf16_t* zr = PROJ + ZS_OFF + (size_t)(row0 + l) * P_ZS + g * 384;
        float v[6][4]; float ss = 0.f;
#pragma unroll
        for (int k = 0; k < 6; ++k) { const int c0 = 4 * (sub + 16 * k); const u32x2 y2 = *(const LAS u32x2*)(F.lds + SL_B + (l * YPITCH + c0) * 2), z2 = zz2[pass][k];
            const float yy[4] = {bflo(y2.x), bfhi(y2.x), bflo(y2.y), bfhi(y2.y)}, zz[4] = {bflo(z2.x), bfhi(z2.x), bflo(z2.y), bfhi(z2.y)};
#pragma unroll
            for (int i = 0; i < 4; ++i) { v[k][i] = yy[i] * silu_f(zz[i]); ss += v[k][i] * v[k][i]; } }
        ss = row_sum16(ss);
        const float rstd = 1.0f / sqrtf(ss * (1.f / 384.f) + EPS);
#pragma unroll
        for (int k = 0; k < 6; ++k) { const int c0 = 4 * (sub + 16 * k); const f32x4 nw = *(const f32x4*)(a.ssd_norm_w + g * 384 + c0);
            bf16_t* zo = DRY ? (bf16_t*)(a.ws + WS_END) + ((size_t)F.vcu * 128 + l) * 384 : zr;
            *(u32x2*)(zo + c0) = (u32x2){pk2(v[k][0] * rstd * nw.x, v[k][1] * rstd * nw.y), pk2(v[k][2] * rstd * nw.z, v[k][3] * rstd * nw.w)}; }
    }
}
template <bool DRY> __device__ __forceinline__ void p4_ssd_out(const Frame& F, const Args& a) {
    for (int u = F.vcu; u < BATCH * 16 * NG; u += F.G) ssd_s3_unit<DRY>(F, a, u / (16 * NG), 1 + (u / NG) % 16, u % NG);
}

__device__ __forceinline__ void p5_norm2(const Frame& F, const Args& a) {
    const int gw = F.vcu * NWAVES + F.wave, NGW = F.G * NWAVES;
    {
        unsigned char* V8 = a.ws + WS_V8; float* SV = (float*)(a.ws + WS_SV);
        for (int r = gw; r < 2 * PK * PK; r += NGW) {
            const bool isv = r >= PK * PK; const int e = isv ? r - PK * PK : r;
            const f32x4* src = (const f32x4*)((isv ? a.expert_v : a.expert_u) + (size_t)e * D) + 4 * F.lane;
            f32x4 v[4];
#pragma unroll
            for (int j = 0; j < 4; ++j) v[j] = src[j];
            if (isv) {
                float amax = 0.f;
#pragma unroll
                for (int j = 0; j < 4; ++j) amax = fmaxf(amax, fmaxf(fmaxf(fabsf(v[j].x), fabsf(v[j].y)), fmaxf(fabsf(v[j].z), fabsf(v[j].w))));
#pragma unroll
                for (int o = 1; o < 64; o <<= 1) amax = fmaxf(amax, __shfl_xor(amax, o));
                const float sc = amax > 0.f ? amax * (1.0f / 440.0f) : 1.0f, inv = 1.0f / sc;
                u32x4 o4; unsigned ow[4];
#pragma unroll
                for (int j = 0; j < 4; ++j) { int p = 0; p = __builtin_amdgcn_cvt_pk_fp8_f32(v[j].x * inv, v[j].y * inv, p, false); p = __builtin_amdgcn_cvt_pk_fp8_f32(v[j].z * inv, v[j].w * inv, p, true); ow[j] = (unsigned)p; }
                o4.x = ow[0]; o4.y = ow[1]; o4.z = ow[2]; o4.w = ow[3];
                *(u32x4*)(V8 + ((size_t)(F.lane >> 3) * (PK * PK) + e) * 128 + 16 * (F.lane & 7)) = o4; if (F.lane == 0) SV[e] = sc;
            } else {
                const f32x4* gr = (const f32x4*)a.g_ffn + 4 * F.lane;
#pragma unroll
                for (int j = 0; j < 4; ++j) v[j] = v[j] * gr[j];
                u32x4* ub = (u32x4*)((bf16_t*)(a.ws + WS_UB) + (size_t)e * D) + 2 * F.lane;
                u32x4 b0, b1; b0.x = pk2(v[0].x, v[0].y); b0.y = pk2(v[0].z, v[0].w); b0.z = pk2(v[1].x, v[1].y); b0.w = pk2(v[1].z, v[1].w); b1.x = pk2(v[2].x, v[2].y); b1.y = pk2(v[2].z, v[2].w); b1.z = pk2(v[3].x, v[3].y); b1.w = pk2(v[3].z, v[3].w);
                ub[0] = b0; ub[1] = b1;
            }
        }
    }
    const bf16_t* H2b = (const bf16_t*)(a.ws + WS_XN); float* RSTD = (float*)(a.ws + WS_RSTD);
    for (int m = gw; m < TR; m += NGW) {
        const u32x4* xr = (const u32x4*)(H2b + (size_t)m * D) + 2 * F.lane; const u32x4 p = xr[0], q = xr[1]; const unsigned w[8] = {p.x, p.y, p.z, p.w, q.x, q.y, q.z, q.w};
        float s = 0.f;
#pragma unroll
        for (int j = 0; j < 8; ++j) { const float lo = bflo(w[j]), hi = bfhi(w[j]); s += lo * lo + hi * hi; }
        s = wave_sum(s);
        if (F.lane == 0) RSTD[m] = 1.0f / sqrtf(s * (1.f / D) + EPS);
    }
}

__device__ __forceinline__ unsigned ord_bits(float f) { const unsigned u = __builtin_bit_cast(unsigned, f); return u ^ ((u >> 31) ? 0xffffffffu : 0x80000000u); }
__device__ __forceinline__ float ord_val(unsigned o) { const unsigned u = (o & 0x80000000u) ? (o ^ 0x80000000u) : ~o; return __builtin_bit_cast(float, u); }
__device__ __forceinline__ void cex_desc(unsigned& x, unsigned& y) { const unsigned hi = x > y ? x : y, lo = x > y ? y : x; x = hi; y = lo; }
__device__ __forceinline__ void sort16_desc(unsigned (&v)[16]) {
#pragma unroll
    for (int k = 2; k <= 16; k <<= 1)
#pragma unroll
        for (int j = k >> 1; j > 0; j >>= 1)
#pragma unroll
            for (int i = 0; i < 16; ++i) { const int l = i ^ j; if (l > i) { if ((i & k) == 0) cex_desc(v[i], v[l]); else cex_desc(v[l], v[i]); } }
}
__device__ __forceinline__ void bitonic_merge16_desc(unsigned (&v)[16]) {
#pragma unroll
    for (int j = 8; j > 0; j >>= 1)
#pragma unroll
        for (int i = 0; i < 16; ++i) { const int l = i ^ j; if (l > i) cex_desc(v[i], v[l]); }
}
__device__ __forceinline__ void top16_merge(unsigned (&T)[16], const unsigned (&B)[16]) {
#pragma unroll
    for (int i = 0; i < 16; ++i) T[i] = T[i] > B[15 - i] ? T[i] : B[15 - i];
    bitonic_merge16_desc(T);
}
__device__ __forceinline__ void p8_topk_mfma(const Frame& F, const Args& a) {
    const bf16_t* Q = (const bf16_t*)(a.ws + WS_Q); int* EIDX = (int*)(a.ws + WS_EIDX); float* GATE = (float*)(a.ws + WS_GATE);
    const int lane = F.lane, lr = lane & 31, hf = lane >> 5;
    for (int task = F.vcu; task < PH * (TR / 1024); task += F.G) {
        const int h = task % PH, rng = task / PH;
        __syncthreads();
        {
            const f32x4* kp = (const f32x4*)(a.sub_keys + (size_t)h * 2 * PK * 128);
            for (int i = F.tid; i < 2 * PK * 128 / 4; i += NTHREADS) { const f32x4 v = kp[i]; const int row = i >> 5, c4 = (i & 31) * 4;
                *(LAS u32x2*)(F.lds + (row * PITCH + c4) * 2) = (u32x2){pk2(v.x, v.y), pk2(v.z, v.w)}; }
        }
        __syncthreads();
        for (int tile = F.wave; tile < 16; tile += NWAVES) {
            const int t0 = rng * 1024 + tile * 64;
            unsigned L0[16], L1[16];
#pragma unroll
            for (int i = 0; i < 16; ++i) { L0[i] = 0u; L1[i] = 0u; }
#pragma unroll 1
            for (int s = 0; s < 2; ++s) {
                unsigned TA[16], R[16];
#pragma unroll
                for (int i = 0; i < 16; ++i) { TA[i] = 0u; R[i] = 0u; }
#pragma unroll 1
                for (int th = 0; th < 2; ++th) {
                    bf16x8 qf[8];
                    const bf16_t* qp = Q + (size_t)(t0 + 32 * th + lr) * PQ + h * 256 + s * 128 + 8 * hf;
#pragma unroll
                    for (int ks = 0; ks < 8; ++ks) qf[ks] = *(const bf16x8*)(qp + 16 * ks);
                    unsigned T[16];
#pragma unroll
                    for (int i = 0; i < 16; ++i) T[i] = 0u;
#pragma unroll 1
                    for (int kb = 0; kb < 4; ++kb) {
                        f32x16 acc;
#pragma unroll
                        for (int r = 0; r < 16; ++r) acc[r] = 0.f;
#pragma unroll
                        for (int ks = 0; ks < 8; ++ks) { const bf16x8 af = *(const LAS bf16x8*)(F.lds + ((s * PK + 32 * kb + lr) * PITCH + 16 * ks + 8 * hf) * 2); acc = mfma32(af, qf[ks], acc); }
                        unsigned B[16];
#pragma unroll
                        for (int r = 0; r < 16; ++r) { const int k = 32 * kb + 8 * (r >> 2) + 4 * hf + (r & 3); B[r] = (ord_bits(acc[r]) & ~127u) | (unsigned)(127 - k); }
                        sort16_desc(B);
                        top16_merge(T, B);
                    }
                    unsigned P[16];
#pragma unroll
                    for (int i = 0; i < 16; ++i) { unsigned lo2, hi2; swap32_self(T[i], lo2, hi2); P[i] = hf ? lo2 : hi2; }
                    top16_merge(T, P);
#pragma unroll
                    for (int i = 0; i < 16; ++i) { R[i] = hf ? T[i] : TA[i]; TA[i] = T[i]; }
                }
#pragma unroll
                for (int i = 0; i < 16; ++i) { L0[i] = L1[i]; L1[i] = R[i]; }
            }
            const int t = t0 + lane;
            unsigned T[16];
            const float v00 = ord_val(L0[0] & ~127u);
#pragma unroll
            for (int j = 0; j < 16; ++j) T[j] = (ord_bits(v00 + ord_val(L1[j] & ~127u)) & ~255u) | (unsigned)(255 - j);
#pragma unroll
            for (int i = 1; i < 16; ++i)
#pragma unroll
                for (int j = 0; j < 16; ++j) if ((i + 1) * (j + 1) <= 16) {
                    const float sum = ord_val(L0[i] & ~127u) + ord_val(L1[j] & ~127u);
                    unsigned e = (ord_bits(sum) & ~255u) | (unsigned)(255 - (i * 16 + j));
#pragma unroll
                    for (int k = 0; k < 16; ++k) { const unsigned hi = T[k] > e ? T[k] : e; e = T[k] > e ? e : T[k]; T[k] = hi; }
                }
            float best[16]; int eid[16];
#pragma unroll
            for (int k = 0; k < 16; ++k) {
                best[k] = ord_val(T[k] & ~255u); const int pos = 255 - (int)(T[k] & 255u), pi = pos >> 4, pj = pos & 15;
                unsigned a0 = 0u, a1 = 0u;
#pragma unroll
                for (int i = 0; i < 16; ++i) { a0 = (pi == i) ? L0[i] : a0; a1 = (pj == i) ? L1[i] : a1; }
                eid[k] = (127 - (int)(a0 & 127u)) * PK + (127 - (int)(a1 & 127u));
            }
            const float rst = ((const float*)(a.ws + WS_RSTD))[t];
            float se = 0.f, ex[16];
#pragma unroll
            for (int k = 0; k < 16; ++k) { ex[k] = __expf((best[k] - best[0]) * rst); se += ex[k]; }
            const float inv = 1.f / se;
            int* ep = EIDX + (size_t)t * 128 + h * 16; float* gp = GATE + (size_t)t * 128 + h * 16;
#pragma unroll
            for (int k = 0; k < 16; k += 4) { *(int4*)(ep + k) = make_int4(eid[k], eid[k + 1], eid[k + 2], eid[k + 3]); *(f32x4*)(gp + k) = (f32x4){ex[k] * inv, ex[k + 1] * inv, ex[k + 2] * inv, ex[k + 3] * inv}; }
        }
    }
}

typedef __bf16 bf16x2_t __attribute__((ext_vector_type(2)));
__device__ __forceinline__ float dot2bf(unsigned w, unsigned x, float acc) { return __builtin_amdgcn_fdot2_f32_bf16(__builtin_bit_cast(bf16x2_t, w), __builtin_bit_cast(bf16x2_t, x), acc, false); }

__device__ __forceinline__ float shx32(float x, int lane) { unsigned a, b; swap32_self(__builtin_bit_cast(unsigned, x), a, b); return __builtin_bit_cast(float, (lane & 32) ? a : b); }
__device__ __forceinline__ float shx16(float x, int lane) { unsigned a, b; swap16_self(__builtin_bit_cast(unsigned, x), a, b); return __builtin_bit_cast(float, (lane & 16) ? a : b); }
template <int CTRL> __device__ __forceinline__ float dppf(float x) { return __builtin_bit_cast(float, __builtin_amdgcn_update_dpp(0, __builtin_bit_cast(int, x), CTRL, 0xF, 0xF, true)); }
__device__ __forceinline__ float shx8(float x) { return dppf<0x128>(x); }
__device__ __forceinline__ float shx4(float x, int) { return dppf<0x1B>(dppf<0x141>(x)); }

__device__ __forceinline__ float gelu_as(float v) {
    const float av = __builtin_fabsf(v), t = __builtin_amdgcn_rcpf(av * 0.2316418882f + 1.0f);
    float q = t * 0.5307027145f + (-0.7265760135f); q = q * t + 0.7107068705f; q = q * t + (-0.142248368f); q = q * t + 0.127414796f; q = q * t;
    const float e = __builtin_amdgcn_exp2f((v * v) * (-0.72134752044f));
    const float m = v * (q * e);
    return v < 0.f ? m : v - m;
}
__device__ __forceinline__ unsigned cvt_pk_bf16(float lo, float hi) { unsigned r; asm volatile("v_cvt_pk_bf16_f32 %0, %1, %2" : "=v"(r) : "v"(lo), "v"(hi)); return r; }
__device__ __forceinline__ int rdlane(int v, int l) { return __builtin_amdgcn_readlane(v, l); }
__device__ __forceinline__ float rdlanef(float v, int l) { return __builtin_bit_cast(float, __builtin_amdgcn_readlane(__builtin_bit_cast(int, v), l)); }

struct PeerBatch { int l0, l1, l2, l3; u32x4 r[4][2]; };
__device__ __forceinline__ void peerA_take(unsigned long long& m, PeerBatch& B, const bf16_t* Ub, int lane, int ev) {
    B.l0 = __builtin_ctzll(m); m &= m - 1; B.l1 = B.l0; B.l2 = B.l0; B.l3 = B.l0;
    if (m) { B.l1 = __builtin_ctzll(m); m &= m - 1; if (m) { B.l2 = __builtin_ctzll(m); m &= m - 1; if (m) { B.l3 = __builtin_ctzll(m); m &= m - 1; } } }
    const int e0 = rdlane(ev, B.l0), e1 = rdlane(ev, B.l1), e2 = rdlane(ev, B.l2), e3 = rdlane(ev, B.l3);
    const u32x4* r0 = (const u32x4*)(Ub + (size_t)e0 * D) + 2 * lane; const u32x4* r1 = (const u32x4*)(Ub + (size_t)e1 * D) + 2 * lane;
    const u32x4* r2 = (const u32x4*)(Ub + (size_t)e2 * D) + 2 * lane; const u32x4* r3 = (const u32x4*)(Ub + (size_t)e3 * D) + 2 * lane;
    B.r[0][0] = r0[0]; B.r[0][1] = r0[1]; B.r[1][0] = r1[0]; B.r[1][1] = r1[1]; B.r[2][0] = r2[0]; B.r[2][1] = r2[1]; B.r[3][0] = r3[0]; B.r[3][1] = r3[1];
}
__device__ __forceinline__ void peerA_finish(const PeerBatch& B, int lane, int& agv, const unsigned (&xp)[8], float rs) {
#define DOT16(lo, hi) (dot2bf((hi).w, xp[7], dot2bf((hi).z, xp[6], dot2bf((hi).y, xp[5], dot2bf((hi).x, xp[4], 0.f)))) + dot2bf((lo).w, xp[3], dot2bf((lo).z, xp[2], dot2bf((lo).y, xp[1], dot2bf((lo).x, xp[0], 0.f)))))
    const float p0 = DOT16(B.r[0][0], B.r[0][1]), p1 = DOT16(B.r[1][0], B.r[1][1]), p2 = DOT16(B.r[2][0], B.r[2][1]), p3 = DOT16(B.r[3][0], B.r[3][1]);
#undef DOT16
    const bool hi5 = lane & 32, hi4 = lane & 16;
    const float k0 = hi5 ? p2 : p0, s0 = hi5 ? p0 : p2, k1 = hi5 ? p3 : p1, s1 = hi5 ? p1 : p3;
    const float t0 = k0 + shx32(s0, lane), t1 = k1 + shx32(s1, lane);
    const float k2 = hi4 ? t1 : t0, s2 = hi4 ? t0 : t1;
    const float d = row_sum16(k2 + shx16(s2, lane));
    const float agf = __builtin_bit_cast(float, agv);
    const float g0 = rdlanef(agf, B.l0), g1 = rdlanef(agf, B.l1), g2 = rdlanef(agf, B.l2), g3 = rdlanef(agf, B.l3);
    const float gq = hi5 ? (hi4 ? g3 : g2) : (hi4 ? g1 : g0);
    const int ai = __builtin_bit_cast(int, gelu_as(d * rs) * gq);
    const int w0 = rdlane(ai, 0), w1 = rdlane(ai, 16), w2 = rdlane(ai, 32), w3 = rdlane(ai, 48);
    agv = lane == B.l0 ? w0 : agv; agv = lane == B.l1 ? w1 : agv; agv = lane == B.l2 ? w2 : agv; agv = lane == B.l3 ? w3 : agv;
}
struct PeerGather8 { u32x4 vv[16]; float aw[16]; };
__device__ __forceinline__ void peerB8_gather(PeerGather8& G, const unsigned char* V8, int lane, int cs, const LAS int* ELt, const LAS float* ALt) {
    const int rg = lane >> 3, cl = lane & 7;
#pragma unroll
    for (int j = 0; j < 16; ++j) { const int e = ELt[8 * j + rg]; G.aw[j] = ALt[8 * j + rg];
        G.vv[j] = *(const u32x4*)(V8 + (((unsigned)(cs * PK * PK) + (unsigned)e) * 128u + (unsigned)(cl * 16))); }
}
__device__ __forceinline__ f32x2 peerB8_reduce(const PeerGather8& G, int lane) {
    f32x2 acc[8];
#pragma unroll
    for (int c = 0; c < 8; ++c) acc[c] = (f32x2){0.f, 0.f};
#pragma unroll
    for (int j = 0; j < 16; ++j) { const unsigned ww[4] = {G.vv[j].x, G.vv[j].y, G.vv[j].z, G.vv[j].w}; const f32x2 a2 = (f32x2){G.aw[j], G.aw[j]};
#pragma unroll
        for (int m = 0; m < 4; ++m) { acc[2 * m] += __builtin_amdgcn_cvt_pk_f32_fp8(ww[m], false) * a2; acc[2 * m + 1] += __builtin_amdgcn_cvt_pk_f32_fp8(ww[m], true) * a2; } }
    const bool b5 = lane & 32, b4 = lane & 16, b3 = lane & 8;
    f32x2 v4[4], v2[2];
#pragma unroll
    for (int c = 0; c < 4; ++c) { const f32x2 keep = b5 ? acc[c + 4] : acc[c], send = b5 ? acc[c] : acc[c + 4]; v4[c] = keep + (f32x2){shx32(send.x, lane), shx32(send.y, lane)}; }
#pragma unroll
    for (int c = 0; c < 2; ++c) { const f32x2 keep = b4 ? v4[c + 2] : v4[c], send = b4 ? v4[c] : v4[c + 2]; v2[c] = keep + (f32x2){shx16(send.x, lane), shx16(send.y, lane)}; }
    const f32x2 keep = b3 ? v2[1] : v2[0], send = b3 ? v2[0] : v2[1];
    return keep + (f32x2){shx8(send.x), shx8(send.y)};
}
#ifndef HSHIFT
#define HSHIFT 11
#endif
__device__ __forceinline__ void peerA_token2(const bf16_t* Ub, int lane, int s, int e0lo, int e0hi, int& a0lo, int& a0hi, const unsigned (&xp0)[8], float rs0,
                                             int e1lo, int e1hi, int& a1lo, int& a1hi, const unsigned (&xp1)[8], float rs1) {
    unsigned long long m0 = __ballot((e0lo >> HSHIFT) == s), m1 = __ballot((e0hi >> HSHIFT) == s), m2 = __ballot((e1lo >> HSHIFT) == s), m3 = __ballot((e1hi >> HSHIFT) == s);
    while (m0 | m1 | m2 | m3) {
        const bool h0 = m0 != 0ull, h1 = m1 != 0ull, h2 = m2 != 0ull, h3 = m3 != 0ull;
        PeerBatch B0, B1, B2, B3;
        if (h0) peerA_take(m0, B0, Ub, lane, e0lo);
        if (h1) peerA_take(m1, B1, Ub, lane, e0hi);
        if (h2) peerA_take(m2, B2, Ub, lane, e1lo);
        if (h3) peerA_take(m3, B3, Ub, lane, e1hi);
        if (h0) peerA_finish(B0, lane, a0lo, xp0, rs0);
        if (h1) peerA_finish(B1, lane, a0hi, xp0, rs0);
        if (h2) peerA_finish(B2, lane, a1lo, xp1, rs1);
        if (h3) peerA_finish(B3, lane, a1hi, xp1, rs1);
    }
}
__device__ __forceinline__ void p9_peer_hybrid(const Frame& F, const Args& a, float* dst) {
    const int* EIDX = (const int*)(a.ws + WS_EIDX); const float* GATE = (const float*)(a.ws + WS_GATE); const float* RSTD = (const float*)(a.ws + WS_RSTD);
    const bf16_t* Ub = (const bf16_t*)(a.ws + WS_UB); const unsigned char* V8 = a.ws + WS_V8; const float* SV = (const float*)(a.ws + WS_SV);
    bf16_t* H2b = (bf16_t*)(a.ws + WS_XN);
    const int gw = F.vcu * NWAVES + F.wave, lane = F.lane, tokb = gw * 16;
    LAS int* EL = (LAS int*)(F.lds + F.wave * 16384); LAS float* AL = (LAS float*)(F.lds + F.wave * 16384 + 8192);
#pragma unroll 4
    for (int ti = 0; ti < 16; ++ti) { const size_t o = (size_t)(tokb + ti) * 128;
        EL[ti * 128 + lane] = EIDX[o + lane]; EL[ti * 128 + 64 + lane] = EIDX[o + 64 + lane]; AL[ti * 128 + lane] = GATE[o + lane]; AL[ti * 128 + 64 + lane] = GATE[o + 64 + lane]; }
    const float myrs = RSTD[tokb + (lane & 15)];
#pragma unroll 1
    for (int s = 0; s < (16384 >> HSHIFT); ++s) {
#pragma unroll 1
        for (int i = 0; i < 16; i += 2) { const int o = i * 128;
            const u32x4* x0 = (const u32x4*)(H2b + (size_t)(tokb + i) * D) + 2 * lane; const u32x4* x1 = x0 + D / 8;
            const u32x4 xa = x0[0], xb = x0[1], xc = x1[0], xd = x1[1];
            const unsigned xp0[8] = {xa.x, xa.y, xa.z, xa.w, xb.x, xb.y, xb.z, xb.w}, xp1[8] = {xc.x, xc.y, xc.z, xc.w, xd.x, xd.y, xd.z, xd.w};
            const float rs0 = rdlanef(myrs, i), rs1 = rdlanef(myrs, i + 1);
            const int e0lo = EL[o + lane], e0hi = EL[o + 64 + lane], e1lo = EL[o + 128 + lane], e1hi = EL[o + 192 + lane];
            int a0lo = __builtin_bit_cast(int, AL[o + lane]), a0hi = __builtin_bit_cast(int, AL[o + 64 + lane]), a1lo = __builtin_bit_cast(int, AL[o + 128 + lane]), a1hi = __builtin_bit_cast(int, AL[o + 192 + lane]);
            peerA_token2(Ub, lane, s, e0lo, e0hi, a0lo, a0hi, xp0, rs0, e1lo, e1hi, a1lo, a1hi, xp1, rs1);
            AL[o + lane] = __builtin_bit_cast(float, a0lo); AL[o + 64 + lane] = __builtin_bit_cast(float, a0hi); AL[o + 128 + lane] = __builtin_bit_cast(float, a1lo); AL[o + 192 + lane] = __builtin_bit_cast(float, a1hi); }
    }
#pragma unroll 4
    for (int ti = 0; ti < 16; ++ti) { AL[ti * 128 + lane] *= SV[EL[ti * 128 + lane]]; AL[ti * 128 + 64 + lane] *= SV[EL[ti * 128 + 64 + lane]]; }
    const int col = 16 * (lane & 7) + ((lane >> 5) & 1) * 8 + ((lane >> 4) & 1) * 4 + ((lane >> 3) & 1) * 2;
#pragma unroll 1
    for (int cs = 0; cs < 8; ++cs) {
        PeerGather8 G0, G1;
        peerB8_gather(G0, V8, lane, cs, EL, AL);
#pragma unroll 1
        for (int ti = 0; ti < 16; ti += 2) {
            unsigned* hp0 = (unsigned*)(H2b + (size_t)(tokb + ti) * D + cs * 128 + col); unsigned* hp1 = hp0 + D / 2; const unsigned h0 = *hp0, h1 = *hp1;
            peerB8_gather(G1, V8, lane, cs, EL + (ti + 1) * 128, AL + (ti + 1) * 128);
            { const f32x2 r = peerB8_reduce(G0, lane); *hp0 = pk2(bflo(h0) + r.x, bfhi(h0) + r.y); }
            if (ti + 2 < 16) peerB8_gather(G0, V8, lane, cs, EL + (ti + 2) * 128, AL + (ti + 2) * 128);
            { const f32x2 r = peerB8_reduce(G1, lane); *hp1 = pk2(bflo(h1) + r.x, bfhi(h1) + r.y); }
        }
    }
    asm volatile("s_waitcnt vmcnt(0)" ::: "memory");
    __builtin_amdgcn_fence(__ATOMIC_RELEASE, "workgroup"); __builtin_amdgcn_fence(__ATOMIC_ACQUIRE, "workgroup");
#pragma unroll 2
    for (int ti = 0; ti < 16; ++ti) {
        const u32x4* hr = (const u32x4*)(H2b + (size_t)(tokb + ti) * D) + 2 * lane; f32x4* orow = (f32x4*)(dst + (size_t)(tokb + ti) * D) + 4 * lane; const f32x4* gf = (const f32x4*)a.g_final + 4 * lane;
        const u32x4 p = hr[0], q = hr[1]; const unsigned w[8] = {p.x, p.y, p.z, p.w, q.x, q.y, q.z, q.w};
        float hv[16]; float s2 = 0.f;
#pragma unroll
        for (int j = 0; j < 8; ++j) { hv[2 * j] = bflo(w[j]); hv[2 * j + 1] = bfhi(w[j]); s2 += hv[2 * j] * hv[2 * j] + hv[2 * j + 1] * hv[2 * j + 1]; }
        const float rstd2 = 1.0f / sqrtf(wave_sum(s2) * (1.f / D) + EPS);
#pragma unroll
        for (int j = 0; j < 4; ++j) { const f32x4 g4 = gf[j]; orow[j] = (f32x4){hv[4 * j] * rstd2 * g4.x, hv[4 * j + 1] * rstd2 * g4.y, hv[4 * j + 2] * rstd2 * g4.z, hv[4 * j + 3] * rstd2 * g4.w}; }
    }
}

__global__ void __launch_bounds__(NTHREADS, 2) fwd(Args a) {
    extern __shared__ __attribute__((aligned(16))) unsigned char lds[];
    Frame F; F.lds = (LAS unsigned char*)lds; F.tid = threadIdx.x; F.lane = F.tid & 63; F.wave = __builtin_amdgcn_readfirstlane(F.tid >> 6);
    F.G = gridDim.x; { const int bx = blockIdx.x; F.vcu = (F.G % 8 == 0) ? (bx % 8) * (F.G / 8) + bx / 8 : bx; }
    volatile LAS unsigned* MISC = (volatile LAS unsigned*)(F.lds + LDSCTL_OFF);
    for (int u = F.tid; u < (LDS_BYTES - LDSCTL_OFF) / 4; u += NTHREADS) ((LAS unsigned*)(F.lds + LDSCTL_OFF))[u] = 0u;
    __syncthreads();
    XcdBarrier bar; bar.bar = (unsigned*)(a.ws + WS_CTL) + CW_BAR; bar.x = 0; bar.st = nullptr;
    if (N_LAUNCHES == 1) bar = xcd_barrier_post((unsigned*)(a.ws + WS_CTL) + CW_BAR, MISC + 8);
    const int lo = a.ph_lo, hi = a.ph_hi;
#ifndef PHASE_MASK
#define PHASE_MASK 0xFFFF
#endif
#define IN(k) (((PHASE_MASK >> (k)) & 1) && lo <= (k) && (k) < hi)
#if USE_PG8
#define GEMM_CALL(EPI) pg8::gemm_phase<EPI, pg8::StaticOrder, true, true>(F.lds, g, S, E)
#else
#define GEMM_CALL(EPI) pg8::gemm_simple(g, S, E)
#endif
#define SEAM(k) do { if (IN(k) && IN((k) + 1)) xcd_barrier(bar); } while (0)
    bf16_t* PROJ = (bf16_t*)(a.ws + WS_PROJ);
#ifndef PROBE_REP
#define PROBE_REP 0
#endif
#define REPK(k) ((PROBE_REP >> (k)) & 1)
#define GEMM_P1 { pg8::Gemm g{(const bf16_t*)(a.ws + WS_XN), (const bf16_t*)(a.ws + WS_WIN), ROWS_A, LDP, D, D, D}; pg8::StaticOrder S; S.init(ROWS_A, LDP, F.G, (int)blockIdx.x); pg8::EpiPanels E{PROJ}; GEMM_CALL(pg8::EpiPanels); }
#define GEMM_P5 { pg8::Gemm g{PROJ + ZS_OFF, (const bf16_t*)(a.ws + WS_WOUT), TR, D, D_MIX, P_ZS, D_MIX}; pg8::StaticOrder S; S.init(TR, D, F.G, (int)blockIdx.x); pg8::EpiResBf16 E{a.x, (bf16_t*)(a.ws + WS_XN), D}; GEMM_CALL(pg8::EpiResBf16); }
#define GEMM_P7 { pg8::Gemm g{(const bf16_t*)(a.ws + WS_XN), (const bf16_t*)(a.ws + WS_WQ), TR, PQ, D, D, D}; pg8::StaticOrder S; S.init(TR, PQ, F.G, (int)blockIdx.x); pg8::EpiBf16 E{(bf16_t*)(a.ws + WS_Q), PQ}; GEMM_CALL(pg8::EpiBf16); }
    if (IN(0)) { if (REPK(0)) p0_prologue(F, a); p0_prologue(F, a); } SEAM(0);
    if (IN(1)) { if (REPK(1)) GEMM_P1 GEMM_P1 } SEAM(1);
    if (IN(2)) { if (REPK(2)) p2_ssd_states(F, a, true); p2_ssd_states(F, a, false); } SEAM(2);
    if (IN(3)) { p3_ssd_recur(F, a); } SEAM(3);
    if (IN(4)) { if (REPK(4)) p4_ssd_out<true>(F, a); p4_ssd_out<false>(F, a); } SEAM(4);
    if (IN(5)) { if (REPK(5)) GEMM_P5 GEMM_P5 } SEAM(5);
    if (IN(6)) { if (REPK(6)) p5_norm2(F, a); p5_norm2(F, a); } SEAM(6);
    if (IN(7)) { if (REPK(7)) GEMM_P7 GEMM_P7 } SEAM(7);
    if (IN(8)) { if (REPK(8)) p8_topk_mfma(F, a); p8_topk_mfma(F, a); } SEAM(8);
    if (IN(9)) { p9_peer_hybrid(F, a, a.out); }
#undef IN
#undef SEAM
}

extern "C" void kernel_launch(void* const* d_in, const int* in_sizes, int n_in, void* d_out, int out_size, void* d_ws, size_t ws_size, hipStream_t stream) {
    static int grid = 0;
    if (grid == 0) {
        if (n_in != 18 || out_size != TR * D || ws_size < WS_END) { fprintf(stderr, "kernel_launch: unexpected problem (n_in %d out %d ws %zu)\n", n_in, out_size, ws_size); grid = -1; return; }
        int dev = 0, cus = 0, per_cu = 0;
        if (hipGetDevice(&dev) != hipSuccess || hipDeviceGetAttribute(&cus, hipDeviceAttributeMultiprocessorCount, dev) != hipSuccess) { grid = -1; return; }
        if (hipFuncSetAttribute((const void*)fwd, hipFuncAttributeMaxDynamicSharedMemorySize, LDS_BYTES) != hipSuccess) { fprintf(stderr, "kernel_launch: hipFuncSetAttribute failed\n"); grid = -1; return; }
        if (hipOccupancyMaxActiveBlocksPerMultiprocessor(&per_cu, (const void*)fwd, NTHREADS, LDS_BYTES) != hipSuccess || per_cu < 1) fprintf(stderr, "kernel_launch: occupancy query says %d\n", per_cu);
        (void)hipGetLastError();
        grid = cus;
    }
    if (grid < 0) return;
    if (hipMemsetAsync((char*)d_ws + WS_CTL, 0, CTL_ZERO_BYTES, stream) != hipSuccess) return;
    Args a{};
    a.x = (const float*)d_in[0]; a.meta = (const float*)d_in[1]; a.g_mix = (const float*)d_in[2]; a.w_in = (const float*)d_in[3]; a.conv_ssd_w = (const float*)d_in[4]; a.conv_ssd_b = (const float*)d_in[5];
    a.dt_bias = (const float*)d_in[6]; a.a_log = (const float*)d_in[7]; a.d_skip = (const float*)d_in[8]; a.ssd_norm_w = (const float*)d_in[9]; a.conv_sc_w = (const float*)d_in[10]; a.w_out = (const float*)d_in[11];
    a.g_ffn = (const float*)d_in[12]; a.w_q = (const float*)d_in[13]; a.sub_keys = (const float*)d_in[14]; a.expert_u = (const float*)d_in[15]; a.expert_v = (const float*)d_in[16]; a.g_final = (const float*)d_in[17];
    a.out = (float*)d_out; a.ws = (unsigned char*)d_ws;
    if (N_LAUNCHES == 1) { a.ph_lo = 0; a.ph_hi = NPHASE; hipLaunchKernelGGL(fwd, dim3(grid), dim3(NTHREADS), LDS_BYTES, stream, a); }
    else for (int p = 0; p < NPHASE; ++p) { a.ph_lo = p; a.ph_hi = p + 1; hipLaunchKernelGGL(fwd, dim3(grid), dim3(NTHREADS), LDS_BYTES, stream, a); }
}
```

```cpp
#include <hip/hip_runtime.h>
#include <cstdio>
#include <cstdint>

#define GAS __attribute__((address_space(1)))
#define LAS __attribute__((address_space(3)))
typedef unsigned short bf16_t;
typedef short bf16x8 __attribute__((ext_vector_type(8)));
typedef float f32x4 __attribute__((ext_vector_type(4)));
typedef float f32x2 __attribute__((ext_vector_type(2)));
typedef unsigned u32x4 __attribute__((ext_vector_type(4)));
typedef unsigned u32x2 __attribute__((ext_vector_type(2)));

constexpr int D = 1024, BATCH = 16, SEQ = 2048, NMETA = 16, LSEQ = SEQ + NMETA;
constexpr int TR = BATCH * SEQ;
constexpr int ROWS_A = 33024;
constexpr int D_SSD = 1536, HEADS = 24, HD = 64, NG = 4, NS = 128, D_XBC = 2560, D_SC = 512, D_IN = 5656, D_MIX = 2048;
constexpr int LDP = 5888;
constexpr int C_Z = 0, C_SCB = 1536, C_XBC = 2048, C_SCC = 4608, C_SCX = 5120, C_DT = 5632;
constexpr int P_ZS = 2048, P_XG = 640, P_SC = 1024, P_DT = 32;
constexpr size_t ZS_OFF = 0, XG_OFF = (size_t)ROWS_A * P_ZS, XG_STRIDE = (size_t)ROWS_A * P_XG, SC_OFF = XG_OFF + 4 * XG_STRIDE, DT_OFF = SC_OFF + (size_t)ROWS_A * P_SC, PANELS_END = DT_OFF + (size_t)ROWS_A * P_DT;
static_assert(PANELS_END <= (size_t)ROWS_A * LDP, "panels fit the PROJ region");
__host__ __device__ __forceinline__ size_t proj_dst(int j, int& pitch) {
    if (j < 2048) { pitch = P_ZS; return ZS_OFF + j; }
    if (j < 4608) { const int ch = j - 2048; pitch = P_XG;
        if (ch < 1536) { const int g = ch / 384; return XG_OFF + g * XG_STRIDE + (ch - 384 * g); }
        if (ch < 2048) { const int r = ch - 1536; return XG_OFF + (r >> 7) * XG_STRIDE + 384 + (r & 127); }
        const int r = ch - 2048; return XG_OFF + (r >> 7) * XG_STRIDE + 512 + (r & 127); }
    if (j < 5632) { pitch = P_SC; return SC_OFF + (j - 4608); }
    if (j < 5664) { pitch = P_DT; return DT_OFF + (j - 5632); }
    pitch = 0; return 0;
}
constexpr int PH = 8, PK = 128, PTOP = 16, PQ = 2048;
constexpr float EPS = 1e-6f;

__host__ __device__ constexpr int proj_src_col(int j) {
    return j < 1536 ? j : j < 2048 ? 4120 + (j - 1536) : j < 4608 ? 1536 + (j - 2048) : j < 5120 ? 4632 + (j - 4608) : j < 5632 ? 5144 + (j - 5120) : j < 5656 ? 4096 + (j - 5632) : -1;
}

constexpr size_t MiB = 1u << 20;
constexpr size_t WS_CTL = 0, CTL_ZERO_BYTES = 1 * MiB;
constexpr size_t WS_WIN = 1 * MiB;
constexpr size_t WS_WOUT = 13 * MiB;
constexpr size_t WS_WQ = 17 * MiB;
constexpr size_t WS_XN = 22 * MiB;
constexpr size_t WS_PROJ = 88 * MiB;
constexpr size_t WS_Q = WS_PROJ;
constexpr size_t WS_EIDX = WS_PROJ + 128 * MiB;
constexpr size_t WS_GATE = WS_PROJ + 144 * MiB;
constexpr size_t WS_UB = WS_PROJ + 160 * MiB;
constexpr size_t WS_V8 = WS_PROJ + 192 * MiB;
constexpr size_t WS_SV = WS_PROJ + 224 * MiB + 65536;
constexpr size_t WS_RSTD = WS_PROJ + 225 * MiB;
constexpr size_t WS_END = WS_PROJ + (size_t)ROWS_A * LDP * 2;
static_assert(WS_RSTD + (1u << 20) <= WS_END, "ws map");
static_assert(WS_XN + (size_t)ROWS_A * D * 2 <= WS_PROJ, "ws map");
static_assert(WS_END <= 512 * MiB, "ws map");

typedef __bf16 bf16x2h_t __attribute__((ext_vector_type(2)));
__device__ __forceinline__ unsigned f2bf(float f) { return (unsigned)__builtin_bit_cast(unsigned short, (__bf16)f); }
__device__ __forceinline__ unsigned pk2(float lo, float hi) { bf16x2h_t v; v.x = (__bf16)lo; v.y = (__bf16)hi; return __builtin_bit_cast(unsigned, v); }
__device__ __forceinline__ float bf2f(unsigned short b) { return __builtin_bit_cast(float, ((unsigned)b) << 16); }
__device__ __forceinline__ float bflo(unsigned w) { return __builtin_bit_cast(float, w << 16); }
__device__ __forceinline__ float bfhi(unsigned w) { return __builtin_bit_cast(float, w & 0xffff0000u); }
template <int CTRL> __device__ __forceinline__ float dppf0(float x) { return __builtin_bit_cast(float, __builtin_amdgcn_update_dpp(0, __builtin_bit_cast(int, x), CTRL, 0xF, 0xF, true)); }
__device__ __forceinline__ void swap32_self(unsigned u, unsigned& lo_lo, unsigned& hi_hi) { unsigned u2 = u; asm volatile("" : "+v"(u2)); auto r = __builtin_amdgcn_permlane32_swap(u, u2, false, false); lo_lo = r[0]; hi_hi = r[1]; }
__device__ __forceinline__ void swap16_self(unsigned u, unsigned& even2, unsigned& odd2) { unsigned u2 = u; asm volatile("" : "+v"(u2)); auto r = __builtin_amdgcn_permlane16_swap(u, u2, false, false); even2 = r[0]; odd2 = r[1]; }
__device__ __forceinline__ float wave_sum(float v) {
    v += dppf0<0xB1>(v); v += dppf0<0x4E>(v); v += dppf0<0x141>(v); v += dppf0<0x140>(v);
    unsigned p, q; swap16_self(__builtin_bit_cast(unsigned, v), p, q); v = __builtin_bit_cast(float, p) + __builtin_bit_cast(float, q);
    swap32_self(__builtin_bit_cast(unsigned, v), p, q); v = __builtin_bit_cast(float, p) + __builtin_bit_cast(float, q);
    return v;
}
__device__ __forceinline__ float row_sum16(float x) { x += dppf0<0xB1>(x); x += dppf0<0x4E>(x); x += dppf0<0x141>(x); x += dppf0<0x140>(x); return x; }
__device__ __forceinline__ int row_of(int b, int pos) { return pos < NMETA ? TR + pos : b * SEQ + (pos - NMETA); }

namespace pg8 {
#define PG8_LAS __attribute__((address_space(3)))
constexpr int BM = 256, BK = 64, HALF = 128, HTB = HALF * BK * 2  , STAGE_BYTES = 8 * HTB, NXCD = 8, WGM = 8;
__host__ __device__ __forceinline__ int perm32(int rho) { const int n = rho >> 4, i = rho & 15; return 8 * (i >> 2) + 4 * n + (i & 3); }
__host__ __device__ __forceinline__ int lds_byte(int r, int c) { const int st = (r >> 4) * 2 + (c >> 5), rr = r & 15, cc = c & 31, ob = rr * 64 + cc * 2; return st * 1024 + (ob ^ (((ob >> 9) & 1) << 5)); }
__host__ __device__ __forceinline__ void stage_rc(int b, int& R, int& C) { const int st = b / 1024, sb = b % 1024, swz = sb ^ (((sb >> 9) & 1) << 5); R = (st >> 1) * 16 + swz / 64; C = (st & 1) * 32 + (swz % 64) / 2; }
struct Unit { int pm, pn; };
struct Gemm { const bf16_t* A; const bf16_t* Bt; int M, N, K, lda, ldb; };
struct StaticOrder {
    int nM, nN, nwg, G, c;
    __host__ __device__ void init(int M, int N, int G_, int c_) { nM = M / BM; nN = N / BM; nwg = nM * nN; G = G_; c = c_; }
    __host__ __device__ bool next(int i, Unit& u) const {
        const long L = (long)i * G + c; if (L >= nwg) return false;
        int wgid = (int)L; { const int q = nwg / NXCD, r = nwg % NXCD, xcd = wgid % NXCD, off = wgid / NXCD; wgid = (xcd < r ? xcd * (q + 1) : r * (q + 1) + (xcd - r) * q) + off; }
        const int nig = WGM * nN, gid = wgid / nig, fm = gid * WGM, gsz = (nM - fm) < WGM ? (nM - fm) : WGM;
        u.pm = fm + ((wgid % nig) % gsz); u.pn = (wgid % nig) / gsz; return true;
    }
    __device__ __forceinline__ void a_ready(const Unit&) const {}
    __device__ __forceinline__ void done(const Unit&) const {}
};
struct EpiBf16 {
    static constexpr bool PERM = true, AFTER_DRAIN = false;
    bf16_t* O; int ldc;
    __device__ __forceinline__ void operator()(const f32x4 (&acc)[2][2][4][2], const Unit& u, int wr, int wc, int fr, int fq) const {
        const int row0 = u.pm * BM + wr * 64 + fr, col0 = u.pn * BM + wc * 32 + 8 * fq;
#pragma unroll
        for (int ai = 0; ai < 2; ++ai)
#pragma unroll
            for (int m = 0; m < 4; ++m) { bf16_t* rowp = O + (size_t)(row0 + ai * HALF + m * 16) * ldc + col0;
#pragma unroll
                for (int bj = 0; bj < 2; ++bj) { const f32x4 v0 = acc[ai][bj][m][0], v1 = acc[ai][bj][m][1];
                    u32x4 w; w.x = pk2(v0[0], v0[1]); w.y = pk2(v0[2], v0[3]); w.z = pk2(v1[0], v1[1]); w.w = pk2(v1[2], v1[3]);
                    *(u32x4*)(rowp + bj * HALF) = w; } }
    }
};
struct EpiPanels {
    static constexpr bool PERM = true, AFTER_DRAIN = false;
    bf16_t* P;
    __device__ __forceinline__ void operator()(const f32x4 (&acc)[2][2][4][2], const Unit& u, int wr, int wc, int fr, int fq) const {
        const int row0 = u.pm * BM + wr * 64 + fr, col0 = u.pn * BM + wc * 32 + 8 * fq;
#pragma unroll
        for (int bj = 0; bj < 2; ++bj) { int pitch; const size_t off = proj_dst(col0 + bj * HALF, pitch); if (pitch == 0) continue;
#pragma unroll
            for (int ai = 0; ai < 2; ++ai)
#pragma unroll
                for (int m = 0; m < 4; ++m) { const f32x4 v0 = acc[ai][bj][m][0], v1 = acc[ai][bj][m][1];
                    u32x4 w; w.x = pk2(v0[0], v0[1]); w.y = pk2(v0[2], v0[3]); w.z = pk2(v1[0], v1[1]); w.w = pk2(v1[2], v1[3]);
                    *(u32x4*)(P + off + (size_t)(row0 + ai * HALF + m * 16) * pitch) = w; } }
    }
};
struct EpiResBf16 {
    static constexpr bool PERM = true, AFTER_DRAIN = false;
    const float* base; bf16_t* O; int ldc;
    __device__ __forceinline__ void operator()(const f32x4 (&acc)[2][2][4][2], const Unit& u, int wr, int wc, int fr, int fq) const {
        const int row0 = u.pm * BM + wr * 64 + fr, col0 = u.pn * BM + wc * 32 + 8 * fq;
#pragma unroll
        for (int ai = 0; ai < 2; ++ai)
#pragma unroll
            for (int m = 0; m < 4; ++m) { const size_t off = (size_t)(row0 + ai * HALF + m * 16) * ldc + col0;
#pragma unroll
                for (int bj = 0; bj < 2; ++bj) { const f32x4 b0 = *(const f32x4*)(base + off + bj * HALF), b1 = *(const f32x4*)(base + off + bj * HALF + 4);
                    const f32x4 v0 = acc[ai][bj][m][0] + b0, v1 = acc[ai][bj][m][1] + b1;
                    u32x4 w; w.x = pk2(v0[0], v0[1]); w.y = pk2(v0[2], v0[3]); w.z = pk2(v1[0], v1[1]); w.w = pk2(v1[2], v1[3]);
                    *(u32x4*)(O + off + bj * HALF) = w; } }
    }
};
template <class Epi, class Sched, bool ALIGN_EPI = false, bool SP2 = false>
__device__ __forceinline__ void gemm_phase(PG8_LAS unsigned char* lds, const Gemm g, const Sched& S, const Epi& E) {
    const int tid = threadIdx.x, wid = __builtin_amdgcn_readfirstlane(tid >> 6), lane = tid & 63, wr = wid >> 2, wc = wid & 3, fr = lane & 15, fq = lane >> 4;
    const int K = g.K, nt = K / BK;
    unsigned voffA[2], voffB[2];
#pragma unroll
    for (int i = 0; i < 2; ++i) { int R, C; stage_rc(tid * 16 + i * 8192, R, C); const int Rb = Epi::PERM ? ((R & ~31) + perm32(R & 31)) : R;
        voffA[i] = (unsigned)(R * g.lda + C) * 2u; voffB[i] = (unsigned)(Rb * g.ldb + C) * 2u; }
    const size_t kstep = (size_t)(BK * 2);
    const size_t hstepA = (size_t)HALF * g.lda * 2, hstepB = (size_t)HALF * g.ldb * 2;
    const size_t tstepA = 2 * hstepA, tstepB = 2 * hstepB;
    const unsigned ldsw = (unsigned)wid * 1024u;
    const int aoff = lds_byte(wr * 64 + fr, fq * 8), boff = lds_byte(wc * 32 + fr, fq * 8);
#define PG8_SA(b, h) (((b) * 2 + (h)) * HTB)
#define PG8_SB(b, h) ((4 + (b) * 2 + (h)) * HTB)
#define PG8_STAGE(bufoff, gbase, voff) do { _Pragma("unroll") for (int _i = 0; _i < 2; ++_i) \
        __builtin_amdgcn_global_load_lds((const unsigned*)((const char*)(gbase) + (voff)[_i]), (PG8_LAS unsigned*)(lds + (bufoff) + ldsw + _i * 8192), 16, 0, 0); } while (0)
#define PG8_LDA(dst, b, h) do { _Pragma("unroll") for (int m = 0; m < 4; ++m) _Pragma("unroll") for (int k = 0; k < 2; ++k) dst[m][k] = *(const PG8_LAS bf16x8*)(lds + PG8_SA(b, h) + aoff + m * 2048 + k * 1024); } while (0)
#define PG8_LDB(dst, b, h) do { _Pragma("unroll") for (int n = 0; n < 2; ++n) _Pragma("unroll") for (int k = 0; k < 2; ++k) dst[n][k] = *(const PG8_LAS bf16x8*)(lds + PG8_SB(b, h) + boff + n * 2048 + k * 1024); } while (0)
#define PG8_MMA(ai, bj, At, Bt) do { __builtin_amdgcn_s_setprio(1); _Pragma("unroll") for (int m = 0; m < 4; ++m) _Pragma("unroll") for (int n = 0; n < 2; ++n) _Pragma("unroll") for (int k = 0; k < 2; ++k) \
        acc[ai][bj][m][n] = __builtin_amdgcn_mfma_f32_16x16x32_bf16(Bt[n][k], At[m][k], acc[ai][bj][m][n], 0, 0, 0); __builtin_amdgcn_s_setprio(0); } while (0)
#define PG8_WAIT_V(n) asm volatile("s_waitcnt vmcnt(" #n ")" ::: "memory")
#define PG8_WAIT_L(n) asm volatile("s_waitcnt lgkmcnt(" #n ")" ::: "memory")
#define PG8_BAR __builtin_amdgcn_s_barrier()
#define PG8_SCHED __builtin_amdgcn_sched_barrier(0)
    Unit cur, nxt; int ui = 0;
    if (!S.next(0, cur)) return;
    f32x4 acc[2][2][4][2];
#pragma unroll
    for (int a = 0; a < 2; ++a)
#pragma unroll
        for (int b = 0; b < 2; ++b)
#pragma unroll
            for (int m = 0; m < 4; ++m)
#pragma unroll
                for (int n = 0; n < 2; ++n) acc[a][b][m][n] = (f32x4){0.f, 0.f, 0.f, 0.f};
    bf16x8 At[4][2], B0[2][2], B1[2][2];
    const char* cA = (const char*)g.A + (size_t)cur.pm * tstepA; const char* cB = (const char*)g.Bt + (size_t)cur.pn * tstepB;
    S.a_ready(cur);
    if constexpr (SP2) {
        PG8_STAGE(PG8_SB(0, 0), cB, voffB); PG8_STAGE(PG8_SB(0, 1), cB + hstepB, voffB); PG8_STAGE(PG8_SA(0, 0), cA, voffA); PG8_STAGE(PG8_SA(0, 1), cA + hstepA, voffA);
        if (wr == 1) PG8_BAR;
        PG8_WAIT_V(2); PG8_BAR;
        PG8_STAGE(PG8_SB(1, 0), cB + kstep, voffB); PG8_STAGE(PG8_SA(1, 0), cA + kstep, voffA); PG8_STAGE(PG8_SB(1, 1), cB + hstepB + kstep, voffB);
        PG8_WAIT_V(6); PG8_BAR;
    } else {
        PG8_STAGE(PG8_SB(0, 0), cB, voffB); PG8_STAGE(PG8_SA(0, 0), cA, voffA); PG8_STAGE(PG8_SB(0, 1), cB + hstepB, voffB); PG8_STAGE(PG8_SA(0, 1), cA + hstepA, voffA);
        if (wr == 1) PG8_BAR;
        PG8_WAIT_V(4); PG8_BAR;
        PG8_STAGE(PG8_SB(1, 0), cB + kstep, voffB); PG8_STAGE(PG8_SA(1, 0), cA + kstep, voffA); PG8_STAGE(PG8_SB(1, 1), cB + hstepB + kstep, voffB);
        PG8_WAIT_V(6); PG8_BAR;
    }
    for (;;) {
        const bool has_next = S.next(ui + 1, nxt);
        const char* nA = has_next ? (const char*)g.A + (size_t)nxt.pm * tstepA : cA; const char* nB = has_next ? (const char*)g.Bt + (size_t)nxt.pn * tstepB : cB;
        for (int t = 0; t < nt; t += 2) {
            const bool last = (t == nt - 2);
            const char* a1 = cA + (size_t)(t + 1) * kstep;
            const char* a2 = last ? nA : cA + (size_t)(t + 2) * kstep; const char* b2 = last ? nB : cB + (size_t)(t + 2) * kstep;
            const char* a3 = a2 + kstep; const char* b3 = b2 + kstep;
            if (last && has_next) S.a_ready(nxt);
            if constexpr (SP2) {
            PG8_LDB(B0, 0, 0); PG8_LDB(B1, 0, 1); PG8_SCHED; PG8_LDA(At, 0, 0); PG8_STAGE(PG8_SA(1, 1), a1 + hstepA, voffA);
            PG8_WAIT_V(8); PG8_WAIT_L(0); PG8_BAR; PG8_MMA(0, 0, At, B0); PG8_MMA(0, 1, At, B1); PG8_BAR; PG8_SCHED;
            PG8_LDA(At, 0, 1); PG8_STAGE(PG8_SB(0, 0), b2, voffB); PG8_STAGE(PG8_SB(0, 1), b2 + hstepB, voffB); PG8_STAGE(PG8_SA(0, 0), a2, voffA);
            PG8_WAIT_V(8); PG8_WAIT_L(0); PG8_BAR; PG8_MMA(1, 0, At, B0); PG8_MMA(1, 1, At, B1); PG8_BAR; PG8_SCHED;
            PG8_LDB(B0, 1, 0); PG8_LDB(B1, 1, 1); PG8_SCHED; PG8_LDA(At, 1, 0); PG8_STAGE(PG8_SA(0, 1), a2 + hstepA, voffA);
            PG8_WAIT_V(8); PG8_WAIT_L(0); PG8_BAR; PG8_MMA(0, 0, At, B0); PG8_MMA(0, 1, At, B1); PG8_BAR; PG8_SCHED;
            PG8_LDA(At, 1, 1); PG8_STAGE(PG8_SB(1, 0), b3, voffB); PG8_STAGE(PG8_SB(1, 1), b3 + hstepB, voffB); PG8_STAGE(PG8_SA(1, 0), a3, voffA);
            PG8_WAIT_V(8); PG8_WAIT_L(0); PG8_BAR; PG8_MMA(1, 0, At, B0); PG8_MMA(1, 1, At, B1); PG8_BAR; PG8_SCHED;
            } else {
            PG8_LDB(B0, 0, 0); PG8_SCHED; PG8_LDA(At, 0, 0); PG8_STAGE(PG8_SA(1, 1), a1 + hstepA, voffA);
            PG8_WAIT_L(8); PG8_BAR; PG8_WAIT_L(0); PG8_MMA(0, 0, At, B0); PG8_BAR; PG8_SCHED;
            PG8_LDB(B1, 0, 1); PG8_STAGE(PG8_SB(0, 0), b2, voffB);
            PG8_BAR; PG8_WAIT_L(0); PG8_MMA(0, 1, At, B1); PG8_BAR;
            PG8_LDA(At, 0, 1); PG8_STAGE(PG8_SA(0, 0), a2, voffA);
            PG8_BAR; PG8_WAIT_L(0); PG8_MMA(1, 0, At, B0); PG8_BAR; PG8_SCHED;
            PG8_STAGE(PG8_SB(0, 1), b2 + hstepB, voffB);
            PG8_WAIT_V(6); PG8_BAR; PG8_MMA(1, 1, At, B1); PG8_BAR;
            PG8_LDB(B0, 1, 0); PG8_SCHED; PG8_LDA(At, 1, 0); PG8_STAGE(PG8_SA(0, 1), a2 + hstepA, voffA);
            PG8_WAIT_L(8); PG8_BAR; PG8_WAIT_L(0); PG8_MMA(0, 0, At, B0); PG8_BAR; PG8_SCHED;
            PG8_LDB(B1, 1, 1); PG8_STAGE(PG8_SB(1, 0), b3, voffB);
            PG8_BAR; PG8_WAIT_L(0); PG8_MMA(0, 1, At, B1); PG8_BAR;
            PG8_LDA(At, 1, 1); PG8_STAGE(PG8_SA(1, 0), a3, voffA);
            PG8_BAR; PG8_WAIT_L(0); PG8_MMA(1, 0, At, B0); PG8_BAR; PG8_SCHED;
            PG8_STAGE(PG8_SB(1, 1), b3 + hstepB, voffB);
            PG8_WAIT_V(6); PG8_BAR; PG8_MMA(1, 1, At, B1); PG8_BAR;
            }
        }
        if constexpr (ALIGN_EPI) { if (wr == 0) PG8_BAR; }
        if constexpr (!Epi::AFTER_DRAIN) { E(acc, cur, wr, wc, fr, fq); S.done(cur); }
        if (!has_next) break;
#pragma unroll
        for (int a = 0; a < 2; ++a)
#pragma unroll
            for (int b = 0; b < 2; ++b)
#pragma unroll
                for (int m = 0; m < 4; ++m)
#pragma unroll
                    for (int n = 0; n < 2; ++n) acc[a][b][m][n] = (f32x4){0.f, 0.f, 0.f, 0.f};
        cur = nxt; cA = nA; cB = nB; ++ui;
        if constexpr (ALIGN_EPI) { if (wr == 1) PG8_BAR; }
    }
    PG8_WAIT_V(0);
    if constexpr (!ALIGN_EPI) { if (wr == 0) PG8_BAR; }
    PG8_BAR;
    if constexpr (Epi::AFTER_DRAIN) { E.fused(acc, cur, wr, wc, fr, fq, lds, wid, lane); S.done(cur); }
#undef PG8_SA
#undef PG8_SB
#undef PG8_STAGE
#undef PG8_LDA
#undef PG8_LDB
#undef PG8_MMA
#undef PG8_WAIT_V
#undef PG8_WAIT_L
#undef PG8_BAR
#undef PG8_SCHED
}

}

#define XB_TMO      128
#define XB_XCNT(j)  (256  + 64 * (j))
#define XB_XSUB(j)  (1280 + 64 * (j))
#define XB_XGEN(j)  (2304 + 64 * (j))
#define XB_TOP      3328
#define XB_TOPGEN   3392
#define XCD_BAR_WORDS 3456
#define XB_SPIN_CAP (1u << 18)
__device__ __forceinline__ unsigned xb_ld(unsigned* p)              { return __hip_atomic_load(p, __ATOMIC_RELAXED, __HIP_MEMORY_SCOPE_AGENT); }
__device__ __forceinline__ unsigned xb_add(unsigned* p, unsigned v) { return __hip_atomic_fetch_add(p, v, __ATOMIC_RELAXED, __HIP_MEMORY_SCOPE_AGENT); }
__device__ __forceinline__ unsigned xb_xcc_id() { return (unsigned)__builtin_amdgcn_s_getreg((3 << 11) | 20) & 0xFu; }
#define XB_SPIN(cond, bar) do { unsigned _sp = 0; while (cond) { __builtin_amdgcn_s_sleep(1); \
    if ((++_sp & 255u) == 0u) { if (xb_ld(&(bar)[XB_TMO])) break; if (_sp > XB_SPIN_CAP) { atomicAdd(&(bar)[XB_TMO], 1u); break; } } } } while (0)
struct XcdBarrier { unsigned* bar; unsigned x; volatile LAS unsigned* st; };
__device__ __forceinline__ XcdBarrier xcd_barrier_post(unsigned* bar, volatile LAS unsigned* st) {
    XcdBarrier b; b.bar = bar; b.x = xb_xcc_id(); b.st = st;
    if (threadIdx.x == 0) (void)xb_add(&bar[XB_XCNT(b.x)], 1u);
    return b;
}
__device__ __forceinline__ void xcd_barrier_complete(unsigned* bar, unsigned x, unsigned& nloc, unsigned& nx) {
    const unsigned G = gridDim.x * gridDim.y * gridDim.z;
    unsigned sum, cnt, mine, sp = 0u;
    for (;;) {
        sum = 0u; cnt = 0u; mine = 0u;
#pragma unroll
        for (unsigned j = 0; j < 16; ++j) { const unsigned c = xb_ld(&bar[XB_XCNT(j)]); sum += c; cnt += (c > 0u) ? 1u : 0u; mine = (j == x) ? c : mine; }
        if (sum == G) break;
        __builtin_amdgcn_s_sleep(1);
        if ((++sp & 255u) == 0u) { if (xb_ld(&bar[XB_TMO])) break; if (sp > XB_SPIN_CAP) { atomicAdd(&bar[XB_TMO], 1u); break; } }
    }
    nloc = mine > 0u ? mine : 1u; nx = cnt > 0u ? cnt : 1u;
}
__device__ __forceinline__ void xcd_barrier(const XcdBarrier& b) {
    asm volatile("s_waitcnt vmcnt(0)" ::: "memory");
    __syncthreads();
    if (threadIdx.x == 0) {
        unsigned* bar = b.bar;
        __builtin_amdgcn_s_waitcnt(0);
        unsigned nloc = b.st[0], nx = b.st[1];
        if (nloc == 0u) { xcd_barrier_complete(bar, b.x, nloc, nx); b.st[0] = nloc; b.st[1] = nx; }
        const unsigned old = xb_add(&bar[XB_XSUB(b.x)], 1u);
        const unsigned gen = old / nloc;
        if (old + 1u == (gen + 1u) * nloc) {
            __builtin_amdgcn_fence(__ATOMIC_RELEASE, "agent");
            asm volatile("s_waitcnt vmcnt(0)" ::: "memory");
            const unsigned og = xb_add(&bar[XB_TOP], 1u);
            const unsigned tg = og / nx;
            if (og + 1u == (tg + 1u) * nx) xb_add(&bar[XB_TOPGEN], 1u);
            else XB_SPIN(xb_ld(&bar[XB_TOPGEN]) == tg, bar);
            __builtin_amdgcn_fence(__ATOMIC_ACQUIRE, "agent");
            xb_add(&bar[XB_XGEN(b.x)], 1u);
            asm volatile("s_waitcnt vmcnt(0)" ::: "memory");
        } else {
            XB_SPIN(xb_ld(&bar[XB_XGEN(b.x)]) == gen, bar);
            __builtin_amdgcn_fence(__ATOMIC_ACQUIRE, "agent");
            asm volatile("s_waitcnt vmcnt(0)" ::: "memory");
        }
    }
    __syncthreads();
}

constexpr int NWAVES = 8, NTHREADS = 512;
constexpr int NPHASE = 10;
#ifndef MK_N_LAUNCHES
#define MK_N_LAUNCHES 1
#endif
constexpr int N_LAUNCHES = MK_N_LAUNCHES;
constexpr int RING_BYTES = 131072, LDS_BYTES = 163840, LDSCTL_OFF = LDS_BYTES - 256;
constexpr int CW_BAR = 4096;

struct Args {
    const float *x, *meta, *g_mix, *w_in, *conv_ssd_w, *conv_ssd_b, *dt_bias, *a_log, *d_skip, *ssd_norm_w, *conv_sc_w, *w_out, *g_ffn, *w_q, *sub_keys, *expert_u, *expert_v, *g_final;
    float* out; unsigned char* ws; int ph_lo, ph_hi;
};
struct Frame { LAS unsigned char* lds; int tid, lane, wave, G, vcu; };

template <class ColMap>
__device__ __forceinline__ void p0_transpose_item(const float* W, int K, int N, bf16_t* WT, int nblk, LAS float* scr, int item, int lane, ColMap cm, const float* kscale = nullptr) {
    const int kb = item / nblk, nb = item % nblk, k0 = 64 * kb, n0 = 32 * nb;
    const int sc = cm(n0 + (lane & 31));
#pragma unroll 8
    for (int i = 0; i < 32; ++i) { const int kk = 2 * i + (lane >> 5); scr[kk * 33 + (lane & 31)] = sc >= 0 ? W[(size_t)(k0 + kk) * N + sc] * (kscale ? kscale[k0 + kk] : 1.f) : 0.f; }
    asm volatile("s_waitcnt lgkmcnt(0)" ::: "memory");
    const int c = lane & 7;
#pragma unroll
    for (int j = 0; j < 4; ++j) { const int n = (lane >> 3) + 8 * j; const LAS float* s = scr + (8 * c) * 33 + n;
        u32x4 o; o.x = pk2(s[0 * 33], s[1 * 33]); o.y = pk2(s[2 * 33], s[3 * 33]); o.z = pk2(s[4 * 33], s[5 * 33]); o.w = pk2(s[6 * 33], s[7 * 33]);
        *(u32x4*)(WT + (size_t)(n0 + n) * K + k0 + 8 * c) = o; }
    asm volatile("s_waitcnt lgkmcnt(0)" ::: "memory");
}
__device__ __forceinline__ void p0_prologue(const Frame& F, const Args& a) {
    LAS float* scr = (LAS float*)(F.lds + F.wave * 16384);
    const int gw = F.vcu * NWAVES + F.wave, NGW = F.G * NWAVES;
    bf16_t* WinT = (bf16_t*)(a.ws + WS_WIN); bf16_t* WoutT = (bf16_t*)(a.ws + WS_WOUT); bf16_t* WqT = (bf16_t*)(a.ws + WS_WQ); bf16_t* XN = (bf16_t*)(a.ws + WS_XN);
    constexpr int I_IN = (D / 64) * (LDP / 32), I_OUT = (D_MIX / 64) * (D / 32), I_Q = (D / 64) * (PQ / 32);
    for (int it = gw; it < I_IN + I_OUT + I_Q; it += NGW) {
        int r = it;
        if (r < I_IN) { p0_transpose_item(a.w_in, D, D_IN, WinT, LDP / 32, scr, r, F.lane, [](int j) { return proj_src_col(j); }); continue; } r -= I_IN;
        if (r < I_OUT) { p0_transpose_item(a.w_out, D_MIX, D, WoutT, D / 32, scr, r, F.lane, [](int j) { return j; }); continue; } r -= I_OUT;
        p0_transpose_item(a.w_q, D, PQ, WqT, PQ / 32, scr, r, F.lane, [](int j) { return j; }, a.g_ffn);
    }
    for (int m = gw; m < ROWS_A; m += NGW) {
        u32x2* o8 = (u32x2*)(XN + (size_t)m * D) + F.lane;
        if (m >= TR + NMETA) {
#pragma unroll
            for (int j = 0; j < 4; ++j) o8[64 * j] = (u32x2){0u, 0u};
            continue; }
        const float* src = m < TR ? a.x + (size_t)m * D : a.meta + (size_t)(m - TR) * D;
        const f32x4* xr = (const f32x4*)src + F.lane; const f32x4* gr = (const f32x4*)a.g_mix + F.lane;
        f32x4 v[4]; float s = 0.f;
#pragma unroll
        for (int j = 0; j < 4; ++j) { v[j] = xr[64 * j]; s += (v[j].x * v[j].x + v[j].y * v[j].y) + (v[j].z * v[j].z + v[j].w * v[j].w); }
        const float rstd = 1.0f / sqrtf(wave_sum(s) * (1.f / D) + EPS);
#pragma unroll
        for (int j = 0; j < 4; ++j) { const f32x4 gg = gr[64 * j]; o8[64 * j] = (u32x2){pk2(v[j].x * rstd * gg.x, v[j].y * rstd * gg.y), pk2(v[j].z * rstd * gg.z, v[j].w * rstd * gg.w)}; }
    }
}

typedef float f32x16 __attribute__((ext_vector_type(16)));
constexpr int PITCH = 136;
constexpr int SL_C = 0, SL_B = 34816, SL_M0 = 69632, SL_X = 104448, SL_DT = 139264, SL_ACS = 142336;
constexpr int YPITCH = 396;
static_assert(SL_B + 128 * YPITCH * 2 <= SL_DT, "staging fits below dt/acs");
constexpr size_t WS_DAT = WS_XN;
constexpr size_t WS_SMETA = WS_XN + 65536;

__device__ __forceinline__ f32x16 mfma32(bf16x8 a, bf16x8 b, f32x16 c) { return __builtin_amdgcn_mfma_f32_32x32x16_bf16(a, b, c, 0, 0, 0); }
__device__ __forceinline__ float silu_f(float v) { return v / (1.f + __expf(-v)); }

template <int NP> struct ConvW { u32x4 raw[NP + 3]; };
template <int NP> __device__ __forceinline__ void convw_load(ConvW<NP>& ci, const bf16_t* xgc  , int b, int pos0) {
#pragma unroll
    for (int i = 0; i < NP + 3; ++i) { const int pos = pos0 - 3 + i; u32x4 v = (u32x4){0u, 0u, 0u, 0u};
        if (pos >= 0) v = *(const u32x4*)(xgc + (size_t)row_of(b, pos) * P_XG);
        ci.raw[i] = v; }
}
struct ConvWt { f32x4 w[4][2], cb[2]; };
__device__ __forceinline__ void convw_weights(ConvWt& cw, const Args& a, int ch) {
    cw.cb[0] = *(const f32x4*)(a.conv_ssd_b + ch); cw.cb[1] = *(const f32x4*)(a.conv_ssd_b + ch + 4);
#pragma unroll
    for (int wi = 0; wi < 4; ++wi) { cw.w[wi][0] = *(const f32x4*)(a.conv_ssd_w + wi * D_XBC + ch); cw.w[wi][1] = *(const f32x4*)(a.conv_ssd_w + wi * D_XBC + ch + 4); }
}
__device__ __forceinline__ float bfel(const u32x4& v, int c) { const unsigned w = (c >> 1) == 0 ? v.x : (c >> 1) == 1 ? v.y : (c >> 1) == 2 ? v.z : v.w; return (c & 1) ? bfhi(w) : bflo(w); }
template <int NP> __device__ __forceinline__ void convw_pos(const ConvW<NP>& ci, const ConvWt& cw, int s, float (&o)[8]) {
#pragma unroll
    for (int c = 0; c < 8; ++c) { const int q = c >> 2, e = c & 3;
        o[c] = silu_f(cw.cb[q][e] + cw.w[0][q][e] * bfel(ci.raw[s], c) + cw.w[1][q][e] * bfel(ci.raw[s + 1], c) + cw.w[2][q][e] * bfel(ci.raw[s + 2], c) + cw.w[3][q][e] * bfel(ci.raw[s + 3], c)); }
}
__device__ __forceinline__ void ssd_dt_acs(const Frame& F_, const Args& a, const bf16_t* PROJ, int b, int p0, int g, float* dat  ) {
    const Frame& F0 = F_;
    if (F0.wave < 6) {
        int lane_ = F0.lane; asm volatile("" : "+v"(lane_));
        Frame Fl = F0; Fl.lane = lane_;
        const Frame& F = Fl;
        const int h = g * 6 + F.wave; const float A = -__expf(a.a_log[h]), dtb = a.dt_bias[h];
        LAS float* dtL = (LAS float*)(F.lds + SL_DT) + F.wave * 128; LAS float* acL = (LAS float*)(F.lds + SL_ACS) + F.wave * 128;
        float dv[2], av[2];
#pragma unroll
        for (int hf = 0; hf < 2; ++hf) { const int pos = p0 + F.lane + 64 * hf; float d = 0.f;
            if (pos >= 0) { const float v = bf2f(PROJ[DT_OFF + (size_t)row_of(b, pos) * P_DT + h]) + dtb, t = __expf(-fabsf(v));
                d = fmaxf(v, 0.f) + (t < 1e-3f ? t * (1.f - 0.5f * t) : __logf(1.f + t)); }
            dv[hf] = d; av[hf] = d * A; }
#pragma unroll
        for (int o = 1; o < 64; o <<= 1) { const float t0 = __shfl_up(av[0], o), t1 = __shfl_up(av[1], o); if (F.lane >= o) { av[0] += t0; av[1] += t1; } }
        av[1] += __shfl(av[0], 63);
        dtL[F.lane] = dv[0]; dtL[F.lane + 64] = dv[1]; acL[F.lane] = av[0]; acL[F.lane + 64] = av[1];
        if (dat && F.lane == 63) dat[h] = __expf(av[1]);
    }
}

__device__ __forceinline__ void ssd_s1_unit(const Frame& F, const Args& a, int b, int c, int g) {
    const bf16_t* PROJ = (const bf16_t*)(a.ws + WS_PROJ);
    const int p0 = c == 0 ? -112 : NMETA + 128 * (c - 1), lr = F.lane & 31, hf = F.lane >> 5;
    __syncthreads();
    ssd_dt_acs(F, a, PROJ, b, p0, g, (float*)(a.ws + WS_DAT) + (size_t)(b * 17 + c) * HEADS);
    if (F.tid < 256) { const int chg = F.tid & 15, sr = F.tid >> 4, ch = D_SSD + g * 128 + 8 * chg;
        ConvW<8> ci; convw_load<8>(ci, PROJ + XG_OFF + g * XG_STRIDE + 384 + 8 * chg, b, p0 + 8 * sr); ConvWt cw; convw_weights(cw, a, ch);
        unsigned pk[8][4];
#pragma unroll
        for (int s2 = 0; s2 < 4; ++s2) { float o0[8], o1[8]; convw_pos<8>(ci, cw, 2 * s2, o0); convw_pos<8>(ci, cw, 2 * s2 + 1, o1);
#pragma unroll
            for (int c = 0; c < 8; ++c) pk[c][s2] = pk2(o0[c], o1[c]); }
#pragma unroll
        for (int c = 0; c < 8; ++c) *(LAS u32x4*)(F.lds + SL_C + ((8 * chg + c) * PITCH + 8 * sr) * 2) = (u32x4){pk[c][0], pk[c][1], pk[c][2], pk[c][3]}; }
    __syncthreads();
    const bf16_t* xg1 = PROJ + XG_OFF + g * XG_STRIDE + 8 * (F.tid & 7);
    ConvW<2> cin; convw_load<2>(cin, xg1, b, p0 + 2 * (F.tid >> 3));
#pragma unroll 1
    for (int hh = 0; hh < 6; ++hh) {
        const int h = g * 6 + hh, buf = hh & 1;
        {
            const int chg = F.tid & 7, sp = F.tid >> 3, ch = h * 64 + 8 * chg;
            const ConvW<2> ci = cin; ConvWt cw; convw_weights(cw, a, ch);
            if (hh < 5) convw_load<2>(cin, xg1 + (hh + 1) * 64, b, p0 + 2 * sp);
            const LAS float* dtL = (const LAS float*)(F.lds + SL_DT) + hh * 128; const LAS float* acL = (const LAS float*)(F.lds + SL_ACS) + hh * 128;
            const float aend = acL[127], w0 = dtL[2 * sp] * __expf(aend - acL[2 * sp]), w1 = dtL[2 * sp + 1] * __expf(aend - acL[2 * sp + 1]);
            float o0[8], o1[8]; convw_pos<2>(ci, cw, 0, o0); convw_pos<2>(ci, cw, 1, o1);
#pragma unroll
            for (int c = 0; c < 8; ++c) *(LAS unsigned*)(F.lds + SL_X + buf * 17408 + ((8 * chg + c) * PITCH + 2 * sp) * 2) = pk2(o0[c] * w0, o1[c] * w1);
        }
        __syncthreads();
        const int pb = F.wave >> 2, nb = F.wave & 3;
        f32x16 acc;
#pragma unroll
        for (int r = 0; r < 16; ++r) acc[r] = 0.f;
#pragma unroll
        for (int ks = 0; ks < 8; ++ks) {
            const bf16x8 af = *(const LAS bf16x8*)(F.lds + SL_C + ((32 * nb + lr) * PITCH + 16 * ks + 8 * hf) * 2);
            const bf16x8 bf = *(const LAS bf16x8*)(F.lds + SL_X + buf * 17408 + ((32 * pb + lr) * PITCH + 16 * ks + 8 * hf) * 2);
            acc = mfma32(af, bf, acc);
        }
        bf16_t* dst = c == 0 ? (bf16_t*)(a.ws + WS_SMETA) + (size_t)h * 8192 : (bf16_t*)a.out + ((size_t)(b * 16 + (c - 1)) * HEADS + h) * 8192;
        u32x4* d4 = (u32x4*)(dst + ((size_t)(pb * 4 + nb) * 64 + F.lane) * 16);
        u32x4 w0, w1; w0.x = pk2(acc[0], acc[1]); w0.y = pk2(acc[2], acc[3]); w0.z = pk2(acc[4], acc[5]); w0.w = pk2(acc[6], acc[7]);
        w1.x = pk2(acc[8], acc[9]); w1.y = pk2(acc[10], acc[11]); w1.z = pk2(acc[12], acc[13]); w1.w = pk2(acc[14], acc[15]);
        d4[0] = w0; d4[1] = w1;
    }
}
__device__ __forceinline__ void short_conv_all(const Frame& F, const Args& a) {
    bf16_t* PROJ = (bf16_t*)(a.ws + WS_PROJ);
    const size_t gt = (size_t)F.vcu * NTHREADS + F.tid, NT = (size_t)F.G * NTHREADS;
    for (size_t it = gt; it < (size_t)TR * (D_SC / 8); it += NT) {
        const int r = (int)(it / (D_SC / 8)), c0 = (int)(it % (D_SC / 8)) * 8, b = r / SEQ, pos = r % SEQ + NMETA;
        float accv[8];
#pragma unroll
        for (int j = 0; j < 8; ++j) accv[j] = 0.f;
#pragma unroll
        for (int w = 0; w < 3; ++w) { const int rr = row_of(b, pos - 2 + w);
            const u32x4 cc = *(const u32x4*)(PROJ + SC_OFF + (size_t)rr * P_SC + c0), xx = *(const u32x4*)(PROJ + SC_OFF + (size_t)rr * P_SC + 512 + c0);
            const unsigned cw[4] = {cc.x, cc.y, cc.z, cc.w}, xw[4] = {xx.x, xx.y, xx.z, xx.w};
#pragma unroll
            for (int j = 0; j < 4; ++j) { accv[2 * j] += a.conv_sc_w[w * D_SC + c0 + 2 * j] * (bflo(cw[j]) * bflo(xw[j])); accv[2 * j + 1] += a.conv_sc_w[w * D_SC + c0 + 2 * j + 1] * (bfhi(cw[j]) * bfhi(xw[j])); } }
        const u32x4 bb = *(const u32x4*)(PROJ + ZS_OFF + (size_t)r * P_ZS + 1536 + c0); const unsigned bw[4] = {bb.x, bb.y, bb.z, bb.w};
        u32x4 o; unsigned ow[4];
#pragma unroll
        for (int j = 0; j < 4; ++j) ow[j] = pk2(bflo(bw[j]) * accv[2 * j], bfhi(bw[j]) * accv[2 * j + 1]);
        o.x = ow[0]; o.y = ow[1]; o.z = ow[2]; o.w = ow[3];
        *(u32x4*)(PROJ + ZS_OFF + (size_t)r * P_ZS + 1536 + c0) = o;
    }
}
__device__ __forceinline__ void p2_ssd_states(const Frame& F, const Args& a, bool dryrun) {
    if (!dryrun) short_conv_all(F, a);
    for (int u = F.vcu; u < 4 + BATCH * 15 * NG; u += F.G) {
        if (u < 4) ssd_s1_unit(F, a, 0, 0, u);
        else { const int v = u - 4; ssd_s1_unit(F, a, v / (15 * NG), 1 + (v / NG) % 15, v % NG); }
    }
}
__device__ __forceinline__ void p3_ssd_recur(const Frame& F, const Args& a) {
    const float* dat = (const float*)(a.ws + WS_DAT); const bf16_t* SM = (const bf16_t*)(a.ws + WS_SMETA); bf16_t* SF = (bf16_t*)a.out;
    for (int it = F.vcu; it < BATCH * HEADS * 1024 / NTHREADS; it += F.G) {
        const int idx = it * NTHREADS + F.tid, bh = idx >> 10, e8 = idx & 1023, b = bh / HEADS, h = bh % HEADS;
        u32x4 ld[15];
#pragma unroll
        for (int c = 1; c <= 15; ++c) ld[c - 1] = *(const u32x4*)(SF + ((size_t)(b * 16 + (c - 1)) * HEADS + h) * 8192 + e8 * 8);
        const u32x4 m = *(const u32x4*)(SM + (size_t)h * 8192 + e8 * 8);
        float cy[8] = {bflo(m.x), bfhi(m.x), bflo(m.y), bfhi(m.y), bflo(m.z), bfhi(m.z), bflo(m.w), bfhi(m.w)};
#pragma unroll
        for (int c = 1; c <= 16; ++c) {
            u32x4 o; o.x = pk2(cy[0], cy[1]); o.y = pk2(cy[2], cy[3]); o.z = pk2(cy[4], cy[5]); o.w = pk2(cy[6], cy[7]);
            *(u32x4*)(SF + ((size_t)(b * 16 + (c - 1)) * HEADS + h) * 8192 + e8 * 8) = o;
            if (c <= 15) { const float dA = dat[(size_t)(b * 17 + c) * HEADS + h]; const u32x4 t = ld[c - 1];
                cy[0] = cy[0] * dA + bflo(t.x); cy[1] = cy[1] * dA + bfhi(t.x); cy[2] = cy[2] * dA + bflo(t.y); cy[3] = cy[3] * dA + bfhi(t.y);
                cy[4] = cy[4] * dA + bflo(t.z); cy[5] = cy[5] * dA + bfhi(t.z); cy[6] = cy[6] * dA + bflo(t.w); cy[7] = cy[7] * dA + bfhi(t.w); }
        }
    }
}
template <bool DRY> __device__ __forceinline__ void ssd_s3_unit(const Frame& F, const Args& a, int b, int c, int g) {
    bf16_t* PROJ = (bf16_t*)(a.ws + WS_PROJ);
    const int p0 = NMETA + 128 * (c - 1), row0 = b * SEQ + 128 * (c - 1), lr = F.lane & 31, hf = F.lane >> 5;
    __syncthreads();
    ssd_dt_acs(F, a, PROJ, b, p0, g, nullptr);
    {   const int mat = F.tid >> 8, it = F.tid & 255, chg = it & 15, sr = it >> 4, ch = D_SSD + (mat ? 0 : 512) + g * 128 + 8 * chg;
        ConvW<8> ci; convw_load<8>(ci, PROJ + XG_OFF + g * XG_STRIDE + (mat ? 384 : 512) + 8 * chg, b, p0 + 8 * sr); ConvWt cw; convw_weights(cw, a, ch);
#pragma unroll
        for (int s = 0; s < 8; ++s) { float o[8]; convw_pos<8>(ci, cw, s, o);
            *(LAS u32x4*)(F.lds + (mat ? SL_B : SL_C) + ((8 * sr + s) * PITCH + 8 * chg) * 2) = (u32x4){pk2(o[0], o[1]), pk2(o[2], o[3]), pk2(o[4], o[5]), pk2(o[6], o[7])}; } }
    __syncthreads();
    constexpr unsigned SI_P = 0u | (0u << 2) | (1u << 4) | (0u << 6) | (1u << 8) | (2u << 10) | (0u << 12) | (1u << 14) | (2u << 16) | (3u << 18);
    constexpr unsigned LI_P = 0u | (1u << 2) | (1u << 4) | (2u << 6) | (2u << 8) | (2u << 10) | (3u << 12) | (3u << 14) | (3u << 16) | (3u << 18);
    const int nslot = F.wave < 2 ? 2 : 1;
    f32x16 cb[2];
#pragma unroll
    for (int sl = 0; sl < 2; ++sl) {
#pragma unroll
        for (int r = 0; r < 16; ++r) cb[sl][r] = 0.f;
        if (sl < nslot) { const int ti = F.wave + 8 * sl, si = (SI_P >> (2 * ti)) & 3, li = (LI_P >> (2 * ti)) & 3;
#pragma unroll
            for (int ks = 0; ks < 8; ++ks) {
                const bf16x8 af = *(const LAS bf16x8*)(F.lds + SL_B + ((32 * si + lr) * PITCH + 16 * ks + 8 * hf) * 2);
                const bf16x8 bf = *(const LAS bf16x8*)(F.lds + SL_C + ((32 * li + lr) * PITCH + 16 * ks + 8 * hf) * 2);
                cb[sl] = mfma32(af, bf, cb[sl]); } }
    }
    __syncthreads();
    const int pb = F.wave & 1, lio = F.wave >> 1;
    unsigned ypk[6][8];
#pragma unroll
    for (int i = 0; i < 6; ++i)
#pragma unroll
        for (int r = 0; r < 8; ++r) ypk[i][r] = 0u;
#pragma unroll 1
    for (int hh = 0; hh < 6; ++hh) {
        const int h = g * 6 + hh, buf = hh & 1, mofs = buf ? SL_B : SL_M0;
        const LAS float* dtL = (const LAS float*)(F.lds + SL_DT) + hh * 128; const LAS float* acL = (const LAS float*)(F.lds + SL_ACS) + hh * 128;
        const bf16_t* sp = (const bf16_t*)a.out + ((size_t)(b * 16 + (c - 1)) * HEADS + h) * 8192;
        {
            const int chg = F.tid & 7, spp = F.tid >> 3, ch = h * 64 + 8 * chg;
            ConvW<2> ci; convw_load<2>(ci, PROJ + XG_OFF + g * XG_STRIDE + hh * 64 + 8 * chg, b, p0 + 2 * spp); ConvWt cw; convw_weights(cw, a, ch);
            float o0[8], o1[8]; convw_pos<2>(ci, cw, 0, o0); convw_pos<2>(ci, cw, 1, o1);
#pragma unroll
            for (int cc = 0; cc < 8; ++cc) *(LAS unsigned*)(F.lds + SL_X + buf * 17408 + ((8 * chg + cc) * PITCH + 2 * spp) * 2) = pk2(o0[cc], o1[cc]);
        }
        u32x4 sf[4][2];
#pragma unroll
        for (int nb = 0; nb < 4; ++nb) { const u32x4* s4 = (const u32x4*)(sp + ((size_t)(pb * 4 + nb) * 64 + F.lane) * 16); sf[nb][0] = s4[0]; sf[nb][1] = s4[1]; }
        {
            const float Dh = a.d_skip[h];
#pragma unroll
            for (int sl = 0; sl < 2; ++sl) if (sl < nslot) { const int ti = F.wave + 8 * sl, si = (SI_P >> (2 * ti)) & 3, li = (LI_P >> (2 * ti)) & 3;
                const int l = 32 * li + lr; const float acl = acL[l];
#pragma unroll
                for (int q = 0; q < 4; ++q) { const int s0 = 32 * si + 8 * q + 4 * hf;
                    const f32x4 d4 = *(const LAS f32x4*)(dtL + s0), a4 = *(const LAS f32x4*)(acL + s0); float v[4];
#pragma unroll
                    for (int i = 0; i < 4; ++i) { const int s = s0 + i; float t = s <= l ? cb[sl][4 * q + i] * __expf(acl - a4[i]) * d4[i] : 0.f; if (s == l) t += Dh; v[i] = t; }
                    *(LAS u32x2*)(F.lds + mofs + (l * PITCH + s0) * 2) = (u32x2){pk2(v[0], v[1]), pk2(v[2], v[3])}; } }
        }
        f32x16 acc;
#pragma unroll
        for (int r = 0; r < 16; ++r) acc[r] = 0.f;
        {
#pragma unroll
            for (int nb = 0; nb < 4; ++nb) {
#pragma unroll
                for (int qp = 0; qp < 2; ++qp) { const LAS unsigned char* cp_ = F.lds + SL_C + ((32 * lio + lr) * PITCH + 32 * nb + 16 * qp + 4 * hf) * 2;
                    const u32x2 c0 = *(const LAS u32x2*)cp_, c1 = *(const LAS u32x2*)(cp_ + 16);
                    const u32x4 bfr = (u32x4){c0.x, c0.y, c1.x, c1.y};
                    acc = mfma32(__builtin_bit_cast(bf16x8, sf[nb][qp]), __builtin_bit_cast(bf16x8, bfr), acc); } }
            const float sc = __expf(acL[32 * lio + lr]);
#pragma unroll
            for (int r = 0; r < 16; ++r) acc[r] *= sc;
        }
        __syncthreads();
        for (int ks = 0; ks < 2 * (lio + 1); ++ks) {
            const bf16x8 af = *(const LAS bf16x8*)(F.lds + SL_X + buf * 17408 + ((32 * pb + lr) * PITCH + 16 * ks + 8 * hf) * 2);
            const bf16x8 bf = *(const LAS bf16x8*)(F.lds + mofs + ((32 * lio + lr) * PITCH + 16 * ks + 8 * hf) * 2);
            acc = mfma32(af, bf, acc);
        }
#pragma unroll
        for (int i = 0; i < 5; ++i)
#pragma unroll
            for (int r = 0; r < 8; ++r) ypk[i][r] = ypk[i + 1][r];
#pragma unroll
        for (int r = 0; r < 8; ++r) ypk[5][r] = pk2(acc[2 * r], acc[2 * r + 1]);
    }
    __syncthreads();
#pragma unroll
    for (int hh = 0; hh < 6; ++hh)
#pragma unroll
        for (int q = 0; q < 4; ++q) *(LAS u32x2*)(F.lds + SL_B + ((32 * lio + lr) * YPITCH + hh * 64 + 32 * pb + 8 * q + 4 * hf) * 2) = (u32x2){ypk[hh][2 * q], ypk[hh][2 * q + 1]};
    u32x2 zz2[4][6];
#pragma unroll
    for (int pass = 0; pass < 4; ++pass) { const int l = pass * 32 + F.wave * 4 + (F.lane >> 4), sub = F.lane & 15; const bf16_t* zr = PROJ + ZS_OFF + (size_t)(row0 + l) * P_ZS + g * 384;
#pragma unroll
        for (int k = 0; k < 6; ++k) zz2[pass][k] = *(const u32x2*)(zr + 4 * (sub + 16 * k)); }
    __syncthreads();
#pragma unroll
    for (int pass = 0; pass < 4; ++pass) {
        const int l = pass * 32 + F.wave * 4 + (F.lane >> 4), sub = F.lane & 15; bf16_t* zr = PROJ + ZS_OFF + (size_t)(row0 + l) * P_ZS + g * 384;
        float v[6][4]; float ss = 0.f;
#pragma unroll
        for (int k = 0; k < 6; ++k) { const int c0 = 4 * (sub + 16 * k); const u32x2 y2 = *(const LAS u32x2*)(F.lds + SL_B + (l * YPITCH + c0) * 2), z2 = zz2[pass][k];
            const float yy[4] = {bflo(y2.x), bfhi(y2.x), bflo(y2.y), bfhi(y2.y)}, zz[4] = {bflo(z2.x), bfhi(z2.x), bflo(z2.y), bfhi(z2.y)};
#pragma unroll
            for (int i = 0; i < 4; ++i) { v[k][i] = yy[i] * silu_f(zz[i]); ss += v[k][i] * v[k][i]; } }
        ss = row_sum16(ss);
        const float rstd = 1.0f / sqrtf(ss * (1.f / 384.f) + EPS);
#pragma unroll
        for (int k = 0; k < 6; ++k) { const int c0 = 4 * (sub + 16 * k); const f32x4 nw = *(const f32x4*)(a.ssd_norm_w + g * 384 + c0);
            bf16_t* zo = DRY ? (bf16_t*)(a.ws + WS_END) + ((size_t)F.vcu * 128 + l) * 384 : zr;
            *(u32x2*)(zo + c0) = (u32x2){pk2(v[k][0] * rstd * nw.x, v[k][1] * rstd * nw.y), pk2(v[k][2] * rstd * nw.z, v[k][3] * rstd * nw.w)}; }
    }
}
template <bool DRY> __device__ __forceinline__ void p4_ssd_out(const Frame& F, const Args& a) {
    for (int u = F.vcu; u < BATCH * 16 * NG; u += F.G) ssd_s3_unit<DRY>(F, a, u / (16 * NG), 1 + (u / NG) % 16, u % NG);
}

__device__ __forceinline__ void p5_norm2(const Frame& F, const Args& a) {
    const int gw = F.vcu * NWAVES + F.wave, NGW = F.G * NWAVES;
    {
        unsigned char* V8 = a.ws + WS_V8; float* SV = (float*)(a.ws + WS_SV);
        for (int r = gw; r < 2 * PK * PK; r += NGW) {
            const bool isv = r >= PK * PK; const int e = isv ? r - PK * PK : r;
            const f32x4* src = (const f32x4*)((isv ? a.expert_v : a.expert_u) + (size_t)e * D) + 4 * F.lane;
            f32x4 v[4];
#pragma unroll
            for (int j = 0; j < 4; ++j) v[j] = src[j];
            if (isv) {
                float amax = 0.f;
#pragma unroll
                for (int j = 0; j < 4; ++j) amax = fmaxf(amax, fmaxf(fmaxf(fabsf(v[j].x), fabsf(v[j].y)), fmaxf(fabsf(v[j].z), fabsf(v[j].w))));
#pragma unroll
                for (int o = 1; o < 64; o <<= 1) amax = fmaxf(amax, __shfl_xor(amax, o));
                const float sc = amax > 0.f ? amax * (1.0f / 440.0f) : 1.0f, inv = 1.0f / sc;
                u32x4 o4; unsigned ow[4];
#pragma unroll
                for (int j = 0; j < 4; ++j) { int p = 0; p = __builtin_amdgcn_cvt_pk_fp8_f32(v[j].x * inv, v[j].y * inv, p, false); p = __builtin_amdgcn_cvt_pk_fp8_f32(v[j].z * inv, v[j].w * inv, p, true); ow[j] = (unsigned)p; }
                o4.x = ow[0]; o4.y = ow[1]; o4.z = ow[2]; o4.w = ow[3];
                *(u32x4*)(V8 + ((size_t)(F.lane >> 3) * (PK * PK) + e) * 128 + 16 * (F.lane & 7)) = o4; if (F.lane == 0) SV[e] = sc;
            } else {
                const f32x4* gr = (const f32x4*)a.g_ffn + 4 * F.lane;
#pragma unroll
                for (int j = 0; j < 4; ++j) v[j] = v[j] * gr[j];
                u32x4* ub = (u32x4*)((bf16_t*)(a.ws + WS_UB) + (size_t)e * D) + 2 * F.lane;
                u32x4 b0, b1; b0.x = pk2(v[0].x, v[0].y); b0.y = pk2(v[0].z, v[0].w); b0.z = pk2(v[1].x, v[1].y); b0.w = pk2(v[1].z, v[1].w); b1.x = pk2(v[2].x, v[2].y); b1.y = pk2(v[2].z, v[2].w); b1.z = pk2(v[3].x, v[3].y); b1.w = pk2(v[3].z, v[3].w);
                ub[0] = b0; ub[1] = b1;
            }
        }
    }
    const bf16_t* H2b = (const bf16_t*)(a.ws + WS_XN); float* RSTD = (float*)(a.ws + WS_RSTD);
    for (int m = gw; m < TR; m += NGW) {
        const u32x4* xr = (const u32x4*)(H2b + (size_t)m * D) + 2 * F.lane; const u32x4 p = xr[0], q = xr[1]; const unsigned w[8] = {p.x, p.y, p.z, p.w, q.x, q.y, q.z, q.w};
        float s = 0.f;
#pragma unroll
        for (int j = 0; j < 8; ++j) { const float lo = bflo(w[j]), hi = bfhi(w[j]); s += lo * lo + hi * hi; }
        s = wave_sum(s);
        if (F.lane == 0) RSTD[m] = 1.0f / sqrtf(s * (1.f / D) + EPS);
    }
}

__device__ __forceinline__ unsigned ord_bits(float f) { const unsigned u = __builtin_bit_cast(unsigned, f); return u ^ ((u >> 31) ? 0xffffffffu : 0x80000000u); }
__device__ __forceinline__ float ord_val(unsigned o) { const unsigned u = (o & 0x80000000u) ? (o ^ 0x80000000u) : ~o; return __builtin_bit_cast(float, u); }
__device__ __forceinline__ void cex_desc(unsigned& x, unsigned& y) { const unsigned hi = x > y ? x : y, lo = x > y ? y : x; x = hi; y = lo; }
__device__ __forceinline__ void sort16_desc(unsigned (&v)[16]) {
#pragma unroll
    for (int k = 2; k <= 16; k <<= 1)
#pragma unroll
        for (int j = k >> 1; j > 0; j >>= 1)
#pragma unroll
            for (int i = 0; i < 16; ++i) { const int l = i ^ j; if (l > i) { if ((i & k) == 0) cex_desc(v[i], v[l]); else cex_desc(v[l], v[i]); } }
}
__device__ __forceinline__ void bitonic_merge16_desc(unsigned (&v)[16]) {
#pragma unroll
    for (int j = 8; j > 0; j >>= 1)
#pragma unroll
        for (int i = 0; i < 16; ++i) { const int l = i ^ j; if (l > i) cex_desc(v[i], v[l]); }
}
__device__ __forceinline__ void top16_merge(unsigned (&T)[16], const unsigned (&B)[16]) {
#pragma unroll
    for (int i = 0; i < 16; ++i) T[i] = T[i] > B[15 - i] ? T[i] : B[15 - i];
    bitonic_merge16_desc(T);
}
__device__ __forceinline__ void p8_topk_mfma(const Frame& F, const Args& a) {
    const bf16_t* Q = (const bf16_t*)(a.ws + WS_Q); int* EIDX = (int*)(a.ws + WS_EIDX); float* GATE = (float*)(a.ws + WS_GATE);
    const int lane = F.lane, lr = lane & 31, hf = lane >> 5;
    for (int task = F.vcu; task < PH * (TR / 1024); task += F.G) {
        const int h = task % PH, rng = task / PH;
        __syncthreads();
        {
            const f32x4* kp = (const f32x4*)(a.sub_keys + (size_t)h * 2 * PK * 128);
            for (int i = F.tid; i < 2 * PK * 128 / 4; i += NTHREADS) { const f32x4 v = kp[i]; const int row = i >> 5, c4 = (i & 31) * 4;
                *(LAS u32x2*)(F.lds + (row * PITCH + c4) * 2) = (u32x2){pk2(v.x, v.y), pk2(v.z, v.w)}; }
        }
        __syncthreads();
        for (int tile = F.wave; tile < 16; tile += NWAVES) {
            const int t0 = rng * 1024 + tile * 64;
            unsigned L0[16], L1[16];
#pragma unroll
            for (int i = 0; i < 16; ++i) { L0[i] = 0u; L1[i] = 0u; }
#pragma unroll 1
            for (int s = 0; s < 2; ++s) {
                unsigned TA[16], R[16];
#pragma unroll
                for (int i = 0; i < 16; ++i) { TA[i] = 0u; R[i] = 0u; }
#pragma unroll 1
                for (int th = 0; th < 2; ++th) {
                    bf16x8 qf[8];
                    const bf16_t* qp = Q + (size_t)(t0 + 32 * th + lr) * PQ + h * 256 + s * 128 + 8 * hf;
#pragma unroll
                    for (int ks = 0; ks < 8; ++ks) qf[ks] = *(const bf16x8*)(qp + 16 * ks);
                    unsigned T[16];
#pragma unroll
                    for (int i = 0; i < 16; ++i) T[i] = 0u;
#pragma unroll 1
                    for (int kb = 0; kb < 4; ++kb) {
                        f32x16 acc;
#pragma unroll
                        for (int r = 0; r < 16; ++r) acc[r] = 0.f;
#pragma unroll
                        for (int ks = 0; ks < 8; ++ks) { const bf16x8 af = *(const LAS bf16x8*)(F.lds + ((s * PK + 32 * kb + lr) * PITCH + 16 * ks + 8 * hf) * 2); acc = mfma32(af, qf[ks], acc); }
                        unsigned B[16];
#pragma unroll
                        for (int r = 0; r < 16; ++r) { const int k = 32 * kb + 8 * (r >> 2) + 4 * hf + (r & 3); B[r] = (ord_bits(acc[r]) & ~127u) | (unsigned)(127 - k); }
                        sort16_desc(B);
                        top16_merge(T, B);
                    }
                    unsigned P[16];
#pragma unroll
                    for (int i = 0; i < 16; ++i) { unsigned lo2, hi2; swap32_self(T[i], lo2, hi2); P[i] = hf ? lo2 : hi2; }
                    top16_merge(T, P);
#pragma unroll
                    for (int i = 0; i < 16; ++i) { R[i] = hf ? T[i] : TA[i]; TA[i] = T[i]; }
                }
#pragma unroll
                for (int i = 0; i < 16; ++i) { L0[i] = L1[i]; L1[i] = R[i]; }
            }
            const int t = t0 + lane;
            unsigned T[16];
            const float v00 = ord_val(L0[0] & ~127u);
#pragma unroll
            for (int j = 0; j < 16; ++j) T[j] = (ord_bits(v00 + ord_val(L1[j] & ~127u)) & ~255u) | (unsigned)(255 - j);
#pragma unroll
            for (int i = 1; i < 16; ++i)
#pragma unroll
                for (int j = 0; j < 16; ++j) if ((i + 1) * (j + 1) <= 16) {
                    const float sum = ord_val(L0[i] & ~127u) + ord_val(L1[j] & ~127u);
                    unsigned e = (ord_bits(sum) & ~255u) | (unsigned)(255 - (i * 16 + j));
#pragma unroll
                    for (int k = 0; k < 16; ++k) { const unsigned hi = T[k] > e ? T[k] : e; e = T[k] > e ? e : T[k]; T[k] = hi; }
                }
            float best[16]; int eid[16];
#pragma unroll
            for (int k = 0; k < 16; ++k) {
                best[k] = ord_val(T[k] & ~255u); const int pos = 255 - (int)(T[k] & 255u), pi = pos >> 4, pj = pos & 15;
                unsigned a0 = 0u, a1 = 0u;
#pragma unroll
                for (int i = 0; i < 16; ++i) { a0 = (pi == i) ? L0[i] : a0; a1 = (pj == i) ? L1[i] : a1; }
                eid[k] = (127 - (int)(a0 & 127u)) * PK + (127 - (int)(a1 & 127u));
            }
            const float rst = ((const float*)(a.ws + WS_RSTD))[t];
            float se = 0.f, ex[16];
#pragma unroll
            for (int k = 0; k < 16; ++k) { ex[k] = __expf((best[k] - best[0]) * rst); se += ex[k]; }
            const float inv = 1.f / se;
            int* ep = EIDX + (size_t)t * 128 + h * 16; float* gp = GATE + (size_t)t * 128 + h * 16;
#pragma unroll
            for (int k = 0; k < 16; k += 4) { *(int4*)(ep + k) = make_int4(eid[k], eid[k + 1], eid[k + 2], eid[k + 3]); *(f32x4*)(gp + k) = (f32x4){ex[k] * inv, ex[k + 1] * inv, ex[k + 2] * inv, ex[k + 3] * inv}; }
        }
    }
}

typedef __bf16 bf16x2_t __attribute__((ext_vector_type(2)));
__device__ __forceinline__ float dot2bf(unsigned w, unsigned x, float acc) { return __builtin_amdgcn_fdot2_f32_bf16(__builtin_bit_cast(bf16x2_t, w), __builtin_bit_cast(bf16x2_t, x), acc, false); }

__device__ __forceinline__ float shx32(float x, int lane) { unsigned a, b; swap32_self(__builtin_bit_cast(unsigned, x), a, b); return __builtin_bit_cast(float, (lane & 32) ? a : b); }
__device__ __forceinline__ float shx16(float x, int lane) { unsigned a, b; swap16_self(__builtin_bit_cast(unsigned, x), a, b); return __builtin_bit_cast(float, (lane & 16) ? a : b); }
template <int CTRL> __device__ __forceinline__ float dppf(float x) { return __builtin_bit_cast(float, __builtin_amdgcn_update_dpp(0, __builtin_bit_cast(int, x), CTRL, 0xF, 0xF, true)); }
__device__ __forceinline__ float shx8(float x) { return dppf<0x128>(x); }
__device__ __forceinline__ float shx4(float x, int) { return dppf<0x1B>(dppf<0x141>(x)); }

__device__ __forceinline__ float gelu_as(float v) {
    const float av = __builtin_fabsf(v), t = __builtin_amdgcn_rcpf(av * 0.2316418882f + 1.0f);
    float q = t * 0.5307027145f + (-0.7265760135f); q = q * t + 0.7107068705f; q = q * t + (-0.142248368f); q = q * t + 0.127414796f; q = q * t;
    const float e = __builtin_amdgcn_exp2f((v * v) * (-0.72134752044f));
    const float m = v * (q * e);
    return v < 0.f ? m : v - m;
}
__device__ __forceinline__ int rdlane(int v, int l) { return __builtin_amdgcn_readlane(v, l); }
__device__ __forceinline__ float rdlanef(float v, int l) { return __builtin_bit_cast(float, __builtin_amdgcn_readlane(__builtin_bit_cast(int, v), l)); }

struct PeerBatch { int l0, l1, l2, l3; u32x4 r[4][2]; };
__device__ __forceinline__ void peerA_take(unsigned long long& m, PeerBatch& B, const bf16_t* Ub, int lane, int ev) {
    B.l0 = __builtin_ctzll(m); m &= m - 1; B.l1 = B.l0; B.l2 = B.l0; B.l3 = B.l0;
    if (m) { B.l1 = __builtin_ctzll(m); m &= m - 1; if (m) { B.l2 = __builtin_ctzll(m); m &= m - 1; if (m) { B.l3 = __builtin_ctzll(m); m &= m - 1; } } }
    const int e0 = rdlane(ev, B.l0), e1 = rdlane(ev, B.l1), e2 = rdlane(ev, B.l2), e3 = rdlane(ev, B.l3);
    const u32x4* r0 = (const u32x4*)(Ub + (size_t)e0 * D) + 2 * lane; const u32x4* r1 = (const u32x4*)(Ub + (size_t)e1 * D) + 2 * lane;
    const u32x4* r2 = (const u32x4*)(Ub + (size_t)e2 * D) + 2 * lane; const u32x4* r3 = (const u32x4*)(Ub + (size_t)e3 * D) + 2 * lane;
    B.r[0][0] = r0[0]; B.r[0][1] = r0[1]; B.r[1][0] = r1[0]; B.r[1][1] = r1[1]; B.r[2][0] = r2[0]; B.r[2][1] = r2[1]; B.r[3][0] = r3[0]; B.r[3][1] = r3[1];
}
__device__ __forceinline__ void peerA_finish(const PeerBatch& B, int lane, int& agv, const unsigned (&xp)[8], float rs) {
#define DOT16(lo, hi) (dot2bf((hi).w, xp[7], dot2bf((hi).z, xp[6], dot2bf((hi).y, xp[5], dot2bf((hi).x, xp[4], 0.f)))) + dot2bf((lo).w, xp[3], dot2bf((lo).z, xp[2], dot2bf((lo).y, xp[1], dot2bf((lo).x, xp[0], 0.f)))))
    const float p0 = DOT16(B.r[0][0], B.r[0][1]), p1 = DOT16(B.r[1][0], B.r[1][1]), p2 = DOT16(B.r[2][0], B.r[2][1]), p3 = DOT16(B.r[3][0], B.r[3][1]);
#undef DOT16
    const bool hi5 = lane & 32, hi4 = lane & 16;
    const float k0 = hi5 ? p2 : p0, s0 = hi5 ? p0 : p2, k1 = hi5 ? p3 : p1, s1 = hi5 ? p1 : p3;
    const float t0 = k0 + shx32(s0, lane), t1 = k1 + shx32(s1, lane);
    const float k2 = hi4 ? t1 : t0, s2 = hi4 ? t0 : t1;
    const float d = row_sum16(k2 + shx16(s2, lane));
    const float agf = __builtin_bit_cast(float, agv);
    const float g0 = rdlanef(agf, B.l0), g1 = rdlanef(agf, B.l1), g2 = rdlanef(agf, B.l2), g3 = rdlanef(agf, B.l3);
    const float gq = hi5 ? (hi4 ? g3 : g2) : (hi4 ? g1 : g0);
    const int ai = __builtin_bit_cast(int, gelu_as(d * rs) * gq);
    const int w0 = rdlane(ai, 0), w1 = rdlane(ai, 16), w2 = rdlane(ai, 32), w3 = rdlane(ai, 48);
    agv = lane == B.l0 ? w0 : agv; agv = lane == B.l1 ? w1 : agv; agv = lane == B.l2 ? w2 : agv; agv = lane == B.l3 ? w3 : agv;
}
struct PeerGather8 { u32x4 vv[16]; float aw[16]; };
__device__ __forceinline__ void peerB8_gather(PeerGather8& G, const unsigned char* V8, int lane, int cs, const LAS int* ELt, const LAS float* ALt) {
    const int rg = lane >> 3, cl = lane & 7;
#pragma unroll
    for (int j = 0; j < 16; ++j) { const int e = ELt[8 * j + rg]; G.aw[j] = ALt[8 * j + rg];
        G.vv[j] = *(const u32x4*)(V8 + (((unsigned)(cs * PK * PK) + (unsigned)e) * 128u + (unsigned)(cl * 16))); }
}
__device__ __forceinline__ f32x2 peerB8_reduce(const PeerGather8& G, int lane) {
    f32x2 acc[8];
#pragma unroll
    for (int c = 0; c < 8; ++c) acc[c] = (f32x2){0.f, 0.f};
#pragma unroll
    for (int j = 0; j < 16; ++j) { const unsigned ww[4] = {G.vv[j].x, G.vv[j].y, G.vv[j].z, G.vv[j].w}; const f32x2 a2 = (f32x2){G.aw[j], G.aw[j]};
#pragma unroll
        for (int m = 0; m < 4; ++m) { acc[2 * m] += __builtin_amdgcn_cvt_pk_f32_fp8(ww[m], false) * a2; acc[2 * m + 1] += __builtin_amdgcn_cvt_pk_f32_fp8(ww[m], true) * a2; } }
    const bool b5 = lane & 32, b4 = lane & 16, b3 = lane & 8;
    f32x2 v4[4], v2[2];
#pragma unroll
    for (int c = 0; c < 4; ++c) { const f32x2 keep = b5 ? acc[c + 4] : acc[c], send = b5 ? acc[c] : acc[c + 4]; v4[c] = keep + (f32x2){shx32(send.x, lane), shx32(send.y, lane)}; }
#pragma unroll
    for (int c = 0; c < 2; ++c) { const f32x2 keep = b4 ? v4[c + 2] : v4[c], send = b4 ? v4[c] : v4[c + 2]; v2[c] = keep + (f32x2){shx16(send.x, lane), shx16(send.y, lane)}; }
    const f32x2 keep = b3 ? v2[1] : v2[0], send = b3 ? v2[0] : v2[1];
    return keep + (f32x2){shx8(send.x), shx8(send.y)};
}
#ifndef HSHIFT
#define HSHIFT 11
#endif
__device__ __forceinline__ void peerA_token2(const bf16_t* Ub, int lane, int s, int e0lo, int e0hi, int& a0lo, int& a0hi, const unsigned (&xp0)[8], float rs0,
                                             int e1lo, int e1hi, int& a1lo, int& a1hi, const unsigned (&xp1)[8], float rs1) {
    unsigned long long m0 = __ballot((e0lo >> HSHIFT) == s), m1 = __ballot((e0hi >> HSHIFT) == s), m2 = __ballot((e1lo >> HSHIFT) == s), m3 = __ballot((e1hi >> HSHIFT) == s);
    while (m0 | m1 | m2 | m3) {
        const bool h0 = m0 != 0ull, h1 = m1 != 0ull, h2 = m2 != 0ull, h3 = m3 != 0ull;
        PeerBatch B0, B1, B2, B3;
        if (h0) peerA_take(m0, B0, Ub, lane, e0lo);
        if (h1) peerA_take(m1, B1, Ub, lane, e0hi);
        if (h2) peerA_take(m2, B2, Ub, lane, e1lo);
        if (h3) peerA_take(m3, B3, Ub, lane, e1hi);
        if (h0) peerA_finish(B0, lane, a0lo, xp0, rs0);
        if (h1) peerA_finish(B1, lane, a0hi, xp0, rs0);
        if (h2) peerA_finish(B2, lane, a1lo, xp1, rs1);
        if (h3) peerA_finish(B3, lane, a1hi, xp1, rs1);
    }
}
__device__ __forceinline__ void p9_peer_hybrid(const Frame& F, const Args& a, float* dst) {
    const int* EIDX = (const int*)(a.ws + WS_EIDX); const float* GATE = (const float*)(a.ws + WS_GATE); const float* RSTD = (const float*)(a.ws + WS_RSTD);
    const bf16_t* Ub = (const bf16_t*)(a.ws + WS_UB); const unsigned char* V8 = a.ws + WS_V8; const float* SV = (const float*)(a.ws + WS_SV);
    bf16_t* H2b = (bf16_t*)(a.ws + WS_XN);
    const int gw = F.vcu * NWAVES + F.wave, lane = F.lane, tokb = gw * 16;
    LAS int* EL = (LAS int*)(F.lds + F.wave * 16384); LAS float* AL = (LAS float*)(F.lds + F.wave * 16384 + 8192);
#pragma unroll 4
    for (int ti = 0; ti < 16; ++ti) { const size_t o = (size_t)(tokb + ti) * 128;
        EL[ti * 128 + lane] = EIDX[o + lane]; EL[ti * 128 + 64 + lane] = EIDX[o + 64 + lane]; AL[ti * 128 + lane] = GATE[o + lane]; AL[ti * 128 + 64 + lane] = GATE[o + 64 + lane]; }
    const float myrs = RSTD[tokb + (lane & 15)];
#pragma unroll 1
    for (int s = 0; s < (16384 >> HSHIFT); ++s) {
#pragma unroll 1
        for (int i = 0; i < 16; i += 2) { const int o = i * 128;
            const u32x4* x0 = (const u32x4*)(H2b + (size_t)(tokb + i) * D) + 2 * lane; const u32x4* x1 = x0 + D / 8;
            const u32x4 xa = x0[0], xb = x0[1], xc = x1[0], xd = x1[1];
            const unsigned xp0[8] = {xa.x, xa.y, xa.z, xa.w, xb.x, xb.y, xb.z, xb.w}, xp1[8] = {xc.x, xc.y, xc.z, xc.w, xd.x, xd.y, xd.z, xd.w};
            const float rs0 = rdlanef(myrs, i), rs1 = rdlanef(myrs, i + 1);
            const int e0lo = EL[o + lane], e0hi = EL[o + 64 + lane], e1lo = EL[o + 128 + lane], e1hi = EL[o + 192 + lane];
            int a0lo = __builtin_bit_cast(int, AL[o + lane]), a0hi = __builtin_bit_cast(int, AL[o + 64 + lane]), a1lo = __builtin_bit_cast(int, AL[o + 128 + lane]), a1hi = __builtin_bit_cast(int, AL[o + 192 + lane]);
            peerA_token2(Ub, lane, s, e0lo, e0hi, a0lo, a0hi, xp0, rs0, e1lo, e1hi, a1lo, a1hi, xp1, rs1);
            AL[o + lane] = __builtin_bit_cast(float, a0lo); AL[o + 64 + lane] = __builtin_bit_cast(float, a0hi); AL[o + 128 + lane] = __builtin_bit_cast(float, a1lo); AL[o + 192 + lane] = __builtin_bit_cast(float, a1hi); }
    }
#pragma unroll 4
    for (int ti = 0; ti < 16; ++ti) { AL[ti * 128 + lane] *= SV[EL[ti * 128 + lane]]; AL[ti * 128 + 64 + lane] *= SV[EL[ti * 128 + 64 + lane]]; }
    const int col = 16 * (lane & 7) + ((lane >> 5) & 1) * 8 + ((lane >> 4) & 1) * 4 + ((lane >> 3) & 1) * 2;
#pragma unroll 1
    for (int cs = 0; cs < 8; ++cs) {
        PeerGather8 G0, G1;
        peerB8_gather(G0, V8, lane, cs, EL, AL);
#pragma unroll 1
        for (int ti = 0; ti < 16; ti += 2) {
            unsigned* hp0 = (unsigned*)(H2b + (size_t)(tokb + ti) * D + cs * 128 + col); unsigned* hp1 = hp0 + D / 2; const unsigned h0 = *hp0, h1 = *hp1;
            peerB8_gather(G1, V8, lane, cs, EL + (ti + 1) * 128, AL + (ti + 1) * 128);
            { const f32x2 r = peerB8_reduce(G0, lane); *hp0 = pk2(bflo(h0) + r.x, bfhi(h0) + r.y); }
            if (ti + 2 < 16) peerB8_gather(G0, V8, lane, cs, EL + (ti + 2) * 128, AL + (ti + 2) * 128);
            { const f32x2 r = peerB8_reduce(G1, lane); *hp1 = pk2(bflo(h1) + r.x, bfhi(h1) + r.y); }
        }
    }
    asm volatile("s_waitcnt vmcnt(0)" ::: "memory");
    __builtin_amdgcn_fence(__ATOMIC_RELEASE, "workgroup"); __builtin_amdgcn_fence(__ATOMIC_ACQUIRE, "workgroup");
#pragma unroll 2
    for (int ti = 0; ti < 16; ++ti) {
        const u32x4* hr = (const u32x4*)(H2b + (size_t)(tokb + ti) * D) + 2 * lane; f32x4* orow = (f32x4*)(dst + (size_t)(tokb + ti) * D) + 4 * lane; const f32x4* gf = (const f32x4*)a.g_final + 4 * lane;
        const u32x4 p = hr[0], q = hr[1]; const unsigned w[8] = {p.x, p.y, p.z, p.w, q.x, q.y, q.z, q.w};
        float hv[16]; float s2 = 0.f;
#pragma unroll
        for (int j = 0; j < 8; ++j) { hv[2 * j] = bflo(w[j]); hv[2 * j + 1] = bfhi(w[j]); s2 += hv[2 * j] * hv[2 * j] + hv[2 * j + 1] * hv[2 * j + 1]; }
        const float rstd2 = 1.0f / sqrtf(wave_sum(s2) * (1.f / D) + EPS);
#pragma unroll
        for (int j = 0; j < 4; ++j) { const f32x4 g4 = gf[j]; orow[j] = (f32x4){hv[4 * j] * rstd2 * g4.x, hv[4 * j + 1] * rstd2 * g4.y, hv[4 * j + 2] * rstd2 * g4.z, hv[4 * j + 3] * rstd2 * g4.w}; }
    }
}

__global__ void __launch_bounds__(NTHREADS, 2) fwd(Args a) {
    extern __shared__ __attribute__((aligned(16))) unsigned char lds[];
    Frame F; F.lds = (LAS unsigned char*)lds; F.tid = threadIdx.x; F.lane = F.tid & 63; F.wave = __builtin_amdgcn_readfirstlane(F.tid >> 6);
    F.G = gridDim.x; { const int bx = blockIdx.x; F.vcu = (F.G % 8 == 0) ? (bx % 8) * (F.G / 8) + bx / 8 : bx; }
    volatile LAS unsigned* MISC = (volatile LAS unsigned*)(F.lds + LDSCTL_OFF);
    for (int u = F.tid; u < (LDS_BYTES - LDSCTL_OFF) / 4; u += NTHREADS) ((LAS unsigned*)(F.lds + LDSCTL_OFF))[u] = 0u;
    __syncthreads();
    XcdBarrier bar; bar.bar = (unsigned*)(a.ws + WS_CTL) + CW_BAR; bar.x = 0; bar.st = nullptr;
    if (N_LAUNCHES == 1) bar = xcd_barrier_post((unsigned*)(a.ws + WS_CTL) + CW_BAR, MISC + 8);
    const int lo = a.ph_lo, hi = a.ph_hi;
#ifndef PHASE_MASK
#define PHASE_MASK 0xFFFF
#endif
#define IN(k) (((PHASE_MASK >> (k)) & 1) && lo <= (k) && (k) < hi)
#define GEMM_CALL(EPI) pg8::gemm_phase<EPI, pg8::StaticOrder, true, true>(F.lds, g, S, E)
#define SEAM(k) do { if (IN(k) && IN((k) + 1)) xcd_barrier(bar); } while (0)
    bf16_t* PROJ = (bf16_t*)(a.ws + WS_PROJ);
#ifndef PROBE_REP
#define PROBE_REP 0
#endif
#define REPK(k) ((PROBE_REP >> (k)) & 1)
#define GEMM_P1 { pg8::Gemm g{(const bf16_t*)(a.ws + WS_XN), (const bf16_t*)(a.ws + WS_WIN), ROWS_A, LDP, D, D, D}; pg8::StaticOrder S; S.init(ROWS_A, LDP, F.G, (int)blockIdx.x); pg8::EpiPanels E{PROJ}; GEMM_CALL(pg8::EpiPanels); }
#define GEMM_P5 { pg8::Gemm g{PROJ + ZS_OFF, (const bf16_t*)(a.ws + WS_WOUT), TR, D, D_MIX, P_ZS, D_MIX}; pg8::StaticOrder S; S.init(TR, D, F.G, (int)blockIdx.x); pg8::EpiResBf16 E{a.x, (bf16_t*)(a.ws + WS_XN), D}; GEMM_CALL(pg8::EpiResBf16); }
#define GEMM_P7 { pg8::Gemm g{(const bf16_t*)(a.ws + WS_XN), (const bf16_t*)(a.ws + WS_WQ), TR, PQ, D, D, D}; pg8::StaticOrder S; S.init(TR, PQ, F.G, (int)blockIdx.x); pg8::EpiBf16 E{(bf16_t*)(a.ws + WS_Q), PQ}; GEMM_CALL(pg8::EpiBf16); }
    if (IN(0)) { if (REPK(0)) p0_prologue(F, a); p0_prologue(F, a); } SEAM(0);
    if (IN(1)) { if (REPK(1)) GEMM_P1 GEMM_P1 } SEAM(1);
    if (IN(2)) { if (REPK(2)) p2_ssd_states(F, a, true); p2_ssd_states(F, a, false); } SEAM(2);
    if (IN(3)) { p3_ssd_recur(F, a); } SEAM(3);
    if (IN(4)) { if (REPK(4)) p4_ssd_out<true>(F, a); p4_ssd_out<false>(F, a); } SEAM(4);
    if (IN(5)) { if (REPK(5)) GEMM_P5 GEMM_P5 } SEAM(5);
    if (IN(6)) { if (REPK(6)) p5_norm2(F, a); p5_norm2(F, a); } SEAM(6);
    if (IN(7)) { if (REPK(7)) GEMM_P7 GEMM_P7 } SEAM(7);
    if (IN(8)) { if (REPK(8)) p8_topk_mfma(F, a); p8_topk_mfma(F, a); } SEAM(8);
    if (IN(9)) { p9_peer_hybrid(F, a, a.out); }
#undef IN
#undef SEAM
}

extern "C" void kernel_launch(void* const* d_in, const int* in_sizes, int n_in, void* d_out, int out_size, void* d_ws, size_t ws_size, hipStream_t stream) {
    static int grid = 0;
    if (grid == 0) {
        if (n_in != 18 || out_size != TR * D || ws_size < WS_END) { fprintf(stderr, "kernel_launch: unexpected problem (n_in %d out %d ws %zu)\n", n_in, out_size, ws_size); grid = -1; return; }
        int dev = 0, cus = 0, per_cu = 0;
        if (hipGetDevice(&dev) != hipSuccess || hipDeviceGetAttribute(&cus, hipDeviceAttributeMultiprocessorCount, dev) != hipSuccess) { grid = -1; return; }
        if (hipFuncSetAttribute((const void*)fwd, hipFuncAttributeMaxDynamicSharedMemorySize, LDS_BYTES) != hipSuccess) { fprintf(stderr, "kernel_launch: hipFuncSetAttribute failed\n"); grid = -1; return; }
        if (hipOccupancyMaxActiveBlocksPerMultiprocessor(&per_cu, (const void*)fwd, NTHREADS, LDS_BYTES) != hipSuccess || per_cu < 1) fprintf(stderr, "kernel_launch: occupancy query says %d\n", per_cu);
        (void)hipGetLastError();
        grid = cus;
        if (grid * NWAVES * 16 != TR) { fprintf(stderr, "kernel_launch: built for 256 CUs (the expert phase deals 16 tokens to each of 2048 waves); this device has %d; nothing launched\n", cus); grid = -1; return; }
    }
    if (grid < 0) return;
    if (hipMemsetAsync((char*)d_ws + WS_CTL, 0, CTL_ZERO_BYTES, stream) != hipSuccess) return;
    Args a{};
    a.x = (const float*)d_in[0]; a.meta = (const float*)d_in[1]; a.g_mix = (const float*)d_in[2]; a.w_in = (const float*)d_in[3]; a.conv_ssd_w = (const float*)d_in[4]; a.conv_ssd_b = (const float*)d_in[5];
    a.dt_bias = (const float*)d_in[6]; a.a_log = (const float*)d_in[7]; a.d_skip = (const float*)d_in[8]; a.ssd_norm_w = (const float*)d_in[9]; a.conv_sc_w = (const float*)d_in[10]; a.w_out = (const float*)d_in[11];
    a.g_ffn = (const float*)d_in[12]; a.w_q = (const float*)d_in[13]; a.sub_keys = (const float*)d_in[14]; a.expert_u = (const float*)d_in[15]; a.expert_v = (const float*)d_in[16]; a.g_final = (const float*)d_in[17];
    a.out = (float*)d_out; a.ws = (unsigned char*)d_ws;
    if (N_LAUNCHES == 1) { a.ph_lo = 0; a.ph_hi = NPHASE; hipLaunchKernelGGL(fwd, dim3(grid), dim3(NTHREADS), LDS_BYTES, stream, a); }
    else for (int p = 0; p < NPHASE; ++p) { a.ph_lo = p; a.ph_hi = p + 1; hipLaunchKernelGGL(fwd, dim3(grid), dim3(NTHREADS), LDS_BYTES, stream, a); }
}
```

```cpp
#include <hip/hip_runtime.h>
#include <cstdio>
#include <cstdint>

#define GAS __attribute__((address_space(1)))
#define LAS __attribute__((address_space(3)))
typedef unsigned short bf16_t;
typedef short bf16x8 __attribute__((ext_vector_type(8)));
typedef float f32x4 __attribute__((ext_vector_type(4)));
typedef float f32x2 __attribute__((ext_vector_type(2)));
typedef unsigned u32x4 __attribute__((ext_vector_type(4)));
typedef unsigned u32x2 __attribute__((ext_vector_type(2)));

constexpr int D = 1024, BATCH = 16, SEQ = 2048, NMETA = 16, LSEQ = SEQ + NMETA;
constexpr int TR = BATCH * SEQ;
constexpr int ROWS_A = 33024;
constexpr int D_SSD = 1536, HEADS = 24, HD = 64, NG = 4, NS = 128, D_XBC = 2560, D_SC = 512, D_IN = 5656, D_MIX = 2048;
constexpr int LDP = 5888;
constexpr int C_Z = 0, C_SCB = 1536, C_XBC = 2048, C_SCC = 4608, C_SCX = 5120, C_DT = 5632;
constexpr int P_ZS = 2048, P_XG = 640, P_SC = 1024, P_DT = 32;
constexpr size_t ZS_OFF = 0, XG_OFF = (size_t)ROWS_A * P_ZS, XG_STRIDE = (size_t)ROWS_A * P_XG, SC_OFF = XG_OFF + 4 * XG_STRIDE, DT_OFF = SC_OFF + (size_t)ROWS_A * P_SC, PANELS_END = DT_OFF + (size_t)ROWS_A * P_DT;
static_assert(PANELS_END <= (size_t)ROWS_A * LDP, "panels fit the PROJ region");
__host__ __device__ __forceinline__ size_t proj_dst(int j, int& pitch) {
    if (j < 2048) { pitch = P_ZS; return ZS_OFF + j; }
    if (j < 4608) { const int ch = j - 2048; pitch = P_XG;
        if (ch < 1536) { const int g = ch / 384; return XG_OFF + g * XG_STRIDE + (ch - 384 * g); }
        if (ch < 2048) { const int r = ch - 1536; return XG_OFF + (r >> 7) * XG_STRIDE + 384 + (r & 127); }
        const int r = ch - 2048; return XG_OFF + (r >> 7) * XG_STRIDE + 512 + (r & 127); }
    if (j < 5632) { pitch = P_SC; return SC_OFF + (j - 4608); }
    if (j < 5664) { pitch = P_DT; return DT_OFF + (j - 5632); }
    pitch = 0; return 0;
}
constexpr int PH = 8, PK = 128, PTOP = 16, PQ = 2048;
constexpr float EPS = 1e-6f;

__host__ __device__ constexpr int proj_src_col(int j) {
    return j < 1536 ? j : j < 2048 ? 4120 + (j - 1536) : j < 4608 ? 1536 + (j - 2048) : j < 5120 ? 4632 + (j - 4608) : j < 5632 ? 5144 + (j - 5120) : j < 5656 ? 4096 + (j - 5632) : -1;
}

constexpr size_t MiB = 1u << 20;
constexpr size_t WS_CTL = 0, CTL_ZERO_BYTES = 1 * MiB;
constexpr size_t WS_WIN = 1 * MiB;
constexpr size_t WS_WOUT = 13 * MiB;
constexpr size_t WS_WQ = 17 * MiB;
constexpr size_t WS_XN = 22 * MiB;
constexpr size_t WS_PROJ = 88 * MiB;
constexpr size_t WS_Q = WS_PROJ;
constexpr size_t WS_EIDX = WS_PROJ + 128 * MiB;
constexpr size_t WS_GATE = WS_PROJ + 144 * MiB;
constexpr size_t WS_UB = WS_PROJ + 160 * MiB;
constexpr size_t WS_V8 = WS_PROJ + 192 * MiB;
constexpr size_t WS_SV = WS_PROJ + 224 * MiB + 65536;
constexpr size_t WS_RSTD = WS_PROJ + 225 * MiB;
constexpr size_t WS_END = WS_PROJ + (size_t)ROWS_A * LDP * 2;
static_assert(WS_RSTD + (1u << 20) <= WS_END, "ws map");
static_assert(WS_XN + (size_t)ROWS_A * D * 2 <= WS_PROJ, "ws map");
static_assert(WS_END <= 512 * MiB, "ws map");

typedef __bf16 bf16x2h_t __attribute__((ext_vector_type(2)));
__device__ __forceinline__ unsigned f2bf(float f) { return (unsigned)__builtin_bit_cast(unsigned short, (__bf16)f); }
__device__ __forceinline__ unsigned pk2(float lo, float hi) { bf16x2h_t v; v.x = (__bf16)lo; v.y = (__bf16)hi; return __builtin_bit_cast(unsigned, v); }
__device__ __forceinline__ float bf2f(unsigned short b) { return __builtin_bit_cast(float, ((unsigned)b) << 16); }
__device__ __forceinline__ float bflo(unsigned w) { return __builtin_bit_cast(float, w << 16); }
__device__ __forceinline__ float bfhi(unsigned w) { return __builtin_bit_cast(float, w & 0xffff0000u); }
template <int CTRL> __device__ __forceinline__ float dppf0(float x) { return __builtin_bit_cast(float, __builtin_amdgcn_update_dpp(0, __builtin_bit_cast(int, x), CTRL, 0xF, 0xF, true)); }
__device__ __forceinline__ void swap32_self(unsigned u, unsigned& lo_lo, unsigned& hi_hi) { unsigned u2 = u; asm volatile("" : "+v"(u2)); auto r = __builtin_amdgcn_permlane32_swap(u, u2, false, false); lo_lo = r[0]; hi_hi = r[1]; }
__device__ __forceinline__ void swap16_self(unsigned u, unsigned& even2, unsigned& odd2) { unsigned u2 = u; asm volatile("" : "+v"(u2)); auto r = __builtin_amdgcn_permlane16_swap(u, u2, false, false); even2 = r[0]; odd2 = r[1]; }
__device__ __forceinline__ float wave_sum(float v) {
    v += dppf0<0xB1>(v); v += dppf0<0x4E>(v); v += dppf0<0x141>(v); v += dppf0<0x140>(v);
    unsigned p, q; swap16_self(__builtin_bit_cast(unsigned, v), p, q); v = __builtin_bit_cast(float, p) + __builtin_bit_cast(float, q);
    swap32_self(__builtin_bit_cast(unsigned, v), p, q); v = __builtin_bit_cast(float, p) + __builtin_bit_cast(float, q);
    return v;
}
__device__ __forceinline__ float row_sum16(float x) { x += dppf0<0xB1>(x); x += dppf0<0x4E>(x); x += dppf0<0x141>(x); x += dppf0<0x140>(x); return x; }
__device__ __forceinline__ int row_of(int b, int pos) { return pos < NMETA ? TR + pos : b * SEQ + (pos - NMETA); }

namespace pg8 {
#define PG8_LAS __attribute__((address_space(3)))
constexpr int BM = 256, BK = 64, HALF = 128, HTB = HALF * BK * 2  , STAGE_BYTES = 8 * HTB, NXCD = 8, WGM = 8;
__host__ __device__ __forceinline__ int perm32(int rho) { const int n = rho >> 4, i = rho & 15; return 8 * (i >> 2) + 4 * n + (i & 3); }
__host__ __device__ __forceinline__ int lds_byte(int r, int c) { const int st = (r >> 4) * 2 + (c >> 5), rr = r & 15, cc = c & 31, ob = rr * 64 + cc * 2; return st * 1024 + (ob ^ (((ob >> 9) & 1) << 5)); }
__host__ __device__ __forceinline__ void stage_rc(int b, int& R, int& C) { const int st = b / 1024, sb = b % 1024, swz = sb ^ (((sb >> 9) & 1) << 5); R = (st >> 1) * 16 + swz / 64; C = (st & 1) * 32 + (swz % 64) / 2; }
struct Unit { int pm, pn; };
struct Gemm { const bf16_t* A; const bf16_t* Bt; int M, N, K, lda, ldb; };
struct StaticOrder {
    int nM, nN, nwg, G, c;
    __host__ __device__ void init(int M, int N, int G_, int c_) { nM = M / BM; nN = N / BM; nwg = nM * nN; G = G_; c = c_; }
    __host__ __device__ bool next(int i, Unit& u) const {
        const long L = (long)i * G + c; if (L >= nwg) return false;
        int wgid = (int)L; { const int q = nwg / NXCD, r = nwg % NXCD, xcd = wgid % NXCD, off = wgid / NXCD; wgid = (xcd < r ? xcd * (q + 1) : r * (q + 1) + (xcd - r) * q) + off; }
        const int nig = WGM * nN, gid = wgid / nig, fm = gid * WGM, gsz = (nM - fm) < WGM ? (nM - fm) : WGM;
        u.pm = fm + ((wgid % nig) % gsz); u.pn = (wgid % nig) / gsz; return true;
    }
    __device__ __forceinline__ void a_ready(const Unit&) const {}
    __device__ __forceinline__ void done(const Unit&) const {}
};
struct EpiBf16 {
    static constexpr bool PERM = true, AFTER_DRAIN = false;
    bf16_t* O; int ldc;
    __device__ __forceinline__ void operator()(const f32x4 (&acc)[2][2][4][2], const Unit& u, int wr, int wc, int fr, int fq) const {
        const int row0 = u.pm * BM + wr * 64 + fr, col0 = u.pn * BM + wc * 32 + 8 * fq;
#pragma unroll
        for (int ai = 0; ai < 2; ++ai)
#pragma unroll
            for (int m = 0; m < 4; ++m) { bf16_t* rowp = O + (size_t)(row0 + ai * HALF + m * 16) * ldc + col0;
#pragma unroll
                for (int bj = 0; bj < 2; ++bj) { const f32x4 v0 = acc[ai][bj][m][0], v1 = acc[ai][bj][m][1];
                    u32x4 w; w.x = pk2(v0[0], v0[1]); w.y = pk2(v0[2], v0[3]); w.z = pk2(v1[0], v1[1]); w.w = pk2(v1[2], v1[3]);
                    *(u32x4*)(rowp + bj * HALF) = w; } }
    }
};
struct EpiPanels {
    static constexpr bool PERM = true, AFTER_DRAIN = false;
    bf16_t* P;
    __device__ __forceinline__ void operator()(const f32x4 (&acc)[2][2][4][2], const Unit& u, int wr, int wc, int fr, int fq) const {
        const int row0 = u.pm * BM + wr * 64 + fr, col0 = u.pn * BM + wc * 32 + 8 * fq;
#pragma unroll
        for (int bj = 0; bj < 2; ++bj) { int pitch; const size_t off = proj_dst(col0 + bj * HALF, pitch); if (pitch == 0) continue;
#pragma unroll
            for (int ai = 0; ai < 2; ++ai)
#pragma unroll
                for (int m = 0; m < 4; ++m) { const f32x4 v0 = acc[ai][bj][m][0], v1 = acc[ai][bj][m][1];
                    u32x4 w; w.x = pk2(v0[0], v0[1]); w.y = pk2(v0[2], v0[3]); w.z = pk2(v1[0], v1[1]); w.w = pk2(v1[2], v1[3]);
                    *(u32x4*)(P + off + (size_t)(row0 + ai * HALF + m * 16) * pitch) = w; } }
    }
};
struct EpiResBf16 {
    static constexpr bool PERM = true, AFTER_DRAIN = false;
    const float* base; bf16_t* O; int ldc;
    __device__ __forceinline__ void operator()(const f32x4 (&acc)[2][2][4][2], const Unit& u, int wr, int wc, int fr, int fq) const {
        const int row0 = u.pm * BM + wr * 64 + fr, col0 = u.pn * BM + wc * 32 + 8 * fq;
#pragma unroll
        for (int ai = 0; ai < 2; ++ai)
#pragma unroll
            for (int m = 0; m < 4; ++m) { const size_t off = (size_t)(row0 + ai * HALF + m * 16) * ldc + col0;
#pragma unroll
                for (int bj = 0; bj < 2; ++bj) { const f32x4 b0 = *(const f32x4*)(base + off + bj * HALF), b1 = *(const f32x4*)(base + off + bj * HALF + 4);
                    const f32x4 v0 = acc[ai][bj][m][0] + b0, v1 = acc[ai][bj][m][1] + b1;
                    u32x4 w; w.x = pk2(v0[0], v0[1]); w.y = pk2(v0[2], v0[3]); w.z = pk2(v1[0], v1[1]); w.w = pk2(v1[2], v1[3]);
                    *(u32x4*)(O + off + bj * HALF) = w; } }
    }
};
template <class Epi, class Sched, bool ALIGN_EPI = false, bool SP2 = false>
__device__ __forceinline__ void gemm_phase(PG8_LAS unsigned char* lds, const Gemm g, const Sched& S, const Epi& E) {
    const int tid = threadIdx.x, wid = __builtin_amdgcn_readfirstlane(tid >> 6), lane = tid & 63, wr = wid >> 2, wc = wid & 3, fr = lane & 15, fq = lane >> 4;
    const int K = g.K, nt = K / BK;
    unsigned voffA[2], voffB[2];
#pragma unroll
    for (int i = 0; i < 2; ++i) { int R, C; stage_rc(tid * 16 + i * 8192, R, C); const int Rb = Epi::PERM ? ((R & ~31) + perm32(R & 31)) : R;
        voffA[i] = (unsigned)(R * g.lda + C) * 2u; voffB[i] = (unsigned)(Rb * g.ldb + C) * 2u; }
    const size_t kstep = (size_t)(BK * 2);
    const size_t hstepA = (size_t)HALF * g.lda * 2, hstepB = (size_t)HALF * g.ldb * 2;
    const size_t tstepA = 2 * hstepA, tstepB = 2 * hstepB;
    const unsigned ldsw = (unsigned)wid * 1024u;
    const int aoff = lds_byte(wr * 64 + fr, fq * 8), boff = lds_byte(wc * 32 + fr, fq * 8);
#define PG8_SA(b, h) (((b) * 2 + (h)) * HTB)
#define PG8_SB(b, h) ((4 + (b) * 2 + (h)) * HTB)
#define PG8_STAGE(bufoff, gbase, voff) do { _Pragma("unroll") for (int _i = 0; _i < 2; ++_i) \
        __builtin_amdgcn_global_load_lds((const unsigned*)((const char*)(gbase) + (voff)[_i]), (PG8_LAS unsigned*)(lds + (bufoff) + ldsw + _i * 8192), 16, 0, 0); } while (0)
#define PG8_LDA(dst, b, h) do { _Pragma("unroll") for (int m = 0; m < 4; ++m) _Pragma("unroll") for (int k = 0; k < 2; ++k) dst[m][k] = *(const PG8_LAS bf16x8*)(lds + PG8_SA(b, h) + aoff + m * 2048 + k * 1024); } while (0)
#define PG8_LDB(dst, b, h) do { _Pragma("unroll") for (int n = 0; n < 2; ++n) _Pragma("unroll") for (int k = 0; k < 2; ++k) dst[n][k] = *(const PG8_LAS bf16x8*)(lds + PG8_SB(b, h) + boff + n * 2048 + k * 1024); } while (0)
#define PG8_MMA(ai, bj, At, Bt) do { __builtin_amdgcn_s_setprio(1); _Pragma("unroll") for (int m = 0; m < 4; ++m) _Pragma("unroll") for (int n = 0; n < 2; ++n) _Pragma("unroll") for (int k = 0; k < 2; ++k) \
        acc[ai][bj][m][n] = __builtin_amdgcn_mfma_f32_16x16x32_bf16(Bt[n][k], At[m][k], acc[ai][bj][m][n], 0, 0, 0); __builtin_amdgcn_s_setprio(0); } while (0)
#define PG8_WAIT_V(n) asm volatile("s_waitcnt vmcnt(" #n ")" ::: "memory")
#define PG8_WAIT_L(n) asm volatile("s_waitcnt lgkmcnt(" #n ")" ::: "memory")
#define PG8_BAR __builtin_amdgcn_s_barrier()
#define PG8_SCHED __builtin_amdgcn_sched_barrier(0)
    Unit cur, nxt; int ui = 0;
    if (!S.next(0, cur)) return;
    f32x4 acc[2][2][4][2];
#pragma unroll
    for (int a = 0; a < 2; ++a)
#pragma unroll
        for (int b = 0; b < 2; ++b)
#pragma unroll
            for (int m = 0; m < 4; ++m)
#pragma unroll
                for (int n = 0; n < 2; ++n) acc[a][b][m][n] = (f32x4){0.f, 0.f, 0.f, 0.f};
    bf16x8 At[4][2], B0[2][2], B1[2][2];
    const char* cA = (const char*)g.A + (size_t)cur.pm * tstepA; const char* cB = (const char*)g.Bt + (size_t)cur.pn * tstepB;
    S.a_ready(cur);
    if constexpr (SP2) {
        PG8_STAGE(PG8_SB(0, 0), cB, voffB); PG8_STAGE(PG8_SB(0, 1), cB + hstepB, voffB); PG8_STAGE(PG8_SA(0, 0), cA, voffA); PG8_STAGE(PG8_SA(0, 1), cA + hstepA, voffA);
        if (wr == 1) PG8_BAR;
        PG8_WAIT_V(2); PG8_BAR;
        PG8_STAGE(PG8_SB(1, 0), cB + kstep, voffB); PG8_STAGE(PG8_SA(1, 0), cA + kstep, voffA); PG8_STAGE(PG8_SB(1, 1), cB + hstepB + kstep, voffB);
        PG8_WAIT_V(6); PG8_BAR;
    } else {
        PG8_STAGE(PG8_SB(0, 0), cB, voffB); PG8_STAGE(PG8_SA(0, 0), cA, voffA); PG8_STAGE(PG8_SB(0, 1), cB + hstepB, voffB); PG8_STAGE(PG8_SA(0, 1), cA + hstepA, voffA);
        if (wr == 1) PG8_BAR;
        PG8_WAIT_V(4); PG8_BAR;
        PG8_STAGE(PG8_SB(1, 0), cB + kstep, voffB); PG8_STAGE(PG8_SA(1, 0), cA + kstep, voffA); PG8_STAGE(PG8_SB(1, 1), cB + hstepB + kstep, voffB);
        PG8_WAIT_V(6); PG8_BAR;
    }
    for (;;) {
        const bool has_next = S.next(ui + 1, nxt);
        const char* nA = has_next ? (const char*)g.A + (size_t)nxt.pm * tstepA : cA; const char* nB = has_next ? (const char*)g.Bt + (size_t)nxt.pn * tstepB : cB;
        for (int t = 0; t < nt; t += 2) {
            const bool last = (t == nt - 2);
            const char* a1 = cA + (size_t)(t + 1) * kstep;
            const char* a2 = last ? nA : cA + (size_t)(t + 2) * kstep; const char* b2 = last ? nB : cB + (size_t)(t + 2) * kstep;
            const char* a3 = a2 + kstep; const char* b3 = b2 + kstep;
            if (last && has_next) S.a_ready(nxt);
            if constexpr (SP2) {
            PG8_LDB(B0, 0, 0); PG8_LDB(B1, 0, 1); PG8_SCHED; PG8_LDA(At, 0, 0); PG8_STAGE(PG8_SA(1, 1), a1 + hstepA, voffA);
            PG8_WAIT_V(8); PG8_WAIT_L(0); PG8_BAR; PG8_MMA(0, 0, At, B0); PG8_MMA(0, 1, At, B1); PG8_BAR; PG8_SCHED;
            PG8_LDA(At, 0, 1); PG8_STAGE(PG8_SB(0, 0), b2, voffB); PG8_STAGE(PG8_SB(0, 1), b2 + hstepB, voffB); PG8_STAGE(PG8_SA(0, 0), a2, voffA);
            PG8_WAIT_V(8); PG8_WAIT_L(0); PG8_BAR; PG8_MMA(1, 0, At, B0); PG8_MMA(1, 1, At, B1); PG8_BAR; PG8_SCHED;
            PG8_LDB(B0, 1, 0); PG8_LDB(B1, 1, 1); PG8_SCHED; PG8_LDA(At, 1, 0); PG8_STAGE(PG8_SA(0, 1), a2 + hstepA, voffA);
            PG8_WAIT_V(8); PG8_WAIT_L(0); PG8_BAR; PG8_MMA(0, 0, At, B0); PG8_MMA(0, 1, At, B1); PG8_BAR; PG8_SCHED;
            PG8_LDA(At, 1, 1); PG8_STAGE(PG8_SB(1, 0), b3, voffB); PG8_STAGE(PG8_SB(1, 1), b3 + hstepB, voffB); PG8_STAGE(PG8_SA(1, 0), a3, voffA);
            PG8_WAIT_V(8); PG8_WAIT_L(0); PG8_BAR; PG8_MMA(1, 0, At, B0); PG8_MMA(1, 1, At, B1); PG8_BAR; PG8_SCHED;
            } else {
            PG8_LDB(B0, 0, 0); PG8_SCHED; PG8_LDA(At, 0, 0); PG8_STAGE(PG8_SA(1, 1), a1 + hstepA, voffA);
            PG8_WAIT_L(8); PG8_BAR; PG8_WAIT_L(0); PG8_MMA(0, 0, At, B0); PG8_BAR; PG8_SCHED;
            PG8_LDB(B1, 0, 1); PG8_STAGE(PG8_SB(0, 0), b2, voffB);
            PG8_BAR; PG8_WAIT_L(0); PG8_MMA(0, 1, At, B1); PG8_BAR;
            PG8_LDA(At, 0, 1); PG8_STAGE(PG8_SA(0, 0), a2, voffA);
            PG8_BAR; PG8_WAIT_L(0); PG8_MMA(1, 0, At, B0); PG8_BAR; PG8_SCHED;
            PG8_STAGE(PG8_SB(0, 1), b2 + hstepB, voffB);
            PG8_WAIT_V(6); PG8_BAR; PG8_MMA(1, 1, At, B1); PG8_BAR;
            PG8_LDB(B0, 1, 0); PG8_SCHED; PG8_LDA(At, 1, 0); PG8_STAGE(PG8_SA(0, 1), a2 + hstepA, voffA);
            PG8_WAIT_L(8); PG8_BAR; PG8_WAIT_L(0); PG8_MMA(0, 0, At, B0); PG8_BAR; PG8_SCHED;
            PG8_LDB(B1, 1, 1); PG8_STAGE(PG8_SB(1, 0), b3, voffB);
            PG8_BAR; PG8_WAIT_L(0); PG8_MMA(0, 1, At, B1); PG8_BAR;
            PG8_LDA(At, 1, 1); PG8_STAGE(PG8_SA(1, 0), a3, voffA);
            PG8_BAR; PG8_WAIT_L(0); PG8_MMA(1, 0, At, B0); PG8_BAR; PG8_SCHED;
            PG8_STAGE(PG8_SB(1, 1), b3 + hstepB, voffB);
            PG8_WAIT_V(6); PG8_BAR; PG8_MMA(1, 1, At, B1); PG8_BAR;
            }
        }
        if constexpr (ALIGN_EPI) { if (wr == 0) PG8_BAR; }
        if constexpr (!Epi::AFTER_DRAIN) { E(acc, cur, wr, wc, fr, fq); S.done(cur); }
        if (!has_next) break;
#pragma unroll
        for (int a = 0; a < 2; ++a)
#pragma unroll
            for (int b = 0; b < 2; ++b)
#pragma unroll
                for (int m = 0; m < 4; ++m)
#pragma unroll
                    for (int n = 0; n < 2; ++n) acc[a][b][m][n] = (f32x4){0.f, 0.f, 0.f, 0.f};
        cur = nxt; cA = nA; cB = nB; ++ui;
        if constexpr (ALIGN_EPI) { if (wr == 1) PG8_BAR; }
    }
    PG8_WAIT_V(0);
    if constexpr (!ALIGN_EPI) { if (wr == 0) PG8_BAR; }
    PG8_BAR;
    if constexpr (Epi::AFTER_DRAIN) { E.fused(acc, cur, wr, wc, fr, fq, lds, wid, lane); S.done(cur); }
#undef PG8_SA
#undef PG8_SB
#undef PG8_STAGE
#undef PG8_LDA
#undef PG8_LDB
#undef PG8_MMA
#undef PG8_WAIT_V
#undef PG8_WAIT_L
#undef PG8_BAR
#undef PG8_SCHED
}

}

#define XB_TMO      128
#define XB_XCNT(j)  (256  + 64 * (j))
#define XB_XSUB(j)  (1280 + 64 * (j))
#define XB_XGEN(j)  (2304 + 64 * (j))
#define XB_TOP      3328
#define XB_TOPGEN   3392
#define XCD_BAR_WORDS 3456
#define XB_SPIN_CAP (1u << 18)
__device__ __forceinline__ unsigned xb_ld(unsigned* p)              { return __hip_atomic_load(p, __ATOMIC_RELAXED, __HIP_MEMORY_SCOPE_AGENT); }
__device__ __forceinline__ unsigned xb_add(unsigned* p, unsigned v) { return __hip_atomic_fetch_add(p, v, __ATOMIC_RELAXED, __HIP_MEMORY_SCOPE_AGENT); }
__device__ __forceinline__ unsigned xb_xcc_id() { return (unsigned)__builtin_amdgcn_s_getreg((3 << 11) | 20) & 0xFu; }
#define XB_SPIN(cond, bar) do { unsigned _sp = 0; while (cond) { __builtin_amdgcn_s_sleep(1); \
    if ((++_sp & 255u) == 0u) { if (xb_ld(&(bar)[XB_TMO])) break; if (_sp > XB_SPIN_CAP) { atomicAdd(&(bar)[XB_TMO], 1u); break; } } } } while (0)
struct XcdBarrier { unsigned* bar; unsigned x; volatile LAS unsigned* st; };
__device__ __forceinline__ XcdBarrier xcd_barrier_post(unsigned* bar, volatile LAS unsigned* st) {
    XcdBarrier b; b.bar = bar; b.x = xb_xcc_id(); b.st = st;
    if (threadIdx.x == 0) (void)xb_add(&bar[XB_XCNT(b.x)], 1u);
    return b;
}
__device__ __forceinline__ void xcd_barrier_complete(unsigned* bar, unsigned x, unsigned& nloc, unsigned& nx) {
    const unsigned G = gridDim.x * gridDim.y * gridDim.z;
    unsigned sum, cnt, mine, sp = 0u;
    for (;;) {
        sum = 0u; cnt = 0u; mine = 0u;
#pragma unroll
        for (unsigned j = 0; j < 16; ++j) { const unsigned c = xb_ld(&bar[XB_XCNT(j)]); sum += c; cnt += (c > 0u) ? 1u : 0u; mine = (j == x) ? c : mine; }
        if (sum == G) break;
        __builtin_amdgcn_s_sleep(1);
        if ((++sp & 255u) == 0u) { if (xb_ld(&bar[XB_TMO])) break; if (sp > XB_SPIN_CAP) { atomicAdd(&bar[XB_TMO], 1u); break; } }
    }
    nloc = mine > 0u ? mine : 1u; nx = cnt > 0u ? cnt : 1u;
}
__device__ __forceinline__ void xcd_barrier(const XcdBarrier& b) {
    asm volatile("s_waitcnt vmcnt(0)" ::: "memory");
    __syncthreads();
    if (threadIdx.x == 0) {
        unsigned* bar = b.bar;
        __builtin_amdgcn_s_waitcnt(0);
        unsigned nloc = b.st[0], nx = b.st[1];
        if (nloc == 0u) { xcd_barrier_complete(bar, b.x, nloc, nx); b.st[0] = nloc; b.st[1] = nx; }
        const unsigned old = xb_add(&bar[XB_XSUB(b.x)], 1u);
        const unsigned gen = old / nloc;
        if (old + 1u == (gen + 1u) * nloc) {
            __builtin_amdgcn_fence(__ATOMIC_RELEASE, "agent");
            asm volatile("s_waitcnt vmcnt(0)" ::: "memory");
            const unsigned og = xb_add(&bar[XB_TOP], 1u);
            const unsigned tg = og / nx;
            if (og + 1u == (tg + 1u) * nx) xb_add(&bar[XB_TOPGEN], 1u);
            else XB_SPIN(xb_ld(&bar[XB_TOPGEN]) == tg, bar);
            __builtin_amdgcn_fence(__ATOMIC_ACQUIRE, "agent");
            xb_add(&bar[XB_XGEN(b.x)], 1u);
            asm volatile("s_waitcnt vmcnt(0)" ::: "memory");
        } else {
            XB_SPIN(xb_ld(&bar[XB_XGEN(b.x)]) == gen, bar);
            __builtin_amdgcn_fence(__ATOMIC_ACQUIRE, "agent");
            asm volatile("s_waitcnt vmcnt(0)" ::: "memory");
        }
    }
    __syncthreads();
}

constexpr int NWAVES = 8, NTHREADS = 512;
constexpr int NPHASE = 10;
#ifndef MK_N_LAUNCHES
#define MK_N_LAUNCHES 1
#endif
constexpr int N_LAUNCHES = MK_N_LAUNCHES;
constexpr int RING_BYTES = 131072, LDS_BYTES = 163840, LDSCTL_OFF = LDS_BYTES - 256;
constexpr int CW_BAR = 4096;

struct Args {
    const float *x, *meta, *g_mix, *w_in, *conv_ssd_w, *conv_ssd_b, *dt_bias, *a_log, *d_skip, *ssd_norm_w, *conv_sc_w, *w_out, *g_ffn, *w_q, *sub_keys, *expert_u, *expert_v, *g_final;
    float* out; unsigned char* ws; int ph_lo, ph_hi;
};
struct Frame { LAS unsigned char* lds; int tid, lane, wave, G, vcu; };

template <class ColMap>
__device__ __forceinline__ void p0_transpose_item(const float* W, int K, int N, bf16_t* WT, int nblk, LAS float* scr, int item, int lane, ColMap cm, const float* kscale = nullptr) {
    const int kb = item / nblk, nb = item % nblk, k0 = 64 * kb, n0 = 32 * nb;
    const int sc = cm(n0 + (lane & 31));
#pragma unroll 8
    for (int i = 0; i < 32; ++i) { const int kk = 2 * i + (lane >> 5); scr[kk * 33 + (lane & 31)] = sc >= 0 ? W[(size_t)(k0 + kk) * N + sc] * (kscale ? kscale[k0 + kk] : 1.f) : 0.f; }
    asm volatile("s_waitcnt lgkmcnt(0)" ::: "memory");
    const int c = lane & 7;
#pragma unroll
    for (int j = 0; j < 4; ++j) { const int n = (lane >> 3) + 8 * j; const LAS float* s = scr + (8 * c) * 33 + n;
        u32x4 o; o.x = pk2(s[0 * 33], s[1 * 33]); o.y = pk2(s[2 * 33], s[3 * 33]); o.z = pk2(s[4 * 33], s[5 * 33]); o.w = pk2(s[6 * 33], s[7 * 33]);
        *(u32x4*)(WT + (size_t)(n0 + n) * K + k0 + 8 * c) = o; }
    asm volatile("s_waitcnt lgkmcnt(0)" ::: "memory");
}
__device__ __forceinline__ void p0_prologue(const Frame& F, const Args& a) {
    LAS float* scr = (LAS float*)(F.lds + F.wave * 16384);
    const int gw = F.vcu * NWAVES + F.wave, NGW = F.G * NWAVES;
    bf16_t* WinT = (bf16_t*)(a.ws + WS_WIN); bf16_t* WoutT = (bf16_t*)(a.ws + WS_WOUT); bf16_t* WqT = (bf16_t*)(a.ws + WS_WQ); bf16_t* XN = (bf16_t*)(a.ws + WS_XN);
    constexpr int I_IN = (D / 64) * (LDP / 32), I_OUT = (D_MIX / 64) * (D / 32), I_Q = (D / 64) * (PQ / 32);
    for (int it = gw; it < I_IN + I_OUT + I_Q; it += NGW) {
        int r = it;
        if (r < I_IN) { p0_transpose_item(a.w_in, D, D_IN, WinT, LDP / 32, scr, r, F.lane, [](int j) { return proj_src_col(j); }); continue; } r -= I_IN;
        if (r < I_OUT) { p0_transpose_item(a.w_out, D_MIX, D, WoutT, D / 32, scr, r, F.lane, [](int j) { return j; }); continue; } r -= I_OUT;
        p0_transpose_item(a.w_q, D, PQ, WqT, PQ / 32, scr, r, F.lane, [](int j) { return j; }, a.g_ffn);
    }
    for (int m = gw; m < ROWS_A; m += NGW) {
        u32x2* o8 = (u32x2*)(XN + (size_t)m * D) + F.lane;
        if (m >= TR + NMETA) {
#pragma unroll
            for (int j = 0; j < 4; ++j) o8[64 * j] = (u32x2){0u, 0u};
            continue; }
        const float* src = m < TR ? a.x + (size_t)m * D : a.meta + (size_t)(m - TR) * D;
        const f32x4* xr = (const f32x4*)src + F.lane; const f32x4* gr = (const f32x4*)a.g_mix + F.lane;
        f32x4 v[4]; float s = 0.f;
#pragma unroll
        for (int j = 0; j < 4; ++j) { v[j] = xr[64 * j]; s += (v[j].x * v[j].x + v[j].y * v[j].y) + (v[j].z * v[j].z + v[j].w * v[j].w); }
        const float rstd = 1.0f / sqrtf(wave_sum(s) * (1.f / D) + EPS);
#pragma unroll
        for (int j = 0; j < 4; ++j) { const f32x4 gg = gr[64 * j]; o8[64 * j] = (u32x2){pk2(v[j].x * rstd * gg.x, v[j].y * rstd * gg.y), pk2(v[j].z * rstd * gg.z, v[j].w * rstd * gg.w)}; }
    }
}

typedef float f32x16 __attribute__((ext_vector_type(16)));
constexpr int PITCH = 136;
constexpr int SL_C = 0, SL_B = 34816, SL_M0 = 69632, SL_X = 104448, SL_DT = 139264, SL_ACS = 142336;
constexpr int YPITCH = 396;
static_assert(SL_B + 128 * YPITCH * 2 <= SL_DT, "staging fits below dt/acs");
constexpr size_t WS_DAT = WS_XN;
constexpr size_t WS_SMETA = WS_XN + 65536;

__device__ __forceinline__ f32x16 mfma32(bf16x8 a, bf16x8 b, f32x16 c) { return __builtin_amdgcn_mfma_f32_32x32x16_bf16(a, b, c, 0, 0, 0); }
__device__ __forceinline__ float silu_f(float v) { return v / (1.f + __expf(-v)); }

template <int NP> struct ConvW { u32x4 raw[NP + 3]; };
template <int NP> __device__ __forceinline__ void convw_load(ConvW<NP>& ci, const bf16_t* xgc  , int b, int pos0) {
#pragma unroll
    for (int i = 0; i < NP + 3; ++i) { const int pos = pos0 - 3 + i; u32x4 v = (u32x4){0u, 0u, 0u, 0u};
        if (pos >= 0) v = *(const u32x4*)(xgc + (size_t)row_of(b, pos) * P_XG);
        ci.raw[i] = v; }
}
struct ConvWt { f32x4 w[4][2], cb[2]; };
__device__ __forceinline__ void convw_weights(ConvWt& cw, const Args& a, int ch) {
    cw.cb[0] = *(const f32x4*)(a.conv_ssd_b + ch); cw.cb[1] = *(const f32x4*)(a.conv_ssd_b + ch + 4);
#pragma unroll
    for (int wi = 0; wi < 4; ++wi) { cw.w[wi][0] = *(const f32x4*)(a.conv_ssd_w + wi * D_XBC + ch); cw.w[wi][1] = *(const f32x4*)(a.conv_ssd_w + wi * D_XBC + ch + 4); }
}
__device__ __forceinline__ float bfel(const u32x4& v, int c) { const unsigned w = (c >> 1) == 0 ? v.x : (c >> 1) == 1 ? v.y : (c >> 1) == 2 ? v.z : v.w; return (c & 1) ? bfhi(w) : bflo(w); }
template <int NP> __device__ __forceinline__ void convw_pos(const ConvW<NP>& ci, const ConvWt& cw, int s, float (&o)[8]) {
#pragma unroll
    for (int c = 0; c < 8; ++c) { const int q = c >> 2, e = c & 3;
        o[c] = silu_f(cw.cb[q][e] + cw.w[0][q][e] * bfel(ci.raw[s], c) + cw.w[1][q][e] * bfel(ci.raw[s + 1], c) + cw.w[2][q][e] * bfel(ci.raw[s + 2], c) + cw.w[3][q][e] * bfel(ci.raw[s + 3], c)); }
}
__device__ __forceinline__ void ssd_dt_acs(const Frame& F_, const Args& a, const bf16_t* PROJ, int b, int p0, int g, float* dat  ) {
    const Frame& F0 = F_;
    if (F0.wave < 6) {
        int lane_ = F0.lane; asm volatile("" : "+v"(lane_));
        Frame Fl = F0; Fl.lane = lane_;
        const Frame& F = Fl;
        const int h = g * 6 + F.wave; const float A = -__expf(a.a_log[h]), dtb = a.dt_bias[h];
        LAS float* dtL = (LAS float*)(F.lds + SL_DT) + F.wave * 128; LAS float* acL = (LAS float*)(F.lds + SL_ACS) + F.wave * 128;
        float dv[2], av[2];
#pragma unroll
        for (int hf = 0; hf < 2; ++hf) { const int pos = p0 + F.lane + 64 * hf; float d = 0.f;
            if (pos >= 0) { const float v = bf2f(PROJ[DT_OFF + (size_t)row_of(b, pos) * P_DT + h]) + dtb, t = __expf(-fabsf(v));
                d = fmaxf(v, 0.f) + (t < 1e-3f ? t * (1.f - 0.5f * t) : __logf(1.f + t)); }
            dv[hf] = d; av[hf] = d * A; }
#pragma unroll
        for (int o = 1; o < 64; o <<= 1) { const float t0 = __shfl_up(av[0], o), t1 = __shfl_up(av[1], o); if (F.lane >= o) { av[0] += t0; av[1] += t1; } }
        av[1] += __shfl(av[0], 63);
        dtL[F.lane] = dv[0]; dtL[F.lane + 64] = dv[1]; acL[F.lane] = av[0]; acL[F.lane + 64] = av[1];
        if (dat && F.lane == 63) dat[h] = __expf(av[1]);
    }
}

__device__ __forceinline__ void ssd_s1_unit(const Frame& F, const Args& a, int b, int c, int g) {
    const bf16_t* PROJ = (const bf16_t*)(a.ws + WS_PROJ);
    const int p0 = c == 0 ? -112 : NMETA + 128 * (c - 1), lr = F.lane & 31, hf = F.lane >> 5;
    __syncthreads();
    ssd_dt_acs(F, a, PROJ, b, p0, g, (float*)(a.ws + WS_DAT) + (size_t)(b * 17 + c) * HEADS);
    if (F.tid < 256) { const int chg = F.tid & 15, sr = F.tid >> 4, ch = D_SSD + g * 128 + 8 * chg;
        ConvW<8> ci; convw_load<8>(ci, PROJ + XG_OFF + g * XG_STRIDE + 384 + 8 * chg, b, p0 + 8 * sr); ConvWt cw; convw_weights(cw, a, ch);
        unsigned pk[8][4];
#pragma unroll
        for (int s2 = 0; s2 < 4; ++s2) { float o0[8], o1[8]; convw_pos<8>(ci, cw, 2 * s2, o0); convw_pos<8>(ci, cw, 2 * s2 + 1, o1);
#pragma unroll
            for (int c = 0; c < 8; ++c) pk[c][s2] = pk2(o0[c], o1[c]); }
#pragma unroll
        for (int c = 0; c < 8; ++c) *(LAS u32x4*)(F.lds + SL_C + ((8 * chg + c) * PITCH + 8 * sr) * 2) = (u32x4){pk[c][0], pk[c][1], pk[c][2], pk[c][3]}; }
    __syncthreads();
    const bf16_t* xg1 = PROJ + XG_OFF + g * XG_STRIDE + 8 * (F.tid & 7);
    ConvW<2> cin; convw_load<2>(cin, xg1, b, p0 + 2 * (F.tid >> 3));
#pragma unroll 1
    for (int hh = 0; hh < 6; ++hh) {
        const int h = g * 6 + hh, buf = hh & 1;
        {
            const int chg = F.tid & 7, sp = F.tid >> 3, ch = h * 64 + 8 * chg;
            const ConvW<2> ci = cin; ConvWt cw; convw_weights(cw, a, ch);
            if (hh < 5) convw_load<2>(cin, xg1 + (hh + 1) * 64, b, p0 + 2 * sp);
            const LAS float* dtL = (const LAS float*)(F.lds + SL_DT) + hh * 128; const LAS float* acL = (const LAS float*)(F.lds + SL_ACS) + hh * 128;
            const float aend = acL[127], w0 = dtL[2 * sp] * __expf(aend - acL[2 * sp]), w1 = dtL[2 * sp + 1] * __expf(aend - acL[2 * sp + 1]);
            float o0[8], o1[8]; convw_pos<2>(ci, cw, 0, o0); convw_pos<2>(ci, cw, 1, o1);
#pragma unroll
            for (int c = 0; c < 8; ++c) *(LAS unsigned*)(F.lds + SL_X + buf * 17408 + ((8 * chg + c) * PITCH + 2 * sp) * 2) = pk2(o0[c] * w0, o1[c] * w1);
        }
        __syncthreads();
        const int pb = F.wave >> 2, nb = F.wave & 3;
        f32x16 acc;
#pragma unroll
        for (int r = 0; r < 16; ++r) acc[r] = 0.f;
#pragma unroll
        for (int ks = 0; ks < 8; ++ks) {
            const bf16x8 af = *(const LAS bf16x8*)(F.lds + SL_C + ((32 * nb + lr) * PITCH + 16 * ks + 8 * hf) * 2);
            const bf16x8 bf = *(const LAS bf16x8*)(F.lds + SL_X + buf * 17408 + ((32 * pb + lr) * PITCH + 16 * ks + 8 * hf) * 2);
            acc = mfma32(af, bf, acc);
        }
        bf16_t* dst = c == 0 ? (bf16_t*)(a.ws + WS_SMETA) + (size_t)h * 8192 : (bf16_t*)a.out + ((size_t)(b * 16 + (c - 1)) * HEADS + h) * 8192;
        u32x4* d4 = (u32x4*)(dst + ((size_t)(pb * 4 + nb) * 64 + F.lane) * 16);
        u32x4 w0, w1; w0.x = pk2(acc[0], acc[1]); w0.y = pk2(acc[2], acc[3]); w0.z = pk2(acc[4], acc[5]); w0.w = pk2(acc[6], acc[7]);
        w1.x = pk2(acc[8], acc[9]); w1.y = pk2(acc[10], acc[11]); w1.z = pk2(acc[12], acc[13]); w1.w = pk2(acc[14], acc[15]);
        d4[0] = w0; d4[1] = w1;
    }
}
__device__ __forceinline__ void short_conv_all(const Frame& F, const Args& a) {
    bf16_t* PROJ = (bf16_t*)(a.ws + WS_PROJ);
    const size_t gt = (size_t)F.vcu * NTHREADS + F.tid, NT = (size_t)F.G * NTHREADS;
    for (size_t it = gt; it < (size_t)TR * (D_SC / 8); it += NT) {
        const int r = (int)(it / (D_SC / 8)), c0 = (int)(it % (D_SC / 8)) * 8, b = r / SEQ, pos = r % SEQ + NMETA;
        float accv[8];
#pragma unroll
        for (int j = 0; j < 8; ++j) accv[j] = 0.f;
#pragma unroll
        for (int w = 0; w < 3; ++w) { const int rr = row_of(b, pos - 2 + w);
            const u32x4 cc = *(const u32x4*)(PROJ + SC_OFF + (size_t)rr * P_SC + c0), xx = *(const u32x4*)(PROJ + SC_OFF + (size_t)rr * P_SC + 512 + c0);
            const unsigned cw[4] = {cc.x, cc.y, cc.z, cc.w}, xw[4] = {xx.x, xx.y, xx.z, xx.w};
#pragma unroll
            for (int j = 0; j < 4; ++j) { accv[2 * j] += a.conv_sc_w[w * D_SC + c0 + 2 * j] * (bflo(cw[j]) * bflo(xw[j])); accv[2 * j + 1] += a.conv_sc_w[w * D_SC + c0 + 2 * j + 1] * (bfhi(cw[j]) * bfhi(xw[j])); } }
        const u32x4 bb = *(const u32x4*)(PROJ + ZS_OFF + (size_t)r * P_ZS + 1536 + c0); const unsigned bw[4] = {bb.x, bb.y, bb.z, bb.w};
        u32x4 o; unsigned ow[4];
#pragma unroll
        for (int j = 0; j < 4; ++j) ow[j] = pk2(bflo(bw[j]) * accv[2 * j], bfhi(bw[j]) * accv[2 * j + 1]);
        o.x = ow[0]; o.y = ow[1]; o.z = ow[2]; o.w = ow[3];
        *(u32x4*)(PROJ + ZS_OFF + (size_t)r * P_ZS + 1536 + c0) = o;
    }
}
__device__ __forceinline__ void p2_ssd_states(const Frame& F, const Args& a, bool dryrun) {
    if (!dryrun) short_conv_all(F, a);
    for (int u = F.vcu; u < 4 + BATCH * 15 * NG; u += F.G) {
        if (u < 4) ssd_s1_unit(F, a, 0, 0, u);
        else { const int v = u - 4; ssd_s1_unit(F, a, v / (15 * NG), 1 + (v / NG) % 15, v % NG); }
    }
}
__device__ __forceinline__ void p3_ssd_recur(const Frame& F, const Args& a) {
    const float* dat = (const float*)(a.ws + WS_DAT); const bf16_t* SM = (const bf16_t*)(a.ws + WS_SMETA); bf16_t* SF = (bf16_t*)a.out;
    for (int it = F.vcu; it < BATCH * HEADS * 1024 / NTHREADS; it += F.G) {
        const int idx = it * NTHREADS + F.tid, bh = idx >> 10, e8 = idx & 1023, b = bh / HEADS, h = bh % HEADS;
        u32x4 ld[15];
#pragma unroll
        for (int c = 1; c <= 15; ++c) ld[c - 1] = *(const u32x4*)(SF + ((size_t)(b * 16 + (c - 1)) * HEADS + h) * 8192 + e8 * 8);
        const u32x4 m = *(const u32x4*)(SM + (size_t)h * 8192 + e8 * 8);
        float cy[8] = {bflo(m.x), bfhi(m.x), bflo(m.y), bfhi(m.y), bflo(m.z), bfhi(m.z), bflo(m.w), bfhi(m.w)};
#pragma unroll
        for (int c = 1; c <= 16; ++c) {
            u32x4 o; o.x = pk2(cy[0], cy[1]); o.y = pk2(cy[2], cy[3]); o.z = pk2(cy[4], cy[5]); o.w = pk2(cy[6], cy[7]);
            *(u32x4*)(SF + ((size_t)(b * 16 + (c - 1)) * HEADS + h) * 8192 + e8 * 8) = o;
            if (c <= 15) { const float dA = dat[(size_t)(b * 17 + c) * HEADS + h]; const u32x4 t = ld[c - 1];
                cy[0] = cy[0] * dA + bflo(t.x); cy[1] = cy[1] * dA + bfhi(t.x); cy[2] = cy[2] * dA + bflo(t.y); cy[3] = cy[3] * dA + bfhi(t.y);
                cy[4] = cy[4] * dA + bflo(t.z); cy[5] = cy[5] * dA + bfhi(t.z); cy[6] = cy[6] * dA + bflo(t.w); cy[7] = cy[7] * dA + bfhi(t.w); }
        }
    }
}
template <bool DRY> __device__ __forceinline__ void ssd_s3_unit(const Frame& F, const Args& a, int b, int c, int g) {
    bf16_t* PROJ = (bf16_t*)(a.ws + WS_PROJ);
    const int p0 = NMETA + 128 * (c - 1), row0 = b * SEQ + 128 * (c - 1), lr = F.lane & 31, hf = F.lane >> 5;
    __syncthreads();
    ssd_dt_acs(F, a, PROJ, b, p0, g, nullptr);
    {   const int mat = F.tid >> 8, it = F.tid & 255, chg = it & 15, sr = it >> 4, ch = D_SSD + (mat ? 0 : 512) + g * 128 + 8 * chg;
        ConvW<8> ci; convw_load<8>(ci, PROJ + XG_OFF + g * XG_STRIDE + (mat ? 384 : 512) + 8 * chg, b, p0 + 8 * sr); ConvWt cw; convw_weights(cw, a, ch);
#pragma unroll
        for (int s = 0; s < 8; ++s) { float o[8]; convw_pos<8>(ci, cw, s, o);
            *(LAS u32x4*)(F.lds + (mat ? SL_B : SL_C) + ((8 * sr + s) * PITCH + 8 * chg) * 2) = (u32x4){pk2(o[0], o[1]), pk2(o[2], o[3]), pk2(o[4], o[5]), pk2(o[6], o[7])}; } }
    __syncthreads();
    constexpr unsigned SI_P = 0u | (0u << 2) | (1u << 4) | (0u << 6) | (1u << 8) | (2u << 10) | (0u << 12) | (1u << 14) | (2u << 16) | (3u << 18);
    constexpr unsigned LI_P = 0u | (1u << 2) | (1u << 4) | (2u << 6) | (2u << 8) | (2u << 10) | (3u << 12) | (3u << 14) | (3u << 16) | (3u << 18);
    const int nslot = F.wave < 2 ? 2 : 1;
    f32x16 cb[2];
#pragma unroll
    for (int sl = 0; sl < 2; ++sl) {
#pragma unroll
        for (int r = 0; r < 16; ++r) cb[sl][r] = 0.f;
        if (sl < nslot) { const int ti = F.wave + 8 * sl, si = (SI_P >> (2 * ti)) & 3, li = (LI_P >> (2 * ti)) & 3;
#pragma unroll
            for (int ks = 0; ks < 8; ++ks) {
                const bf16x8 af = *(const LAS bf16x8*)(F.lds + SL_B + ((32 * si + lr) * PITCH + 16 * ks + 8 * hf) * 2);
                const bf16x8 bf = *(const LAS bf16x8*)(F.lds + SL_C + ((32 * li + lr) * PITCH + 16 * ks + 8 * hf) * 2);
                cb[sl] = mfma32(af, bf, cb[sl]); } }
    }
    __syncthreads();
    const int pb = F.wave & 1, lio = F.wave >> 1;
    unsigned ypk[6][8];
#pragma unroll
    for (int i = 0; i < 6; ++i)
#pragma unroll
        for (int r = 0; r < 8; ++r) ypk[i][r] = 0u;
#pragma unroll 1
    for (int hh = 0; hh < 6; ++hh) {
        const int h = g * 6 + hh, buf = hh & 1, mofs = buf ? SL_B : SL_M0;
        const LAS float* dtL = (const LAS float*)(F.lds + SL_DT) + hh * 128; const LAS float* acL = (const LAS float*)(F.lds + SL_ACS) + hh * 128;
        const bf16_t* sp = (const bf16_t*)a.out + ((size_t)(b * 16 + (c - 1)) * HEADS + h) * 8192;
        {
            const int chg = F.tid & 7, spp = F.tid >> 3, ch = h * 64 + 8 * chg;
            ConvW<2> ci; convw_load<2>(ci, PROJ + XG_OFF + g * XG_STRIDE + hh * 64 + 8 * chg, b, p0 + 2 * spp); ConvWt cw; convw_weights(cw, a, ch);
            float o0[8], o1[8]; convw_pos<2>(ci, cw, 0, o0); convw_pos<2>(ci, cw, 1, o1);
#pragma unroll
            for (int cc = 0; cc < 8; ++cc) *(LAS unsigned*)(F.lds + SL_X + buf * 17408 + ((8 * chg + cc) * PITCH + 2 * spp) * 2) = pk2(o0[cc], o1[cc]);
        }
        u32x4 sf[4][2];
#pragma unroll
        for (int nb = 0; nb < 4; ++nb) { const u32x4* s4 = (const u32x4*)(sp + ((size_t)(pb * 4 + nb) * 64 + F.lane) * 16); sf[nb][0] = s4[0]; sf[nb][1] = s4[1]; }
        {
            const float Dh = a.d_skip[h];
#pragma unroll
            for (int sl = 0; sl < 2; ++sl) if (sl < nslot) { const int ti = F.wave + 8 * sl, si = (SI_P >> (2 * ti)) & 3, li = (LI_P >> (2 * ti)) & 3;
                const int l = 32 * li + lr; const float acl = acL[l];
#pragma unroll
                for (int q = 0; q < 4; ++q) { const int s0 = 32 * si + 8 * q + 4 * hf;
                    const f32x4 d4 = *(const LAS f32x4*)(dtL + s0), a4 = *(const LAS f32x4*)(acL + s0); float v[4];
#pragma unroll
                    for (int i = 0; i < 4; ++i) { const int s = s0 + i; float t = s <= l ? cb[sl][4 * q + i] * __expf(acl - a4[i]) * d4[i] : 0.f; if (s == l) t += Dh; v[i] = t; }
                    *(LAS u32x2*)(F.lds + mofs + (l * PITCH + s0) * 2) = (u32x2){pk2(v[0], v[1]), pk2(v[2], v[3])}; } }
        }
        f32x16 acc;
#pragma unroll
        for (int r = 0; r < 16; ++r) acc[r] = 0.f;
        {
#pragma unroll
            for (int nb = 0; nb < 4; ++nb) {
#pragma unroll
                for (int qp = 0; qp < 2; ++qp) { const LAS unsigned char* cp_ = F.lds + SL_C + ((32 * lio + lr) * PITCH + 32 * nb + 16 * qp + 4 * hf) * 2;
                    const u32x2 c0 = *(const LAS u32x2*)cp_, c1 = *(const LAS u32x2*)(cp_ + 16);
                    const u32x4 bfr = (u32x4){c0.x, c0.y, c1.x, c1.y};
                    acc = mfma32(__builtin_bit_cast(bf16x8, sf[nb][qp]), __builtin_bit_cast(bf16x8, bfr), acc); } }
            const float sc = __expf(acL[32 * lio + lr]);
#pragma unroll
            for (int r = 0; r < 16; ++r) acc[r] *= sc;
        }
        __syncthreads();
        for (int ks = 0; ks < 2 * (lio + 1); ++ks) {
            const bf16x8 af = *(const LAS bf16x8*)(F.lds + SL_X + buf * 17408 + ((32 * pb + lr) * PITCH + 16 * ks + 8 * hf) * 2);
            const bf16x8 bf = *(const LAS bf16x8*)(F.lds + mofs + ((32 * lio + lr) * PITCH + 16 * ks + 8 * hf) * 2);
            acc = mfma32(af, bf, acc);
        }
#pragma unroll
        for (int i = 0; i < 5; ++i)
#pragma unroll
            for (int r = 0; r < 8; ++r) ypk[i][r] = ypk[i + 1][r];
#pragma unroll
        for (int r = 0; r < 8; ++r) ypk[5][r] = pk2(acc[2 * r], acc[2 * r + 1]);
    }
    __syncthreads();
#pragma unroll
    for (int hh = 0; hh < 6; ++hh)
#pragma unroll
        for (int q = 0; q < 4; ++q) *(LAS u32x2*)(F.lds + SL_B + ((32 * lio + lr) * YPITCH + hh * 64 + 32 * pb + 8 * q + 4 * hf) * 2) = (u32x2){ypk[hh][2 * q], ypk[hh][2 * q + 1]};
    u32x2 zz2[4][6];
#pragma unroll
    for (int pass = 0; pass < 4; ++pass) { const int l = pass * 32 + F.wave * 4 + (F.lane >> 4), sub = F.lane & 15; const bf16_t* zr = PROJ + ZS_OFF + (size_t)(row0 + l) * P_ZS + g * 384;
#pragma unroll
        for (int k = 0; k < 6; ++k) zz2[pass][k] = *(const u32x2*)(zr + 4 * (sub + 16 * k)); }
    __syncthreads();
#pragma unroll
    for (int pass = 0; pass < 4; ++pass) {
        const int l = pass * 32 + F.wave * 4 + (F.lane >> 4), sub = F.lane & 15; bf16_t* zr = PROJ + ZS_OFF + (size_t)(row0 + l) * P_ZS + g * 384;
        float v[6][4]; float ss = 0.f;
#pragma unroll
        for (int k = 0; k < 6; ++k) { const int c0 = 4 * (sub + 16 * k); const u32x2 y2 = *(const LAS u32x2*)(F.lds + SL_B + (l * YPITCH + c0) * 2), z2 = zz2[pass][k];
            const float yy[4] = {bflo(y2.x), bfhi(y2.x), bflo(y2.y), bfhi(y2.y)}, zz[4] = {bflo(z2.x), bfhi(z2.x), bflo(z2.y), bfhi(z2.y)};
#pragma unroll
            for (int i = 0; i < 4; ++i) { v[k][i] = yy[i] * silu_f(zz[i]); ss += v[k][i] * v[k][i]; } }
        ss = row_sum16(ss);
        const float rstd = 1.0f / sqrtf(ss * (1.f / 384.f) + EPS);
#pragma unroll
        for (int k = 0; k < 6; ++k) { const int c0 = 4 * (sub + 16 * k); const f32x4 nw = *(const f32x4*)(a.ssd_norm_w + g * 384 + c0);
            bf16_t* zo = DRY ? (bf16_t*)(a.ws + WS_END) + ((size_t)F.vcu * 128 + l) * 384 : zr;
            *(u32x2*)(zo + c0) = (u32x2){pk2(v[k][0] * rstd * nw.x, v[k][1] * rstd * nw.y), pk2(v[k][2] * rstd * nw.z, v[k][3] * rstd * nw.w)}; }
    }
}
template <bool DRY> __device__ __forceinline__ void p4_ssd_out(const Frame& F, const Args& a) {
    for (int u = F.vcu; u < BATCH * 16 * NG; u += F.G) ssd_s3_unit<DRY>(F, a, u / (16 * NG), 1 + (u / NG) % 16, u % NG);
}

__device__ __forceinline__ void p5_norm2(const Frame& F, const Args& a) {
    const int gw = F.vcu * NWAVES + F.wave, NGW = F.G * NWAVES;
    {
        unsigned char* V8 = a.ws + WS_V8; float* SV = (float*)(a.ws + WS_SV);
        for (int r = gw; r < 2 * PK * PK; r += NGW) {
            const bool isv = r >= PK * PK; const int e = isv ? r - PK * PK : r;
            const f32x4* src = (const f32x4*)((isv ? a.expert_v : a.expert_u) + (size_t)e * D) + 4 * F.lane;
            f32x4 v[4];
#pragma unroll
            for (int j = 0; j < 4; ++j) v[j] = src[j];
            if (isv) {
                float amax = 0.f;
#pragma unroll
                for (int j = 0; j < 4; ++j) amax = fmaxf(amax, fmaxf(fmaxf(fabsf(v[j].x), fabsf(v[j].y)), fmaxf(fabsf(v[j].z), fabsf(v[j].w))));
#pragma unroll
                for (int o = 1; o < 64; o <<= 1) amax = fmaxf(amax, __shfl_xor(amax, o));
                const float sc = amax > 0.f ? amax * (1.0f / 440.0f) : 1.0f, inv = 1.0f / sc;
                u32x4 o4; unsigned ow[4];
#pragma unroll
                for (int j = 0; j < 4; ++j) { int p = 0; p = __builtin_amdgcn_cvt_pk_fp8_f32(v[j].x * inv, v[j].y * inv, p, false); p = __builtin_amdgcn_cvt_pk_fp8_f32(v[j].z * inv, v[j].w * inv, p, true); ow[j] = (unsigned)p; }
                o4.x = ow[0]; o4.y = ow[1]; o4.z = ow[2]; o4.w = ow[3];
                *(u32x4*)(V8 + ((size_t)(F.lane >> 3) * (PK * PK) + e) * 128 + 16 * (F.lane & 7)) = o4; if (F.lane == 0) SV[e] = sc;
            } else {
                const f32x4* gr = (const f32x4*)a.g_ffn + 4 * F.lane;
#pragma unroll
                for (int j = 0; j < 4; ++j) v[j] = v[j] * gr[j];
                u32x4* ub = (u32x4*)((bf16_t*)(a.ws + WS_UB) + (size_t)e * D) + 2 * F.lane;
                u32x4 b0, b1; b0.x = pk2(v[0].x, v[0].y); b0.y = pk2(v[0].z, v[0].w); b0.z = pk2(v[1].x, v[1].y); b0.w = pk2(v[1].z, v[1].w); b1.x = pk2(v[2].x, v[2].y); b1.y = pk2(v[2].z, v[2].w); b1.z = pk2(v[3].x, v[3].y); b1.w = pk2(v[3].z, v[3].w);
                ub[0] = b0; ub[1] = b1;
            }
        }
    }
    const bf16_t* H2b = (const bf16_t*)(a.ws + WS_XN); float* RSTD = (float*)(a.ws + WS_RSTD);
    for (int m = gw; m < TR; m += NGW) {
        const u32x4* xr = (const u32x4*)(H2b + (size_t)m * D) + 2 * F.lane; const u32x4 p = xr[0], q = xr[1]; const unsigned w[8] = {p.x, p.y, p.z, p.w, q.x, q.y, q.z, q.w};
        float s = 0.f;
#pragma unroll
        for (int j = 0; j < 8; ++j) { const float lo = bflo(w[j]), hi = bfhi(w[j]); s += lo * lo + hi * hi; }
        s = wave_sum(s);
        if (F.lane == 0) RSTD[m] = 1.0f / sqrtf(s * (1.f / D) + EPS);
    }
}

__device__ __forceinline__ unsigned ord_bits(float f) { const unsigned u = __builtin_bit_cast(unsigned, f); return u ^ ((u >> 31) ? 0xffffffffu : 0x80000000u); }
__device__ __forceinline__ float ord_val(unsigned o) { const unsigned u = (o & 0x80000000u) ? (o ^ 0x80000000u) : ~o; return __builtin_bit_cast(float, u); }
__device__ __forceinline__ void cex_desc(unsigned& x, unsigned& y) { const unsigned hi = x > y ? x : y, lo = x > y ? y : x; x = hi; y = lo; }
__device__ __forceinline__ void sort16_desc(unsigned (&v)[16]) {
#pragma unroll
    for (int k = 2; k <= 16; k <<= 1)
#pragma unroll
        for (int j = k >> 1; j > 0; j >>= 1)
#pragma unroll
            for (int i = 0; i < 16; ++i) { const int l = i ^ j; if (l > i) { if ((i & k) == 0) cex_desc(v[i], v[l]); else cex_desc(v[l], v[i]); } }
}
__device__ __forceinline__ void bitonic_merge16_desc(unsigned (&v)[16]) {
#pragma unroll
    for (int j = 8; j > 0; j >>= 1)
#pragma unroll
        for (int i = 0; i < 16; ++i) { const int l = i ^ j; if (l > i) cex_desc(v[i], v[l]); }
}
__device__ __forceinline__ void top16_merge(unsigned (&T)[16], const unsigned (&B)[16]) {
#pragma unroll
    for (int i = 0; i < 16; ++i) T[i] = T[i] > B[15 - i] ? T[i] : B[15 - i];
    bitonic_merge16_desc(T);
}
__device__ __forceinline__ void p8_topk_mfma(const Frame& F, const Args& a) {
    const bf16_t* Q = (const bf16_t*)(a.ws + WS_Q); int* EIDX = (int*)(a.ws + WS_EIDX); float* GATE = (float*)(a.ws + WS_GATE);
    const int lane = F.lane, lr = lane & 31, hf = lane >> 5;
    for (int task = F.vcu; task < PH * (TR / 1024); task += F.G) {
        const int h = task % PH, rng = task / PH;
        __syncthreads();
        {
            const f32x4* kp = (const f32x4*)(a.sub_keys + (size_t)h * 2 * PK * 128);
            for (int i = F.tid; i < 2 * PK * 128 / 4; i += NTHREADS) { const f32x4 v = kp[i]; const int row = i >> 5, c4 = (i & 31) * 4;
                *(LAS u32x2*)(F.lds + (row * PITCH + c4) * 2) = (u32x2){pk2(v.x, v.y), pk2(v.z, v.w)}; }
        }
        __syncthreads();
        for (int tile = F.wave; tile < 16; tile += NWAVES) {
            const int t0 = rng * 1024 + tile * 64;
            unsigned L0[16], L1[16];
#pragma unroll
            for (int i = 0; i < 16; ++i) { L0[i] = 0u; L1[i] = 0u; }
#pragma unroll 1
            for (int s = 0; s < 2; ++s) {
                unsigned TA[16], R[16];
#pragma unroll
                for (int i = 0; i < 16; ++i) { TA[i] = 0u; R[i] = 0u; }
#pragma unroll 1
                for (int th = 0; th < 2; ++th) {
                    bf16x8 qf[8];
                    const bf16_t* qp = Q + (size_t)(t0 + 32 * th + lr) * PQ + h * 256 + s * 128 + 8 * hf;
#pragma unroll
                    for (int ks = 0; ks < 8; ++ks) qf[ks] = *(const bf16x8*)(qp + 16 * ks);
                    unsigned T[16];
#pragma unroll
                    for (int i = 0; i < 16; ++i) T[i] = 0u;
#pragma unroll 1
                    for (int kb = 0; kb < 4; ++kb) {
                        f32x16 acc;
#pragma unroll
                        for (int r = 0; r < 16; ++r) acc[r] = 0.f;
#pragma unroll
                        for (int ks = 0; ks < 8; ++ks) { const bf16x8 af = *(const LAS bf16x8*)(F.lds + ((s * PK + 32 * kb + lr) * PITCH + 16 * ks + 8 * hf) * 2); acc = mfma32(af, qf[ks], acc); }
                        unsigned B[16];
#pragma unroll
                        for (int r = 0; r < 16; ++r) { const int k = 32 * kb + 8 * (r >> 2) + 4 * hf + (r & 3); B[r] = (ord_bits(acc[r]) & ~127u) | (unsigned)(127 - k); }
                        sort16_desc(B);
                        top16_merge(T, B);
                    }
                    unsigned P[16];
#pragma unroll
                    for (int i = 0; i < 16; ++i) { unsigned lo2, hi2; swap32_self(T[i], lo2, hi2); P[i] = hf ? lo2 : hi2; }
                    top16_merge(T, P);
#pragma unroll
                    for (int i = 0; i < 16; ++i) { R[i] = hf ? T[i] : TA[i]; TA[i] = T[i]; }
                }
#pragma unroll
                for (int i = 0; i < 16; ++i) { L0[i] = L1[i]; L1[i] = R[i]; }
            }
            const int t = t0 + lane;
            unsigned T[16];
            const float v00 = ord_val(L0[0] & ~127u);
#pragma unroll
            for (int j = 0; j < 16; ++j) T[j] = (ord_bits(v00 + ord_val(L1[j] & ~127u)) & ~255u) | (unsigned)(255 - j);
#pragma unroll
            for (int i = 1; i < 16; ++i)
#pragma unroll
                for (int j = 0; j < 16; ++j) if ((i + 1) * (j + 1) <= 16) {
                    const float sum = ord_val(L0[i] & ~127u) + ord_val(L1[j] & ~127u);
                    unsigned e = (ord_bits(sum) & ~255u) | (unsigned)(255 - (i * 16 + j));
#pragma unroll
                    for (int k = 0; k < 16; ++k) { const unsigned hi = T[k] > e ? T[k] : e; e = T[k] > e ? e : T[k]; T[k] = hi; }
                }
            float best[16]; int eid[16];
#pragma unroll
            for (int k = 0; k < 16; ++k) {
                best[k] = ord_val(T[k] & ~255u); const int pos = 255 - (int)(T[k] & 255u), pi = pos >> 4, pj = pos & 15;
                unsigned a0 = 0u, a1 = 0u;
#pragma unroll
                for (int i = 0; i < 16; ++i) { a0 = (pi == i) ? L0[i] : a0; a1 = (pj == i) ? L1[i] : a1; }
                eid[k] = (127 - (int)(a0 & 127u)) * PK + (127 - (int)(a1 & 127u));
            }
            const float rst = ((const float*)(a.ws + WS_RSTD))[t];
            float se = 0.f, ex[16];
#pragma unroll
            for (int k = 0; k < 16; ++k) { ex[k] = __expf((best[k] - best[0]) * rst); se += ex[k]; }
            const float inv = 1.f / se;
            int* ep = EIDX + (size_t)t * 128 + h * 16; float* gp = GATE + (size_t)t * 128 + h * 16;
#pragma unroll
            for (int k = 0; k < 16; k += 4) { *(int4*)(ep + k) = make_int4(eid[k], eid[k + 1], eid[k + 2], eid[k + 3]); *(f32x4*)(gp + k) = (f32x4){ex[k] * inv, ex[k + 1] * inv, ex[k + 2] * inv, ex[k + 3] * inv}; }
        }
    }
}

typedef __bf16 bf16x2_t __attribute__((ext_vector_type(2)));
__device__ __forceinline__ float dot2bf(unsigned w, unsigned x, float acc) { return __builtin_amdgcn_fdot2_f32_bf16(__builtin_bit_cast(bf16x2_t, w), __builtin_bit_cast(bf16x2_t, x), acc, false); }

__device__ __forceinline__ float shx32(float x, int lane) { unsigned a, b; swap32_self(__builtin_bit_cast(unsigned, x), a, b); return __builtin_bit_cast(float, (lane & 32) ? a : b); }
__device__ __forceinline__ float shx16(float x, int lane) { unsigned a, b; swap16_self(__builtin_bit_cast(unsigned, x), a, b); return __builtin_bit_cast(float, (lane & 16) ? a : b); }
template <int CTRL> __device__ __forceinline__ float dppf(float x) { return __builtin_bit_cast(float, __builtin_amdgcn_update_dpp(0, __builtin_bit_cast(int, x), CTRL, 0xF, 0xF, true)); }
__device__ __forceinline__ float shx8(float x) { return dppf<0x128>(x); }
__device__ __forceinline__ float shx4(float x, int) { return dppf<0x1B>(dppf<0x141>(x)); }

__device__ __forceinline__ float gelu_as(float v) {
    const float av = __builtin_fabsf(v), t = __builtin_amdgcn_rcpf(av * 0.2316418882f + 1.0f);
    float q = t * 0.5307027145f + (-0.7265760135f); q = q * t + 0.7107068705f; q = q * t + (-0.142248368f); q = q * t + 0.127414796f; q = q * t;
    const float e = __builtin_amdgcn_exp2f((v * v) * (-0.72134752044f));
    const float m = v * (q * e);
    return v < 0.f ? m : v - m;
}
__device__ __forceinline__ int rdlane(int v, int l) { return __builtin_amdgcn_readlane(v, l); }
__device__ __forceinline__ float rdlanef(float v, int l) { return __builtin_bit_cast(float, __builtin_amdgcn_readlane(__builtin_bit_cast(int, v), l)); }

struct PeerBatch { int l0, l1, l2, l3; u32x4 r[4][2]; };
__device__ __forceinline__ void peerA_take(unsigned long long& m, PeerBatch& B, const bf16_t* Ub, int lane, int ev) {
    B.l0 = __builtin_ctzll(m); m &= m - 1; B.l1 = B.l0; B.l2 = B.l0; B.l3 = B.l0;
    if (m) { B.l1 = __builtin_ctzll(m); m &= m - 1; if (m) { B.l2 = __builtin_ctzll(m); m &= m - 1; if (m) { B.l3 = __builtin_ctzll(m); m &= m - 1; } } }
    const int e0 = rdlane(ev, B.l0), e1 = rdlane(ev, B.l1), e2 = rdlane(ev, B.l2), e3 = rdlane(ev, B.l3);
    const u32x4* r0 = (const u32x4*)(Ub + (size_t)e0 * D) + 2 * lane; const u32x4* r1 = (const u32x4*)(Ub + (size_t)e1 * D) + 2 * lane;
    const u32x4* r2 = (const u32x4*)(Ub + (size_t)e2 * D) + 2 * lane; const u32x4* r3 = (const u32x4*)(Ub + (size_t)e3 * D) + 2 * lane;
    B.r[0][0] = r0[0]; B.r[0][1] = r0[1]; B.r[1][0] = r1[0]; B.r[1][1] = r1[1]; B.r[2][0] = r2[0]; B.r[2][1] = r2[1]; B.r[3][0] = r3[0]; B.r[3][1] = r3[1];
}
__device__ __forceinline__ void peerA_finish(const PeerBatch& B, int lane, LAS float* dl  , const unsigned (&xp)[8]) {
#define DOT16(lo, hi) dot2bf((hi).w, xp[7], dot2bf((hi).z, xp[6], dot2bf((hi).y, xp[5], dot2bf((hi).x, xp[4], dot2bf((lo).w, xp[3], dot2bf((lo).z, xp[2], dot2bf((lo).y, xp[1], dot2bf((lo).x, xp[0], 0.f))))))))
    const float p0 = DOT16(B.r[0][0], B.r[0][1]), p1 = DOT16(B.r[1][0], B.r[1][1]), p2 = DOT16(B.r[2][0], B.r[2][1]), p3 = DOT16(B.r[3][0], B.r[3][1]);
#undef DOT16
    const bool hi5 = lane & 32, hi4 = lane & 16;
    const float k0 = hi5 ? p2 : p0, s0 = hi5 ? p0 : p2, k1 = hi5 ? p3 : p1, s1 = hi5 ? p1 : p3;
    const float t0 = k0 + shx32(s0, lane), t1 = k1 + shx32(s1, lane);
    const float k2 = hi4 ? t1 : t0, s2 = hi4 ? t0 : t1;
    const float d = row_sum16(k2 + shx16(s2, lane));
    const int sl0 = __builtin_amdgcn_readfirstlane(B.l0), sl1 = __builtin_amdgcn_readfirstlane(B.l1), sl2 = __builtin_amdgcn_readfirstlane(B.l2), sl3 = __builtin_amdgcn_readfirstlane(B.l3);
    const int slot = hi5 ? (hi4 ? sl3 : sl2) : (hi4 ? sl1 : sl0);
    if ((lane & 15) == 0) dl[slot] = d;
}
struct PeerGather8 { u32x4 vv[16]; float aw[16]; };
__device__ __forceinline__ void peerB8_gather(PeerGather8& G, const unsigned char* V8, int lane, int cs, const LAS int* ELt, const LAS float* ALt) {
    const int rg = lane >> 3, cl = lane & 7;
#pragma unroll
    for (int j = 0; j < 16; ++j) { const int e = ELt[8 * j + rg]; G.aw[j] = ALt[8 * j + rg];
        G.vv[j] = *(const u32x4*)(V8 + (((unsigned)(cs * PK * PK) + (unsigned)e) * 128u + (unsigned)(cl * 16))); }
}
__device__ __forceinline__ f32x2 peerB8_reduce(const PeerGather8& G, int lane) {
    f32x2 acc[8];
#pragma unroll
    for (int c = 0; c < 8; ++c) acc[c] = (f32x2){0.f, 0.f};
#pragma unroll
    for (int j = 0; j < 16; ++j) { const unsigned ww[4] = {G.vv[j].x, G.vv[j].y, G.vv[j].z, G.vv[j].w}; const f32x2 a2 = (f32x2){G.aw[j], G.aw[j]};
#pragma unroll
        for (int m = 0; m < 4; ++m) { acc[2 * m] += __builtin_amdgcn_cvt_pk_f32_fp8(ww[m], false) * a2; acc[2 * m + 1] += __builtin_amdgcn_cvt_pk_f32_fp8(ww[m], true) * a2; } }
    const bool b5 = lane & 32, b4 = lane & 16, b3 = lane & 8;
    f32x2 v4[4], v2[2];
#pragma unroll
    for (int c = 0; c < 4; ++c) { const f32x2 keep = b5 ? acc[c + 4] : acc[c], send = b5 ? acc[c] : acc[c + 4]; v4[c] = keep + (f32x2){shx32(send.x, lane), shx32(send.y, lane)}; }
#pragma unroll
    for (int c = 0; c < 2; ++c) { const f32x2 keep = b4 ? v4[c + 2] : v4[c], send = b4 ? v4[c] : v4[c + 2]; v2[c] = keep + (f32x2){shx16(send.x, lane), shx16(send.y, lane)}; }
    const f32x2 keep = b3 ? v2[1] : v2[0], send = b3 ? v2[0] : v2[1];
    return keep + (f32x2){shx8(send.x), shx8(send.y)};
}
#ifndef NSLICE
#define NSLICE 10
#endif
__device__ __forceinline__ int slice_of(int e) { return (e * NSLICE) >> 14; }
__device__ __forceinline__ void peerA_token2(const bf16_t* Ub, int lane, int s, int e0lo, int e0hi, LAS float* d0, const unsigned (&xp0)[8], int e1lo, int e1hi, LAS float* d1, const unsigned (&xp1)[8]) {
    unsigned long long m0 = __ballot(slice_of(e0lo) == s), m1 = __ballot(slice_of(e0hi) == s), m2 = __ballot(slice_of(e1lo) == s), m3 = __ballot(slice_of(e1hi) == s);
    while (m0 | m1 | m2 | m3) {
        const bool h0 = m0 != 0ull, h1 = m1 != 0ull, h2 = m2 != 0ull, h3 = m3 != 0ull;
        PeerBatch B0, B1, B2, B3;
        if (h0) peerA_take(m0, B0, Ub, lane, e0lo);
        if (h1) peerA_take(m1, B1, Ub, lane, e0hi);
        if (h2) peerA_take(m2, B2, Ub, lane, e1lo);
        if (h3) peerA_take(m3, B3, Ub, lane, e1hi);
        if (h0) peerA_finish(B0, lane, d0, xp0);
        if (h1) peerA_finish(B1, lane, d0 + 64, xp0);
        if (h2) peerA_finish(B2, lane, d1, xp1);
        if (h3) peerA_finish(B3, lane, d1 + 64, xp1);
    }
}
__device__ __forceinline__ void p9_peer_hybrid(const Frame& F, const Args& a, float* dst) {
    const int* EIDX = (const int*)(a.ws + WS_EIDX); const float* GATE = (const float*)(a.ws + WS_GATE); const float* RSTD = (const float*)(a.ws + WS_RSTD);
    const bf16_t* Ub = (const bf16_t*)(a.ws + WS_UB); const unsigned char* V8 = a.ws + WS_V8; const float* SV = (const float*)(a.ws + WS_SV);
    bf16_t* H2b = (bf16_t*)(a.ws + WS_XN);
    const int gw = F.vcu * NWAVES + F.wave, lane = F.lane, tokb = gw * 16;
    LAS int* EL = (LAS int*)(F.lds + F.wave * 16384); LAS float* AL = (LAS float*)(F.lds + F.wave * 16384 + 8192);
#pragma unroll 4
    for (int ti = 0; ti < 16; ++ti) { const size_t o = (size_t)(tokb + ti) * 128;
        EL[ti * 128 + lane] = EIDX[o + lane] | (int)(f2bf(GATE[o + lane]) << 16); EL[ti * 128 + 64 + lane] = EIDX[o + 64 + lane] | (int)(f2bf(GATE[o + 64 + lane]) << 16); }
    const float myrs = RSTD[tokb + (lane & 15)];
#pragma unroll 1
    for (int s = 0; s < NSLICE; ++s) {
#pragma unroll 1
        for (int i = 0; i < 16; i += 2) { const int o = i * 128;
            const u32x4* x0 = (const u32x4*)(H2b + (size_t)(tokb + i) * D) + 2 * lane; const u32x4* x1 = x0 + D / 8;
            const u32x4 xa = x0[0], xb = x0[1], xc = x1[0], xd = x1[1];
            const unsigned xp0[8] = {xa.x, xa.y, xa.z, xa.w, xb.x, xb.y, xb.z, xb.w}, xp1[8] = {xc.x, xc.y, xc.z, xc.w, xd.x, xd.y, xd.z, xd.w};
            const int e0lo = EL[o + lane] & 0x3fff, e0hi = EL[o + 64 + lane] & 0x3fff, e1lo = EL[o + 128 + lane] & 0x3fff, e1hi = EL[o + 192 + lane] & 0x3fff;
            peerA_token2(Ub, lane, s, e0lo, e0hi, AL + o, xp0, e1lo, e1hi, AL + o + 128, xp1); }
    }
#pragma unroll 2
    for (int ti = 0; ti < 16; ++ti) { const float rs = rdlanef(myrs, ti);
#pragma unroll
        for (int hf = 0; hf < 2; ++hf) { const int k = ti * 128 + 64 * hf + lane; const int w = EL[k], e = w & 0x3fff; const float gate = __builtin_bit_cast(float, (unsigned)w & 0xffff0000u);
            AL[k] = gelu_as(AL[k] * rs) * gate * SV[e]; EL[k] = e; } }
    const int col = 16 * (lane & 7) + ((lane >> 5) & 1) * 8 + ((lane >> 4) & 1) * 4 + ((lane >> 3) & 1) * 2;
#pragma unroll 1
    for (int cs = 0; cs < 8; ++cs) {
        PeerGather8 G0, G1;
        peerB8_gather(G0, V8, lane, cs, EL, AL);
#pragma unroll 1
        for (int ti = 0; ti < 16; ti += 2) {
            unsigned* hp0 = (unsigned*)(H2b + (size_t)(tokb + ti) * D + cs * 128 + col); unsigned* hp1 = hp0 + D / 2; const unsigned h0 = *hp0, h1 = *hp1;
            peerB8_gather(G1, V8, lane, cs, EL + (ti + 1) * 128, AL + (ti + 1) * 128);
            { const f32x2 r = peerB8_reduce(G0, lane); *hp0 = pk2(bflo(h0) + r.x, bfhi(h0) + r.y); }
            if (ti + 2 < 16) peerB8_gather(G0, V8, lane, cs, EL + (ti + 2) * 128, AL + (ti + 2) * 128);
            { const f32x2 r = peerB8_reduce(G1, lane); *hp1 = pk2(bflo(h1) + r.x, bfhi(h1) + r.y); }
        }
    }
    asm volatile("s_waitcnt vmcnt(0)" ::: "memory");
    __builtin_amdgcn_fence(__ATOMIC_RELEASE, "workgroup"); __builtin_amdgcn_fence(__ATOMIC_ACQUIRE, "workgroup");
#pragma unroll 2
    for (int ti = 0; ti < 16; ++ti) {
        const u32x4* hr = (const u32x4*)(H2b + (size_t)(tokb + ti) * D) + 2 * lane; f32x4* orow = (f32x4*)(dst + (size_t)(tokb + ti) * D) + 4 * lane; const f32x4* gf = (const f32x4*)a.g_final + 4 * lane;
        const u32x4 p = hr[0], q = hr[1]; const unsigned w[8] = {p.x, p.y, p.z, p.w, q.x, q.y, q.z, q.w};
        float hv[16]; float s2 = 0.f;
#pragma unroll
        for (int j = 0; j < 8; ++j) { hv[2 * j] = bflo(w[j]); hv[2 * j + 1] = bfhi(w[j]); s2 += hv[2 * j] * hv[2 * j] + hv[2 * j + 1] * hv[2 * j + 1]; }
        const float rstd2 = 1.0f / sqrtf(wave_sum(s2) * (1.f / D) + EPS);
#pragma unroll
        for (int j = 0; j < 4; ++j) { const f32x4 g4 = gf[j]; orow[j] = (f32x4){hv[4 * j] * rstd2 * g4.x, hv[4 * j + 1] * rstd2 * g4.y, hv[4 * j + 2] * rstd2 * g4.z, hv[4 * j + 3] * rstd2 * g4.w}; }
    }
}

__global__ void __launch_bounds__(NTHREADS, 2) fwd(Args a) {
    extern __shared__ __attribute__((aligned(16))) unsigned char lds[];
    Frame F; F.lds = (LAS unsigned char*)lds; F.tid = threadIdx.x; F.lane = F.tid & 63; F.wave = __builtin_amdgcn_readfirstlane(F.tid >> 6);
    F.G = gridDim.x; { const int bx = blockIdx.x; F.vcu = (F.G % 8 == 0) ? (bx % 8) * (F.G / 8) + bx / 8 : bx; }
    volatile LAS unsigned* MISC = (volatile LAS unsigned*)(F.lds + LDSCTL_OFF);
    for (int u = F.tid; u < (LDS_BYTES - LDSCTL_OFF) / 4; u += NTHREADS) ((LAS unsigned*)(F.lds + LDSCTL_OFF))[u] = 0u;
    __syncthreads();
    XcdBarrier bar; bar.bar = (unsigned*)(a.ws + WS_CTL) + CW_BAR; bar.x = 0; bar.st = nullptr;
    if (N_LAUNCHES == 1) bar = xcd_barrier_post((unsigned*)(a.ws + WS_CTL) + CW_BAR, MISC + 8);
    const int lo = a.ph_lo, hi = a.ph_hi;
#ifndef PHASE_MASK
#define PHASE_MASK 0xFFFF
#endif
#define IN(k) (((PHASE_MASK >> (k)) & 1) && lo <= (k) && (k) < hi)
#define GEMM_CALL(EPI) pg8::gemm_phase<EPI, pg8::StaticOrder, true, true>(F.lds, g, S, E)
#define SEAM(k) do { if (IN(k) && IN((k) + 1)) xcd_barrier(bar); } while (0)
    bf16_t* PROJ = (bf16_t*)(a.ws + WS_PROJ);
#ifndef PROBE_REP
#define PROBE_REP 0
#endif
#define REPK(k) ((PROBE_REP >> (k)) & 1)
#define GEMM_P1 { pg8::Gemm g{(const bf16_t*)(a.ws + WS_XN), (const bf16_t*)(a.ws + WS_WIN), ROWS_A, LDP, D, D, D}; pg8::StaticOrder S; S.init(ROWS_A, LDP, F.G, (int)blockIdx.x); pg8::EpiPanels E{PROJ}; GEMM_CALL(pg8::EpiPanels); }
#define GEMM_P5 { pg8::Gemm g{PROJ + ZS_OFF, (const bf16_t*)(a.ws + WS_WOUT), TR, D, D_MIX, P_ZS, D_MIX}; pg8::StaticOrder S; S.init(TR, D, F.G, (int)blockIdx.x); pg8::EpiResBf16 E{a.x, (bf16_t*)(a.ws + WS_XN), D}; GEMM_CALL(pg8::EpiResBf16); }
#define GEMM_P7 { pg8::Gemm g{(const bf16_t*)(a.ws + WS_XN), (const bf16_t*)(a.ws + WS_WQ), TR, PQ, D, D, D}; pg8::StaticOrder S; S.init(TR, PQ, F.G, (int)blockIdx.x); pg8::EpiBf16 E{(bf16_t*)(a.ws + WS_Q), PQ}; GEMM_CALL(pg8::EpiBf16); }
    if (IN(0)) { if (REPK(0)) p0_prologue(F, a); p0_prologue(F, a); } SEAM(0);
    if (IN(1)) { if (REPK(1)) GEMM_P1 GEMM_P1 } SEAM(1);
    if (IN(2)) { if (REPK(2)) p2_ssd_states(F, a, true); p2_ssd_states(F, a, false); } SEAM(2);
    if (IN(3)) { p3_ssd_recur(F, a); } SEAM(3);
    if (IN(4)) { if (REPK(4)) p4_ssd_out<true>(F, a); p4_ssd_out<false>(F, a); } SEAM(4);
    if (IN(5)) { if (REPK(5)) GEMM_P5 GEMM_P5 } SEAM(5);
    if (IN(6)) { if (REPK(6)) p5_norm2(F, a); p5_norm2(F, a); } SEAM(6);
    if (IN(7)) { if (REPK(7)) GEMM_P7 GEMM_P7 } SEAM(7);
    if (IN(8)) { if (REPK(8)) p8_topk_mfma(F, a); p8_topk_mfma(F, a); } SEAM(8);
    if (IN(9)) { p9_peer_hybrid(F, a, a.out); }
#undef IN
#undef SEAM
}

extern "C" void kernel_launch(void* const* d_in, const int* in_sizes, int n_in, void* d_out, int out_size, void* d_ws, size_t ws_size, hipStream_t stream) {
    static int grid = 0;
    if (grid == 0) {
        if (n_in != 18 || out_size != TR * D || ws_size < WS_END) { fprintf(stderr, "kernel_launch: unexpected problem (n_in %d out %d ws %zu)\n", n_in, out_size, ws_size); grid = -1; return; }
        int dev = 0, cus = 0, per_cu = 0;
        if (hipGetDevice(&dev) != hipSuccess || hipDeviceGetAttribute(&cus, hipDeviceAttributeMultiprocessorCount, dev) != hipSuccess) { grid = -1; return; }
        if (hipFuncSetAttribute((const void*)fwd, hipFuncAttributeMaxDynamicSharedMemorySize, LDS_BYTES) != hipSuccess) { fprintf(stderr, "kernel_launch: hipFuncSetAttribute failed\n"); grid = -1; return; }
        if (hipOccupancyMaxActiveBlocksPerMultiprocessor(&per_cu, (const void*)fwd, NTHREADS, LDS_BYTES) != hipSuccess || per_cu < 1) fprintf(stderr, "kernel_launch: occupancy query says %d\n", per_cu);
        (void)hipGetLastError();
        grid = cus;
        if (grid * NWAVES * 16 != TR) { fprintf(stderr, "kernel_launch: built for 256 CUs (the expert phase deals 16 tokens to each of 2048 waves); this device has %d; nothing launched\n", cus); grid = -1; return; }
    }
    if (grid < 0) return;
    if (hipMemsetAsync((char*)d_ws + WS_CTL, 0, CTL_ZERO_BYTES, stream) != hipSuccess) return;
    Args a{};
    a.x = (const float*)d_in[0]; a.meta = (const float*)d_in[1]; a.g_mix = (const float*)d_in[2]; a.w_in = (const float*)d_in[3]; a.conv_ssd_w = (const float*)d_in[4]; a.conv_ssd_b = (const float*)d_in[5];
    a.dt_bias = (const float*)d_in[6]; a.a_log = (const float*)d_in[7]; a.d_skip = (const float*)d_in[8]; a.ssd_norm_w = (const float*)d_in[9]; a.conv_sc_w = (const float*)d_in[10]; a.w_out = (const float*)d_in[11];
    a.g_ffn = (const float*)d_in[12]; a.w_q = (const float*)d_in[13]; a.sub_keys = (const float*)d_in[14]; a.expert_u = (const float*)d_in[15]; a.expert_v = (const float*)d_in[16]; a.g_final = (const float*)d_in[17];
    a.out = (float*)d_out; a.ws = (unsigned char*)d_ws;
    if (N_LAUNCHES == 1) { a.ph_lo = 0; a.ph_hi = NPHASE; hipLaunchKernelGGL(fwd, dim3(grid), dim3(NTHREADS), LDS_BYTES, stream, a); }
    else for (int p = 0; p < NPHASE; ++p) { a.ph_lo = p; a.ph_hi = p + 1; hipLaunchKernelGGL(fwd, dim3(grid), dim3(NTHREADS), LDS_BYTES, stream, a); }
}
```

```cpp
#include <hip/hip_runtime.h>
#include <cstdio>
#include <cstdint>

#define GAS __attribute__((address_space(1)))
#define LAS __attribute__((address_space(3)))
typedef unsigned short bf16_t;
typedef short bf16x8 __attribute__((ext_vector_type(8)));
typedef float f32x4 __attribute__((ext_vector_type(4)));
typedef float f32x2 __attribute__((ext_vector_type(2)));
typedef unsigned u32x4 __attribute__((ext_vector_type(4)));
typedef unsigned u32x2 __attribute__((ext_vector_type(2)));

constexpr int D = 1024, BATCH = 16, SEQ = 2048, NMETA = 16, LSEQ = SEQ + NMETA;
constexpr int TR = BATCH * SEQ;
constexpr int ROWS_A = 33024;
constexpr int D_SSD = 1536, HEADS = 24, HD = 64, NG = 4, NS = 128, D_XBC = 2560, D_SC = 512, D_IN = 5656, D_MIX = 2048;
constexpr int LDP = 5888;
constexpr int C_Z = 0, C_SCB = 1536, C_XBC = 2048, C_SCC = 4608, C_SCX = 5120, C_DT = 5632;
constexpr int P_ZS = 2048, P_XG = 640, P_SC = 1024, P_DT = 32;
constexpr size_t ZS_OFF = 0, XG_OFF = (size_t)ROWS_A * P_ZS, XG_STRIDE = (size_t)ROWS_A * P_XG, SC_OFF = XG_OFF + 4 * XG_STRIDE, DT_OFF = SC_OFF + (size_t)ROWS_A * P_SC, PANELS_END = DT_OFF + (size_t)ROWS_A * P_DT;
static_assert(PANELS_END <= (size_t)ROWS_A * LDP, "panels fit the PROJ region");
__host__ __device__ __forceinline__ size_t proj_dst(int j, int& pitch) {
    if (j < 2048) { pitch = P_ZS; return ZS_OFF + j; }
    if (j < 4608) { const int ch = j - 2048; pitch = P_XG;
        if (ch < 1536) { const int g = ch / 384; return XG_OFF + g * XG_STRIDE + (ch - 384 * g); }
        if (ch < 2048) { const int r = ch - 1536; return XG_OFF + (r >> 7) * XG_STRIDE + 384 + (r & 127); }
        const int r = ch - 2048; return XG_OFF + (r >> 7) * XG_STRIDE + 512 + (r & 127); }
    if (j < 5632) { pitch = P_SC; return SC_OFF + (j - 4608); }
    if (j < 5664) { pitch = P_DT; return DT_OFF + (j - 5632); }
    pitch = 0; return 0;
}
constexpr int PH = 8, PK = 128, PTOP = 16, PQ = 2048;
constexpr float EPS = 1e-6f;

__host__ __device__ constexpr int proj_src_col(int j) {
    return j < 1536 ? j : j < 2048 ? 4120 + (j - 1536) : j < 4608 ? 1536 + (j - 2048) : j < 5120 ? 4632 + (j - 4608) : j < 5632 ? 5144 + (j - 5120) : j < 5656 ? 4096 + (j - 5632) : -1;
}

constexpr size_t MiB = 1u << 20;
constexpr size_t WS_CTL = 0, CTL_ZERO_BYTES = 1 * MiB;
constexpr size_t WS_WIN = 1 * MiB;
constexpr size_t WS_WOUT = 13 * MiB;
constexpr size_t WS_WQ = 17 * MiB;
constexpr size_t WS_XN = 22 * MiB;
constexpr size_t WS_PROJ = 88 * MiB;
constexpr size_t WS_Q = WS_PROJ;
constexpr size_t WS_EIDX = WS_PROJ + 128 * MiB;
constexpr size_t WS_GATE = WS_PROJ + 144 * MiB;
constexpr size_t WS_UB = WS_PROJ + 160 * MiB;
constexpr size_t WS_V8 = WS_PROJ + 192 * MiB;
constexpr size_t WS_SV = WS_PROJ + 224 * MiB + 65536;
constexpr size_t WS_RSTD = WS_PROJ + 225 * MiB;
constexpr size_t WS_END = WS_PROJ + (size_t)ROWS_A * LDP * 2;
static_assert(WS_RSTD + (1u << 20) <= WS_END, "ws map");
static_assert(WS_XN + (size_t)ROWS_A * D * 2 <= WS_PROJ, "ws map");
static_assert(WS_END <= 512 * MiB, "ws map");

typedef __bf16 bf16x2h_t __attribute__((ext_vector_type(2)));
__device__ __forceinline__ unsigned f2bf(float f) { return (unsigned)__builtin_bit_cast(unsigned short, (__bf16)f); }
__device__ __forceinline__ unsigned pk2(float lo, float hi) { bf16x2h_t v; v.x = (__bf16)lo; v.y = (__bf16)hi; return __builtin_bit_cast(unsigned, v); }
__device__ __forceinline__ float bf2f(unsigned short b) { return __builtin_bit_cast(float, ((unsigned)b) << 16); }
__device__ __forceinline__ float bflo(unsigned w) { return __builtin_bit_cast(float, w << 16); }
__device__ __forceinline__ float bfhi(unsigned w) { return __builtin_bit_cast(float, w & 0xffff0000u); }
template <int CTRL> __device__ __forceinline__ float dppf0(float x) { return __builtin_bit_cast(float, __builtin_amdgcn_update_dpp(0, __builtin_bit_cast(int, x), CTRL, 0xF, 0xF, true)); }
__device__ __forceinline__ void swap32_self(unsigned u, unsigned& lo_lo, unsigned& hi_hi) { unsigned u2 = u; asm volatile("" : "+v"(u2)); auto r = __builtin_amdgcn_permlane32_swap(u, u2, false, false); lo_lo = r[0]; hi_hi = r[1]; }
__device__ __forceinline__ void swap16_self(unsigned u, unsigned& even2, unsigned& odd2) { unsigned u2 = u; asm volatile("" : "+v"(u2)); auto r = __builtin_amdgcn_permlane16_swap(u, u2, false, false); even2 = r[0]; odd2 = r[1]; }
__device__ __forceinline__ float wave_sum(float v) {
    v += dppf0<0xB1>(v); v += dppf0<0x4E>(v); v += dppf0<0x141>(v); v += dppf0<0x140>(v);
    unsigned p, q; swap16_self(__builtin_bit_cast(unsigned, v), p, q); v = __builtin_bit_cast(float, p) + __builtin_bit_cast(float, q);
    swap32_self(__builtin_bit_cast(unsigned, v), p, q); v = __builtin_bit_cast(float, p) + __builtin_bit_cast(float, q);
    return v;
}
__device__ __forceinline__ float row_sum16(float x) { x += dppf0<0xB1>(x); x += dppf0<0x4E>(x); x += dppf0<0x141>(x); x += dppf0<0x140>(x); return x; }
__device__ __forceinline__ int row_of(int b, int pos) { return pos < NMETA ? TR + pos : b * SEQ + (pos - NMETA); }

namespace pg8 {
#define PG8_LAS __attribute__((address_space(3)))
constexpr int BM = 256, BK = 64, HALF = 128, HTB = HALF * BK * 2  , STAGE_BYTES = 8 * HTB, NXCD = 8, WGM = 8;
__host__ __device__ __forceinline__ int perm32(int rho) { const int n = rho >> 4, i = rho & 15; return 8 * (i >> 2) + 4 * n + (i & 3); }
__host__ __device__ __forceinline__ int lds_byte(int r, int c) { const int st = (r >> 4) * 2 + (c >> 5), rr = r & 15, cc = c & 31, ob = rr * 64 + cc * 2; return st * 1024 + (ob ^ (((ob >> 9) & 1) << 5)); }
__host__ __device__ __forceinline__ void stage_rc(int b, int& R, int& C) { const int st = b / 1024, sb = b % 1024, swz = sb ^ (((sb >> 9) & 1) << 5); R = (st >> 1) * 16 + swz / 64; C = (st & 1) * 32 + (swz % 64) / 2; }
struct Unit { int pm, pn; };
struct Gemm { const bf16_t* A; const bf16_t* Bt; int M, N, K, lda, ldb; };
struct StaticOrder {
    int nM, nN, nwg, G, c;
    __host__ __device__ void init(int M, int N, int G_, int c_) { nM = M / BM; nN = N / BM; nwg = nM * nN; G = G_; c = c_; }
    __host__ __device__ bool next(int i, Unit& u) const {
        const long L = (long)i * G + c; if (L >= nwg) return false;
        int wgid = (int)L; { const int q = nwg / NXCD, r = nwg % NXCD, xcd = wgid % NXCD, off = wgid / NXCD; wgid = (xcd < r ? xcd * (q + 1) : r * (q + 1) + (xcd - r) * q) + off; }
        const int nig = WGM * nN, gid = wgid / nig, fm = gid * WGM, gsz = (nM - fm) < WGM ? (nM - fm) : WGM;
        u.pm = fm + ((wgid % nig) % gsz); u.pn = (wgid % nig) / gsz; return true;
    }
    __device__ __forceinline__ void a_ready(const Unit&) const {}
    __device__ __forceinline__ void done(const Unit&) const {}
};
struct EpiBf16 {
    static constexpr bool PERM = true, AFTER_DRAIN = false;
    bf16_t* O; int ldc;
    __device__ __forceinline__ void operator()(const f32x4 (&acc)[2][2][4][2], const Unit& u, int wr, int wc, int fr, int fq) const {
        const int row0 = u.pm * BM + wr * 64 + fr, col0 = u.pn * BM + wc * 32 + 8 * fq;
#pragma unroll
        for (int ai = 0; ai < 2; ++ai)
#pragma unroll
            for (int m = 0; m < 4; ++m) { bf16_t* rowp = O + (size_t)(row0 + ai * HALF + m * 16) * ldc + col0;
#pragma unroll
                for (int bj = 0; bj < 2; ++bj) { const f32x4 v0 = acc[ai][bj][m][0], v1 = acc[ai][bj][m][1];
                    u32x4 w; w.x = pk2(v0[0], v0[1]); w.y = pk2(v0[2], v0[3]); w.z = pk2(v1[0], v1[1]); w.w = pk2(v1[2], v1[3]);
                    *(u32x4*)(rowp + bj * HALF) = w; } }
    }
};
struct EpiPanels {
    static constexpr bool PERM = true, AFTER_DRAIN = false;
    bf16_t* P;
    __device__ __forceinline__ void operator()(const f32x4 (&acc)[2][2][4][2], const Unit& u, int wr, int wc, int fr, int fq) const {
        const int row0 = u.pm * BM + wr * 64 + fr, col0 = u.pn * BM + wc * 32 + 8 * fq;
#pragma unroll
        for (int bj = 0; bj < 2; ++bj) { int pitch; const size_t off = proj_dst(col0 + bj * HALF, pitch); if (pitch == 0) continue;
#pragma unroll
            for (int ai = 0; ai < 2; ++ai)
#pragma unroll
                for (int m = 0; m < 4; ++m) { const f32x4 v0 = acc[ai][bj][m][0], v1 = acc[ai][bj][m][1];
                    u32x4 w; w.x = pk2(v0[0], v0[1]); w.y = pk2(v0[2], v0[3]); w.z = pk2(v1[0], v1[1]); w.w = pk2(v1[2], v1[3]);
                    *(u32x4*)(P + off + (size_t)(row0 + ai * HALF + m * 16) * pitch) = w; } }
    }
};
struct EpiResBf16 {
    static constexpr bool PERM = true, AFTER_DRAIN = false;
    const float* base; bf16_t* O; int ldc;
    __device__ __forceinline__ void operator()(const f32x4 (&acc)[2][2][4][2], const Unit& u, int wr, int wc, int fr, int fq) const {
        const int row0 = u.pm * BM + wr * 64 + fr, col0 = u.pn * BM + wc * 32 + 8 * fq;
#pragma unroll
        for (int ai = 0; ai < 2; ++ai)
#pragma unroll
            for (int m = 0; m < 4; ++m) { const size_t off = (size_t)(row0 + ai * HALF + m * 16) * ldc + col0;
#pragma unroll
                for (int bj = 0; bj < 2; ++bj) { const f32x4 b0 = *(const f32x4*)(base + off + bj * HALF), b1 = *(const f32x4*)(base + off + bj * HALF + 4);
                    const f32x4 v0 = acc[ai][bj][m][0] + b0, v1 = acc[ai][bj][m][1] + b1;
                    u32x4 w; w.x = pk2(v0[0], v0[1]); w.y = pk2(v0[2], v0[3]); w.z = pk2(v1[0], v1[1]); w.w = pk2(v1[2], v1[3]);
                    *(u32x4*)(O + off + bj * HALF) = w; } }
    }
};
template <class Epi, class Sched, bool ALIGN_EPI = false, bool SP2 = false>
__device__ __forceinline__ void gemm_phase(PG8_LAS unsigned char* lds, const Gemm g, const Sched& S, const Epi& E) {
    const int tid = threadIdx.x, wid = __builtin_amdgcn_readfirstlane(tid >> 6), lane = tid & 63, wr = wid >> 2, wc = wid & 3, fr = lane & 15, fq = lane >> 4;
    const int K = g.K, nt = K / BK;
    unsigned voffA[2], voffB[2];
#pragma unroll
    for (int i = 0; i < 2; ++i) { int R, C; stage_rc(tid * 16 + i * 8192, R, C); const int Rb = Epi::PERM ? ((R & ~31) + perm32(R & 31)) : R;
        voffA[i] = (unsigned)(R * g.lda + C) * 2u; voffB[i] = (unsigned)(Rb * g.ldb + C) * 2u; }
    const size_t kstep = (size_t)(BK * 2);
    const size_t hstepA = (size_t)HALF * g.lda * 2, hstepB = (size_t)HALF * g.ldb * 2;
    const size_t tstepA = 2 * hstepA, tstepB = 2 * hstepB;
    const unsigned ldsw = (unsigned)wid * 1024u;
    const int aoff = lds_byte(wr * 64 + fr, fq * 8), boff = lds_byte(wc * 32 + fr, fq * 8);
#define PG8_SA(b, h) (((b) * 2 + (h)) * HTB)
#define PG8_SB(b, h) ((4 + (b) * 2 + (h)) * HTB)
#define PG8_STAGE(bufoff, gbase, voff) do { _Pragma("unroll") for (int _i = 0; _i < 2; ++_i) \
        __builtin_amdgcn_global_load_lds((const unsigned*)((const char*)(gbase) + (voff)[_i]), (PG8_LAS unsigned*)(lds + (bufoff) + ldsw + _i * 8192), 16, 0, 0); } while (0)
#define PG8_LDA(dst, b, h) do { _Pragma("unroll") for (int m = 0; m < 4; ++m) _Pragma("unroll") for (int k = 0; k < 2; ++k) dst[m][k] = *(const PG8_LAS bf16x8*)(lds + PG8_SA(b, h) + aoff + m * 2048 + k * 1024); } while (0)
#define PG8_LDB(dst, b, h) do { _Pragma("unroll") for (int n = 0; n < 2; ++n) _Pragma("unroll") for (int k = 0; k < 2; ++k) dst[n][k] = *(const PG8_LAS bf16x8*)(lds + PG8_SB(b, h) + boff + n * 2048 + k * 1024); } while (0)
#define PG8_MMA(ai, bj, At, Bt) do { __builtin_amdgcn_s_setprio(1); _Pragma("unroll") for (int m = 0; m < 4; ++m) _Pragma("unroll") for (int n = 0; n < 2; ++n) _Pragma("unroll") for (int k = 0; k < 2; ++k) \
        acc[ai][bj][m][n] = __builtin_amdgcn_mfma_f32_16x16x32_bf16(Bt[n][k], At[m][k], acc[ai][bj][m][n], 0, 0, 0); __builtin_amdgcn_s_setprio(0); } while (0)
#define PG8_WAIT_V(n) asm volatile("s_waitcnt vmcnt(" #n ")" ::: "memory")
#define PG8_WAIT_L(n) asm volatile("s_waitcnt lgkmcnt(" #n ")" ::: "memory")
#define PG8_BAR __builtin_amdgcn_s_barrier()
#define PG8_SCHED __builtin_amdgcn_sched_barrier(0)
    Unit cur, nxt; int ui = 0;
    if (!S.next(0, cur)) return;
    f32x4 acc[2][2][4][2];
#pragma unroll
    for (int a = 0; a < 2; ++a)
#pragma unroll
        for (int b = 0; b < 2; ++b)
#pragma unroll
            for (int m = 0; m < 4; ++m)
#pragma unroll
                for (int n = 0; n < 2; ++n) acc[a][b][m][n] = (f32x4){0.f, 0.f, 0.f, 0.f};
    bf16x8 At[4][2], B0[2][2], B1[2][2];
    const char* cA = (const char*)g.A + (size_t)cur.pm * tstepA; const char* cB = (const char*)g.Bt + (size_t)cur.pn * tstepB;
    S.a_ready(cur);
    if constexpr (SP2) {
        PG8_STAGE(PG8_SB(0, 0), cB, voffB); PG8_STAGE(PG8_SB(0, 1), cB + hstepB, voffB); PG8_STAGE(PG8_SA(0, 0), cA, voffA); PG8_STAGE(PG8_SA(0, 1), cA + hstepA, voffA);
        if (wr == 1) PG8_BAR;
        PG8_WAIT_V(2); PG8_BAR;
        PG8_STAGE(PG8_SB(1, 0), cB + kstep, voffB); PG8_STAGE(PG8_SA(1, 0), cA + kstep, voffA); PG8_STAGE(PG8_SB(1, 1), cB + hstepB + kstep, voffB);
        PG8_WAIT_V(6); PG8_BAR;
    } else {
        PG8_STAGE(PG8_SB(0, 0), cB, voffB); PG8_STAGE(PG8_SA(0, 0), cA, voffA); PG8_STAGE(PG8_SB(0, 1), cB + hstepB, voffB); PG8_STAGE(PG8_SA(0, 1), cA + hstepA, voffA);
        if (wr == 1) PG8_BAR;
        PG8_WAIT_V(4); PG8_BAR;
        PG8_STAGE(PG8_SB(1, 0), cB + kstep, voffB); PG8_STAGE(PG8_SA(1, 0), cA + kstep, voffA); PG8_STAGE(PG8_SB(1, 1), cB + hstepB + kstep, voffB);
        PG8_WAIT_V(6); PG8_BAR;
    }
    for (;;) {
        const bool has_next = S.next(ui + 1, nxt);
        const char* nA = has_next ? (const char*)g.A + (size_t)nxt.pm * tstepA : cA; const char* nB = has_next ? (const char*)g.Bt + (size_t)nxt.pn * tstepB : cB;
        for (int t = 0; t < nt; t += 2) {
            const bool last = (t == nt - 2);
            const char* a1 = cA + (size_t)(t + 1) * kstep;
            const char* a2 = last ? nA : cA + (size_t)(t + 2) * kstep; const char* b2 = last ? nB : cB + (size_t)(t + 2) * kstep;
            const char* a3 = a2 + kstep; const char* b3 = b2 + kstep;
            if (last && has_next) S.a_ready(nxt);
            if constexpr (SP2) {
            PG8_LDB(B0, 0, 0); PG8_LDB(B1, 0, 1); PG8_SCHED; PG8_LDA(At, 0, 0); PG8_STAGE(PG8_SA(1, 1), a1 + hstepA, voffA);
            PG8_WAIT_V(8); PG8_WAIT_L(0); PG8_BAR; PG8_MMA(0, 0, At, B0); PG8_MMA(0, 1, At, B1); PG8_BAR; PG8_SCHED;
            PG8_LDA(At, 0, 1); PG8_STAGE(PG8_SB(0, 0), b2, voffB); PG8_STAGE(PG8_SB(0, 1), b2 + hstepB, voffB); PG8_STAGE(PG8_SA(0, 0), a2, voffA);
            PG8_WAIT_V(8); PG8_WAIT_L(0); PG8_BAR; PG8_MMA(1, 0, At, B0); PG8_MMA(1, 1, At, B1); PG8_BAR; PG8_SCHED;
            PG8_LDB(B0, 1, 0); PG8_LDB(B1, 1, 1); PG8_SCHED; PG8_LDA(At, 1, 0); PG8_STAGE(PG8_SA(0, 1), a2 + hstepA, voffA);
            PG8_WAIT_V(8); PG8_WAIT_L(0); PG8_BAR; PG8_MMA(0, 0, At, B0); PG8_MMA(0, 1, At, B1); PG8_BAR; PG8_SCHED;
            PG8_LDA(At, 1, 1); PG8_STAGE(PG8_SB(1, 0), b3, voffB); PG8_STAGE(PG8_SB(1, 1), b3 + hstepB, voffB); PG8_STAGE(PG8_SA(1, 0), a3, voffA);
            PG8_WAIT_V(8); PG8_WAIT_L(0); PG8_BAR; PG8_MMA(1, 0, At, B0); PG8_MMA(1, 1, At, B1); PG8_BAR; PG8_SCHED;
            } else {
            PG8_LDB(B0, 0, 0); PG8_SCHED; PG8_LDA(At, 0, 0); PG8_STAGE(PG8_SA(1, 1), a1 + hstepA, voffA);
            PG8_WAIT_L(8); PG8_BAR; PG8_WAIT_L(0); PG8_MMA(0, 0, At, B0); PG8_BAR; PG8_SCHED;
            PG8_LDB(B1, 0, 1); PG8_STAGE(PG8_SB(0, 0), b2, voffB);
            PG8_BAR; PG8_WAIT_L(0); PG8_MMA(0, 1, At, B1); PG8_BAR;
            PG8_LDA(At, 0, 1); PG8_STAGE(PG8_SA(0, 0), a2, voffA);
            PG8_BAR; PG8_WAIT_L(0); PG8_MMA(1, 0, At, B0); PG8_BAR; PG8_SCHED;
            PG8_STAGE(PG8_SB(0, 1), b2 + hstepB, voffB);
            PG8_WAIT_V(6); PG8_BAR; PG8_MMA(1, 1, At, B1); PG8_BAR;
            PG8_LDB(B0, 1, 0); PG8_SCHED; PG8_LDA(At, 1, 0); PG8_STAGE(PG8_SA(0, 1), a2 + hstepA, voffA);
            PG8_WAIT_L(8); PG8_BAR; PG8_WAIT_L(0); PG8_MMA(0, 0, At, B0); PG8_BAR; PG8_SCHED;
            PG8_LDB(B1, 1, 1); PG8_STAGE(PG8_SB(1, 0), b3, voffB);
            PG8_BAR; PG8_WAIT_L(0); PG8_MMA(0, 1, At, B1); PG8_BAR;
            PG8_LDA(At, 1, 1); PG8_STAGE(PG8_SA(1, 0), a3, voffA);
            PG8_BAR; PG8_WAIT_L(0); PG8_MMA(1, 0, At, B0); PG8_BAR; PG8_SCHED;
            PG8_STAGE(PG8_SB(1, 1), b3 + hstepB, voffB);
            PG8_WAIT_V(6); PG8_BAR; PG8_MMA(1, 1, At, B1); PG8_BAR;
            }
        }
        if constexpr (ALIGN_EPI) { if (wr == 0) PG8_BAR; }
        if constexpr (!Epi::AFTER_DRAIN) { E(acc, cur, wr, wc, fr, fq); S.done(cur); }
        if (!has_next) break;
#pragma unroll
        for (int a = 0; a < 2; ++a)
#pragma unroll
            for (int b = 0; b < 2; ++b)
#pragma unroll
                for (int m = 0; m < 4; ++m)
#pragma unroll
                    for (int n = 0; n < 2; ++n) acc[a][b][m][n] = (f32x4){0.f, 0.f, 0.f, 0.f};
        cur = nxt; cA = nA; cB = nB; ++ui;
        if constexpr (ALIGN_EPI) { if (wr == 1) PG8_BAR; }
    }
    PG8_WAIT_V(0);
    if constexpr (!ALIGN_EPI) { if (wr == 0) PG8_BAR; }
    PG8_BAR;
    if constexpr (Epi::AFTER_DRAIN) { E.fused(acc, cur, wr, wc, fr, fq, lds, wid, lane); S.done(cur); }
#undef PG8_SA
#undef PG8_SB
#undef PG8_STAGE
#undef PG8_LDA
#undef PG8_LDB
#undef PG8_MMA
#undef PG8_WAIT_V
#undef PG8_WAIT_L
#undef PG8_BAR
#undef PG8_SCHED
}

}

#define XB_TMO      128
#define XB_XCNT(j)  (256  + 64 * (j))
#define XB_XSUB(j)  (1280 + 64 * (j))
#define XB_XGEN(j)  (2304 + 64 * (j))
#define XB_TOP      3328
#define XB_TOPGEN   3392
#define XCD_BAR_WORDS 3456
#define XB_SPIN_CAP (1u << 18)
__device__ __forceinline__ unsigned xb_ld(unsigned* p)              { return __hip_atomic_load(p, __ATOMIC_RELAXED, __HIP_MEMORY_SCOPE_AGENT); }
__device__ __forceinline__ unsigned xb_add(unsigned* p, unsigned v) { return __hip_atomic_fetch_add(p, v, __ATOMIC_RELAXED, __HIP_MEMORY_SCOPE_AGENT); }
__device__ __forceinline__ unsigned xb_xcc_id() { return (unsigned)__builtin_amdgcn_s_getreg((3 << 11) | 20) & 0xFu; }
#define XB_SPIN(cond, bar) do { unsigned _sp = 0; while (cond) { __builtin_amdgcn_s_sleep(1); \
    if ((++_sp & 255u) == 0u) { if (xb_ld(&(bar)[XB_TMO])) break; if (_sp > XB_SPIN_CAP) { atomicAdd(&(bar)[XB_TMO], 1u); break; } } } } while (0)
struct XcdBarrier { unsigned* bar; unsigned x; volatile LAS unsigned* st; };
__device__ __forceinline__ XcdBarrier xcd_barrier_post(unsigned* bar, volatile LAS unsigned* st) {
    XcdBarrier b; b.bar = bar; b.x = xb_xcc_id(); b.st = st;
    if (threadIdx.x == 0) (void)xb_add(&bar[XB_XCNT(b.x)], 1u);
    return b;
}
__device__ __forceinline__ void xcd_barrier_complete(unsigned* bar, unsigned x, unsigned& nloc, unsigned& nx) {
    const unsigned G = gridDim.x * gridDim.y * gridDim.z;
    unsigned sum, cnt, mine, sp = 0u;
    for (;;) {
        sum = 0u; cnt = 0u; mine = 0u;
#pragma unroll
        for (unsigned j = 0; j < 16; ++j) { const unsigned c = xb_ld(&bar[XB_XCNT(j)]); sum += c; cnt += (c > 0u) ? 1u : 0u; mine = (j == x) ? c : mine; }
        if (sum == G) break;
        __builtin_amdgcn_s_sleep(1);
        if ((++sp & 255u) == 0u) { if (xb_ld(&bar[XB_TMO])) break; if (sp > XB_SPIN_CAP) { atomicAdd(&bar[XB_TMO], 1u); break; } }
    }
    nloc = mine > 0u ? mine : 1u; nx = cnt > 0u ? cnt : 1u;
}
__device__ __forceinline__ void xcd_barrier(const XcdBarrier& b) {
    asm volatile("s_waitcnt vmcnt(0)" ::: "memory");
    __syncthreads();
    if (threadIdx.x == 0) {
        unsigned* bar = b.bar;
        __builtin_amdgcn_s_waitcnt(0);
        unsigned nloc = b.st[0], nx = b.st[1];
        if (nloc == 0u) { xcd_barrier_complete(bar, b.x, nloc, nx); b.st[0] = nloc; b.st[1] = nx; }
        const unsigned old = xb_add(&bar[XB_XSUB(b.x)], 1u);
        const unsigned gen = old / nloc;
        if (old + 1u == (gen + 1u) * nloc) {
            __builtin_amdgcn_fence(__ATOMIC_RELEASE, "agent");
            asm volatile("s_waitcnt vmcnt(0)" ::: "memory");
            const unsigned og = xb_add(&bar[XB_TOP], 1u);
            const unsigned tg = og / nx;
            if (og + 1u == (tg + 1u) * nx) xb_add(&bar[XB_TOPGEN], 1u);
            else XB_SPIN(xb_ld(&bar[XB_TOPGEN]) == tg, bar);
            __builtin_amdgcn_fence(__ATOMIC_ACQUIRE, "agent");
            xb_add(&bar[XB_XGEN(b.x)], 1u);
            asm volatile("s_waitcnt vmcnt(0)" ::: "memory");
        } else {
            XB_SPIN(xb_ld(&bar[XB_XGEN(b.x)]) == gen, bar);
            __builtin_amdgcn_fence(__ATOMIC_ACQUIRE, "agent");
            asm volatile("s_waitcnt vmcnt(0)" ::: "memory");
        }
    }
    __syncthreads();
}

constexpr int NWAVES = 8, NTHREADS = 512;
constexpr int NPHASE = 10;
#ifndef MK_N_LAUNCHES
#define MK_N_LAUNCHES 1
#endif
constexpr int N_LAUNCHES = MK_N_LAUNCHES;
constexpr int RING_BYTES = 131072, LDS_BYTES = 163840, LDSCTL_OFF = LDS_BYTES - 256;
constexpr int CW_BAR = 4096;

struct Args {
    const float *x, *meta, *g_mix, *w_in, *conv_ssd_w, *conv_ssd_b, *dt_bias, *a_log, *d_skip, *ssd_norm_w, *conv_sc_w, *w_out, *g_ffn, *w_q, *sub_keys, *expert_u, *expert_v, *g_final;
    float* out; unsigned char* ws; int ph_lo, ph_hi;
};
struct Frame { LAS unsigned char* lds; int tid, lane, wave, G, vcu; };

template <class ColMap>
__device__ __forceinline__ void p0_transpose_item(const float* W, int K, int N, bf16_t* WT, int nblk, LAS float* scr, int item, int lane, ColMap cm, const float* kscale = nullptr) {
    const int kb = item / nblk, nb = item % nblk, k0 = 64 * kb, n0 = 32 * nb;
    const int sc = cm(n0 + (lane & 31));
#pragma unroll 8
    for (int i = 0; i < 32; ++i) { const int kk = 2 * i + (lane >> 5); scr[kk * 33 + (lane & 31)] = sc >= 0 ? W[(size_t)(k0 + kk) * N + sc] * (kscale ? kscale[k0 + kk] : 1.f) : 0.f; }
    asm volatile("s_waitcnt lgkmcnt(0)" ::: "memory");
    const int c = lane & 7;
#pragma unroll
    for (int j = 0; j < 4; ++j) { const int n = (lane >> 3) + 8 * j; const LAS float* s = scr + (8 * c) * 33 + n;
        u32x4 o; o.x = pk2(s[0 * 33], s[1 * 33]); o.y = pk2(s[2 * 33], s[3 * 33]); o.z = pk2(s[4 * 33], s[5 * 33]); o.w = pk2(s[6 * 33], s[7 * 33]);
        *(u32x4*)(WT + (size_t)(n0 + n) * K + k0 + 8 * c) = o; }
    asm volatile("s_waitcnt lgkmcnt(0)" ::: "memory");
}
__device__ __forceinline__ void p0_prologue(const Frame& F, const Args& a) {
    LAS float* scr = (LAS float*)(F.lds + F.wave * 16384);
    const int gw = F.vcu * NWAVES + F.wave, NGW = F.G * NWAVES;
    bf16_t* WinT = (bf16_t*)(a.ws + WS_WIN); bf16_t* WoutT = (bf16_t*)(a.ws + WS_WOUT); bf16_t* WqT = (bf16_t*)(a.ws + WS_WQ); bf16_t* XN = (bf16_t*)(a.ws + WS_XN);
    constexpr int I_IN = (D / 64) * (LDP / 32), I_OUT = (D_MIX / 64) * (D / 32), I_Q = (D / 64) * (PQ / 32);
    for (int it = gw; it < I_IN + I_OUT + I_Q; it += NGW) {
        int r = it;
        if (r < I_IN) { p0_transpose_item(a.w_in, D, D_IN, WinT, LDP / 32, scr, r, F.lane, [](int j) { return proj_src_col(j); }); continue; } r -= I_IN;
        if (r < I_OUT) { p0_transpose_item(a.w_out, D_MIX, D, WoutT, D / 32, scr, r, F.lane, [](int j) { return j; }); continue; } r -= I_OUT;
        p0_transpose_item(a.w_q, D, PQ, WqT, PQ / 32, scr, r, F.lane, [](int j) { return j; }, a.g_ffn);
    }
    for (int m = gw; m < ROWS_A; m += NGW) {
        u32x2* o8 = (u32x2*)(XN + (size_t)m * D) + F.lane;
        if (m >= TR + NMETA) {
#pragma unroll
            for (int j = 0; j < 4; ++j) o8[64 * j] = (u32x2){0u, 0u};
            continue; }
        const float* src = m < TR ? a.x + (size_t)m * D : a.meta + (size_t)(m - TR) * D;
        const f32x4* xr = (const f32x4*)src + F.lane; const f32x4* gr = (const f32x4*)a.g_mix + F.lane;
        f32x4 v[4]; float s = 0.f;
#pragma unroll
        for (int j = 0; j < 4; ++j) { v[j] = xr[64 * j]; s += (v[j].x * v[j].x + v[j].y * v[j].y) + (v[j].z * v[j].z + v[j].w * v[j].w); }
        const float rstd = 1.0f / sqrtf(wave_sum(s) * (1.f / D) + EPS);
#pragma unroll
        for (int j = 0; j < 4; ++j) { const f32x4 gg = gr[64 * j]; o8[64 * j] = (u32x2){pk2(v[j].x * rstd * gg.x, v[j].y * rstd * gg.y), pk2(v[j].z * rstd * gg.z, v[j].w * rstd * gg.w)}; }
    }
}

typedef float f32x16 __attribute__((ext_vector_type(16)));
constexpr int PITCH = 136;
constexpr int SL_C = 0, SL_B = 34816, SL_M0 = 69632, SL_X = 104448, SL_DT = 139264, SL_ACS = 142336;
constexpr int YPITCH = 396;
static_assert(SL_B + 128 * YPITCH * 2 <= SL_DT, "staging fits below dt/acs");
constexpr size_t WS_DAT = WS_XN;
constexpr size_t WS_SMETA = WS_XN + 65536;

__device__ __forceinline__ f32x16 mfma32(bf16x8 a, bf16x8 b, f32x16 c) { return __builtin_amdgcn_mfma_f32_32x32x16_bf16(a, b, c, 0, 0, 0); }
__device__ __forceinline__ float silu_f(float v) { return v / (1.f + __expf(-v)); }

template <int NP> struct ConvW { u32x4 raw[NP + 3]; };
template <int NP> __device__ __forceinline__ void convw_load(ConvW<NP>& ci, const bf16_t* xgc  , int b, int pos0) {
#pragma unroll
    for (int i = 0; i < NP + 3; ++i) { const int pos = pos0 - 3 + i; u32x4 v = (u32x4){0u, 0u, 0u, 0u};
        if (pos >= 0) v = *(const u32x4*)(xgc + (size_t)row_of(b, pos) * P_XG);
        ci.raw[i] = v; }
}
struct ConvWt { f32x4 w[4][2], cb[2]; };
__device__ __forceinline__ void convw_weights(ConvWt& cw, const Args& a, int ch) {
    cw.cb[0] = *(const f32x4*)(a.conv_ssd_b + ch); cw.cb[1] = *(const f32x4*)(a.conv_ssd_b + ch + 4);
#pragma unroll
    for (int wi = 0; wi < 4; ++wi) { cw.w[wi][0] = *(const f32x4*)(a.conv_ssd_w + wi * D_XBC + ch); cw.w[wi][1] = *(const f32x4*)(a.conv_ssd_w + wi * D_XBC + ch + 4); }
}
__device__ __forceinline__ float bfel(const u32x4& v, int c) { const unsigned w = (c >> 1) == 0 ? v.x : (c >> 1) == 1 ? v.y : (c >> 1) == 2 ? v.z : v.w; return (c & 1) ? bfhi(w) : bflo(w); }
template <int NP> __device__ __forceinline__ void convw_pos(const ConvW<NP>& ci, const ConvWt& cw, int s, float (&o)[8]) {
#pragma unroll
    for (int c = 0; c < 8; ++c) { const int q = c >> 2, e = c & 3;
        o[c] = silu_f(cw.cb[q][e] + cw.w[0][q][e] * bfel(ci.raw[s], c) + cw.w[1][q][e] * bfel(ci.raw[s + 1], c) + cw.w[2][q][e] * bfel(ci.raw[s + 2], c) + cw.w[3][q][e] * bfel(ci.raw[s + 3], c)); }
}
__device__ __forceinline__ void ssd_dt_acs(const Frame& F_, const Args& a, const bf16_t* PROJ, int b, int p0, int g, float* dat  ) {
    const Frame& F0 = F_;
    if (F0.wave < 6) {
        int lane_ = F0.lane; asm volatile("" : "+v"(lane_));
        Frame Fl = F0; Fl.lane = lane_;
        const Frame& F = Fl;
        const int h = g * 6 + F.wave; const float A = -__expf(a.a_log[h]), dtb = a.dt_bias[h];
        LAS float* dtL = (LAS float*)(F.lds + SL_DT) + F.wave * 128; LAS float* acL = (LAS float*)(F.lds + SL_ACS) + F.wave * 128;
        float dv[2], av[2];
#pragma unroll
        for (int hf = 0; hf < 2; ++hf) { const int pos = p0 + F.lane + 64 * hf; float d = 0.f;
            if (pos >= 0) { const float v = bf2f(PROJ[DT_OFF + (size_t)row_of(b, pos) * P_DT + h]) + dtb, t = __expf(-fabsf(v));
                d = fmaxf(v, 0.f) + (t < 1e-3f ? t * (1.f - 0.5f * t) : __logf(1.f + t)); }
            dv[hf] = d; av[hf] = d * A; }
#pragma unroll
        for (int o = 1; o < 64; o <<= 1) { const float t0 = __shfl_up(av[0], o), t1 = __shfl_up(av[1], o); if (F.lane >= o) { av[0] += t0; av[1] += t1; } }
        av[1] += __shfl(av[0], 63);
        dtL[F.lane] = dv[0]; dtL[F.lane + 64] = dv[1]; acL[F.lane] = av[0]; acL[F.lane + 64] = av[1];
        if (dat && F.lane == 63) dat[h] = __expf(av[1]);
    }
}

__device__ __forceinline__ void ssd_s1_unit(const Frame& F, const Args& a, int b, int c, int g) {
    const bf16_t* PROJ = (const bf16_t*)(a.ws + WS_PROJ);
    const int p0 = c == 0 ? -112 : NMETA + 128 * (c - 1), lr = F.lane & 31, hf = F.lane >> 5;
    __syncthreads();
    ssd_dt_acs(F, a, PROJ, b, p0, g, (float*)(a.ws + WS_DAT) + (size_t)(b * 17 + c) * HEADS);
    if (F.tid < 256) { const int chg = F.tid & 15, sr = F.tid >> 4, ch = D_SSD + g * 128 + 8 * chg;
        ConvW<8> ci; convw_load<8>(ci, PROJ + XG_OFF + g * XG_STRIDE + 384 + 8 * chg, b, p0 + 8 * sr); ConvWt cw; convw_weights(cw, a, ch);
        unsigned pk[8][4];
#pragma unroll
        for (int s2 = 0; s2 < 4; ++s2) { float o0[8], o1[8]; convw_pos<8>(ci, cw, 2 * s2, o0); convw_pos<8>(ci, cw, 2 * s2 + 1, o1);
#pragma unroll
            for (int c = 0; c < 8; ++c) pk[c][s2] = pk2(o0[c], o1[c]); }
#pragma unroll
        for (int c = 0; c < 8; ++c) *(LAS u32x4*)(F.lds + SL_C + ((8 * chg + c) * PITCH + 8 * sr) * 2) = (u32x4){pk[c][0], pk[c][1], pk[c][2], pk[c][3]}; }
    __syncthreads();
    const bf16_t* xg1 = PROJ + XG_OFF + g * XG_STRIDE + 8 * (F.tid & 7);
    ConvW<2> cin; convw_load<2>(cin, xg1, b, p0 + 2 * (F.tid >> 3));
#pragma unroll 1
    for (int hh = 0; hh < 6; ++hh) {
        const int h = g * 6 + hh, buf = hh & 1;
        {
            const int chg = F.tid & 7, sp = F.tid >> 3, ch = h * 64 + 8 * chg;
            const ConvW<2> ci = cin; ConvWt cw; convw_weights(cw, a, ch);
            if (hh < 5) convw_load<2>(cin, xg1 + (hh + 1) * 64, b, p0 + 2 * sp);
            const LAS float* dtL = (const LAS float*)(F.lds + SL_DT) + hh * 128; const LAS float* acL = (const LAS float*)(F.lds + SL_ACS) + hh * 128;
            const float aend = acL[127], w0 = dtL[2 * sp] * __expf(aend - acL[2 * sp]), w1 = dtL[2 * sp + 1] * __expf(aend - acL[2 * sp + 1]);
            float o0[8], o1[8]; convw_pos<2>(ci, cw, 0, o0); convw_pos<2>(ci, cw, 1, o1);
#pragma unroll
            for (int c = 0; c < 8; ++c) *(LAS unsigned*)(F.lds + SL_X + buf * 17408 + ((8 * chg + c) * PITCH + 2 * sp) * 2) = pk2(o0[c] * w0, o1[c] * w1);
        }
        __syncthreads();
        const int pb = F.wave >> 2, nb = F.wave & 3;
        f32x16 acc;
#pragma unroll
        for (int r = 0; r < 16; ++r) acc[r] = 0.f;
#pragma unroll
        for (int ks = 0; ks < 8; ++ks) {
            const bf16x8 af = *(const LAS bf16x8*)(F.lds + SL_C + ((32 * nb + lr) * PITCH + 16 * ks + 8 * hf) * 2);
            const bf16x8 bf = *(const LAS bf16x8*)(F.lds + SL_X + buf * 17408 + ((32 * pb + lr) * PITCH + 16 * ks + 8 * hf) * 2);
            acc = mfma32(af, bf, acc);
        }
        bf16_t* dst = c == 0 ? (bf16_t*)(a.ws + WS_SMETA) + (size_t)h * 8192 : (bf16_t*)a.out + ((size_t)(b * 16 + (c - 1)) * HEADS + h) * 8192;
        u32x4* d4 = (u32x4*)(dst + ((size_t)(pb * 4 + nb) * 64 + F.lane) * 16);
        u32x4 w0, w1; w0.x = pk2(acc[0], acc[1]); w0.y = pk2(acc[2], acc[3]); w0.z = pk2(acc[4], acc[5]); w0.w = pk2(acc[6], acc[7]);
        w1.x = pk2(acc[8], acc[9]); w1.y = pk2(acc[10], acc[11]); w1.z = pk2(acc[12], acc[13]); w1.w = pk2(acc[14], acc[15]);
        d4[0] = w0; d4[1] = w1;
    }
}
__device__ __forceinline__ void short_conv_all(const Frame& F, const Args& a) {
    bf16_t* PROJ = (bf16_t*)(a.ws + WS_PROJ);
    const size_t gt = (size_t)F.vcu * NTHREADS + F.tid, NT = (size_t)F.G * NTHREADS;
    for (size_t it = gt; it < (size_t)TR * (D_SC / 8); it += NT) {
        const int r = (int)(it / (D_SC / 8)), c0 = (int)(it % (D_SC / 8)) * 8, b = r / SEQ, pos = r % SEQ + NMETA;
        float accv[8];
#pragma unroll
        for (int j = 0; j < 8; ++j) accv[j] = 0.f;
#pragma unroll
        for (int w = 0; w < 3; ++w) { const int rr = row_of(b, pos - 2 + w);
            const u32x4 cc = *(const u32x4*)(PROJ + SC_OFF + (size_t)rr * P_SC + c0), xx = *(const u32x4*)(PROJ + SC_OFF + (size_t)rr * P_SC + 512 + c0);
            const unsigned cw[4] = {cc.x, cc.y, cc.z, cc.w}, xw[4] = {xx.x, xx.y, xx.z, xx.w};
#pragma unroll
            for (int j = 0; j < 4; ++j) { accv[2 * j] += a.conv_sc_w[w * D_SC + c0 + 2 * j] * (bflo(cw[j]) * bflo(xw[j])); accv[2 * j + 1] += a.conv_sc_w[w * D_SC + c0 + 2 * j + 1] * (bfhi(cw[j]) * bfhi(xw[j])); } }
        const u32x4 bb = *(const u32x4*)(PROJ + ZS_OFF + (size_t)r * P_ZS + 1536 + c0); const unsigned bw[4] = {bb.x, bb.y, bb.z, bb.w};
        u32x4 o; unsigned ow[4];
#pragma unroll
        for (int j = 0; j < 4; ++j) ow[j] = pk2(bflo(bw[j]) * accv[2 * j], bfhi(bw[j]) * accv[2 * j + 1]);
        o.x = ow[0]; o.y = ow[1]; o.z = ow[2]; o.w = ow[3];
        *(u32x4*)(PROJ + ZS_OFF + (size_t)r * P_ZS + 1536 + c0) = o;
    }
}
__device__ __forceinline__ void p2_ssd_states(const Frame& F, const Args& a, bool dryrun) {
    if (!dryrun) short_conv_all(F, a);
    for (int u = F.vcu; u < 4 + BATCH * 15 * NG; u += F.G) {
        if (u < 4) ssd_s1_unit(F, a, 0, 0, u);
        else { const int v = u - 4; ssd_s1_unit(F, a, v / (15 * NG), 1 + (v / NG) % 15, v % NG); }
    }
}
__device__ __forceinline__ void p3_ssd_recur(const Frame& F, const Args& a) {
    const float* dat = (const float*)(a.ws + WS_DAT); const bf16_t* SM = (const bf16_t*)(a.ws + WS_SMETA); bf16_t* SF = (bf16_t*)a.out;
    for (int it = F.vcu; it < BATCH * HEADS * 1024 / NTHREADS; it += F.G) {
        const int idx = it * NTHREADS + F.tid, bh = idx >> 10, e8 = idx & 1023, b = bh / HEADS, h = bh % HEADS;
        u32x4 ld[15];
#pragma unroll
        for (int c = 1; c <= 15; ++c) ld[c - 1] = *(const u32x4*)(SF + ((size_t)(b * 16 + (c - 1)) * HEADS + h) * 8192 + e8 * 8);
        const u32x4 m = *(const u32x4*)(SM + (size_t)h * 8192 + e8 * 8);
        float cy[8] = {bflo(m.x), bfhi(m.x), bflo(m.y), bfhi(m.y), bflo(m.z), bfhi(m.z), bflo(m.w), bfhi(m.w)};
#pragma unroll
        for (int c = 1; c <= 16; ++c) {
            u32x4 o; o.x = pk2(cy[0], cy[1]); o.y = pk2(cy[2], cy[3]); o.z = pk2(cy[4], cy[5]); o.w = pk2(cy[6], cy[7]);
            *(u32x4*)(SF + ((size_t)(b * 16 + (c - 1)) * HEADS + h) * 8192 + e8 * 8) = o;
            if (c <= 15) { const float dA = dat[(size_t)(b * 17 + c) * HEADS + h]; const u32x4 t = ld[c - 1];
                cy[0] = cy[0] * dA + bflo(t.x); cy[1] = cy[1] * dA + bfhi(t.x); cy[2] = cy[2] * dA + bflo(t.y); cy[3] = cy[3] * dA + bfhi(t.y);
                cy[4] = cy[4] * dA + bflo(t.z); cy[5] = cy[5] * dA + bfhi(t.z); cy[6] = cy[6] * dA + bflo(t.w); cy[7] = cy[7] * dA + bfhi(t.w); }
        }
    }
}
template <bool DRY> __device__ __forceinline__ void ssd_s3_unit(const Frame& F, const Args& a, int b, int c, int g) {
    bf16_t* PROJ = (bf16_t*)(a.ws + WS_PROJ);
    const int p0 = NMETA + 128 * (c - 1), row0 = b * SEQ + 128 * (c - 1), lr = F.lane & 31, hf = F.lane >> 5;
    __syncthreads();
    ssd_dt_acs(F, a, PROJ, b, p0, g, nullptr);
    {   const int mat = F.tid >> 8, it = F.tid & 255, chg = it & 15, sr = it >> 4, ch = D_SSD + (mat ? 0 : 512) + g * 128 + 8 * chg;
        ConvW<8> ci; convw_load<8>(ci, PROJ + XG_OFF + g * XG_STRIDE + (mat ? 384 : 512) + 8 * chg, b, p0 + 8 * sr); ConvWt cw; convw_weights(cw, a, ch);
#pragma unroll
        for (int s = 0; s < 8; ++s) { float o[8]; convw_pos<8>(ci, cw, s, o);
            *(LAS u32x4*)(F.lds + (mat ? SL_B : SL_C) + ((8 * sr + s) * PITCH + 8 * chg) * 2) = (u32x4){pk2(o[0], o[1]), pk2(o[2], o[3]), pk2(o[4], o[5]), pk2(o[6], o[7])}; } }
    __syncthreads();
    constexpr unsigned SI_P = 0u | (0u << 2) | (1u << 4) | (0u << 6) | (1u << 8) | (2u << 10) | (0u << 12) | (1u << 14) | (2u << 16) | (3u << 18);
    constexpr unsigned LI_P = 0u | (1u << 2) | (1u << 4) | (2u << 6) | (2u << 8) | (2u << 10) | (3u << 12) | (3u << 14) | (3u << 16) | (3u << 18);
    const int nslot = F.wave < 2 ? 2 : 1;
    f32x16 cb[2];
#pragma unroll
    for (int sl = 0; sl < 2; ++sl) {
#pragma unroll
        for (int r = 0; r < 16; ++r) cb[sl][r] = 0.f;
        if (sl < nslot) { const int ti = F.wave + 8 * sl, si = (SI_P >> (2 * ti)) & 3, li = (LI_P >> (2 * ti)) & 3;
#pragma unroll
            for (int ks = 0; ks < 8; ++ks) {
                const bf16x8 af = *(const LAS bf16x8*)(F.lds + SL_B + ((32 * si + lr) * PITCH + 16 * ks + 8 * hf) * 2);
                const bf16x8 bf = *(const LAS bf16x8*)(F.lds + SL_C + ((32 * li + lr) * PITCH + 16 * ks + 8 * hf) * 2);
                cb[sl] = mfma32(af, bf, cb[sl]); } }
    }
    __syncthreads();
    const int pb = F.wave & 1, lio = F.wave >> 1;
    unsigned ypk[6][8];
#pragma unroll
    for (int i = 0; i < 6; ++i)
#pragma unroll
        for (int r = 0; r < 8; ++r) ypk[i][r] = 0u;
#pragma unroll 1
    for (int hh = 0; hh < 6; ++hh) {
        const int h = g * 6 + hh, buf = hh & 1, mofs = buf ? SL_B : SL_M0;
        const LAS float* dtL = (const LAS float*)(F.lds + SL_DT) + hh * 128; const LAS float* acL = (const LAS float*)(F.lds + SL_ACS) + hh * 128;
        const bf16_t* sp = (const bf16_t*)a.out + ((size_t)(b * 16 + (c - 1)) * HEADS + h) * 8192;
        {
            const int chg = F.tid & 7, spp = F.tid >> 3, ch = h * 64 + 8 * chg;
            ConvW<2> ci; convw_load<2>(ci, PROJ + XG_OFF + g * XG_STRIDE + hh * 64 + 8 * chg, b, p0 + 2 * spp); ConvWt cw; convw_weights(cw, a, ch);
            float o0[8], o1[8]; convw_pos<2>(ci, cw, 0, o0); convw_pos<2>(ci, cw, 1, o1);
#pragma unroll
            for (int cc = 0; cc < 8; ++cc) *(LAS unsigned*)(F.lds + SL_X + buf * 17408 + ((8 * chg + cc) * PITCH + 2 * spp) * 2) = pk2(o0[cc], o1[cc]);
        }
        u32x4 sf[4][2];
#pragma unroll
        for (int nb = 0; nb < 4; ++nb) { const u32x4* s4 = (const u32x4*)(sp + ((size_t)(pb * 4 + nb) * 64 + F.lane) * 16); sf[nb][0] = s4[0]; sf[nb][1] = s4[1]; }
        {
            const float Dh = a.d_skip[h];
#pragma unroll
            for (int sl = 0; sl < 2; ++sl) if (sl < nslot) { const int ti = F.wave + 8 * sl, si = (SI_P >> (2 * ti)) & 3, li = (LI_P >> (2 * ti)) & 3;
                const int l = 32 * li + lr; const float acl = acL[l];
#pragma unroll
                for (int q = 0; q < 4; ++q) { const int s0 = 32 * si + 8 * q + 4 * hf;
                    const f32x4 d4 = *(const LAS f32x4*)(dtL + s0), a4 = *(const LAS f32x4*)(acL + s0); float v[4];
#pragma unroll
                    for (int i = 0; i < 4; ++i) { const int s = s0 + i; float t = s <= l ? cb[sl][4 * q + i] * __expf(acl - a4[i]) * d4[i] : 0.f; if (s == l) t += Dh; v[i] = t; }
                    *(LAS u32x2*)(F.lds + mofs + (l * PITCH + s0) * 2) = (u32x2){pk2(v[0], v[1]), pk2(v[2], v[3])}; } }
        }
        f32x16 acc;
#pragma unroll
        for (int r = 0; r < 16; ++r) acc[r] = 0.f;
        {
#pragma unroll
            for (int nb = 0; nb < 4; ++nb) {
#pragma unroll
                for (int qp = 0; qp < 2; ++qp) { const LAS unsigned char* cp_ = F.lds + SL_C + ((32 * lio + lr) * PITCH + 32 * nb + 16 * qp + 4 * hf) * 2;
                    const u32x2 c0 = *(const LAS u32x2*)cp_, c1 = *(const LAS u32x2*)(cp_ + 16);
                    const u32x4 bfr = (u32x4){c0.x, c0.y, c1.x, c1.y};
                    acc = mfma32(__builtin_bit_cast(bf16x8, sf[nb][qp]), __builtin_bit_cast(bf16x8, bfr), acc); } }
            const float sc = __expf(acL[32 * lio + lr]);
#pragma unroll
            for (int r = 0; r < 16; ++r) acc[r] *= sc;
        }
        __syncthreads();
        for (int ks = 0; ks < 2 * (lio + 1); ++ks) {
            const bf16x8 af = *(const LAS bf16x8*)(F.lds + SL_X + buf * 17408 + ((32 * pb + lr) * PITCH + 16 * ks + 8 * hf) * 2);
            const bf16x8 bf = *(const LAS bf16x8*)(F.lds + mofs + ((32 * lio + lr) * PITCH + 16 * ks + 8 * hf) * 2);
            acc = mfma32(af, bf, acc);
        }
#pragma unroll
        for (int i = 0; i < 5; ++i)
#pragma unroll
            for (int r = 0; r < 8; ++r) ypk[i][r] = ypk[i + 1][r];
#pragma unroll
        for (int r = 0; r < 8; ++r) ypk[5][r] = pk2(acc[2 * r], acc[2 * r + 1]);
    }
    __syncthreads();
#pragma unroll
    for (int hh = 0; hh < 6; ++hh)
#pragma unroll
        for (int q = 0; q < 4; ++q) *(LAS u32x2*)(F.lds + SL_B + ((32 * lio + lr) * YPITCH + hh * 64 + 32 * pb + 8 * q + 4 * hf) * 2) = (u32x2){ypk[hh][2 * q], ypk[hh][2 * q + 1]};
    u32x2 zz2[4][6];
#pragma unroll
    for (int pass = 0; pass < 4; ++pass) { const int l = pass * 32 + F.wave * 4 + (F.lane >> 4), sub = F.lane & 15; const bf16_t* zr = PROJ + ZS_OFF + (size_t)(row0 + l) * P_ZS + g * 384;
#pragma unroll
        for (int k = 0; k < 6; ++k) zz2[pass][k] = *(const u32x2*)(zr + 4 * (sub + 16 * k)); }
    __syncthreads();
#pragma unroll
    for (int pass = 0; pass < 4; ++pass) {
        const int l = pass * 32 + F.wave * 4 + (F.lane >> 4), sub = F.lane & 15; bf16_t* zr = PROJ + ZS_OFF + (size_t)(row0 + l) * P_ZS + g * 384;
        float v[6][4]; float ss = 0.f;
#pragma unroll
        for (int k = 0; k < 6; ++k) { const int c0 = 4 * (sub + 16 * k); const u32x2 y2 = *(const LAS u32x2*)(F.lds + SL_B + (l * YPITCH + c0) * 2), z2 = zz2[pass][k];
            const float yy[4] = {bflo(y2.x), bfhi(y2.x), bflo(y2.y), bfhi(y2.y)}, zz[4] = {bflo(z2.x), bfhi(z2.x), bflo(z2.y), bfhi(z2.y)};
#pragma unroll
            for (int i = 0; i < 4; ++i) { v[k][i] = yy[i] * silu_f(zz[i]); ss += v[k][i] * v[k][i]; } }
        ss = row_sum16(ss);
        const float rstd = 1.0f / sqrtf(ss * (1.f / 384.f) + EPS);
#pragma unroll
        for (int k = 0; k < 6; ++k) { const int c0 = 4 * (sub + 16 * k); const f32x4 nw = *(const f32x4*)(a.ssd_norm_w + g * 384 + c0);
            bf16_t* zo = DRY ? (bf16_t*)(a.ws + WS_END) + ((size_t)F.vcu * 128 + l) * 384 : zr;
            *(u32x2*)(zo + c0) = (u32x2){pk2(v[k][0] * rstd * nw.x, v[k][1] * rstd * nw.y), pk2(v[k][2] * rstd * nw.z, v[k][3] * rstd * nw.w)}; }
    }
}
template <bool DRY> __device__ __forceinline__ void p4_ssd_out(const Frame& F, const Args& a) {
    for (int u = F.vcu; u < BATCH * 16 * NG; u += F.G) ssd_s3_unit<DRY>(F, a, u / (16 * NG), 1 + (u / NG) % 16, u % NG);
}

__device__ __forceinline__ void p5_norm2(const Frame& F, const Args& a) {
    const int gw = F.vcu * NWAVES + F.wave, NGW = F.G * NWAVES;
    {
        unsigned char* V8 = a.ws + WS_V8; float* SV = (float*)(a.ws + WS_SV);
        for (int r = gw; r < 2 * PK * PK; r += NGW) {
            const bool isv = r >= PK * PK; const int e = isv ? r - PK * PK : r;
            const f32x4* src = (const f32x4*)((isv ? a.expert_v : a.expert_u) + (size_t)e * D) + 4 * F.lane;
            f32x4 v[4];
#pragma unroll
            for (int j = 0; j < 4; ++j) v[j] = src[j];
            if (isv) {
                float amax = 0.f;
#pragma unroll
                for (int j = 0; j < 4; ++j) amax = fmaxf(amax, fmaxf(fmaxf(fabsf(v[j].x), fabsf(v[j].y)), fmaxf(fabsf(v[j].z), fabsf(v[j].w))));
#pragma unroll
                for (int o = 1; o < 64; o <<= 1) amax = fmaxf(amax, __shfl_xor(amax, o));
                const float sc = amax > 0.f ? amax * (1.0f / 440.0f) : 1.0f, inv = 1.0f / sc;
                u32x4 o4; unsigned ow[4];
#pragma unroll
                for (int j = 0; j < 4; ++j) { int p = 0; p = __builtin_amdgcn_cvt_pk_fp8_f32(v[j].x * inv, v[j].y * inv, p, false); p = __builtin_amdgcn_cvt_pk_fp8_f32(v[j].z * inv, v[j].w * inv, p, true); ow[j] = (unsigned)p; }
                o4.x = ow[0]; o4.y = ow[1]; o4.z = ow[2]; o4.w = ow[3];
                *(u32x4*)(V8 + ((size_t)(F.lane >> 3) * (PK * PK) + e) * 128 + 16 * (F.lane & 7)) = o4; if (F.lane == 0) SV[e] = sc;
            } else {
                const f32x4* gr = (const f32x4*)a.g_ffn + 4 * F.lane;
#pragma unroll
                for (int j = 0; j < 4; ++j) v[j] = v[j] * gr[j];
                u32x4* ub = (u32x4*)((bf16_t*)(a.ws + WS_UB) + (size_t)e * D) + 2 * F.lane;
                u32x4 b0, b1; b0.x = pk2(v[0].x, v[0].y); b0.y = pk2(v[0].z, v[0].w); b0.z = pk2(v[1].x, v[1].y); b0.w = pk2(v[1].z, v[1].w); b1.x = pk2(v[2].x, v[2].y); b1.y = pk2(v[2].z, v[2].w); b1.z = pk2(v[3].x, v[3].y); b1.w = pk2(v[3].z, v[3].w);
                ub[0] = b0; ub[1] = b1;
            }
        }
    }
    const bf16_t* H2b = (const bf16_t*)(a.ws + WS_XN); float* RSTD = (float*)(a.ws + WS_RSTD);
    for (int m = gw; m < TR; m += NGW) {
        const u32x4* xr = (const u32x4*)(H2b + (size_t)m * D) + 2 * F.lane; const u32x4 p = xr[0], q = xr[1]; const unsigned w[8] = {p.x, p.y, p.z, p.w, q.x, q.y, q.z, q.w};
        float s = 0.f;
#pragma unroll
        for (int j = 0; j < 8; ++j) { const float lo = bflo(w[j]), hi = bfhi(w[j]); s += lo * lo + hi * hi; }
        s = wave_sum(s);
        if (F.lane == 0) RSTD[m] = 1.0f / sqrtf(s * (1.f / D) + EPS);
    }
}

__device__ __forceinline__ unsigned ord_bits(float f) { const unsigned u = __builtin_bit_cast(unsigned, f); return u ^ ((u >> 31) ? 0xffffffffu : 0x80000000u); }
__device__ __forceinline__ float ord_val(unsigned o) { const unsigned u = (o & 0x80000000u) ? (o ^ 0x80000000u) : ~o; return __builtin_bit_cast(float, u); }
__device__ __forceinline__ void cex_desc(unsigned& x, unsigned& y) { const unsigned hi = x > y ? x : y, lo = x > y ? y : x; x = hi; y = lo; }
__device__ __forceinline__ void sort16_desc(unsigned (&v)[16]) {
#pragma unroll
    for (int k = 2; k <= 16; k <<= 1)
#pragma unroll
        for (int j = k >> 1; j > 0; j >>= 1)
#pragma unroll
            for (int i = 0; i < 16; ++i) { const int l = i ^ j; if (l > i) { if ((i & k) == 0) cex_desc(v[i], v[l]); else cex_desc(v[l], v[i]); } }
}
__device__ __forceinline__ void bitonic_merge16_desc(unsigned (&v)[16]) {
#pragma unroll
    for (int j = 8; j > 0; j >>= 1)
#pragma unroll
        for (int i = 0; i < 16; ++i) { const int l = i ^ j; if (l > i) cex_desc(v[i], v[l]); }
}
__device__ __forceinline__ void top16_merge(unsigned (&T)[16], const unsigned (&B)[16]) {
#pragma unroll
    for (int i = 0; i < 16; ++i) T[i] = T[i] > B[15 - i] ? T[i] : B[15 - i];
    bitonic_merge16_desc(T);
}
__device__ __forceinline__ void p8_topk_mfma(const Frame& F, const Args& a) {
    const bf16_t* Q = (const bf16_t*)(a.ws + WS_Q); int* EIDX = (int*)(a.ws + WS_EIDX); float* GATE = (float*)(a.ws + WS_GATE);
    const int lane = F.lane, lr = lane & 31, hf = lane >> 5;
    for (int task = F.vcu; task < PH * (TR / 1024); task += F.G) {
        const int h = task % PH, rng = task / PH;
        __syncthreads();
        {
            const f32x4* kp = (const f32x4*)(a.sub_keys + (size_t)h * 2 * PK * 128);
            for (int i = F.tid; i < 2 * PK * 128 / 4; i += NTHREADS) { const f32x4 v = kp[i]; const int row = i >> 5, c4 = (i & 31) * 4;
                *(LAS u32x2*)(F.lds + (row * PITCH + c4) * 2) = (u32x2){pk2(v.x, v.y), pk2(v.z, v.w)}; }
        }
        __syncthreads();
        for (int tile = F.wave; tile < 16; tile += NWAVES) {
            const int t0 = rng * 1024 + tile * 64;
            unsigned L0[16], L1[16];
#pragma unroll
            for (int i = 0; i < 16; ++i) { L0[i] = 0u; L1[i] = 0u; }
#pragma unroll 1
            for (int s = 0; s < 2; ++s) {
                unsigned TA[16], R[16];
#pragma unroll
                for (int i = 0; i < 16; ++i) { TA[i] = 0u; R[i] = 0u; }
#pragma unroll 1
                for (int th = 0; th < 2; ++th) {
                    bf16x8 qf[8];
                    const bf16_t* qp = Q + (size_t)(t0 + 32 * th + lr) * PQ + h * 256 + s * 128 + 8 * hf;
#pragma unroll
                    for (int ks = 0; ks < 8; ++ks) qf[ks] = *(const bf16x8*)(qp + 16 * ks);
                    unsigned T[16];
#pragma unroll
                    for (int i = 0; i < 16; ++i) T[i] = 0u;
#pragma unroll 1
                    for (int kb = 0; kb < 4; ++kb) {
                        f32x16 acc;
#pragma unroll
                        for (int r = 0; r < 16; ++r) acc[r] = 0.f;
#pragma unroll
                        for (int ks = 0; ks < 8; ++ks) { const bf16x8 af = *(const LAS bf16x8*)(F.lds + ((s * PK + 32 * kb + lr) * PITCH + 16 * ks + 8 * hf) * 2); acc = mfma32(af, qf[ks], acc); }
                        unsigned B[16];
#pragma unroll
                        for (int r = 0; r < 16; ++r) { const int k = 32 * kb + 8 * (r >> 2) + 4 * hf + (r & 3); B[r] = (ord_bits(acc[r]) & ~127u) | (unsigned)(127 - k); }
                        sort16_desc(B);
                        top16_merge(T, B);
                    }
                    unsigned P[16];
#pragma unroll
                    for (int i = 0; i < 16; ++i) { unsigned lo2, hi2; swap32_self(T[i], lo2, hi2); P[i] = hf ? lo2 : hi2; }
                    top16_merge(T, P);
#pragma unroll
                    for (int i = 0; i < 16; ++i) { R[i] = hf ? T[i] : TA[i]; TA[i] = T[i]; }
                }
#pragma unroll
                for (int i = 0; i < 16; ++i) { L0[i] = L1[i]; L1[i] = R[i]; }
            }
            const int t = t0 + lane;
            unsigned T[16];
            const float v00 = ord_val(L0[0] & ~127u);
#pragma unroll
            for (int j = 0; j < 16; ++j) T[j] = (ord_bits(v00 + ord_val(L1[j] & ~127u)) & ~255u) | (unsigned)(255 - j);
#pragma unroll
            for (int i = 1; i < 16; ++i)
#pragma unroll
                for (int j = 0; j < 16; ++j) if ((i + 1) * (j + 1) <= 16) {
                    const float sum = ord_val(L0[i] & ~127u) + ord_val(L1[j] & ~127u);
                    unsigned e = (ord_bits(sum) & ~255u) | (unsigned)(255 - (i * 16 + j));
#pragma unroll
                    for (int k = 0; k < 16; ++k) { const unsigned hi = T[k] > e ? T[k] : e; e = T[k] > e ? e : T[k]; T[k] = hi; }
                }
            float best[16]; int eid[16];
#pragma unroll
            for (int k = 0; k < 16; ++k) {
                best[k] = ord_val(T[k] & ~255u); const int pos = 255 - (int)(T[k] & 255u), pi = pos >> 4, pj = pos & 15;
                unsigned a0 = 0u, a1 = 0u;
#pragma unroll
                for (int i = 0; i < 16; ++i) { a0 = (pi == i) ? L0[i] : a0; a1 = (pj == i) ? L1[i] : a1; }
                eid[k] = (127 - (int)(a0 & 127u)) * PK + (127 - (int)(a1 & 127u));
            }
            const float rst = ((const float*)(a.ws + WS_RSTD))[t];
            float se = 0.f, ex[16];
#pragma unroll
            for (int k = 0; k < 16; ++k) { ex[k] = __expf((best[k] - best[0]) * rst); se += ex[k]; }
            const float inv = 1.f / se;
            int* ep = EIDX + (size_t)t * 128 + h * 16; float* gp = GATE + (size_t)t * 128 + h * 16;
#pragma unroll
            for (int k = 0; k < 16; k += 4) { *(int4*)(ep + k) = make_int4(eid[k], eid[k + 1], eid[k + 2], eid[k + 3]); *(f32x4*)(gp + k) = (f32x4){ex[k] * inv, ex[k + 1] * inv, ex[k + 2] * inv, ex[k + 3] * inv}; }
        }
    }
}

typedef __bf16 bf16x2_t __attribute__((ext_vector_type(2)));
__device__ __forceinline__ float dot2bf(unsigned w, unsigned x, float acc) { return __builtin_amdgcn_fdot2_f32_bf16(__builtin_bit_cast(bf16x2_t, w), __builtin_bit_cast(bf16x2_t, x), acc, false); }

__device__ __forceinline__ float shx32(float x, int lane) { unsigned a, b; swap32_self(__builtin_bit_cast(unsigned, x), a, b); return __builtin_bit_cast(float, (lane & 32) ? a : b); }
__device__ __forceinline__ float shx16(float x, int lane) { unsigned a, b; swap16_self(__builtin_bit_cast(unsigned, x), a, b); return __builtin_bit_cast(float, (lane & 16) ? a : b); }
template <int CTRL> __device__ __forceinline__ float dppf(float x) { return __builtin_bit_cast(float, __builtin_amdgcn_update_dpp(0, __builtin_bit_cast(int, x), CTRL, 0xF, 0xF, true)); }
__device__ __forceinline__ float shx8(float x) { return dppf<0x128>(x); }
__device__ __forceinline__ float shx4(float x, int) { return dppf<0x1B>(dppf<0x141>(x)); }

__device__ __forceinline__ float gelu_as(float v) {
    const float av = __builtin_fabsf(v), t = __builtin_amdgcn_rcpf(av * 0.2316418882f + 1.0f);
    float q = t * 0.5307027145f + (-0.7265760135f); q = q * t + 0.7107068705f; q = q * t + (-0.142248368f); q = q * t + 0.127414796f; q = q * t;
    const float e = __builtin_amdgcn_exp2f((v * v) * (-0.72134752044f));
    const float m = v * (q * e);
    return v < 0.f ? m : v - m;
}
__device__ __forceinline__ int rdlane(int v, int l) { return __builtin_amdgcn_readlane(v, l); }
__device__ __forceinline__ float rdlanef(float v, int l) { return __builtin_bit_cast(float, __builtin_amdgcn_readlane(__builtin_bit_cast(int, v), l)); }

struct PeerBatch { int l0, l1, l2, l3; u32x4 r[4][2]; };
__device__ __forceinline__ void peerA_take(unsigned long long& m, PeerBatch& B, const bf16_t* Ub, int lane, int ev) {
    B.l0 = __builtin_ctzll(m); m &= m - 1; B.l1 = B.l0; B.l2 = B.l0; B.l3 = B.l0;
    if (m) { B.l1 = __builtin_ctzll(m); m &= m - 1; if (m) { B.l2 = __builtin_ctzll(m); m &= m - 1; if (m) { B.l3 = __builtin_ctzll(m); m &= m - 1; } } }
    const unsigned e0 = (unsigned)rdlane(ev, B.l0), e1 = (unsigned)rdlane(ev, B.l1), e2 = (unsigned)rdlane(ev, B.l2), e3 = (unsigned)rdlane(ev, B.l3);
    const unsigned loff = (unsigned)lane * 32u;
    const char* r0 = (const char*)Ub + ((size_t)e0 << 11); const char* r1 = (const char*)Ub + ((size_t)e1 << 11); const char* r2 = (const char*)Ub + ((size_t)e2 << 11); const char* r3 = (const char*)Ub + ((size_t)e3 << 11);
    B.r[0][0] = *(const u32x4*)(r0 + loff); B.r[0][1] = *(const u32x4*)(r0 + loff + 16); B.r[1][0] = *(const u32x4*)(r1 + loff); B.r[1][1] = *(const u32x4*)(r1 + loff + 16);
    B.r[2][0] = *(const u32x4*)(r2 + loff); B.r[2][1] = *(const u32x4*)(r2 + loff + 16); B.r[3][0] = *(const u32x4*)(r3 + loff); B.r[3][1] = *(const u32x4*)(r3 + loff + 16);
}
__device__ __forceinline__ void peerA_finish(const PeerBatch& B, int lane, LAS float* dl  , const unsigned (&xp)[8]) {
#define DOT16(lo, hi) dot2bf((hi).w, xp[7], dot2bf((hi).z, xp[6], dot2bf((hi).y, xp[5], dot2bf((hi).x, xp[4], dot2bf((lo).w, xp[3], dot2bf((lo).z, xp[2], dot2bf((lo).y, xp[1], dot2bf((lo).x, xp[0], 0.f))))))))
    const float p0 = DOT16(B.r[0][0], B.r[0][1]), p1 = DOT16(B.r[1][0], B.r[1][1]), p2 = DOT16(B.r[2][0], B.r[2][1]), p3 = DOT16(B.r[3][0], B.r[3][1]);
#undef DOT16
    const bool hi5 = lane & 32, hi4 = lane & 16;
    const float k0 = hi5 ? p2 : p0, s0 = hi5 ? p0 : p2, k1 = hi5 ? p3 : p1, s1 = hi5 ? p1 : p3;
    const float t0 = k0 + shx32(s0, lane), t1 = k1 + shx32(s1, lane);
    const float k2 = hi4 ? t1 : t0, s2 = hi4 ? t0 : t1;
    const float d = row_sum16(k2 + shx16(s2, lane));
    const int sl0 = __builtin_amdgcn_readfirstlane(B.l0), sl1 = __builtin_amdgcn_readfirstlane(B.l1), sl2 = __builtin_amdgcn_readfirstlane(B.l2), sl3 = __builtin_amdgcn_readfirstlane(B.l3);
    const int slot = hi5 ? (hi4 ? sl3 : sl2) : (hi4 ? sl1 : sl0);
    if ((lane & 15) == 0) dl[slot] = d;
}
struct PeerGather8 { u32x4 vv[16]; float aw[16]; };
__device__ __forceinline__ void peerB8_gather(PeerGather8& G, const unsigned char* V8, int lane, int cs, const LAS int* ELt, const LAS float* ALt) {
    const int rg = lane >> 3, cl = lane & 7;
#pragma unroll
    for (int j = 0; j < 16; ++j) { const int e = ELt[8 * j + rg]; G.aw[j] = ALt[8 * j + rg];
        G.vv[j] = *(const u32x4*)(V8 + (((unsigned)(cs * PK * PK) + (unsigned)e) * 128u + (unsigned)(cl * 16))); }
}
__device__ __forceinline__ f32x2 peerB8_reduce(const PeerGather8& G, int lane) {
    f32x2 acc[8];
#pragma unroll
    for (int c = 0; c < 8; ++c) acc[c] = (f32x2){0.f, 0.f};
#pragma unroll
    for (int j = 0; j < 16; ++j) { const unsigned ww[4] = {G.vv[j].x, G.vv[j].y, G.vv[j].z, G.vv[j].w}; const f32x2 a2 = (f32x2){G.aw[j], G.aw[j]};
#pragma unroll
        for (int m = 0; m < 4; ++m) { acc[2 * m] += __builtin_amdgcn_cvt_pk_f32_fp8(ww[m], false) * a2; acc[2 * m + 1] += __builtin_amdgcn_cvt_pk_f32_fp8(ww[m], true) * a2; } }
    const bool b5 = lane & 32, b4 = lane & 16, b3 = lane & 8;
    f32x2 v4[4], v2[2];
#pragma unroll
    for (int c = 0; c < 4; ++c) { const f32x2 keep = b5 ? acc[c + 4] : acc[c], send = b5 ? acc[c] : acc[c + 4]; v4[c] = keep + (f32x2){shx32(send.x, lane), shx32(send.y, lane)}; }
#pragma unroll
    for (int c = 0; c < 2; ++c) { const f32x2 keep = b4 ? v4[c + 2] : v4[c], send = b4 ? v4[c] : v4[c + 2]; v2[c] = keep + (f32x2){shx16(send.x, lane), shx16(send.y, lane)}; }
    const f32x2 keep = b3 ? v2[1] : v2[0], send = b3 ? v2[0] : v2[1];
    return keep + (f32x2){shx8(send.x), shx8(send.y)};
}
#ifndef NSLICE
#define NSLICE 10
#endif
__device__ __forceinline__ int slice_of(int e) { return (e * NSLICE) >> 14; }
__device__ __forceinline__ void peerA_token2(const bf16_t* Ub, int lane, int s, int e0lo, int e0hi, LAS float* d0, const unsigned (&xp0)[8], int e1lo, int e1hi, LAS float* d1, const unsigned (&xp1)[8]) {
    unsigned long long m0 = __ballot(slice_of(e0lo) == s), m1 = __ballot(slice_of(e0hi) == s), m2 = __ballot(slice_of(e1lo) == s), m3 = __ballot(slice_of(e1hi) == s);
    while (m0 | m1 | m2 | m3) {
        const bool h0 = m0 != 0ull, h1 = m1 != 0ull, h2 = m2 != 0ull, h3 = m3 != 0ull;
        PeerBatch B0, B1, B2, B3;
        if (h0) peerA_take(m0, B0, Ub, lane, e0lo);
        if (h1) peerA_take(m1, B1, Ub, lane, e0hi);
        if (h2) peerA_take(m2, B2, Ub, lane, e1lo);
        if (h3) peerA_take(m3, B3, Ub, lane, e1hi);
        if (h0) peerA_finish(B0, lane, d0, xp0);
        if (h1) peerA_finish(B1, lane, d0 + 64, xp0);
        if (h2) peerA_finish(B2, lane, d1, xp1);
        if (h3) peerA_finish(B3, lane, d1 + 64, xp1);
    }
}
__device__ __forceinline__ void p9_peer_hybrid(const Frame& F, const Args& a, float* dst) {
    const int* EIDX = (const int*)(a.ws + WS_EIDX); const float* GATE = (const float*)(a.ws + WS_GATE); const float* RSTD = (const float*)(a.ws + WS_RSTD);
    const bf16_t* Ub = (const bf16_t*)(a.ws + WS_UB); const unsigned char* V8 = a.ws + WS_V8; const float* SV = (const float*)(a.ws + WS_SV);
    bf16_t* H2b = (bf16_t*)(a.ws + WS_XN);
    const int gw = F.vcu * NWAVES + F.wave, lane = F.lane, tokb = gw * 16;
    LAS int* EL = (LAS int*)(F.lds + F.wave * 16384); LAS float* AL = (LAS float*)(F.lds + F.wave * 16384 + 8192);
#pragma unroll 4
    for (int ti = 0; ti < 16; ++ti) { const size_t o = (size_t)(tokb + ti) * 128;
        EL[ti * 128 + lane] = EIDX[o + lane] | (int)(f2bf(GATE[o + lane]) << 16); EL[ti * 128 + 64 + lane] = EIDX[o + 64 + lane] | (int)(f2bf(GATE[o + 64 + lane]) << 16); }
    const float myrs = RSTD[tokb + (lane & 15)];
#pragma unroll 1
    for (int s = 0; s < NSLICE; ++s) {
#pragma unroll 1
        for (int i = 0; i < 16; i += 2) { const int o = i * 128;
            const u32x4* x0 = (const u32x4*)(H2b + (size_t)(tokb + i) * D) + 2 * lane; const u32x4* x1 = x0 + D / 8;
            const u32x4 xa = x0[0], xb = x0[1], xc = x1[0], xd = x1[1];
            const unsigned xp0[8] = {xa.x, xa.y, xa.z, xa.w, xb.x, xb.y, xb.z, xb.w}, xp1[8] = {xc.x, xc.y, xc.z, xc.w, xd.x, xd.y, xd.z, xd.w};
            const int e0lo = EL[o + lane] & 0x3fff, e0hi = EL[o + 64 + lane] & 0x3fff, e1lo = EL[o + 128 + lane] & 0x3fff, e1hi = EL[o + 192 + lane] & 0x3fff;
            peerA_token2(Ub, lane, s, e0lo, e0hi, AL + o, xp0, e1lo, e1hi, AL + o + 128, xp1); }
    }
#pragma unroll 2
    for (int ti = 0; ti < 16; ++ti) { const float rs = rdlanef(myrs, ti);
#pragma unroll
        for (int hf = 0; hf < 2; ++hf) { const int k = ti * 128 + 64 * hf + lane; const int w = EL[k], e = w & 0x3fff; const float gate = __builtin_bit_cast(float, (unsigned)w & 0xffff0000u);
            AL[k] = gelu_as(AL[k] * rs) * gate * SV[e]; EL[k] = e; } }
    const int col = 16 * (lane & 7) + ((lane >> 5) & 1) * 8 + ((lane >> 4) & 1) * 4 + ((lane >> 3) & 1) * 2;
#pragma unroll 1
    for (int cs = 0; cs < 8; ++cs) {
        PeerGather8 G0, G1;
        peerB8_gather(G0, V8, lane, cs, EL, AL);
#pragma unroll 1
        for (int ti = 0; ti < 16; ti += 2) {
            unsigned* hp0 = (unsigned*)(H2b + (size_t)(tokb + ti) * D + cs * 128 + col); unsigned* hp1 = hp0 + D / 2; const unsigned h0 = *hp0, h1 = *hp1;
            peerB8_gather(G1, V8, lane, cs, EL + (ti + 1) * 128, AL + (ti + 1) * 128);
            { const f32x2 r = peerB8_reduce(G0, lane); *hp0 = pk2(bflo(h0) + r.x, bfhi(h0) + r.y); }
            if (ti + 2 < 16) peerB8_gather(G0, V8, lane, cs, EL + (ti + 2) * 128, AL + (ti + 2) * 128);
            { const f32x2 r = peerB8_reduce(G1, lane); *hp1 = pk2(bflo(h1) + r.x, bfhi(h1) + r.y); }
        }
    }
    asm volatile("s_waitcnt vmcnt(0)" ::: "memory");
    __builtin_amdgcn_fence(__ATOMIC_RELEASE, "workgroup"); __builtin_amdgcn_fence(__ATOMIC_ACQUIRE, "workgroup");
#pragma unroll 2
    for (int ti = 0; ti < 16; ++ti) {
        const u32x4* hr = (const u32x4*)(H2b + (size_t)(tokb + ti) * D) + 2 * lane; f32x4* orow = (f32x4*)(dst + (size_t)(tokb + ti) * D) + 4 * lane; const f32x4* gf = (const f32x4*)a.g_final + 4 * lane;
        const u32x4 p = hr[0], q = hr[1]; const unsigned w[8] = {p.x, p.y, p.z, p.w, q.x, q.y, q.z, q.w};
        float hv[16]; float s2 = 0.f;
#pragma unroll
        for (int j = 0; j < 8; ++j) { hv[2 * j] = bflo(w[j]); hv[2 * j + 1] = bfhi(w[j]); s2 += hv[2 * j] * hv[2 * j] + hv[2 * j + 1] * hv[2 * j + 1]; }
        const float rstd2 = 1.0f / sqrtf(wave_sum(s2) * (1.f / D) + EPS);
#pragma unroll
        for (int j = 0; j < 4; ++j) { const f32x4 g4 = gf[j]; orow[j] = (f32x4){hv[4 * j] * rstd2 * g4.x, hv[4 * j + 1] * rstd2 * g4.y, hv[4 * j + 2] * rstd2 * g4.z, hv[4 * j + 3] * rstd2 * g4.w}; }
    }
}

__global__ void __launch_bounds__(NTHREADS, 2) fwd(Args a) {
    extern __shared__ __attribute__((aligned(16))) unsigned char lds[];
    Frame F; F.lds = (LAS unsigned char*)lds; F.tid = threadIdx.x; F.lane = F.tid & 63; F.wave = __builtin_amdgcn_readfirstlane(F.tid >> 6);
    F.G = gridDim.x; { const int bx = blockIdx.x; F.vcu = (F.G % 8 == 0) ? (bx % 8) * (F.G / 8) + bx / 8 : bx; }
    volatile LAS unsigned* MISC = (volatile LAS unsigned*)(F.lds + LDSCTL_OFF);
    for (int u = F.tid; u < (LDS_BYTES - LDSCTL_OFF) / 4; u += NTHREADS) ((LAS unsigned*)(F.lds + LDSCTL_OFF))[u] = 0u;
    __syncthreads();
    XcdBarrier bar; bar.bar = (unsigned*)(a.ws + WS_CTL) + CW_BAR; bar.x = 0; bar.st = nullptr;
    if (N_LAUNCHES == 1) bar = xcd_barrier_post((unsigned*)(a.ws + WS_CTL) + CW_BAR, MISC + 8);
    const int lo = a.ph_lo, hi = a.ph_hi;
#ifndef PHASE_MASK
#define PHASE_MASK 0xFFFF
#endif
#define IN(k) (((PHASE_MASK >> (k)) & 1) && lo <= (k) && (k) < hi)
#define GEMM_CALL(EPI) pg8::gemm_phase<EPI, pg8::StaticOrder, true, true>(F.lds, g, S, E)
#define SEAM(k) do { if (IN(k) && IN((k) + 1)) xcd_barrier(bar); } while (0)
    bf16_t* PROJ = (bf16_t*)(a.ws + WS_PROJ);
#ifndef PROBE_REP
#define PROBE_REP 0
#endif
#define REPK(k) ((PROBE_REP >> (k)) & 1)
#define GEMM_P1 { pg8::Gemm g{(const bf16_t*)(a.ws + WS_XN), (const bf16_t*)(a.ws + WS_WIN), ROWS_A, LDP, D, D, D}; pg8::StaticOrder S; S.init(ROWS_A, LDP, F.G, (int)blockIdx.x); pg8::EpiPanels E{PROJ}; GEMM_CALL(pg8::EpiPanels); }
#define GEMM_P5 { pg8::Gemm g{PROJ + ZS_OFF, (const bf16_t*)(a.ws + WS_WOUT), TR, D, D_MIX, P_ZS, D_MIX}; pg8::StaticOrder S; S.init(TR, D, F.G, (int)blockIdx.x); pg8::EpiResBf16 E{a.x, (bf16_t*)(a.ws + WS_XN), D}; GEMM_CALL(pg8::EpiResBf16); }
#define GEMM_P7 { pg8::Gemm g{(const bf16_t*)(a.ws + WS_XN), (const bf16_t*)(a.ws + WS_WQ), TR, PQ, D, D, D}; pg8::StaticOrder S; S.init(TR, PQ, F.G, (int)blockIdx.x); pg8::EpiBf16 E{(bf16_t*)(a.ws + WS_Q), PQ}; GEMM_CALL(pg8::EpiBf16); }
    if (IN(0)) { if (REPK(0)) p0_prologue(F, a); p0_prologue(F, a); } SEAM(0);
    if (IN(1)) { if (REPK(1)) GEMM_P1 GEMM_P1 } SEAM(1);
    if (IN(2)) { if (REPK(2)) p2_ssd_states(F, a, true); p2_ssd_states(F, a, false); } SEAM(2);
    if (IN(3)) { p3_ssd_recur(F, a); } SEAM(3);
    if (IN(4)) { if (REPK(4)) p4_ssd_out<true>(F, a); p4_ssd_out<false>(F, a); } SEAM(4);
    if (IN(5)) { if (REPK(5)) GEMM_P5 GEMM_P5 } SEAM(5);
    if (IN(6)) { if (REPK(6)) p5_norm2(F, a); p5_norm2(F, a); } SEAM(6);
    if (IN(7)) { if (REPK(7)) GEMM_P7 GEMM_P7 } SEAM(7);
    if (IN(8)) { if (REPK(8)) p8_topk_mfma(F, a); p8_topk_mfma(F, a); } SEAM(8);
    if (IN(9)) { p9_peer_hybrid(F, a, a.out); }
#undef IN
#undef SEAM
}

extern "C" void kernel_launch(void* const* d_in, const int* in_sizes, int n_in, void* d_out, int out_size, void* d_ws, size_t ws_size, hipStream_t stream) {
    static int grid = 0;
    if (grid == 0) {
        if (n_in != 18 || out_size != TR * D || ws_size < WS_END) { fprintf(stderr, "kernel_launch: unexpected problem (n_in %d out %d ws %zu)\n", n_in, out_size, ws_size); grid = -1; return; }
        int dev = 0, cus = 0, per_cu = 0;
        if (hipGetDevice(&dev) != hipSuccess || hipDeviceGetAttribute(&cus, hipDeviceAttributeMultiprocessorCount, dev) != hipSuccess) { grid = -1; return; }
        if (hipFuncSetAttribute((const void*)fwd, hipFuncAttributeMaxDynamicSharedMemorySize, LDS_BYTES) != hipSuccess) { fprintf(stderr, "kernel_launch: hipFuncSetAttribute failed\n"); grid = -1; return; }
        if (hipOccupancyMaxActiveBlocksPerMultiprocessor(&per_cu, (const void*)fwd, NTHREADS, LDS_BYTES) != hipSuccess || per_cu < 1) fprintf(stderr, "kernel_launch: occupancy query says %d\n", per_cu);
        (void)hipGetLastError();
        grid = cus;
        if (grid * NWAVES * 16 != TR) { fprintf(stderr, "kernel_launch: built for 256 CUs (the expert phase deals 16 tokens to each of 2048 waves); this device has %d; nothing launched\n", cus); grid = -1; return; }
    }
    if (grid < 0) return;
    if (hipMemsetAsync((char*)d_ws + WS_CTL, 0, CTL_ZERO_BYTES, stream) != hipSuccess) return;
    Args a{};
    a.x = (const float*)d_in[0]; a.meta = (const float*)d_in[1]; a.g_mix = (const float*)d_in[2]; a.w_in = (const float*)d_in[3]; a.conv_ssd_w = (const float*)d_in[4]; a.conv_ssd_b = (const float*)d_in[5];
    a.dt_bias = (const float*)d_in[6]; a.a_log = (const float*)d_in[7]; a.d_skip = (const float*)d_in[8]; a.ssd_norm_w = (const float*)d_in[9]; a.conv_sc_w = (const float*)d_in[10]; a.w_out = (const float*)d_in[11];
    a.g_ffn = (const float*)d_in[12]; a.w_q = (const float*)d_in[13]; a.sub_keys = (const float*)d_in[14]; a.expert_u = (const float*)d_in[15]; a.expert_v = (const float*)d_in[16]; a.g_final = (const float*)d_in[17];
    a.out = (float*)d_out; a.ws = (unsigned char*)d_ws;
    if (N_LAUNCHES == 1) { a.ph_lo = 0; a.ph_hi = NPHASE; hipLaunchKernelGGL(fwd, dim3(grid), dim3(NTHREADS), LDS_BYTES, stream, a); }
    else for (int p = 0; p < NPHASE; ++p) { a.ph_lo = p; a.ph_hi = p + 1; hipLaunchKernelGGL(fwd, dim3(grid), dim3(NTHREADS), LDS_BYTES, stream, a); }
}
```

```cpp
#include <hip/hip_runtime.h>
#include <cstdio>
#include <cstdint>

#define GAS __attribute__((address_space(1)))
#define LAS __attribute__((address_space(3)))
typedef unsigned short bf16_t;
typedef short bf16x8 __attribute__((ext_vector_type(8)));
typedef float f32x4 __attribute__((ext_vector_type(4)));
typedef float f32x2 __attribute__((ext_vector_type(2)));
typedef unsigned u32x4 __attribute__((ext_vector_type(4)));
typedef unsigned u32x2 __attribute__((ext_vector_type(2)));

constexpr int D = 1024, BATCH = 16, SEQ = 2048, NMETA = 16, LSEQ = SEQ + NMETA;
constexpr int TR = BATCH * SEQ;
constexpr int ROWS_A = 33024;
constexpr int D_SSD = 1536, HEADS = 24, HD = 64, NG = 4, NS = 128, D_XBC = 2560, D_SC = 512, D_IN = 5656, D_MIX = 2048;
constexpr int LDP = 5888;
constexpr int C_Z = 0, C_SCB = 1536, C_XBC = 2048, C_SCC = 4608, C_SCX = 5120, C_DT = 5632;
constexpr int P_ZS = 2048, P_XG = 640, P_SC = 1024, P_DT = 32;
constexpr size_t ZS_OFF = 0, XG_OFF = (size_t)ROWS_A * P_ZS, XG_STRIDE = (size_t)ROWS_A * P_XG, SC_OFF = XG_OFF + 4 * XG_STRIDE, DT_OFF = SC_OFF + (size_t)ROWS_A * P_SC, PANELS_END = DT_OFF + (size_t)ROWS_A * P_DT;
static_assert(PANELS_END <= (size_t)ROWS_A * LDP, "panels fit the PROJ region");
__host__ __device__ __forceinline__ size_t proj_dst(int j, int& pitch) {
    if (j < 2048) { pitch = P_ZS; return ZS_OFF + j; }
    if (j < 4608) { const int ch = j - 2048; pitch = P_XG;
        if (ch < 1536) { const int g = ch / 384; return XG_OFF + g * XG_STRIDE + (ch - 384 * g); }
        if (ch < 2048) { const int r = ch - 1536; return XG_OFF + (r >> 7) * XG_STRIDE + 384 + (r & 127); }
        const int r = ch - 2048; return XG_OFF + (r >> 7) * XG_STRIDE + 512 + (r & 127); }
    if (j < 5632) { pitch = P_SC; return SC_OFF + (j - 4608); }
    if (j < 5664) { pitch = P_DT; return DT_OFF + (j - 5632); }
    pitch = 0; return 0;
}
constexpr int PH = 8, PK = 128, PTOP = 16, PQ = 2048;
constexpr float EPS = 1e-6f;

__host__ __device__ constexpr int proj_src_col(int j) {
    return j < 1536 ? j : j < 2048 ? 4120 + (j - 1536) : j < 4608 ? 1536 + (j - 2048) : j < 5120 ? 4632 + (j - 4608) : j < 5632 ? 5144 + (j - 5120) : j < 5656 ? 4096 + (j - 5632) : -1;
}

constexpr size_t MiB = 1u << 20;
constexpr size_t WS_CTL = 0, CTL_ZERO_BYTES = 1 * MiB;
constexpr size_t WS_WIN = 1 * MiB;
constexpr size_t WS_WOUT = 13 * MiB;
constexpr size_t WS_WQ = 17 * MiB;
constexpr size_t WS_XN = 22 * MiB;
constexpr size_t WS_PROJ = 88 * MiB;
constexpr size_t WS_Q = WS_PROJ;
constexpr size_t WS_EIDX = WS_PROJ + 128 * MiB;
constexpr size_t WS_GATE = WS_PROJ + 144 * MiB;
constexpr size_t WS_UB = WS_PROJ + 160 * MiB;
constexpr size_t WS_V8 = WS_PROJ + 192 * MiB;
constexpr size_t WS_SV = WS_PROJ + 224 * MiB + 65536;
constexpr size_t WS_RSTD = WS_PROJ + 225 * MiB;
constexpr size_t WS_END = WS_PROJ + (size_t)ROWS_A * LDP * 2;
static_assert(WS_RSTD + (1u << 20) <= WS_END, "ws map");
static_assert(WS_XN + (size_t)ROWS_A * D * 2 <= WS_PROJ, "ws map");
static_assert(WS_END <= 512 * MiB, "ws map");

typedef __bf16 bf16x2h_t __attribute__((ext_vector_type(2)));
__device__ __forceinline__ unsigned f2bf(float f) { return (unsigned)__builtin_bit_cast(unsigned short, (__bf16)f); }
__device__ __forceinline__ unsigned pk2(float lo, float hi) { bf16x2h_t v; v.x = (__bf16)lo; v.y = (__bf16)hi; return __builtin_bit_cast(unsigned, v); }
__device__ __forceinline__ float bf2f(unsigned short b) { return __builtin_bit_cast(float, ((unsigned)b) << 16); }
__device__ __forceinline__ float bflo(unsigned w) { return __builtin_bit_cast(float, w << 16); }
__device__ __forceinline__ float bfhi(unsigned w) { return __builtin_bit_cast(float, w & 0xffff0000u); }
template <int CTRL> __device__ __forceinline__ float dppf0(float x) { return __builtin_bit_cast(float, __builtin_amdgcn_update_dpp(0, __builtin_bit_cast(int, x), CTRL, 0xF, 0xF, true)); }
__device__ __forceinline__ void swap32_self(unsigned u, unsigned& lo_lo, unsigned& hi_hi) { unsigned u2 = u; asm volatile("" : "+v"(u2)); auto r = __builtin_amdgcn_permlane32_swap(u, u2, false, false); lo_lo = r[0]; hi_hi = r[1]; }
__device__ __forceinline__ void swap16_self(unsigned u, unsigned& even2, unsigned& odd2) { unsigned u2 = u; asm volatile("" : "+v"(u2)); auto r = __builtin_amdgcn_permlane16_swap(u, u2, false, false); even2 = r[0]; odd2 = r[1]; }
__device__ __forceinline__ float wave_sum(float v) {
    v += dppf0<0xB1>(v); v += dppf0<0x4E>(v); v += dppf0<0x141>(v); v += dppf0<0x140>(v);
    unsigned p, q; swap16_self(__builtin_bit_cast(unsigned, v), p, q); v = __builtin_bit_cast(float, p) + __builtin_bit_cast(float, q);
    swap32_self(__builtin_bit_cast(unsigned, v), p, q); v = __builtin_bit_cast(float, p) + __builtin_bit_cast(float, q);
    return v;
}
__device__ __forceinline__ float row_sum16(float x) { x += dppf0<0xB1>(x); x += dppf0<0x4E>(x); x += dppf0<0x141>(x); x += dppf0<0x140>(x); return x; }
__device__ __forceinline__ int row_of(int b, int pos) { return pos < NMETA ? TR + pos : b * SEQ + (pos - NMETA); }

namespace pg8 {
#define PG8_LAS __attribute__((address_space(3)))
constexpr int BM = 256, BK = 64, HALF = 128, HTB = HALF * BK * 2  , STAGE_BYTES = 8 * HTB, NXCD = 8, WGM = 8;
__host__ __device__ __forceinline__ int perm32(int rho) { const int n = rho >> 4, i = rho & 15; return 8 * (i >> 2) + 4 * n + (i & 3); }
__host__ __device__ __forceinline__ int lds_byte(int r, int c) { const int st = (r >> 4) * 2 + (c >> 5), rr = r & 15, cc = c & 31, ob = rr * 64 + cc * 2; return st * 1024 + (ob ^ (((ob >> 9) & 1) << 5)); }
__host__ __device__ __forceinline__ void stage_rc(int b, int& R, int& C) { const int st = b / 1024, sb = b % 1024, swz = sb ^ (((sb >> 9) & 1) << 5); R = (st >> 1) * 16 + swz / 64; C = (st & 1) * 32 + (swz % 64) / 2; }
struct Unit { int pm, pn; };
struct Gemm { const bf16_t* A; const bf16_t* Bt; int M, N, K, lda, ldb; };
struct StaticOrder {
    int nM, nN, nwg, G, c;
    __host__ __device__ void init(int M, int N, int G_, int c_) { nM = M / BM; nN = N / BM; nwg = nM * nN; G = G_; c = c_; }
    __host__ __device__ bool next(int i, Unit& u) const {
        const long L = (long)i * G + c; if (L >= nwg) return false;
        int wgid = (int)L; { const int q = nwg / NXCD, r = nwg % NXCD, xcd = wgid % NXCD, off = wgid / NXCD; wgid = (xcd < r ? xcd * (q + 1) : r * (q + 1) + (xcd - r) * q) + off; }
        const int nig = WGM * nN, gid = wgid / nig, fm = gid * WGM, gsz = (nM - fm) < WGM ? (nM - fm) : WGM;
        u.pm = fm + ((wgid % nig) % gsz); u.pn = (wgid % nig) / gsz; return true;
    }
    __device__ __forceinline__ void a_ready(const Unit&) const {}
    __device__ __forceinline__ void done(const Unit&) const {}
};
struct EpiBf16 {
    static constexpr bool PERM = true, AFTER_DRAIN = false;
    bf16_t* O; int ldc;
    __device__ __forceinline__ void operator()(const f32x4 (&acc)[2][2][4][2], const Unit& u, int wr, int wc, int fr, int fq) const {
        const int row0 = u.pm * BM + wr * 64 + fr, col0 = u.pn * BM + wc * 32 + 8 * fq;
#pragma unroll
        for (int ai = 0; ai < 2; ++ai)
#pragma unroll
            for (int m = 0; m < 4; ++m) { bf16_t* rowp = O + (size_t)(row0 + ai * HALF + m * 16) * ldc + col0;
#pragma unroll
                for (int bj = 0; bj < 2; ++bj) { const f32x4 v0 = acc[ai][bj][m][0], v1 = acc[ai][bj][m][1];
                    u32x4 w; w.x = pk2(v0[0], v0[1]); w.y = pk2(v0[2], v0[3]); w.z = pk2(v1[0], v1[1]); w.w = pk2(v1[2], v1[3]);
                    *(u32x4*)(rowp + bj * HALF) = w; } }
    }
};
struct EpiPanels {
    static constexpr bool PERM = true, AFTER_DRAIN = false;
    bf16_t* P;
    __device__ __forceinline__ void operator()(const f32x4 (&acc)[2][2][4][2], const Unit& u, int wr, int wc, int fr, int fq) const {
        const int row0 = u.pm * BM + wr * 64 + fr, col0 = u.pn * BM + wc * 32 + 8 * fq;
#pragma unroll
        for (int bj = 0; bj < 2; ++bj) { int pitch; const size_t off = proj_dst(col0 + bj * HALF, pitch); if (pitch == 0) continue;
#pragma unroll
            for (int ai = 0; ai < 2; ++ai)
#pragma unroll
                for (int m = 0; m < 4; ++m) { const f32x4 v0 = acc[ai][bj][m][0], v1 = acc[ai][bj][m][1];
                    u32x4 w; w.x = pk2(v0[0], v0[1]); w.y = pk2(v0[2], v0[3]); w.z = pk2(v1[0], v1[1]); w.w = pk2(v1[2], v1[3]);
                    *(u32x4*)(P + off + (size_t)(row0 + ai * HALF + m * 16) * pitch) = w; } }
    }
};
struct EpiResBf16 {
    static constexpr bool PERM = true, AFTER_DRAIN = false;
    const float* base; bf16_t* O; int ldc;
    __device__ __forceinline__ void operator()(const f32x4 (&acc)[2][2][4][2], const Unit& u, int wr, int wc, int fr, int fq) const {
        const int row0 = u.pm * BM + wr * 64 + fr, col0 = u.pn * BM + wc * 32 + 8 * fq;
#pragma unroll
        for (int ai = 0; ai < 2; ++ai)
#pragma unroll
            for (int m = 0; m < 4; ++m) { const size_t off = (size_t)(row0 + ai * HALF + m * 16) * ldc + col0;
#pragma unroll
                for (int bj = 0; bj < 2; ++bj) { const f32x4 b0 = *(const f32x4*)(base + off + bj * HALF), b1 = *(const f32x4*)(base + off + bj * HALF + 4);
                    const f32x4 v0 = acc[ai][bj][m][0] + b0, v1 = acc[ai][bj][m][1] + b1;
                    u32x4 w; w.x = pk2(v0[0], v0[1]); w.y = pk2(v0[2], v0[3]); w.z = pk2(v1[0], v1[1]); w.w = pk2(v1[2], v1[3]);
                    *(u32x4*)(O + off + bj * HALF) = w; } }
    }
};
template <class Epi, class Sched, bool ALIGN_EPI = false, bool SP2 = false>
__device__ __forceinline__ void gemm_phase(PG8_LAS unsigned char* lds, const Gemm g, const Sched& S, const Epi& E) {
    const int tid = threadIdx.x, wid = __builtin_amdgcn_readfirstlane(tid >> 6), lane = tid & 63, wr = wid >> 2, wc = wid & 3, fr = lane & 15, fq = lane >> 4;
    const int K = g.K, nt = K / BK;
    unsigned voffA[2], voffB[2];
#pragma unroll
    for (int i = 0; i < 2; ++i) { int R, C; stage_rc(tid * 16 + i * 8192, R, C); const int Rb = Epi::PERM ? ((R & ~31) + perm32(R & 31)) : R;
        voffA[i] = (unsigned)(R * g.lda + C) * 2u; voffB[i] = (unsigned)(Rb * g.ldb + C) * 2u; }
    const size_t kstep = (size_t)(BK * 2);
    const size_t hstepA = (size_t)HALF * g.lda * 2, hstepB = (size_t)HALF * g.ldb * 2;
    const size_t tstepA = 2 * hstepA, tstepB = 2 * hstepB;
    const unsigned ldsw = (unsigned)wid * 1024u;
    const int aoff = lds_byte(wr * 64 + fr, fq * 8), boff = lds_byte(wc * 32 + fr, fq * 8);
#define PG8_SA(b, h) (((b) * 2 + (h)) * HTB)
#define PG8_SB(b, h) ((4 + (b) * 2 + (h)) * HTB)
#define PG8_STAGE(bufoff, gbase, voff) do { _Pragma("unroll") for (int _i = 0; _i < 2; ++_i) \
        __builtin_amdgcn_global_load_lds((const unsigned*)((const char*)(gbase) + (voff)[_i]), (PG8_LAS unsigned*)(lds + (bufoff) + ldsw + _i * 8192), 16, 0, 0); } while (0)
#define PG8_LDA(dst, b, h) do { _Pragma("unroll") for (int m = 0; m < 4; ++m) _Pragma("unroll") for (int k = 0; k < 2; ++k) dst[m][k] = *(const PG8_LAS bf16x8*)(lds + PG8_SA(b, h) + aoff + m * 2048 + k * 1024); } while (0)
#define PG8_LDB(dst, b, h) do { _Pragma("unroll") for (int n = 0; n < 2; ++n) _Pragma("unroll") for (int k = 0; k < 2; ++k) dst[n][k] = *(const PG8_LAS bf16x8*)(lds + PG8_SB(b, h) + boff + n * 2048 + k * 1024); } while (0)
#define PG8_MMA(ai, bj, At, Bt) do { __builtin_amdgcn_s_setprio(1); _Pragma("unroll") for (int m = 0; m < 4; ++m) _Pragma("unroll") for (int n = 0; n < 2; ++n) _Pragma("unroll") for (int k = 0; k < 2; ++k) \
        acc[ai][bj][m][n] = __builtin_amdgcn_mfma_f32_16x16x32_bf16(Bt[n][k], At[m][k], acc[ai][bj][m][n], 0, 0, 0); __builtin_amdgcn_s_setprio(0); } while (0)
#define PG8_WAIT_V(n) asm volatile("s_waitcnt vmcnt(" #n ")" ::: "memory")
#define PG8_WAIT_L(n) asm volatile("s_waitcnt lgkmcnt(" #n ")" ::: "memory")
#define PG8_BAR __builtin_amdgcn_s_barrier()
#define PG8_SCHED __builtin_amdgcn_sched_barrier(0)
    Unit cur, nxt; int ui = 0;
    if (!S.next(0, cur)) return;
    f32x4 acc[2][2][4][2];
#pragma unroll
    for (int a = 0; a < 2; ++a)
#pragma unroll
        for (int b = 0; b < 2; ++b)
#pragma unroll
            for (int m = 0; m < 4; ++m)
#pragma unroll
                for (int n = 0; n < 2; ++n) acc[a][b][m][n] = (f32x4){0.f, 0.f, 0.f, 0.f};
    bf16x8 At[4][2], B0[2][2], B1[2][2];
    const char* cA = (const char*)g.A + (size_t)cur.pm * tstepA; const char* cB = (const char*)g.Bt + (size_t)cur.pn * tstepB;
    S.a_ready(cur);
    if constexpr (SP2) {
        PG8_STAGE(PG8_SB(0, 0), cB, voffB); PG8_STAGE(PG8_SB(0, 1), cB + hstepB, voffB); PG8_STAGE(PG8_SA(0, 0), cA, voffA); PG8_STAGE(PG8_SA(0, 1), cA + hstepA, voffA);
        if (wr == 1) PG8_BAR;
        PG8_WAIT_V(2); PG8_BAR;
        PG8_STAGE(PG8_SB(1, 0), cB + kstep, voffB); PG8_STAGE(PG8_SA(1, 0), cA + kstep, voffA); PG8_STAGE(PG8_SB(1, 1), cB + hstepB + kstep, voffB);
        PG8_WAIT_V(6); PG8_BAR;
    } else {
        PG8_STAGE(PG8_SB(0, 0), cB, voffB); PG8_STAGE(PG8_SA(0, 0), cA, voffA); PG8_STAGE(PG8_SB(0, 1), cB + hstepB, voffB); PG8_STAGE(PG8_SA(0, 1), cA + hstepA, voffA);
        if (wr == 1) PG8_BAR;
        PG8_WAIT_V(4); PG8_BAR;
        PG8_STAGE(PG8_SB(1, 0), cB + kstep, voffB); PG8_STAGE(PG8_SA(1, 0), cA + kstep, voffA); PG8_STAGE(PG8_SB(1, 1), cB + hstepB + kstep, voffB);
        PG8_WAIT_V(6); PG8_BAR;
    }
    for (;;) {
        const bool has_next = S.next(ui + 1, nxt);
        const char* nA = has_next ? (const char*)g.A + (size_t)nxt.pm * tstepA : cA; const char* nB = has_next ? (const char*)g.Bt + (size_t)nxt.pn * tstepB : cB;
        for (int t = 0; t < nt; t += 2) {
            const bool last = (t == nt - 2);
            const char* a1 = cA + (size_t)(t + 1) * kstep;
            const char* a2 = last ? nA : cA + (size_t)(t + 2) * kstep; const char* b2 = last ? nB : cB + (size_t)(t + 2) * kstep;
            const char* a3 = a2 + kstep; const char* b3 = b2 + kstep;
            if (last && has_next) S.a_ready(nxt);
            if constexpr (SP2) {
            PG8_LDB(B0, 0, 0); PG8_LDB(B1, 0, 1); PG8_SCHED; PG8_LDA(At, 0, 0); PG8_STAGE(PG8_SA(1, 1), a1 + hstepA, voffA);
            PG8_WAIT_V(8); PG8_WAIT_L(0); PG8_BAR; PG8_MMA(0, 0, At, B0); PG8_MMA(0, 1, At, B1); PG8_BAR; PG8_SCHED;
            PG8_LDA(At, 0, 1); PG8_STAGE(PG8_SB(0, 0), b2, voffB); PG8_STAGE(PG8_SB(0, 1), b2 + hstepB, voffB); PG8_STAGE(PG8_SA(0, 0), a2, voffA);
            PG8_WAIT_V(8); PG8_WAIT_L(0); PG8_BAR; PG8_MMA(1, 0, At, B0); PG8_MMA(1, 1, At, B1); PG8_BAR; PG8_SCHED;
            PG8_LDB(B0, 1, 0); PG8_LDB(B1, 1, 1); PG8_SCHED; PG8_LDA(At, 1, 0); PG8_STAGE(PG8_SA(0, 1), a2 + hstepA, voffA);
            PG8_WAIT_V(8); PG8_WAIT_L(0); PG8_BAR; PG8_MMA(0, 0, At, B0); PG8_MMA(0, 1, At, B1); PG8_BAR; PG8_SCHED;
            PG8_LDA(At, 1, 1); PG8_STAGE(PG8_SB(1, 0), b3, voffB); PG8_STAGE(PG8_SB(1, 1), b3 + hstepB, voffB); PG8_STAGE(PG8_SA(1, 0), a3, voffA);
            PG8_WAIT_V(8); PG8_WAIT_L(0); PG8_BAR; PG8_MMA(1, 0, At, B0); PG8_MMA(1, 1, At, B1); PG8_BAR; PG8_SCHED;
            } else {
            PG8_LDB(B0, 0, 0); PG8_SCHED; PG8_LDA(At, 0, 0); PG8_STAGE(PG8_SA(1, 1), a1 + hstepA, voffA);
            PG8_WAIT_L(8); PG8_BAR; PG8_WAIT_L(0); PG8_MMA(0, 0, At, B0); PG8_BAR; PG8_SCHED;
            PG8_LDB(B1, 0, 1); PG8_STAGE(PG8_SB(0, 0), b2, voffB);
            PG8_BAR; PG8_WAIT_L(0); PG8_MMA(0, 1, At, B1); PG8_BAR;
            PG8_LDA(At, 0, 1); PG8_STAGE(PG8_SA(0, 0), a2, voffA);
            PG8_BAR; PG8_WAIT_L(0); PG8_MMA(1, 0, At, B0); PG8_BAR; PG8_SCHED;
            PG8_STAGE(PG8_SB(0, 1), b2 + hstepB, voffB);
            PG8_WAIT_V(6); PG8_BAR; PG8_MMA(1, 1, At, B1); PG8_BAR;
            PG8_LDB(B0, 1, 0); PG8_SCHED; PG8_LDA(At, 1, 0); PG8_STAGE(PG8_SA(0, 1), a2 + hstepA, voffA);
            PG8_WAIT_L(8); PG8_BAR; PG8_WAIT_L(0); PG8_MMA(0, 0, At, B0); PG8_BAR; PG8_SCHED;
            PG8_LDB(B1, 1, 1); PG8_STAGE(PG8_SB(1, 0), b3, voffB);
            PG8_BAR; PG8_WAIT_L(0); PG8_MMA(0, 1, At, B1); PG8_BAR;
            PG8_LDA(At, 1, 1); PG8_STAGE(PG8_SA(1, 0), a3, voffA);
            PG8_BAR; PG8_WAIT_L(0); PG8_MMA(1, 0, At, B0); PG8_BAR; PG8_SCHED;
            PG8_STAGE(PG8_SB(1, 1), b3 + hstepB, voffB);
            PG8_WAIT_V(6); PG8_BAR; PG8_MMA(1, 1, At, B1); PG8_BAR;
            }
        }
        if constexpr (ALIGN_EPI) { if (wr == 0) PG8_BAR; }
        if constexpr (!Epi::AFTER_DRAIN) { E(acc, cur, wr, wc, fr, fq); S.done(cur); }
        if (!has_next) break;
#pragma unroll
        for (int a = 0; a < 2; ++a)
#pragma unroll
            for (int b = 0; b < 2; ++b)
#pragma unroll
                for (int m = 0; m < 4; ++m)
#pragma unroll
                    for (int n = 0; n < 2; ++n) acc[a][b][m][n] = (f32x4){0.f, 0.f, 0.f, 0.f};
        cur = nxt; cA = nA; cB = nB; ++ui;
        if constexpr (ALIGN_EPI) { if (wr == 1) PG8_BAR; }
    }
    PG8_WAIT_V(0);
    if constexpr (!ALIGN_EPI) { if (wr == 0) PG8_BAR; }
    PG8_BAR;
    if constexpr (Epi::AFTER_DRAIN) { E.fused(acc, cur, wr, wc, fr, fq, lds, wid, lane); S.done(cur); }
#undef PG8_SA
#undef PG8_SB
#undef PG8_STAGE
#undef PG8_LDA
#undef PG8_LDB
#undef PG8_MMA
#undef PG8_WAIT_V
#undef PG8_WAIT_L
#undef PG8_BAR
#undef PG8_SCHED
}

}

#define XB_TMO      128
#define XB_XCNT(j)  (256  + 64 * (j))
#define XB_XSUB(j)  (1280 + 64 * (j))
#define XB_XGEN(j)  (2304 + 64 * (j))
#define XB_TOP      3328
#define XB_TOPGEN   3392
#define XCD_BAR_WORDS 3456
#define XB_SPIN_CAP (1u << 18)
__device__ __forceinline__ unsigned xb_ld(unsigned* p)              { return __hip_atomic_load(p, __ATOMIC_RELAXED, __HIP_MEMORY_SCOPE_AGENT); }
__device__ __forceinline__ unsigned xb_add(unsigned* p, unsigned v) { return __hip_atomic_fetch_add(p, v, __ATOMIC_RELAXED, __HIP_MEMORY_SCOPE_AGENT); }
__device__ __forceinline__ unsigned xb_xcc_id() { return (unsigned)__builtin_amdgcn_s_getreg((3 << 11) | 20) & 0xFu; }
#define XB_SPIN(cond, bar) do { unsigned _sp = 0; while (cond) { __builtin_amdgcn_s_sleep(1); \
    if ((++_sp & 255u) == 0u) { if (xb_ld(&(bar)[XB_TMO])) break; if (_sp > XB_SPIN_CAP) { atomicAdd(&(bar)[XB_TMO], 1u); break; } } } } while (0)
struct XcdBarrier { unsigned* bar; unsigned x; volatile LAS unsigned* st; };
__device__ __forceinline__ XcdBarrier xcd_barrier_post(unsigned* bar, volatile LAS unsigned* st) {
    XcdBarrier b; b.bar = bar; b.x = xb_xcc_id(); b.st = st;
    if (threadIdx.x == 0) (void)xb_add(&bar[XB_XCNT(b.x)], 1u);
    return b;
}
__device__ __forceinline__ void xcd_barrier_complete(unsigned* bar, unsigned x, unsigned& nloc, unsigned& nx) {
    const unsigned G = gridDim.x * gridDim.y * gridDim.z;
    unsigned sum, cnt, mine, sp = 0u;
    for (;;) {
        sum = 0u; cnt = 0u; mine = 0u;
#pragma unroll
        for (unsigned j = 0; j < 16; ++j) { const unsigned c = xb_ld(&bar[XB_XCNT(j)]); sum += c; cnt += (c > 0u) ? 1u : 0u; mine = (j == x) ? c : mine; }
        if (sum == G) break;
        __builtin_amdgcn_s_sleep(1);
        if ((++sp & 255u) == 0u) { if (xb_ld(&bar[XB_TMO])) break; if (sp > XB_SPIN_CAP) { atomicAdd(&bar[XB_TMO], 1u); break; } }
    }
    nloc = mine > 0u ? mine : 1u; nx = cnt > 0u ? cnt : 1u;
}
__device__ __forceinline__ void xcd_barrier(const XcdBarrier& b) {
    asm volatile("s_waitcnt vmcnt(0)" ::: "memory");
    __syncthreads();
    if (threadIdx.x == 0) {
        unsigned* bar = b.bar;
        __builtin_amdgcn_s_waitcnt(0);
        unsigned nloc = b.st[0], nx = b.st[1];
        if (nloc == 0u) { xcd_barrier_complete(bar, b.x, nloc, nx); b.st[0] = nloc; b.st[1] = nx; }
        const unsigned old = xb_add(&bar[XB_XSUB(b.x)], 1u);
        const unsigned gen = old / nloc;
        if (old + 1u == (gen + 1u) * nloc) {
            __builtin_amdgcn_fence(__ATOMIC_RELEASE, "agent");
            asm volatile("s_waitcnt vmcnt(0)" ::: "memory");
            const unsigned og = xb_add(&bar[XB_TOP], 1u);
            const unsigned tg = og / nx;
            if (og + 1u == (tg + 1u) * nx) xb_add(&bar[XB_TOPGEN], 1u);
            else XB_SPIN(xb_ld(&bar[XB_TOPGEN]) == tg, bar);
            __builtin_amdgcn_fence(__ATOMIC_ACQUIRE, "agent");
            xb_add(&bar[XB_XGEN(b.x)], 1u);
            asm volatile("s_waitcnt vmcnt(0)" ::: "memory");
        } else {
            XB_SPIN(xb_ld(&bar[XB_XGEN(b.x)]) == gen, bar);
            __builtin_amdgcn_fence(__ATOMIC_ACQUIRE, "agent");
            asm volatile("s_waitcnt vmcnt(0)" ::: "memory");
        }
    }
    __syncthreads();
}

constexpr int NWAVES = 8, NTHREADS = 512;
constexpr int NPHASE = 10;
#ifndef MK_N_LAUNCHES
#define MK_N_LAUNCHES 1
#endif
constexpr int N_LAUNCHES = MK_N_LAUNCHES;
constexpr int RING_BYTES = 131072, LDS_BYTES = 163840, LDSCTL_OFF = LDS_BYTES - 256;
constexpr int CW_BAR = 4096;

struct Args {
    const float *x, *meta, *g_mix, *w_in, *conv_ssd_w, *conv_ssd_b, *dt_bias, *a_log, *d_skip, *ssd_norm_w, *conv_sc_w, *w_out, *g_ffn, *w_q, *sub_keys, *expert_u, *expert_v, *g_final;
    float* out; unsigned char* ws; int ph_lo, ph_hi;
};
struct Frame { LAS unsigned char* lds; int tid, lane, wave, G, vcu; };

template <class ColMap>
__device__ __forceinline__ void p0_transpose_item(const float* W, int K, int N, bf16_t* WT, int nblk, LAS float* scr, int item, int lane, ColMap cm, const float* kscale = nullptr) {
    const int kb = item / nblk, nb = item % nblk, k0 = 64 * kb, n0 = 32 * nb;
    const int sc = cm(n0 + (lane & 31));
#pragma unroll 8
    for (int i = 0; i < 32; ++i) { const int kk = 2 * i + (lane >> 5); scr[kk * 33 + (lane & 31)] = sc >= 0 ? W[(size_t)(k0 + kk) * N + sc] * (kscale ? kscale[k0 + kk] : 1.f) : 0.f; }
    asm volatile("s_waitcnt lgkmcnt(0)" ::: "memory");
    const int c = lane & 7;
#pragma unroll
    for (int j = 0; j < 4; ++j) { const int n = (lane >> 3) + 8 * j; const LAS float* s = scr + (8 * c) * 33 + n;
        u32x4 o; o.x = pk2(s[0 * 33], s[1 * 33]); o.y = pk2(s[2 * 33], s[3 * 33]); o.z = pk2(s[4 * 33], s[5 * 33]); o.w = pk2(s[6 * 33], s[7 * 33]);
        *(u32x4*)(WT + (size_t)(n0 + n) * K + k0 + 8 * c) = o; }
    asm volatile("s_waitcnt lgkmcnt(0)" ::: "memory");
}
__device__ __forceinline__ void p0_prologue(const Frame& F, const Args& a) {
    LAS float* scr = (LAS float*)(F.lds + F.wave * 16384);
    const int gw = F.vcu * NWAVES + F.wave, NGW = F.G * NWAVES;
    bf16_t* WinT = (bf16_t*)(a.ws + WS_WIN); bf16_t* WoutT = (bf16_t*)(a.ws + WS_WOUT); bf16_t* WqT = (bf16_t*)(a.ws + WS_WQ); bf16_t* XN = (bf16_t*)(a.ws + WS_XN);
    constexpr int I_IN = (D / 64) * (LDP / 32), I_OUT = (D_MIX / 64) * (D / 32), I_Q = (D / 64) * (PQ / 32);
    for (int it = gw; it < I_IN + I_OUT + I_Q; it += NGW) {
        int r = it;
        if (r < I_IN) { p0_transpose_item(a.w_in, D, D_IN, WinT, LDP / 32, scr, r, F.lane, [](int j) { return proj_src_col(j); }); continue; } r -= I_IN;
        if (r < I_OUT) { p0_transpose_item(a.w_out, D_MIX, D, WoutT, D / 32, scr, r, F.lane, [](int j) { return j; }); continue; } r -= I_OUT;
        p0_transpose_item(a.w_q, D, PQ, WqT, PQ / 32, scr, r, F.lane, [](int j) { return j; }, a.g_ffn);
    }
    for (int m = gw; m < ROWS_A; m += NGW) {
        u32x2* o8 = (u32x2*)(XN + (size_t)m * D) + F.lane;
        if (m >= TR + NMETA) {
#pragma unroll
            for (int j = 0; j < 4; ++j) o8[64 * j] = (u32x2){0u, 0u};
            continue; }
        const float* src = m < TR ? a.x + (size_t)m * D : a.meta + (size_t)(m - TR) * D;
        const f32x4* xr = (const f32x4*)src + F.lane; const f32x4* gr = (const f32x4*)a.g_mix + F.lane;
        f32x4 v[4]; float s = 0.f;
#pragma unroll
        for (int j = 0; j < 4; ++j) { v[j] = xr[64 * j]; s += (v[j].x * v[j].x + v[j].y * v[j].y) + (v[j].z * v[j].z + v[j].w * v[j].w); }
        const float rstd = 1.0f / sqrtf(wave_sum(s) * (1.f / D) + EPS);
#pragma unroll
        for (int j = 0; j < 4; ++j) { const f32x4 gg = gr[64 * j]; o8[64 * j] = (u32x2){pk2(v[j].x * rstd * gg.x, v[j].y * rstd * gg.y), pk2(v[j].z * rstd * gg.z, v[j].w * rstd * gg.w)}; }
    }
}

typedef float f32x16 __attribute__((ext_vector_type(16)));
constexpr int PITCH = 136;
constexpr int SL_C = 0, SL_B = 34816, SL_M0 = 69632, SL_X = 104448, SL_DT = 139264, SL_ACS = 142336;
constexpr int YPITCH = 396;
static_assert(SL_B + 128 * YPITCH * 2 <= SL_DT, "staging fits below dt/acs");
constexpr size_t WS_DAT = WS_XN;
constexpr size_t WS_SMETA = WS_XN + 65536;

__device__ __forceinline__ f32x16 mfma32(bf16x8 a, bf16x8 b, f32x16 c) { return __builtin_amdgcn_mfma_f32_32x32x16_bf16(a, b, c, 0, 0, 0); }
__device__ __forceinline__ float silu_f(float v) { return v / (1.f + __expf(-v)); }

template <int NP> struct ConvW { u32x4 raw[NP + 3]; };
template <int NP> __device__ __forceinline__ void convw_load(ConvW<NP>& ci, const bf16_t* xgc  , int b, int pos0) {
#pragma unroll
    for (int i = 0; i < NP + 3; ++i) { const int pos = pos0 - 3 + i; u32x4 v = (u32x4){0u, 0u, 0u, 0u};
        if (pos >= 0) v = *(const u32x4*)(xgc + (size_t)row_of(b, pos) * P_XG);
        ci.raw[i] = v; }
}
struct ConvWt { f32x4 w[4][2], cb[2]; };
__device__ __forceinline__ void convw_weights(ConvWt& cw, const Args& a, int ch) {
    cw.cb[0] = *(const f32x4*)(a.conv_ssd_b + ch); cw.cb[1] = *(const f32x4*)(a.conv_ssd_b + ch + 4);
#pragma unroll
    for (int wi = 0; wi < 4; ++wi) { cw.w[wi][0] = *(const f32x4*)(a.conv_ssd_w + wi * D_XBC + ch); cw.w[wi][1] = *(const f32x4*)(a.conv_ssd_w + wi * D_XBC + ch + 4); }
}
__device__ __forceinline__ float bfel(const u32x4& v, int c) { const unsigned w = (c >> 1) == 0 ? v.x : (c >> 1) == 1 ? v.y : (c >> 1) == 2 ? v.z : v.w; return (c & 1) ? bfhi(w) : bflo(w); }
template <int NP> __device__ __forceinline__ void convw_pos(const ConvW<NP>& ci, const ConvWt& cw, int s, float (&o)[8]) {
#pragma unroll
    for (int c = 0; c < 8; ++c) { const int q = c >> 2, e = c & 3;
        o[c] = silu_f(cw.cb[q][e] + cw.w[0][q][e] * bfel(ci.raw[s], c) + cw.w[1][q][e] * bfel(ci.raw[s + 1], c) + cw.w[2][q][e] * bfel(ci.raw[s + 2], c) + cw.w[3][q][e] * bfel(ci.raw[s + 3], c)); }
}
__device__ __forceinline__ void ssd_dt_acs(const Frame& F_, const Args& a, const bf16_t* PROJ, int b, int p0, int g, float* dat  ) {
    const Frame& F0 = F_;
    if (F0.wave < 6) {
        int lane_ = F0.lane; asm volatile("" : "+v"(lane_));
        Frame Fl = F0; Fl.lane = lane_;
        const Frame& F = Fl;
        const int h = g * 6 + F.wave; const float A = -__expf(a.a_log[h]), dtb = a.dt_bias[h];
        LAS float* dtL = (LAS float*)(F.lds + SL_DT) + F.wave * 128; LAS float* acL = (LAS float*)(F.lds + SL_ACS) + F.wave * 128;
        float dv[2], av[2];
#pragma unroll
        for (int hf = 0; hf < 2; ++hf) { const int pos = p0 + F.lane + 64 * hf; float d = 0.f;
            if (pos >= 0) { const float v = bf2f(PROJ[DT_OFF + (size_t)row_of(b, pos) * P_DT + h]) + dtb, t = __expf(-fabsf(v));
                d = fmaxf(v, 0.f) + (t < 1e-3f ? t * (1.f - 0.5f * t) : __logf(1.f + t)); }
            dv[hf] = d; av[hf] = d * A; }
#pragma unroll
        for (int o = 1; o < 64; o <<= 1) { const float t0 = __shfl_up(av[0], o), t1 = __shfl_up(av[1], o); if (F.lane >= o) { av[0] += t0; av[1] += t1; } }
        av[1] += __shfl(av[0], 63);
        dtL[F.lane] = dv[0]; dtL[F.lane + 64] = dv[1]; acL[F.lane] = av[0]; acL[F.lane + 64] = av[1];
        if (dat && F.lane == 63) dat[h] = __expf(av[1]);
    }
}

__device__ __forceinline__ void ssd_s1_unit(const Frame& F, const Args& a, int b, int c, int g) {
    const bf16_t* PROJ = (const bf16_t*)(a.ws + WS_PROJ);
    const int p0 = c == 0 ? -112 : NMETA + 128 * (c - 1), lr = F.lane & 31, hf = F.lane >> 5;
    __syncthreads();
    ssd_dt_acs(F, a, PROJ, b, p0, g, (float*)(a.ws + WS_DAT) + (size_t)(b * 17 + c) * HEADS);
    if (F.tid < 256) { const int chg = F.tid & 15, sr = F.tid >> 4, ch = D_SSD + g * 128 + 8 * chg;
        ConvW<8> ci; convw_load<8>(ci, PROJ + XG_OFF + g * XG_STRIDE + 384 + 8 * chg, b, p0 + 8 * sr); ConvWt cw; convw_weights(cw, a, ch);
        unsigned pk[8][4];
#pragma unroll
        for (int s2 = 0; s2 < 4; ++s2) { float o0[8], o1[8]; convw_pos<8>(ci, cw, 2 * s2, o0); convw_pos<8>(ci, cw, 2 * s2 + 1, o1);
#pragma unroll
            for (int c = 0; c < 8; ++c) pk[c][s2] = pk2(o0[c], o1[c]); }
#pragma unroll
        for (int c = 0; c < 8; ++c) *(LAS u32x4*)(F.lds + SL_C + ((8 * chg + c) * PITCH + 8 * sr) * 2) = (u32x4){pk[c][0], pk[c][1], pk[c][2], pk[c][3]}; }
    __syncthreads();
    const bf16_t* xg1 = PROJ + XG_OFF + g * XG_STRIDE + 8 * (F.tid & 7);
    ConvW<2> cin; convw_load<2>(cin, xg1, b, p0 + 2 * (F.tid >> 3));
#pragma unroll 1
    for (int hh = 0; hh < 6; ++hh) {
        const int h = g * 6 + hh, buf = hh & 1;
        {
            const int chg = F.tid & 7, sp = F.tid >> 3, ch = h * 64 + 8 * chg;
            const ConvW<2> ci = cin; ConvWt cw; convw_weights(cw, a, ch);
            if (hh < 5) convw_load<2>(cin, xg1 + (hh + 1) * 64, b, p0 + 2 * sp);
            const LAS float* dtL = (const LAS float*)(F.lds + SL_DT) + hh * 128; const LAS float* acL = (const LAS float*)(F.lds + SL_ACS) + hh * 128;
            const float aend = acL[127], w0 = dtL[2 * sp] * __expf(aend - acL[2 * sp]), w1 = dtL[2 * sp + 1] * __expf(aend - acL[2 * sp + 1]);
            float o0[8], o1[8]; convw_pos<2>(ci, cw, 0, o0); convw_pos<2>(ci, cw, 1, o1);
#pragma unroll
            for (int c = 0; c < 8; ++c) *(LAS unsigned*)(F.lds + SL_X + buf * 17408 + ((8 * chg + c) * PITCH + 2 * sp) * 2) = pk2(o0[c] * w0, o1[c] * w1);
        }
        __syncthreads();
        const int pb = F.wave >> 2, nb = F.wave & 3;
        f32x16 acc;
#pragma unroll
        for (int r = 0; r < 16; ++r) acc[r] = 0.f;
#pragma unroll
        for (int ks = 0; ks < 8; ++ks) {
            const bf16x8 af = *(const LAS bf16x8*)(F.lds + SL_C + ((32 * nb + lr) * PITCH + 16 * ks + 8 * hf) * 2);
            const bf16x8 bf = *(const LAS bf16x8*)(F.lds + SL_X + buf * 17408 + ((32 * pb + lr) * PITCH + 16 * ks + 8 * hf) * 2);
            acc = mfma32(af, bf, acc);
        }
        bf16_t* dst = c == 0 ? (bf16_t*)(a.ws + WS_SMETA) + (size_t)h * 8192 : (bf16_t*)a.out + ((size_t)(b * 16 + (c - 1)) * HEADS + h) * 8192;
        u32x4* d4 = (u32x4*)(dst + ((size_t)(pb * 4 + nb) * 64 + F.lane) * 16);
        u32x4 w0, w1; w0.x = pk2(acc[0], acc[1]); w0.y = pk2(acc[2], acc[3]); w0.z = pk2(acc[4], acc[5]); w0.w = pk2(acc[6], acc[7]);
        w1.x = pk2(acc[8], acc[9]); w1.y = pk2(acc[10], acc[11]); w1.z = pk2(acc[12], acc[13]); w1.w = pk2(acc[14], acc[15]);
        d4[0] = w0; d4[1] = w1;
    }
}
__device__ __forceinline__ void short_conv_all(const Frame& F, const Args& a) {
    bf16_t* PROJ = (bf16_t*)(a.ws + WS_PROJ);
    const size_t gt = (size_t)F.vcu * NTHREADS + F.tid, NT = (size_t)F.G * NTHREADS;
    for (size_t it = gt; it < (size_t)TR * (D_SC / 8); it += NT) {
        const int r = (int)(it / (D_SC / 8)), c0 = (int)(it % (D_SC / 8)) * 8, b = r / SEQ, pos = r % SEQ + NMETA;
        float accv[8];
#pragma unroll
        for (int j = 0; j < 8; ++j) accv[j] = 0.f;
#pragma unroll
        for (int w = 0; w < 3; ++w) { const int rr = row_of(b, pos - 2 + w);
            const u32x4 cc = *(const u32x4*)(PROJ + SC_OFF + (size_t)rr * P_SC + c0), xx = *(const u32x4*)(PROJ + SC_OFF + (size_t)rr * P_SC + 512 + c0);
            const unsigned cw[4] = {cc.x, cc.y, cc.z, cc.w}, xw[4] = {xx.x, xx.y, xx.z, xx.w};
#pragma unroll
            for (int j = 0; j < 4; ++j) { accv[2 * j] += a.conv_sc_w[w * D_SC + c0 + 2 * j] * (bflo(cw[j]) * bflo(xw[j])); accv[2 * j + 1] += a.conv_sc_w[w * D_SC + c0 + 2 * j + 1] * (bfhi(cw[j]) * bfhi(xw[j])); } }
        const u32x4 bb = *(const u32x4*)(PROJ + ZS_OFF + (size_t)r * P_ZS + 1536 + c0); const unsigned bw[4] = {bb.x, bb.y, bb.z, bb.w};
        u32x4 o; unsigned ow[4];
#pragma unroll
        for (int j = 0; j < 4; ++j) ow[j] = pk2(bflo(bw[j]) * accv[2 * j], bfhi(bw[j]) * accv[2 * j + 1]);
        o.x = ow[0]; o.y = ow[1]; o.z = ow[2]; o.w = ow[3];
        *(u32x4*)(PROJ + ZS_OFF + (size_t)r * P_ZS + 1536 + c0) = o;
    }
}
__device__ __forceinline__ void p2_ssd_states(const Frame& F, const Args& a) {
    short_conv_all(F, a);
    for (int u = F.vcu; u < 4 + BATCH * 15 * NG; u += F.G) {
        if (u < 4) ssd_s1_unit(F, a, 0, 0, u);
        else { const int v = u - 4; ssd_s1_unit(F, a, v / (15 * NG), 1 + (v / NG) % 15, v % NG); }
    }
}
__device__ __forceinline__ void p3_ssd_recur(const Frame& F, const Args& a) {
    const float* dat = (const float*)(a.ws + WS_DAT); const bf16_t* SM = (const bf16_t*)(a.ws + WS_SMETA); bf16_t* SF = (bf16_t*)a.out;
    for (int it = F.vcu; it < BATCH * HEADS * 1024 / NTHREADS; it += F.G) {
        const int idx = it * NTHREADS + F.tid, bh = idx >> 10, e8 = idx & 1023, b = bh / HEADS, h = bh % HEADS;
        u32x4 ld[15];
#pragma unroll
        for (int c = 1; c <= 15; ++c) ld[c - 1] = *(const u32x4*)(SF + ((size_t)(b * 16 + (c - 1)) * HEADS + h) * 8192 + e8 * 8);
        const u32x4 m = *(const u32x4*)(SM + (size_t)h * 8192 + e8 * 8);
        float cy[8] = {bflo(m.x), bfhi(m.x), bflo(m.y), bfhi(m.y), bflo(m.z), bfhi(m.z), bflo(m.w), bfhi(m.w)};
#pragma unroll
        for (int c = 1; c <= 16; ++c) {
            u32x4 o; o.x = pk2(cy[0], cy[1]); o.y = pk2(cy[2], cy[3]); o.z = pk2(cy[4], cy[5]); o.w = pk2(cy[6], cy[7]);
            *(u32x4*)(SF + ((size_t)(b * 16 + (c - 1)) * HEADS + h) * 8192 + e8 * 8) = o;
            if (c <= 15) { const float dA = dat[(size_t)(b * 17 + c) * HEADS + h]; const u32x4 t = ld[c - 1];
                cy[0] = cy[0] * dA + bflo(t.x); cy[1] = cy[1] * dA + bfhi(t.x); cy[2] = cy[2] * dA + bflo(t.y); cy[3] = cy[3] * dA + bfhi(t.y);
                cy[4] = cy[4] * dA + bflo(t.z); cy[5] = cy[5] * dA + bfhi(t.z); cy[6] = cy[6] * dA + bflo(t.w); cy[7] = cy[7] * dA + bfhi(t.w); }
        }
    }
}
__device__ __forceinline__ void ssd_s3_unit(const Frame& F, const Args& a, int b, int c, int g) {
    bf16_t* PROJ = (bf16_t*)(a.ws + WS_PROJ);
    const int p0 = NMETA + 128 * (c - 1), row0 = b * SEQ + 128 * (c - 1), lr = F.lane & 31, hf = F.lane >> 5;
    __syncthreads();
    ssd_dt_acs(F, a, PROJ, b, p0, g, nullptr);
    {   const int mat = F.tid >> 8, it = F.tid & 255, chg = it & 15, sr = it >> 4, ch = D_SSD + (mat ? 0 : 512) + g * 128 + 8 * chg;
        ConvW<8> ci; convw_load<8>(ci, PROJ + XG_OFF + g * XG_STRIDE + (mat ? 384 : 512) + 8 * chg, b, p0 + 8 * sr); ConvWt cw; convw_weights(cw, a, ch);
#pragma unroll
        for (int s = 0; s < 8; ++s) { float o[8]; convw_pos<8>(ci, cw, s, o);
            *(LAS u32x4*)(F.lds + (mat ? SL_B : SL_C) + ((8 * sr + s) * PITCH + 8 * chg) * 2) = (u32x4){pk2(o[0], o[1]), pk2(o[2], o[3]), pk2(o[4], o[5]), pk2(o[6], o[7])}; } }
    __syncthreads();
    constexpr unsigned SI_P = 0u | (0u << 2) | (1u << 4) | (0u << 6) | (1u << 8) | (2u << 10) | (0u << 12) | (1u << 14) | (2u << 16) | (3u << 18);
    constexpr unsigned LI_P = 0u | (1u << 2) | (1u << 4) | (2u << 6) | (2u << 8) | (2u << 10) | (3u << 12) | (3u << 14) | (3u << 16) | (3u << 18);
    const int nslot = F.wave < 2 ? 2 : 1;
    f32x16 cb[2];
#pragma unroll
    for (int sl = 0; sl < 2; ++sl) {
#pragma unroll
        for (int r = 0; r < 16; ++r) cb[sl][r] = 0.f;
        if (sl < nslot) { const int ti = F.wave + 8 * sl, si = (SI_P >> (2 * ti)) & 3, li = (LI_P >> (2 * ti)) & 3;
#pragma unroll
            for (int ks = 0; ks < 8; ++ks) {
                const bf16x8 af = *(const LAS bf16x8*)(F.lds + SL_B + ((32 * si + lr) * PITCH + 16 * ks + 8 * hf) * 2);
                const bf16x8 bf = *(const LAS bf16x8*)(F.lds + SL_C + ((32 * li + lr) * PITCH + 16 * ks + 8 * hf) * 2);
                cb[sl] = mfma32(af, bf, cb[sl]); } }
    }
    __syncthreads();
    const int pb = F.wave & 1, lio = F.wave >> 1;
    unsigned ypk[6][8];
#pragma unroll
    for (int i = 0; i < 6; ++i)
#pragma unroll
        for (int r = 0; r < 8; ++r) ypk[i][r] = 0u;
#pragma unroll 1
    for (int hh = 0; hh < 6; ++hh) {
        const int h = g * 6 + hh, buf = hh & 1, mofs = buf ? SL_B : SL_M0;
        const LAS float* dtL = (const LAS float*)(F.lds + SL_DT) + hh * 128; const LAS float* acL = (const LAS float*)(F.lds + SL_ACS) + hh * 128;
        const bf16_t* sp = (const bf16_t*)a.out + ((size_t)(b * 16 + (c - 1)) * HEADS + h) * 8192;
        {
            const int chg = F.tid & 7, spp = F.tid >> 3, ch = h * 64 + 8 * chg;
            ConvW<2> ci; convw_load<2>(ci, PROJ + XG_OFF + g * XG_STRIDE + hh * 64 + 8 * chg, b, p0 + 2 * spp); ConvWt cw; convw_weights(cw, a, ch);
            float o0[8], o1[8]; convw_pos<2>(ci, cw, 0, o0); convw_pos<2>(ci, cw, 1, o1);
#pragma unroll
            for (int cc = 0; cc < 8; ++cc) *(LAS unsigned*)(F.lds + SL_X + buf * 17408 + ((8 * chg + cc) * PITCH + 2 * spp) * 2) = pk2(o0[cc], o1[cc]);
        }
        u32x4 sf[4][2];
#pragma unroll
        for (int nb = 0; nb < 4; ++nb) { const u32x4* s4 = (const u32x4*)(sp + ((size_t)(pb * 4 + nb) * 64 + F.lane) * 16); sf[nb][0] = s4[0]; sf[nb][1] = s4[1]; }
        {
            const float Dh = a.d_skip[h];
#pragma unroll
            for (int sl = 0; sl < 2; ++sl) if (sl < nslot) { const int ti = F.wave + 8 * sl, si = (SI_P >> (2 * ti)) & 3, li = (LI_P >> (2 * ti)) & 3;
                const int l = 32 * li + lr; const float acl = acL[l];
#pragma unroll
                for (int q = 0; q < 4; ++q) { const int s0 = 32 * si + 8 * q + 4 * hf;
                    const f32x4 d4 = *(const LAS f32x4*)(dtL + s0), a4 = *(const LAS f32x4*)(acL + s0); float v[4];
#pragma unroll
                    for (int i = 0; i < 4; ++i) { const int s = s0 + i; float t = s <= l ? cb[sl][4 * q + i] * __expf(acl - a4[i]) * d4[i] : 0.f; if (s == l) t += Dh; v[i] = t; }
                    *(LAS u32x2*)(F.lds + mofs + (l * PITCH + s0) * 2) = (u32x2){pk2(v[0], v[1]), pk2(v[2], v[3])}; } }
        }
        f32x16 acc;
#pragma unroll
        for (int r = 0; r < 16; ++r) acc[r] = 0.f;
        {
#pragma unroll
            for (int nb = 0; nb < 4; ++nb) {
#pragma unroll
                for (int qp = 0; qp < 2; ++qp) { const LAS unsigned char* cp_ = F.lds + SL_C + ((32 * lio + lr) * PITCH + 32 * nb + 16 * qp + 4 * hf) * 2;
                    const u32x2 c0 = *(const LAS u32x2*)cp_, c1 = *(const LAS u32x2*)(cp_ + 16);
                    const u32x4 bfr = (u32x4){c0.x, c0.y, c1.x, c1.y};
                    acc = mfma32(__builtin_bit_cast(bf16x8, sf[nb][qp]), __builtin_bit_cast(bf16x8, bfr), acc); } }
            const float sc = __expf(acL[32 * lio + lr]);
#pragma unroll
            for (int r = 0; r < 16; ++r) acc[r] *= sc;
        }
        __syncthreads();
        for (int ks = 0; ks < 2 * (lio + 1); ++ks) {
            const bf16x8 af = *(const LAS bf16x8*)(F.lds + SL_X + buf * 17408 + ((32 * pb + lr) * PITCH + 16 * ks + 8 * hf) * 2);
            const bf16x8 bf = *(const LAS bf16x8*)(F.lds + mofs + ((32 * lio + lr) * PITCH + 16 * ks + 8 * hf) * 2);
            acc = mfma32(af, bf, acc);
        }
#pragma unroll
        for (int i = 0; i < 5; ++i)
#pragma unroll
            for (int r = 0; r < 8; ++r) ypk[i][r] = ypk[i + 1][r];
#pragma unroll
        for (int r = 0; r < 8; ++r) ypk[5][r] = pk2(acc[2 * r], acc[2 * r + 1]);
    }
    __syncthreads();
#pragma unroll
    for (int hh = 0; hh < 6; ++hh)
#pragma unroll
        for (int q = 0; q < 4; ++q) *(LAS u32x2*)(F.lds + SL_B + ((32 * lio + lr) * YPITCH + hh * 64 + 32 * pb + 8 * q + 4 * hf) * 2) = (u32x2){ypk[hh][2 * q], ypk[hh][2 * q + 1]};
    u32x2 zz2[4][6];
#pragma unroll
    for (int pass = 0; pass < 4; ++pass) { const int l = pass * 32 + F.wave * 4 + (F.lane >> 4), sub = F.lane & 15; const bf16_t* zr = PROJ + ZS_OFF + (size_t)(row0 + l) * P_ZS + g * 384;
#pragma unroll
        for (int k = 0; k < 6; ++k) zz2[pass][k] = *(const u32x2*)(zr + 4 * (sub + 16 * k)); }
    __syncthreads();
#pragma unroll
    for (int pass = 0; pass < 4; ++pass) {
        const int l = pass * 32 + F.wave * 4 + (F.lane >> 4), sub = F.lane & 15; bf16_t* zr = PROJ + ZS_OFF + (size_t)(row0 + l) * P_ZS + g * 384;
        float v[6][4]; float ss = 0.f;
#pragma unroll
        for (int k = 0; k < 6; ++k) { const int c0 = 4 * (sub + 16 * k); const u32x2 y2 = *(const LAS u32x2*)(F.lds + SL_B + (l * YPITCH + c0) * 2), z2 = zz2[pass][k];
            const float yy[4] = {bflo(y2.x), bfhi(y2.x), bflo(y2.y), bfhi(y2.y)}, zz[4] = {bflo(z2.x), bfhi(z2.x), bflo(z2.y), bfhi(z2.y)};
#pragma unroll
            for (int i = 0; i < 4; ++i) { v[k][i] = yy[i] * silu_f(zz[i]); ss += v[k][i] * v[k][i]; } }
        ss = row_sum16(ss);
        const float rstd = 1.0f / sqrtf(ss * (1.f / 384.f) + EPS);
#pragma unroll
        for (int k = 0; k < 6; ++k) { const int c0 = 4 * (sub + 16 * k); const f32x4 nw = *(const f32x4*)(a.ssd_norm_w + g * 384 + c0);
            *(u32x2*)(zr + c0) = (u32x2){pk2(v[k][0] * rstd * nw.x, v[k][1] * rstd * nw.y), pk2(v[k][2] * rstd * nw.z, v[k][3] * rstd * nw.w)}; }
    }
}
__device__ __forceinline__ void p4_ssd_out(const Frame& F, const Args& a) {
    for (int u = F.vcu; u < BATCH * 16 * NG; u += F.G) ssd_s3_unit(F, a, u / (16 * NG), 1 + (u / NG) % 16, u % NG);
}

__device__ __forceinline__ void p6_tables_rstd(const Frame& F, const Args& a) {
    const int gw = F.vcu * NWAVES + F.wave, NGW = F.G * NWAVES;
    {
        unsigned char* V8 = a.ws + WS_V8; float* SV = (float*)(a.ws + WS_SV);
        for (int r = gw; r < 2 * PK * PK; r += NGW) {
            const bool isv = r >= PK * PK; const int e = isv ? r - PK * PK : r;
            const f32x4* src = (const f32x4*)((isv ? a.expert_v : a.expert_u) + (size_t)e * D) + 4 * F.lane;
            f32x4 v[4];
#pragma unroll
            for (int j = 0; j < 4; ++j) v[j] = src[j];
            if (isv) {
                float amax = 0.f;
#pragma unroll
                for (int j = 0; j < 4; ++j) amax = fmaxf(amax, fmaxf(fmaxf(fabsf(v[j].x), fabsf(v[j].y)), fmaxf(fabsf(v[j].z), fabsf(v[j].w))));
#pragma unroll
                for (int o = 1; o < 64; o <<= 1) amax = fmaxf(amax, __shfl_xor(amax, o));
                const float sc = amax > 0.f ? amax * (1.0f / 440.0f) : 1.0f, inv = 1.0f / sc;
                u32x4 o4; unsigned ow[4];
#pragma unroll
                for (int j = 0; j < 4; ++j) { int p = 0; p = __builtin_amdgcn_cvt_pk_fp8_f32(v[j].x * inv, v[j].y * inv, p, false); p = __builtin_amdgcn_cvt_pk_fp8_f32(v[j].z * inv, v[j].w * inv, p, true); ow[j] = (unsigned)p; }
                o4.x = ow[0]; o4.y = ow[1]; o4.z = ow[2]; o4.w = ow[3];
                *(u32x4*)(V8 + ((size_t)(F.lane >> 3) * (PK * PK) + e) * 128 + 16 * (F.lane & 7)) = o4; if (F.lane == 0) SV[e] = sc;
            } else {
                const f32x4* gr = (const f32x4*)a.g_ffn + 4 * F.lane;
#pragma unroll
                for (int j = 0; j < 4; ++j) v[j] = v[j] * gr[j];
                u32x4* ub = (u32x4*)((bf16_t*)(a.ws + WS_UB) + (size_t)e * D) + 2 * F.lane;
                u32x4 b0, b1; b0.x = pk2(v[0].x, v[0].y); b0.y = pk2(v[0].z, v[0].w); b0.z = pk2(v[1].x, v[1].y); b0.w = pk2(v[1].z, v[1].w); b1.x = pk2(v[2].x, v[2].y); b1.y = pk2(v[2].z, v[2].w); b1.z = pk2(v[3].x, v[3].y); b1.w = pk2(v[3].z, v[3].w);
                ub[0] = b0; ub[1] = b1;
            }
        }
    }
    const bf16_t* H2b = (const bf16_t*)(a.ws + WS_XN); float* RSTD = (float*)(a.ws + WS_RSTD);
    for (int m = gw; m < TR; m += NGW) {
        const u32x4* xr = (const u32x4*)(H2b + (size_t)m * D) + 2 * F.lane; const u32x4 p = xr[0], q = xr[1]; const unsigned w[8] = {p.x, p.y, p.z, p.w, q.x, q.y, q.z, q.w};
        float s = 0.f;
#pragma unroll
        for (int j = 0; j < 8; ++j) { const float lo = bflo(w[j]), hi = bfhi(w[j]); s += lo * lo + hi * hi; }
        s = wave_sum(s);
        if (F.lane == 0) RSTD[m] = 1.0f / sqrtf(s * (1.f / D) + EPS);
    }
}

__device__ __forceinline__ unsigned ord_bits(float f) { const unsigned u = __builtin_bit_cast(unsigned, f); return u ^ ((u >> 31) ? 0xffffffffu : 0x80000000u); }
__device__ __forceinline__ float ord_val(unsigned o) { const unsigned u = (o & 0x80000000u) ? (o ^ 0x80000000u) : ~o; return __builtin_bit_cast(float, u); }
__device__ __forceinline__ void cex_desc(unsigned& x, unsigned& y) { const unsigned hi = x > y ? x : y, lo = x > y ? y : x; x = hi; y = lo; }
__device__ __forceinline__ void sort16_desc(unsigned (&v)[16]) {
#pragma unroll
    for (int k = 2; k <= 16; k <<= 1)
#pragma unroll
        for (int j = k >> 1; j > 0; j >>= 1)
#pragma unroll
            for (int i = 0; i < 16; ++i) { const int l = i ^ j; if (l > i) { if ((i & k) == 0) cex_desc(v[i], v[l]); else cex_desc(v[l], v[i]); } }
}
__device__ __forceinline__ void bitonic_merge16_desc(unsigned (&v)[16]) {
#pragma unroll
    for (int j = 8; j > 0; j >>= 1)
#pragma unroll
        for (int i = 0; i < 16; ++i) { const int l = i ^ j; if (l > i) cex_desc(v[i], v[l]); }
}
__device__ __forceinline__ void top16_merge(unsigned (&T)[16], const unsigned (&B)[16]) {
#pragma unroll
    for (int i = 0; i < 16; ++i) T[i] = T[i] > B[15 - i] ? T[i] : B[15 - i];
    bitonic_merge16_desc(T);
}
__device__ __forceinline__ void p8_topk_mfma(const Frame& F, const Args& a) {
    const bf16_t* Q = (const bf16_t*)(a.ws + WS_Q); int* EIDX = (int*)(a.ws + WS_EIDX); float* GATE = (float*)(a.ws + WS_GATE);
    const int lane = F.lane, lr = lane & 31, hf = lane >> 5;
    for (int task = F.vcu; task < PH * (TR / 1024); task += F.G) {
        const int h = task % PH, rng = task / PH;
        __syncthreads();
        {
            const f32x4* kp = (const f32x4*)(a.sub_keys + (size_t)h * 2 * PK * 128);
            for (int i = F.tid; i < 2 * PK * 128 / 4; i += NTHREADS) { const f32x4 v = kp[i]; const int row = i >> 5, c4 = (i & 31) * 4;
                *(LAS u32x2*)(F.lds + (row * PITCH + c4) * 2) = (u32x2){pk2(v.x, v.y), pk2(v.z, v.w)}; }
        }
        __syncthreads();
        for (int tile = F.wave; tile < 16; tile += NWAVES) {
            const int t0 = rng * 1024 + tile * 64;
            unsigned L0[16], L1[16];
#pragma unroll
            for (int i = 0; i < 16; ++i) { L0[i] = 0u; L1[i] = 0u; }
#pragma unroll 1
            for (int s = 0; s < 2; ++s) {
                unsigned TA[16], R[16];
#pragma unroll
                for (int i = 0; i < 16; ++i) { TA[i] = 0u; R[i] = 0u; }
#pragma unroll 1
                for (int th = 0; th < 2; ++th) {
                    bf16x8 qf[8];
                    const bf16_t* qp = Q + (size_t)(t0 + 32 * th + lr) * PQ + h * 256 + s * 128 + 8 * hf;
#pragma unroll
                    for (int ks = 0; ks < 8; ++ks) qf[ks] = *(const bf16x8*)(qp + 16 * ks);
                    unsigned T[16];
#pragma unroll
                    for (int i = 0; i < 16; ++i) T[i] = 0u;
#pragma unroll 1
                    for (int kb = 0; kb < 4; ++kb) {
                        f32x16 acc;
#pragma unroll
                        for (int r = 0; r < 16; ++r) acc[r] = 0.f;
#pragma unroll
                        for (int ks = 0; ks < 8; ++ks) { const bf16x8 af = *(const LAS bf16x8*)(F.lds + ((s * PK + 32 * kb + lr) * PITCH + 16 * ks + 8 * hf) * 2); acc = mfma32(af, qf[ks], acc); }
                        unsigned B[16];
#pragma unroll
                        for (int r = 0; r < 16; ++r) { const int k = 32 * kb + 8 * (r >> 2) + 4 * hf + (r & 3); B[r] = (ord_bits(acc[r]) & ~127u) | (unsigned)(127 - k); }
                        sort16_desc(B);
                        top16_merge(T, B);
                    }
                    unsigned P[16];
#pragma unroll
                    for (int i = 0; i < 16; ++i) { unsigned lo2, hi2; swap32_self(T[i], lo2, hi2); P[i] = hf ? lo2 : hi2; }
                    top16_merge(T, P);
#pragma unroll
                    for (int i = 0; i < 16; ++i) { R[i] = hf ? T[i] : TA[i]; TA[i] = T[i]; }
                }
#pragma unroll
                for (int i = 0; i < 16; ++i) { L0[i] = L1[i]; L1[i] = R[i]; }
            }
            const int t = t0 + lane;
            unsigned T[16];
            const float v00 = ord_val(L0[0] & ~127u);
#pragma unroll
            for (int j = 0; j < 16; ++j) T[j] = (ord_bits(v00 + ord_val(L1[j] & ~127u)) & ~255u) | (unsigned)(255 - j);
#pragma unroll
            for (int i = 1; i < 16; ++i)
#pragma unroll
                for (int j = 0; j < 16; ++j) if ((i + 1) * (j + 1) <= 16) {
                    const float sum = ord_val(L0[i] & ~127u) + ord_val(L1[j] & ~127u);
                    unsigned e = (ord_bits(sum) & ~255u) | (unsigned)(255 - (i * 16 + j));
#pragma unroll
                    for (int k = 0; k < 16; ++k) { const unsigned hi = T[k] > e ? T[k] : e; e = T[k] > e ? e : T[k]; T[k] = hi; }
                }
            float best[16]; int eid[16];
#pragma unroll
            for (int k = 0; k < 16; ++k) {
                best[k] = ord_val(T[k] & ~255u); const int pos = 255 - (int)(T[k] & 255u), pi = pos >> 4, pj = pos & 15;
                unsigned a0 = 0u, a1 = 0u;
#pragma unroll
                for (int i = 0; i < 16; ++i) { a0 = (pi == i) ? L0[i] : a0; a1 = (pj == i) ? L1[i] : a1; }
                eid[k] = (127 - (int)(a0 & 127u)) * PK + (127 - (int)(a1 & 127u));
            }
            const float rst = ((const float*)(a.ws + WS_RSTD))[t];
            float se = 0.f, ex[16];
#pragma unroll
            for (int k = 0; k < 16; ++k) { ex[k] = __expf((best[k] - best[0]) * rst); se += ex[k]; }
            const float inv = 1.f / se;
            int* ep = EIDX + (size_t)t * 128 + h * 16; float* gp = GATE + (size_t)t * 128 + h * 16;
#pragma unroll
            for (int k = 0; k < 16; k += 4) { *(int4*)(ep + k) = make_int4(eid[k], eid[k + 1], eid[k + 2], eid[k + 3]); *(f32x4*)(gp + k) = (f32x4){ex[k] * inv, ex[k + 1] * inv, ex[k + 2] * inv, ex[k + 3] * inv}; }
        }
    }
}

typedef __bf16 bf16x2_t __attribute__((ext_vector_type(2)));
__device__ __forceinline__ float dot2bf(unsigned w, unsigned x, float acc) { return __builtin_amdgcn_fdot2_f32_bf16(__builtin_bit_cast(bf16x2_t, w), __builtin_bit_cast(bf16x2_t, x), acc, false); }

__device__ __forceinline__ float shx32(float x, int lane) { unsigned a, b; swap32_self(__builtin_bit_cast(unsigned, x), a, b); return __builtin_bit_cast(float, (lane & 32) ? a : b); }
__device__ __forceinline__ float shx16(float x, int lane) { unsigned a, b; swap16_self(__builtin_bit_cast(unsigned, x), a, b); return __builtin_bit_cast(float, (lane & 16) ? a : b); }
template <int CTRL> __device__ __forceinline__ float dppf(float x) { return __builtin_bit_cast(float, __builtin_amdgcn_update_dpp(0, __builtin_bit_cast(int, x), CTRL, 0xF, 0xF, true)); }
__device__ __forceinline__ float shx8(float x) { return dppf<0x128>(x); }
__device__ __forceinline__ float shx4(float x, int) { return dppf<0x1B>(dppf<0x141>(x)); }

__device__ __forceinline__ float gelu_as(float v) {
    const float av = __builtin_fabsf(v), t = __builtin_amdgcn_rcpf(av * 0.2316418882f + 1.0f);
    float q = t * 0.5307027145f + (-0.7265760135f); q = q * t + 0.7107068705f; q = q * t + (-0.142248368f); q = q * t + 0.127414796f; q = q * t;
    const float e = __builtin_amdgcn_exp2f((v * v) * (-0.72134752044f));
    const float m = v * (q * e);
    return v < 0.f ? m : v - m;
}
__device__ __forceinline__ int rdlane(int v, int l) { return __builtin_amdgcn_readlane(v, l); }
__device__ __forceinline__ float rdlanef(float v, int l) { return __builtin_bit_cast(float, __builtin_amdgcn_readlane(__builtin_bit_cast(int, v), l)); }

struct PeerBatch { int l0, l1, l2, l3; u32x4 r[4][2]; };
__device__ __forceinline__ void peerA_take(unsigned long long& m, PeerBatch& B, const bf16_t* Ub, int lane, int ev) {
    B.l0 = __builtin_ctzll(m); m &= m - 1; B.l1 = B.l0; B.l2 = B.l0; B.l3 = B.l0;
    if (m) { B.l1 = __builtin_ctzll(m); m &= m - 1; if (m) { B.l2 = __builtin_ctzll(m); m &= m - 1; if (m) { B.l3 = __builtin_ctzll(m); m &= m - 1; } } }
    const unsigned e0 = (unsigned)rdlane(ev, B.l0), e1 = (unsigned)rdlane(ev, B.l1), e2 = (unsigned)rdlane(ev, B.l2), e3 = (unsigned)rdlane(ev, B.l3);
    const unsigned loff = (unsigned)lane * 32u;
    const char* r0 = (const char*)Ub + ((size_t)e0 << 11); const char* r1 = (const char*)Ub + ((size_t)e1 << 11); const char* r2 = (const char*)Ub + ((size_t)e2 << 11); const char* r3 = (const char*)Ub + ((size_t)e3 << 11);
    B.r[0][0] = *(const u32x4*)(r0 + loff); B.r[0][1] = *(const u32x4*)(r0 + loff + 16); B.r[1][0] = *(const u32x4*)(r1 + loff); B.r[1][1] = *(const u32x4*)(r1 + loff + 16);
    B.r[2][0] = *(const u32x4*)(r2 + loff); B.r[2][1] = *(const u32x4*)(r2 + loff + 16); B.r[3][0] = *(const u32x4*)(r3 + loff); B.r[3][1] = *(const u32x4*)(r3 + loff + 16);
}
__device__ __forceinline__ void peerA_finish(const PeerBatch& B, int lane, LAS float* dl  , const unsigned (&xp)[8]) {
#define DOT16(lo, hi) dot2bf((hi).w, xp[7], dot2bf((hi).z, xp[6], dot2bf((hi).y, xp[5], dot2bf((hi).x, xp[4], dot2bf((lo).w, xp[3], dot2bf((lo).z, xp[2], dot2bf((lo).y, xp[1], dot2bf((lo).x, xp[0], 0.f))))))))
    const float p0 = DOT16(B.r[0][0], B.r[0][1]), p1 = DOT16(B.r[1][0], B.r[1][1]), p2 = DOT16(B.r[2][0], B.r[2][1]), p3 = DOT16(B.r[3][0], B.r[3][1]);
#undef DOT16
    const bool hi5 = lane & 32, hi4 = lane & 16;
    const float k0 = hi5 ? p2 : p0, s0 = hi5 ? p0 : p2, k1 = hi5 ? p3 : p1, s1 = hi5 ? p1 : p3;
    const float t0 = k0 + shx32(s0, lane), t1 = k1 + shx32(s1, lane);
    const float k2 = hi4 ? t1 : t0, s2 = hi4 ? t0 : t1;
    const float d = row_sum16(k2 + shx16(s2, lane));
    const int sl0 = __builtin_amdgcn_readfirstlane(B.l0), sl1 = __builtin_amdgcn_readfirstlane(B.l1), sl2 = __builtin_amdgcn_readfirstlane(B.l2), sl3 = __builtin_amdgcn_readfirstlane(B.l3);
    const int slot = hi5 ? (hi4 ? sl3 : sl2) : (hi4 ? sl1 : sl0);
    if ((lane & 15) == 0) dl[slot] = d;
}
struct PeerGather8 { u32x4 vv[16]; float aw[16]; };
__device__ __forceinline__ void peerB8_gather(PeerGather8& G, const unsigned char* V8, int lane, int cs, const LAS int* ELt, const LAS float* ALt) {
    const int rg = lane >> 3, cl = lane & 7;
#pragma unroll
    for (int j = 0; j < 16; ++j) { const int e = ELt[8 * j + rg]; G.aw[j] = ALt[8 * j + rg];
        G.vv[j] = *(const u32x4*)(V8 + (((unsigned)(cs * PK * PK) + (unsigned)e) * 128u + (unsigned)(cl * 16))); }
}
__device__ __forceinline__ f32x2 peerB8_reduce(const PeerGather8& G, int lane) {
    f32x2 acc[8];
#pragma unroll
    for (int c = 0; c < 8; ++c) acc[c] = (f32x2){0.f, 0.f};
#pragma unroll
    for (int j = 0; j < 16; ++j) { const unsigned ww[4] = {G.vv[j].x, G.vv[j].y, G.vv[j].z, G.vv[j].w}; const f32x2 a2 = (f32x2){G.aw[j], G.aw[j]};
#pragma unroll
        for (int m = 0; m < 4; ++m) { acc[2 * m] += __builtin_amdgcn_cvt_pk_f32_fp8(ww[m], false) * a2; acc[2 * m + 1] += __builtin_amdgcn_cvt_pk_f32_fp8(ww[m], true) * a2; } }
    const bool b5 = lane & 32, b4 = lane & 16, b3 = lane & 8;
    f32x2 v4[4], v2[2];
#pragma unroll
    for (int c = 0; c < 4; ++c) { const f32x2 keep = b5 ? acc[c + 4] : acc[c], send = b5 ? acc[c] : acc[c + 4]; v4[c] = keep + (f32x2){shx32(send.x, lane), shx32(send.y, lane)}; }
#pragma unroll
    for (int c = 0; c < 2; ++c) { const f32x2 keep = b4 ? v4[c + 2] : v4[c], send = b4 ? v4[c] : v4[c + 2]; v2[c] = keep + (f32x2){shx16(send.x, lane), shx16(send.y, lane)}; }
    const f32x2 keep = b3 ? v2[1] : v2[0], send = b3 ? v2[0] : v2[1];
    return keep + (f32x2){shx8(send.x), shx8(send.y)};
}
#ifndef NSLICE
#define NSLICE 10
#endif
__device__ __forceinline__ int slice_of(int e) { return (e * NSLICE) >> 14; }
__device__ __forceinline__ void peerA_token2(const bf16_t* Ub, int lane, int s, int e0lo, int e0hi, LAS float* d0, const unsigned (&xp0)[8], int e1lo, int e1hi, LAS float* d1, const unsigned (&xp1)[8]) {
    unsigned long long m0 = __ballot(slice_of(e0lo) == s), m1 = __ballot(slice_of(e0hi) == s), m2 = __ballot(slice_of(e1lo) == s), m3 = __ballot(slice_of(e1hi) == s);
    while (m0 | m1 | m2 | m3) {
        const bool h0 = m0 != 0ull, h1 = m1 != 0ull, h2 = m2 != 0ull, h3 = m3 != 0ull;
        PeerBatch B0, B1, B2, B3;
        if (h0) peerA_take(m0, B0, Ub, lane, e0lo);
        if (h1) peerA_take(m1, B1, Ub, lane, e0hi);
        if (h2) peerA_take(m2, B2, Ub, lane, e1lo);
        if (h3) peerA_take(m3, B3, Ub, lane, e1hi);
        if (h0) peerA_finish(B0, lane, d0, xp0);
        if (h1) peerA_finish(B1, lane, d0 + 64, xp0);
        if (h2) peerA_finish(B2, lane, d1, xp1);
        if (h3) peerA_finish(B3, lane, d1 + 64, xp1);
    }
}
__device__ __forceinline__ void p9_peer_hybrid(const Frame& F, const Args& a, float* dst) {
    const int* EIDX = (const int*)(a.ws + WS_EIDX); const float* GATE = (const float*)(a.ws + WS_GATE); const float* RSTD = (const float*)(a.ws + WS_RSTD);
    const bf16_t* Ub = (const bf16_t*)(a.ws + WS_UB); const unsigned char* V8 = a.ws + WS_V8; const float* SV = (const float*)(a.ws + WS_SV);
    bf16_t* H2b = (bf16_t*)(a.ws + WS_XN);
    const int gw = F.vcu * NWAVES + F.wave, lane = F.lane, tokb = gw * 16;
    LAS int* EL = (LAS int*)(F.lds + F.wave * 16384); LAS float* AL = (LAS float*)(F.lds + F.wave * 16384 + 8192);
#pragma unroll 4
    for (int ti = 0; ti < 16; ++ti) { const size_t o = (size_t)(tokb + ti) * 128;
        EL[ti * 128 + lane] = EIDX[o + lane] | (int)(f2bf(GATE[o + lane]) << 16); EL[ti * 128 + 64 + lane] = EIDX[o + 64 + lane] | (int)(f2bf(GATE[o + 64 + lane]) << 16); }
    const float myrs = RSTD[tokb + (lane & 15)];
#pragma unroll 1
    for (int s = 0; s < NSLICE; ++s) {
#pragma unroll 1
        for (int i = 0; i < 16; i += 2) { const int o = i * 128;
            const u32x4* x0 = (const u32x4*)(H2b + (size_t)(tokb + i) * D) + 2 * lane; const u32x4* x1 = x0 + D / 8;
            const u32x4 xa = x0[0], xb = x0[1], xc = x1[0], xd = x1[1];
            const unsigned xp0[8] = {xa.x, xa.y, xa.z, xa.w, xb.x, xb.y, xb.z, xb.w}, xp1[8] = {xc.x, xc.y, xc.z, xc.w, xd.x, xd.y, xd.z, xd.w};
            const int e0lo = EL[o + lane] & 0x3fff, e0hi = EL[o + 64 + lane] & 0x3fff, e1lo = EL[o + 128 + lane] & 0x3fff, e1hi = EL[o + 192 + lane] & 0x3fff;
            peerA_token2(Ub, lane, s, e0lo, e0hi, AL + o, xp0, e1lo, e1hi, AL + o + 128, xp1); }
    }
#pragma unroll 2
    for (int ti = 0; ti < 16; ++ti) { const float rs = rdlanef(myrs, ti);
#pragma unroll
        for (int hf = 0; hf < 2; ++hf) { const int k = ti * 128 + 64 * hf + lane; const int w = EL[k], e = w & 0x3fff; const float gate = __builtin_bit_cast(float, (unsigned)w & 0xffff0000u);
            AL[k] = gelu_as(AL[k] * rs) * gate * SV[e]; EL[k] = e; } }
    const int col = 16 * (lane & 7) + ((lane >> 5) & 1) * 8 + ((lane >> 4) & 1) * 4 + ((lane >> 3) & 1) * 2;
#pragma unroll 1
    for (int cs = 0; cs < 8; ++cs) {
        PeerGather8 G0, G1;
        peerB8_gather(G0, V8, lane, cs, EL, AL);
#pragma unroll 1
        for (int ti = 0; ti < 16; ti += 2) {
            unsigned* hp0 = (unsigned*)(H2b + (size_t)(tokb + ti) * D + cs * 128 + col); unsigned* hp1 = hp0 + D / 2; const unsigned h0 = *hp0, h1 = *hp1;
            peerB8_gather(G1, V8, lane, cs, EL + (ti + 1) * 128, AL + (ti + 1) * 128);
            { const f32x2 r = peerB8_reduce(G0, lane); *hp0 = pk2(bflo(h0) + r.x, bfhi(h0) + r.y); }
            if (ti + 2 < 16) peerB8_gather(G0, V8, lane, cs, EL + (ti + 2) * 128, AL + (ti + 2) * 128);
            { const f32x2 r = peerB8_reduce(G1, lane); *hp1 = pk2(bflo(h1) + r.x, bfhi(h1) + r.y); }
        }
    }
    asm volatile("s_waitcnt vmcnt(0)" ::: "memory");
    __builtin_amdgcn_fence(__ATOMIC_RELEASE, "workgroup"); __builtin_amdgcn_fence(__ATOMIC_ACQUIRE, "workgroup");
#pragma unroll 2
    for (int ti = 0; ti < 16; ++ti) {
        const u32x4* hr = (const u32x4*)(H2b + (size_t)(tokb + ti) * D) + 2 * lane; f32x4* orow = (f32x4*)(dst + (size_t)(tokb + ti) * D) + 4 * lane; const f32x4* gf = (const f32x4*)a.g_final + 4 * lane;
        const u32x4 p = hr[0], q = hr[1]; const unsigned w[8] = {p.x, p.y, p.z, p.w, q.x, q.y, q.z, q.w};
        float hv[16]; float s2 = 0.f;
#pragma unroll
        for (int j = 0; j < 8; ++j) { hv[2 * j] = bflo(w[j]); hv[2 * j + 1] = bfhi(w[j]); s2 += hv[2 * j] * hv[2 * j] + hv[2 * j + 1] * hv[2 * j + 1]; }
        const float rstd2 = 1.0f / sqrtf(wave_sum(s2) * (1.f / D) + EPS);
#pragma unroll
        for (int j = 0; j < 4; ++j) { const f32x4 g4 = gf[j]; orow[j] = (f32x4){hv[4 * j] * rstd2 * g4.x, hv[4 * j + 1] * rstd2 * g4.y, hv[4 * j + 2] * rstd2 * g4.z, hv[4 * j + 3] * rstd2 * g4.w}; }
    }
}

__global__ void __launch_bounds__(NTHREADS, 2) fwd(Args a) {
    extern __shared__ __attribute__((aligned(16))) unsigned char lds[];
    Frame F; F.lds = (LAS unsigned char*)lds; F.tid = threadIdx.x; F.lane = F.tid & 63; F.wave = __builtin_amdgcn_readfirstlane(F.tid >> 6);
    F.G = gridDim.x; { const int bx = blockIdx.x; F.vcu = (F.G % 8 == 0) ? (bx % 8) * (F.G / 8) + bx / 8 : bx; }
    volatile LAS unsigned* MISC = (volatile LAS unsigned*)(F.lds + LDSCTL_OFF);
    for (int u = F.tid; u < (LDS_BYTES - LDSCTL_OFF) / 4; u += NTHREADS) ((LAS unsigned*)(F.lds + LDSCTL_OFF))[u] = 0u;
    __syncthreads();
    XcdBarrier bar; bar.bar = (unsigned*)(a.ws + WS_CTL) + CW_BAR; bar.x = 0; bar.st = nullptr;
    if (N_LAUNCHES == 1) bar = xcd_barrier_post((unsigned*)(a.ws + WS_CTL) + CW_BAR, MISC + 8);
    const int lo = a.ph_lo, hi = a.ph_hi;
#define IN(k) (lo <= (k) && (k) < hi)
#define GEMM_CALL(EPI) pg8::gemm_phase<EPI, pg8::StaticOrder, true, true>(F.lds, g, S, E)
#define SEAM(k) do { if (IN(k) && IN((k) + 1)) xcd_barrier(bar); } while (0)
    bf16_t* PROJ = (bf16_t*)(a.ws + WS_PROJ);
#define GEMM_P1 { pg8::Gemm g{(const bf16_t*)(a.ws + WS_XN), (const bf16_t*)(a.ws + WS_WIN), ROWS_A, LDP, D, D, D}; pg8::StaticOrder S; S.init(ROWS_A, LDP, F.G, (int)blockIdx.x); pg8::EpiPanels E{PROJ}; GEMM_CALL(pg8::EpiPanels); }
#define GEMM_P5 { pg8::Gemm g{PROJ + ZS_OFF, (const bf16_t*)(a.ws + WS_WOUT), TR, D, D_MIX, P_ZS, D_MIX}; pg8::StaticOrder S; S.init(TR, D, F.G, (int)blockIdx.x); pg8::EpiResBf16 E{a.x, (bf16_t*)(a.ws + WS_XN), D}; GEMM_CALL(pg8::EpiResBf16); }
#define GEMM_P7 { pg8::Gemm g{(const bf16_t*)(a.ws + WS_XN), (const bf16_t*)(a.ws + WS_WQ), TR, PQ, D, D, D}; pg8::StaticOrder S; S.init(TR, PQ, F.G, (int)blockIdx.x); pg8::EpiBf16 E{(bf16_t*)(a.ws + WS_Q), PQ}; GEMM_CALL(pg8::EpiBf16); }
    if (IN(0)) { p0_prologue(F, a); } SEAM(0);
    if (IN(1)) { GEMM_P1 } SEAM(1);
    if (IN(2)) { p2_ssd_states(F, a); } SEAM(2);
    if (IN(3)) { p3_ssd_recur(F, a); } SEAM(3);
    if (IN(4)) { p4_ssd_out(F, a); } SEAM(4);
    if (IN(5)) { GEMM_P5 } SEAM(5);
    if (IN(6)) { p6_tables_rstd(F, a); } SEAM(6);
    if (IN(7)) { GEMM_P7 } SEAM(7);
    if (IN(8)) { p8_topk_mfma(F, a); } SEAM(8);
    if (IN(9)) { p9_peer_hybrid(F, a, a.out); }
#undef IN
#undef SEAM
}

extern "C" void kernel_launch(void* const* d_in, const int* in_sizes, int n_in, void* d_out, int out_size, void* d_ws, size_t ws_size, hipStream_t stream) {
    static int grid = 0;
    if (grid == 0) {
        if (n_in != 18 || out_size != TR * D || ws_size < WS_END) { fprintf(stderr, "kernel_launch: unexpected problem (n_in %d out %d ws %zu)\n", n_in, out_size, ws_size); grid = -1; return; }
        int dev = 0, cus = 0, per_cu = 0;
        if (hipGetDevice(&dev) != hipSuccess || hipDeviceGetAttribute(&cus, hipDeviceAttributeMultiprocessorCount, dev) != hipSuccess) { grid = -1; return; }
        if (hipFuncSetAttribute((const void*)fwd, hipFuncAttributeMaxDynamicSharedMemorySize, LDS_BYTES) != hipSuccess) { fprintf(stderr, "kernel_launch: hipFuncSetAttribute failed\n"); grid = -1; return; }
        if (hipOccupancyMaxActiveBlocksPerMultiprocessor(&per_cu, (const void*)fwd, NTHREADS, LDS_BYTES) != hipSuccess || per_cu < 1) fprintf(stderr, "kernel_launch: occupancy query says %d\n", per_cu);
        (void)hipGetLastError();
        grid = cus;
        if (grid * NWAVES * 16 != TR) { fprintf(stderr, "kernel_launch: built for 256 CUs (the expert phase deals 16 tokens to each of 2048 waves); this device has %d; nothing launched\n", cus); grid = -1; return; }
    }
    if (grid < 0) return;
    if (hipMemsetAsync((char*)d_ws + WS_CTL, 0, CTL_ZERO_BYTES, stream) != hipSuccess) return;
    Args a{};
    a.x = (const float*)d_in[0]; a.meta = (const float*)d_in[1]; a.g_mix = (const float*)d_in[2]; a.w_in = (const float*)d_in[3]; a.conv_ssd_w = (const float*)d_in[4]; a.conv_ssd_b = (const float*)d_in[5];
    a.dt_bias = (const float*)d_in[6]; a.a_log = (const float*)d_in[7]; a.d_skip = (const float*)d_in[8]; a.ssd_norm_w = (const float*)d_in[9]; a.conv_sc_w = (const float*)d_in[10]; a.w_out = (const float*)d_in[11];
    a.g_ffn = (const float*)d_in[12]; a.w_q = (const float*)d_in[13]; a.sub_keys = (const float*)d_in[14]; a.expert_u = (const float*)d_in[15]; a.expert_v = (const float*)d_in[16]; a.g_final = (const float*)d_in[17];
    a.out = (float*)d_out; a.ws = (unsigned char*)d_ws;
    if (N_LAUNCHES == 1) { a.ph_lo = 0; a.ph_hi = NPHASE; hipLaunchKernelGGL(fwd, dim3(grid), dim3(NTHREADS), LDS_BYTES, stream, a); }
    else for (int p = 0; p < NPHASE; ++p) { a.ph_lo = p; a.ph_hi = p + 1; hipLaunchKernelGGL(fwd, dim3(grid), dim3(NTHREADS), LDS_BYTES, stream, a); }
}
```

```cpp
#include <hip/hip_runtime.h>
#include <cstdio>
#include <cstdint>

#define GAS __attribute__((address_space(1)))
#define LAS __attribute__((address_space(3)))
typedef unsigned short bf16_t;
typedef short bf16x8 __attribute__((ext_vector_type(8)));
typedef float f32x4 __attribute__((ext_vector_type(4)));
typedef float f32x2 __attribute__((ext_vector_type(2)));
typedef unsigned u32x4 __attribute__((ext_vector_type(4)));
typedef unsigned u32x2 __attribute__((ext_vector_type(2)));

constexpr int D = 1024, BATCH = 16, SEQ = 2048, NMETA = 16, LSEQ = SEQ + NMETA;
constexpr int TR = BATCH * SEQ;
constexpr int ROWS_A = 33024;
constexpr int D_SSD = 1536, HEADS = 24, HD = 64, NG = 4, NS = 128, D_XBC = 2560, D_SC = 512, D_IN = 5656, D_MIX = 2048;
constexpr int LDP = 5888;
constexpr int C_Z = 0, C_SCB = 1536, C_XBC = 2048, C_SCC = 4608, C_SCX = 5120, C_DT = 5632;
constexpr int P_ZS = 2048, P_XG = 640, P_SC = 1024, P_DT = 32;
constexpr size_t ZS_OFF = 0, XG_OFF = (size_t)ROWS_A * P_ZS, XG_STRIDE = (size_t)ROWS_A * P_XG, SC_OFF = XG_OFF + 4 * XG_STRIDE, DT_OFF = SC_OFF + (size_t)ROWS_A * P_SC, PANELS_END = DT_OFF + (size_t)ROWS_A * P_DT;
static_assert(PANELS_END <= (size_t)ROWS_A * LDP, "panels fit the PROJ region");
__host__ __device__ __forceinline__ size_t proj_dst(int j, int& pitch) {
    if (j < 2048) { pitch = P_ZS; return ZS_OFF + j; }
    if (j < 4608) { const int ch = j - 2048; pitch = P_XG;
        if (ch < 1536) { const int g = ch / 384; return XG_OFF + g * XG_STRIDE + (ch - 384 * g); }
        if (ch < 2048) { const int r = ch - 1536; return XG_OFF + (r >> 7) * XG_STRIDE + 384 + (r & 127); }
        const int r = ch - 2048; return XG_OFF + (r >> 7) * XG_STRIDE + 512 + (r & 127); }
    if (j < 5632) { pitch = P_SC; return SC_OFF + (j - 4608); }
    if (j < 5664) { pitch = P_DT; return DT_OFF + (j - 5632); }
    pitch = 0; return 0;
}
constexpr int PH = 8, PK = 128, PTOP = 16, PQ = 2048;
constexpr float EPS = 1e-6f;

__host__ __device__ constexpr int proj_src_col(int j) {
    return j < 1536 ? j : j < 2048 ? 4120 + (j - 1536) : j < 4608 ? 1536 + (j - 2048) : j < 5120 ? 4632 + (j - 4608) : j < 5632 ? 5144 + (j - 5120) : j < 5656 ? 4096 + (j - 5632) : -1;
}

constexpr size_t MiB = 1u << 20;
constexpr size_t WS_CTL = 0, CTL_ZERO_BYTES = 1 * MiB;
constexpr size_t WS_WIN = 1 * MiB;
constexpr size_t WS_WOUT = 13 * MiB;
constexpr size_t WS_WQ = 17 * MiB;
constexpr size_t WS_XN = 22 * MiB;
constexpr size_t WS_PROJ = 88 * MiB;
constexpr size_t WS_Q = WS_PROJ;
constexpr size_t WS_EIDX = WS_PROJ + 128 * MiB;
constexpr size_t WS_GATE = WS_PROJ + 144 * MiB;
constexpr size_t WS_UB = WS_PROJ + 160 * MiB;
constexpr size_t WS_V8 = WS_PROJ + 192 * MiB;
constexpr size_t WS_SV = WS_PROJ + 224 * MiB + 65536;
constexpr size_t WS_RSTD = WS_PROJ + 225 * MiB;
constexpr size_t WS_END = WS_PROJ + (size_t)ROWS_A * LDP * 2;
static_assert(WS_RSTD + (1u << 20) <= WS_END, "ws map");
static_assert(WS_XN + (size_t)ROWS_A * D * 2 <= WS_PROJ, "ws map");
static_assert(WS_END <= 512 * MiB, "ws map");

typedef __bf16 bf16x2h_t __attribute__((ext_vector_type(2)));
__device__ __forceinline__ unsigned f2bf(float f) { return (unsigned)__builtin_bit_cast(unsigned short, (__bf16)f); }
__device__ __forceinline__ unsigned pk2(float lo, float hi) { bf16x2h_t v; v.x = (__bf16)lo; v.y = (__bf16)hi; return __builtin_bit_cast(unsigned, v); }
__device__ __forceinline__ float bf2f(unsigned short b) { return __builtin_bit_cast(float, ((unsigned)b) << 16); }
__device__ __forceinline__ float bflo(unsigned w) { return __builtin_bit_cast(float, w << 16); }
__device__ __forceinline__ float bfhi(unsigned w) { return __builtin_bit_cast(float, w & 0xffff0000u); }
template <int CTRL> __device__ __forceinline__ float dppf0(float x) { return __builtin_bit_cast(float, __builtin_amdgcn_update_dpp(0, __builtin_bit_cast(int, x), CTRL, 0xF, 0xF, true)); }
__device__ __forceinline__ void swap32_self(unsigned u, unsigned& lo_lo, unsigned& hi_hi) { unsigned u2 = u; asm volatile("" : "+v"(u2)); auto r = __builtin_amdgcn_permlane32_swap(u, u2, false, false); lo_lo = r[0]; hi_hi = r[1]; }
__device__ __forceinline__ void swap16_self(unsigned u, unsigned& even2, unsigned& odd2) { unsigned u2 = u; asm volatile("" : "+v"(u2)); auto r = __builtin_amdgcn_permlane16_swap(u, u2, false, false); even2 = r[0]; odd2 = r[1]; }
__device__ __forceinline__ float wave_sum(float v) {
    v += dppf0<0xB1>(v); v += dppf0<0x4E>(v); v += dppf0<0x141>(v); v += dppf0<0x140>(v);
    unsigned p, q; swap16_self(__builtin_bit_cast(unsigned, v), p, q); v = __builtin_bit_cast(float, p) + __builtin_bit_cast(float, q);
    swap32_self(__builtin_bit_cast(unsigned, v), p, q); v = __builtin_bit_cast(float, p) + __builtin_bit_cast(float, q);
    return v;
}
__device__ __forceinline__ float row_sum16(float x) { x += dppf0<0xB1>(x); x += dppf0<0x4E>(x); x += dppf0<0x141>(x); x += dppf0<0x140>(x); return x; }
__device__ __forceinline__ int row_of(int b, int pos) { return pos < NMETA ? TR + pos : b * SEQ + (pos - NMETA); }

namespace pg8 {
#define PG8_LAS __attribute__((address_space(3)))
constexpr int BM = 256, BK = 64, HALF = 128, HTB = HALF * BK * 2  , STAGE_BYTES = 8 * HTB, NXCD = 8, WGM = 8;
__host__ __device__ __forceinline__ int perm32(int rho) { const int n = rho >> 4, i = rho & 15; return 8 * (i >> 2) + 4 * n + (i & 3); }
__host__ __device__ __forceinline__ int lds_byte(int r, int c) { const int st = (r >> 4) * 2 + (c >> 5), rr = r & 15, cc = c & 31, ob = rr * 64 + cc * 2; return st * 1024 + (ob ^ (((ob >> 9) & 1) << 5)); }
__host__ __device__ __forceinline__ void stage_rc(int b, int& R, int& C) { const int st = b / 1024, sb = b % 1024, swz = sb ^ (((sb >> 9) & 1) << 5); R = (st >> 1) * 16 + swz / 64; C = (st & 1) * 32 + (swz % 64) / 2; }
struct Unit { int pm, pn; };
struct Gemm { const bf16_t* A; const bf16_t* Bt; int M, N, K, lda, ldb; };
struct StaticOrder {
    int nM, nN, nwg, G, c;
    __host__ __device__ void init(int M, int N, int G_, int c_) { nM = M / BM; nN = N / BM; nwg = nM * nN; G = G_; c = c_; }
    __host__ __device__ bool next(int i, Unit& u) const {
        const long L = (long)i * G + c; if (L >= nwg) return false;
        int wgid = (int)L; { const int q = nwg / NXCD, r = nwg % NXCD, xcd = wgid % NXCD, off = wgid / NXCD; wgid = (xcd < r ? xcd * (q + 1) : r * (q + 1) + (xcd - r) * q) + off; }
        const int nig = WGM * nN, gid = wgid / nig, fm = gid * WGM, gsz = (nM - fm) < WGM ? (nM - fm) : WGM;
        u.pm = fm + ((wgid % nig) % gsz); u.pn = (wgid % nig) / gsz; return true;
    }
    __device__ __forceinline__ void a_ready(const Unit&) const {}
    __device__ __forceinline__ void done(const Unit&) const {}
};
struct EpiBf16 {
    static constexpr bool PERM = true, AFTER_DRAIN = false;
    bf16_t* O; int ldc;
    __device__ __forceinline__ void operator()(const f32x4 (&acc)[2][2][4][2], const Unit& u, int wr, int wc, int fr, int fq) const {
        const int row0 = u.pm * BM + wr * 64 + fr, col0 = u.pn * BM + wc * 32 + 8 * fq;
#pragma unroll
        for (int ai = 0; ai < 2; ++ai)
#pragma unroll
            for (int m = 0; m < 4; ++m) { bf16_t* rowp = O + (size_t)(row0 + ai * HALF + m * 16) * ldc + col0;
#pragma unroll
                for (int bj = 0; bj < 2; ++bj) { const f32x4 v0 = acc[ai][bj][m][0], v1 = acc[ai][bj][m][1];
                    u32x4 w; w.x = pk2(v0[0], v0[1]); w.y = pk2(v0[2], v0[3]); w.z = pk2(v1[0], v1[1]); w.w = pk2(v1[2], v1[3]);
                    *(u32x4*)(rowp + bj * HALF) = w; } }
    }
};
struct EpiPanels {
    static constexpr bool PERM = true, AFTER_DRAIN = false;
    bf16_t* P;
    __device__ __forceinline__ void operator()(const f32x4 (&acc)[2][2][4][2], const Unit& u, int wr, int wc, int fr, int fq) const {
        const int row0 = u.pm * BM + wr * 64 + fr, col0 = u.pn * BM + wc * 32 + 8 * fq;
#pragma unroll
        for (int bj = 0; bj < 2; ++bj) { int pitch; const size_t off = proj_dst(col0 + bj * HALF, pitch); if (pitch == 0) continue;
#pragma unroll
            for (int ai = 0; ai < 2; ++ai)
#pragma unroll
                for (int m = 0; m < 4; ++m) { const f32x4 v0 = acc[ai][bj][m][0], v1 = acc[ai][bj][m][1];
                    u32x4 w; w.x = pk2(v0[0], v0[1]); w.y = pk2(v0[2], v0[3]); w.z = pk2(v1[0], v1[1]); w.w = pk2(v1[2], v1[3]);
                    *(u32x4*)(P + off + (size_t)(row0 + ai * HALF + m * 16) * pitch) = w; } }
    }
};
struct EpiResBf16 {
    static constexpr bool PERM = true, AFTER_DRAIN = false;
    const float* base; bf16_t* O; int ldc;
    __device__ __forceinline__ void operator()(const f32x4 (&acc)[2][2][4][2], const Unit& u, int wr, int wc, int fr, int fq) const {
        const int row0 = u.pm * BM + wr * 64 + fr, col0 = u.pn * BM + wc * 32 + 8 * fq;
#pragma unroll
        for (int ai = 0; ai < 2; ++ai)
#pragma unroll
            for (int m = 0; m < 4; ++m) { const size_t off = (size_t)(row0 + ai * HALF + m * 16) * ldc + col0;
#pragma unroll
                for (int bj = 0; bj < 2; ++bj) { const f32x4 b0 = *(const f32x4*)(base + off + bj * HALF), b1 = *(const f32x4*)(base + off + bj * HALF + 4);
                    const f32x4 v0 = acc[ai][bj][m][0] + b0, v1 = acc[ai][bj][m][1] + b1;
                    u32x4 w; w.x = pk2(v0[0], v0[1]); w.y = pk2(v0[2], v0[3]); w.z = pk2(v1[0], v1[1]); w.w = pk2(v1[2], v1[3]);
                    *(u32x4*)(O + off + bj * HALF) = w; } }
    }
};
template <class Epi, class Sched, bool ALIGN_EPI = false, bool SP2 = false>
__device__ __forceinline__ void gemm_phase(PG8_LAS unsigned char* lds, const Gemm g, const Sched& S, const Epi& E) {
    const int tid = threadIdx.x, wid = __builtin_amdgcn_readfirstlane(tid >> 6), lane = tid & 63, wr = wid >> 2, wc = wid & 3, fr = lane & 15, fq = lane >> 4;
    const int K = g.K, nt = K / BK;
    unsigned voffA[2], voffB[2];
#pragma unroll
    for (int i = 0; i < 2; ++i) { int R, C; stage_rc(tid * 16 + i * 8192, R, C); const int Rb = Epi::PERM ? ((R & ~31) + perm32(R & 31)) : R;
        voffA[i] = (unsigned)(R * g.lda + C) * 2u; voffB[i] = (unsigned)(Rb * g.ldb + C) * 2u; }
    const size_t kstep = (size_t)(BK * 2);
    const size_t hstepA = (size_t)HALF * g.lda * 2, hstepB = (size_t)HALF * g.ldb * 2;
    const size_t tstepA = 2 * hstepA, tstepB = 2 * hstepB;
    const unsigned ldsw = (unsigned)wid * 1024u;
    const int aoff = lds_byte(wr * 64 + fr, fq * 8), boff = lds_byte(wc * 32 + fr, fq * 8);
#define PG8_SA(b, h) (((b) * 2 + (h)) * HTB)
#define PG8_SB(b, h) ((4 + (b) * 2 + (h)) * HTB)
#define PG8_STAGE(bufoff, gbase, voff) do { _Pragma("unroll") for (int _i = 0; _i < 2; ++_i) \
        __builtin_amdgcn_global_load_lds((const unsigned*)((const char*)(gbase) + (voff)[_i]), (PG8_LAS unsigned*)(lds + (bufoff) + ldsw + _i * 8192), 16, 0, 0); } while (0)
#define PG8_LDA(dst, b, h) do { _Pragma("unroll") for (int m = 0; m < 4; ++m) _Pragma("unroll") for (int k = 0; k < 2; ++k) dst[m][k] = *(const PG8_LAS bf16x8*)(lds + PG8_SA(b, h) + aoff + m * 2048 + k * 1024); } while (0)
#define PG8_LDB(dst, b, h) do { _Pragma("unroll") for (int n = 0; n < 2; ++n) _Pragma("unroll") for (int k = 0; k < 2; ++k) dst[n][k] = *(const PG8_LAS bf16x8*)(lds + PG8_SB(b, h) + boff + n * 2048 + k * 1024); } while (0)
#define PG8_MMA(ai, bj, At, Bt) do { __builtin_amdgcn_s_setprio(1); _Pragma("unroll") for (int m = 0; m < 4; ++m) _Pragma("unroll") for (int n = 0; n < 2; ++n) _Pragma("unroll") for (int k = 0; k < 2; ++k) \
        acc[ai][bj][m][n] = __builtin_amdgcn_mfma_f32_16x16x32_bf16(Bt[n][k], At[m][k], acc[ai][bj][m][n], 0, 0, 0); __builtin_amdgcn_s_setprio(0); } while (0)
#define PG8_WAIT_V(n) asm volatile("s_waitcnt vmcnt(" #n ")" ::: "memory")
#define PG8_WAIT_L(n) asm volatile("s_waitcnt lgkmcnt(" #n ")" ::: "memory")
#define PG8_BAR __builtin_amdgcn_s_barrier()
#define PG8_SCHED __builtin_amdgcn_sched_barrier(0)
    Unit cur, nxt; int ui = 0;
    if (!S.next(0, cur)) return;
    f32x4 acc[2][2][4][2];
#pragma unroll
    for (int a = 0; a < 2; ++a)
#pragma unroll
        for (int b = 0; b < 2; ++b)
#pragma unroll
            for (int m = 0; m < 4; ++m)
#pragma unroll
                for (int n = 0; n < 2; ++n) acc[a][b][m][n] = (f32x4){0.f, 0.f, 0.f, 0.f};
    bf16x8 At[4][2], B0[2][2], B1[2][2];
    const char* cA = (const char*)g.A + (size_t)cur.pm * tstepA; const char* cB = (const char*)g.Bt + (size_t)cur.pn * tstepB;
    S.a_ready(cur);
    if constexpr (SP2) {
        PG8_STAGE(PG8_SB(0, 0), cB, voffB); PG8_STAGE(PG8_SB(0, 1), cB + hstepB, voffB); PG8_STAGE(PG8_SA(0, 0), cA, voffA); PG8_STAGE(PG8_SA(0, 1), cA + hstepA, voffA);
        if (wr == 1) PG8_BAR;
        PG8_WAIT_V(2); PG8_BAR;
        PG8_STAGE(PG8_SB(1, 0), cB + kstep, voffB); PG8_STAGE(PG8_SA(1, 0), cA + kstep, voffA); PG8_STAGE(PG8_SB(1, 1), cB + hstepB + kstep, voffB);
        PG8_WAIT_V(6); PG8_BAR;
    } else {
        PG8_STAGE(PG8_SB(0, 0), cB, voffB); PG8_STAGE(PG8_SA(0, 0), cA, voffA); PG8_STAGE(PG8_SB(0, 1), cB + hstepB, voffB); PG8_STAGE(PG8_SA(0, 1), cA + hstepA, voffA);
        if (wr == 1) PG8_BAR;
        PG8_WAIT_V(4); PG8_BAR;
        PG8_STAGE(PG8_SB(1, 0), cB + kstep, voffB); PG8_STAGE(PG8_SA(1, 0), cA + kstep, voffA); PG8_STAGE(PG8_SB(1, 1), cB + hstepB + kstep, voffB);
        PG8_WAIT_V(6); PG8_BAR;
    }
    for (;;) {
        const bool has_next = S.next(ui + 1, nxt);
        const char* nA = has_next ? (const char*)g.A + (size_t)nxt.pm * tstepA : cA; const char* nB = has_next ? (const char*)g.Bt + (size_t)nxt.pn * tstepB : cB;
        for (int t = 0; t < nt; t += 2) {
            const bool last = (t == nt - 2);
            const char* a1 = cA + (size_t)(t + 1) * kstep;
            const char* a2 = last ? nA : cA + (size_t)(t + 2) * kstep; const char* b2 = last ? nB : cB + (size_t)(t + 2) * kstep;
            const char* a3 = a2 + kstep; const char* b3 = b2 + kstep;
            if (last && has_next) S.a_ready(nxt);
            if constexpr (SP2) {
            PG8_LDB(B0, 0, 0); PG8_LDB(B1, 0, 1); PG8_SCHED; PG8_LDA(At, 0, 0); PG8_STAGE(PG8_SA(1, 1), a1 + hstepA, voffA);
            PG8_WAIT_V(8); PG8_WAIT_L(0); PG8_BAR; PG8_MMA(0, 0, At, B0); PG8_MMA(0, 1, At, B1); PG8_BAR; PG8_SCHED;
            PG8_LDA(At, 0, 1); PG8_STAGE(PG8_SB(0, 0), b2, voffB); PG8_STAGE(PG8_SB(0, 1), b2 + hstepB, voffB); PG8_STAGE(PG8_SA(0, 0), a2, voffA);
            PG8_WAIT_V(8); PG8_WAIT_L(0); PG8_BAR; PG8_MMA(1, 0, At, B0); PG8_MMA(1, 1, At, B1); PG8_BAR; PG8_SCHED;
            PG8_LDB(B0, 1, 0); PG8_LDB(B1, 1, 1); PG8_SCHED; PG8_LDA(At, 1, 0); PG8_STAGE(PG8_SA(0, 1), a2 + hstepA, voffA);
            PG8_WAIT_V(8); PG8_WAIT_L(0); PG8_BAR; PG8_MMA(0, 0, At, B0); PG8_MMA(0, 1, At, B1); PG8_BAR; PG8_SCHED;
            PG8_LDA(At, 1, 1); PG8_STAGE(PG8_SB(1, 0), b3, voffB); PG8_STAGE(PG8_SB(1, 1), b3 + hstepB, voffB); PG8_STAGE(PG8_SA(1, 0), a3, voffA);
            PG8_WAIT_V(8); PG8_WAIT_L(0); PG8_BAR; PG8_MMA(1, 0, At, B0); PG8_MMA(1, 1, At, B1); PG8_BAR; PG8_SCHED;
            } else {
            PG8_LDB(B0, 0, 0); PG8_SCHED; PG8_LDA(At, 0, 0); PG8_STAGE(PG8_SA(1, 1), a1 + hstepA, voffA);
            PG8_WAIT_L(8); PG8_BAR; PG8_WAIT_L(0); PG8_MMA(0, 0, At, B0); PG8_BAR; PG8_SCHED;
            PG8_LDB(B1, 0, 1); PG8_STAGE(PG8_SB(0, 0), b2, voffB);
            PG8_BAR; PG8_WAIT_L(0); PG8_MMA(0, 1, At, B1); PG8_BAR;
            PG8_LDA(At, 0, 1); PG8_STAGE(PG8_SA(0, 0), a2, voffA);
            PG8_BAR; PG8_WAIT_L(0); PG8_MMA(1, 0, At, B0); PG8_BAR; PG8_SCHED;
            PG8_STAGE(PG8_SB(0, 1), b2 + hstepB, voffB);
            PG8_WAIT_V(6); PG8_BAR; PG8_MMA(1, 1, At, B1); PG8_BAR;
            PG8_LDB(B0, 1, 0); PG8_SCHED; PG8_LDA(At, 1, 0); PG8_STAGE(PG8_SA(0, 1), a2 + hstepA, voffA);
            PG8_WAIT_L(8); PG8_BAR; PG8_WAIT_L(0); PG8_MMA(0, 0, At, B0); PG8_BAR; PG8_SCHED;
            PG8_LDB(B1, 1, 1); PG8_STAGE(PG8_SB(1, 0), b3, voffB);
            PG8_BAR; PG8_WAIT_L(0); PG8_MMA(0, 1, At, B1); PG8_BAR;
            PG8_LDA(At, 1, 1); PG8_STAGE(PG8_SA(1, 0), a3, voffA);
            PG8_BAR; PG8_WAIT_L(0); PG8_MMA(1, 0, At, B0); PG8_BAR; PG8_SCHED;
            PG8_STAGE(PG8_SB(1, 1), b3 + hstepB, voffB);
            PG8_WAIT_V(6); PG8_BAR; PG8_MMA(1, 1, At, B1); PG8_BAR;
            }
        }
        if constexpr (ALIGN_EPI) { if (wr == 0) PG8_BAR; }
        if constexpr (!Epi::AFTER_DRAIN) { E(acc, cur, wr, wc, fr, fq); S.done(cur); }
        if (!has_next) break;
#pragma unroll
        for (int a = 0; a < 2; ++a)
#pragma unroll
            for (int b = 0; b < 2; ++b)
#pragma unroll
                for (int m = 0; m < 4; ++m)
#pragma unroll
                    for (int n = 0; n < 2; ++n) acc[a][b][m][n] = (f32x4){0.f, 0.f, 0.f, 0.f};
        cur = nxt; cA = nA; cB = nB; ++ui;
        if constexpr (ALIGN_EPI) { if (wr == 1) PG8_BAR; }
    }
    PG8_WAIT_V(0);
    if constexpr (!ALIGN_EPI) { if (wr == 0) PG8_BAR; }
    PG8_BAR;
    if constexpr (Epi::AFTER_DRAIN) { E.fused(acc, cur, wr, wc, fr, fq, lds, wid, lane); S.done(cur); }
#undef PG8_SA
#undef PG8_SB
#undef PG8_STAGE
#undef PG8_LDA
#undef PG8_LDB
#undef PG8_MMA
#undef PG8_WAIT_V
#undef PG8_WAIT_L
#undef PG8_BAR
#undef PG8_SCHED
}

}

#define XB_TMO      128
#define XB_XCNT(j)  (256  + 64 * (j))
#define XB_XSUB(j)  (1280 + 64 * (j))
#define XB_XGEN(j)  (2304 + 64 * (j))
#define XB_TOP      3328
#define XB_TOPGEN   3392
#define XCD_BAR_WORDS 3456
#define XB_SPIN_CAP (1u << 18)
__device__ __forceinline__ unsigned xb_ld(unsigned* p)              { return __hip_atomic_load(p, __ATOMIC_RELAXED, __HIP_MEMORY_SCOPE_AGENT); }
__device__ __forceinline__ unsigned xb_add(unsigned* p, unsigned v) { return __hip_atomic_fetch_add(p, v, __ATOMIC_RELAXED, __HIP_MEMORY_SCOPE_AGENT); }
__device__ __forceinline__ unsigned xb_xcc_id() { return (unsigned)__builtin_amdgcn_s_getreg((3 << 11) | 20) & 0xFu; }
#define XB_SPIN(cond, bar) do { unsigned _sp = 0; while (cond) { __builtin_amdgcn_s_sleep(1); \
    if ((++_sp & 255u) == 0u) { if (xb_ld(&(bar)[XB_TMO])) break; if (_sp > XB_SPIN_CAP) { atomicAdd(&(bar)[XB_TMO], 1u); break; } } } } while (0)
struct XcdBarrier { unsigned* bar; unsigned x; volatile LAS unsigned* st; };
__device__ __forceinline__ XcdBarrier xcd_barrier_post(unsigned* bar, volatile LAS unsigned* st) {
    XcdBarrier b; b.bar = bar; b.x = xb_xcc_id(); b.st = st;
    if (threadIdx.x == 0) (void)xb_add(&bar[XB_XCNT(b.x)], 1u);
    return b;
}
__device__ __forceinline__ void xcd_barrier_complete(unsigned* bar, unsigned x, unsigned& nloc, unsigned& nx) {
    const unsigned G = gridDim.x * gridDim.y * gridDim.z;
    unsigned sum, cnt, mine, sp = 0u;
    for (;;) {
        sum = 0u; cnt = 0u; mine = 0u;
#pragma unroll
        for (unsigned j = 0; j < 16; ++j) { const unsigned c = xb_ld(&bar[XB_XCNT(j)]); sum += c; cnt += (c > 0u) ? 1u : 0u; mine = (j == x) ? c : mine; }
        if (sum == G) break;
        __builtin_amdgcn_s_sleep(1);
        if ((++sp & 255u) == 0u) { if (xb_ld(&bar[XB_TMO])) break; if (sp > XB_SPIN_CAP) { atomicAdd(&bar[XB_TMO], 1u); break; } }
    }
    nloc = mine > 0u ? mine : 1u; nx = cnt > 0u ? cnt : 1u;
}
__device__ __forceinline__ void xcd_barrier(const XcdBarrier& b) {
    asm volatile("s_waitcnt vmcnt(0)" ::: "memory");
    __syncthreads();
    if (threadIdx.x == 0) {
        unsigned* bar = b.bar;
        __builtin_amdgcn_s_waitcnt(0);
        unsigned nloc = b.st[0], nx = b.st[1];
        if (nloc == 0u) { xcd_barrier_complete(bar, b.x, nloc, nx); b.st[0] = nloc; b.st[1] = nx; }
        const unsigned old = xb_add(&bar[XB_XSUB(b.x)], 1u);
        const unsigned gen = old / nloc;
        if (old + 1u == (gen + 1u) * nloc) {
            __builtin_amdgcn_fence(__ATOMIC_RELEASE, "agent");
            asm volatile("s_waitcnt vmcnt(0)" ::: "memory");
            const unsigned og = xb_add(&bar[XB_TOP], 1u);
            const unsigned tg = og / nx;
            if (og + 1u == (tg + 1u) * nx) xb_add(&bar[XB_TOPGEN], 1u);
            else XB_SPIN(xb_ld(&bar[XB_TOPGEN]) == tg, bar);
            __builtin_amdgcn_fence(__ATOMIC_ACQUIRE, "agent");
            xb_add(&bar[XB_XGEN(b.x)], 1u);
            asm volatile("s_waitcnt vmcnt(0)" ::: "memory");
        } else {
            XB_SPIN(xb_ld(&bar[XB_XGEN(b.x)]) == gen, bar);
            __builtin_amdgcn_fence(__ATOMIC_ACQUIRE, "agent");
            asm volatile("s_waitcnt vmcnt(0)" ::: "memory");
        }
    }
    __syncthreads();
}

constexpr int NWAVES = 8, NTHREADS = 512;
constexpr int NPHASE = 10;
#ifndef MK_N_LAUNCHES
#define MK_N_LAUNCHES 1
#endif
constexpr int N_LAUNCHES = MK_N_LAUNCHES;
constexpr int RING_BYTES = 131072, LDS_BYTES = 163840, LDSCTL_OFF = LDS_BYTES - 256;
constexpr int CW_BAR = 4096;

struct Args {
    const float *x, *meta, *g_mix, *w_in, *conv_ssd_w, *conv_ssd_b, *dt_bias, *a_log, *d_skip, *ssd_norm_w, *conv_sc_w, *w_out, *g_ffn, *w_q, *sub_keys, *expert_u, *expert_v, *g_final;
    float* out; unsigned char* ws; int ph_lo, ph_hi;
};
struct Frame { LAS unsigned char* lds; int tid, lane, wave, G, vcu; };

template <class ColMap>
__device__ __forceinline__ void p0_transpose_item(const float* W, int K, int N, bf16_t* WT, int nblk, LAS float* scr, int item, int lane, ColMap cm, const float* kscale = nullptr) {
    const int kb = item / nblk, nb = item % nblk, k0 = 64 * kb, n0 = 32 * nb;
    const int sc = cm(n0 + (lane & 31));
#pragma unroll 8
    for (int i = 0; i < 32; ++i) { const int kk = 2 * i + (lane >> 5); scr[kk * 33 + (lane & 31)] = sc >= 0 ? W[(size_t)(k0 + kk) * N + sc] * (kscale ? kscale[k0 + kk] : 1.f) : 0.f; }
    asm volatile("s_waitcnt lgkmcnt(0)" ::: "memory");
    const int c = lane & 7;
#pragma unroll
    for (int j = 0; j < 4; ++j) { const int n = (lane >> 3) + 8 * j; const LAS float* s = scr + (8 * c) * 33 + n;
        u32x4 o; o.x = pk2(s[0 * 33], s[1 * 33]); o.y = pk2(s[2 * 33], s[3 * 33]); o.z = pk2(s[4 * 33], s[5 * 33]); o.w = pk2(s[6 * 33], s[7 * 33]);
        *(u32x4*)(WT + (size_t)(n0 + n) * K + k0 + 8 * c) = o; }
    asm volatile("s_waitcnt lgkmcnt(0)" ::: "memory");
}
__device__ __forceinline__ void p0_prologue(const Frame& F, const Args& a) {
    LAS float* scr = (LAS float*)(F.lds + F.wave * 16384);
    const int gw = F.vcu * NWAVES + F.wave, NGW = F.G * NWAVES;
    bf16_t* WinT = (bf16_t*)(a.ws + WS_WIN); bf16_t* WoutT = (bf16_t*)(a.ws + WS_WOUT); bf16_t* WqT = (bf16_t*)(a.ws + WS_WQ); bf16_t* XN = (bf16_t*)(a.ws + WS_XN);
    constexpr int I_IN = (D / 64) * (LDP / 32), I_OUT = (D_MIX / 64) * (D / 32), I_Q = (D / 64) * (PQ / 32);
    for (int it = gw; it < I_IN + I_OUT + I_Q; it += NGW) {
        int r = it;
        if (r < I_IN) { p0_transpose_item(a.w_in, D, D_IN, WinT, LDP / 32, scr, r, F.lane, [](int j) { return proj_src_col(j); }); continue; } r -= I_IN;
        if (r < I_OUT) { p0_transpose_item(a.w_out, D_MIX, D, WoutT, D / 32, scr, r, F.lane, [](int j) { return j; }); continue; } r -= I_OUT;
        p0_transpose_item(a.w_q, D, PQ, WqT, PQ / 32, scr, r, F.lane, [](int j) { return j; }, a.g_ffn);
    }
    for (int m = gw; m < ROWS_A; m += NGW) {
        u32x2* o8 = (u32x2*)(XN + (size_t)m * D) + F.lane;
        if (m >= TR + NMETA) {
#pragma unroll
            for (int j = 0; j < 4; ++j) o8[64 * j] = (u32x2){0u, 0u};
            continue; }
        const float* src = m < TR ? a.x + (size_t)m * D : a.meta + (size_t)(m - TR) * D;
        const f32x4* xr = (const f32x4*)src + F.lane; const f32x4* gr = (const f32x4*)a.g_mix + F.lane;
        f32x4 v[4]; float s = 0.f;
#pragma unroll
        for (int j = 0; j < 4; ++j) { v[j] = xr[64 * j]; s += (v[j].x * v[j].x + v[j].y * v[j].y) + (v[j].z * v[j].z + v[j].w * v[j].w); }
        const float rstd = 1.0f / sqrtf(wave_sum(s) * (1.f / D) + EPS);
#pragma unroll
        for (int j = 0; j < 4; ++j) { const f32x4 gg = gr[64 * j]; o8[64 * j] = (u32x2){pk2(v[j].x * rstd * gg.x, v[j].y * rstd * gg.y), pk2(v[j].z * rstd * gg.z, v[j].w * rstd * gg.w)}; }
    }
}

typedef float f32x16 __attribute__((ext_vector_type(16)));
constexpr int PITCH = 136;
constexpr int SL_C = 0, SL_B = 34816, SL_M0 = 69632, SL_X = 104448, SL_DT = 139264, SL_ACS = 142336;
constexpr int YPITCH = 396;
static_assert(SL_B + 128 * YPITCH * 2 <= SL_DT, "staging fits below dt/acs");
constexpr size_t WS_DAT = WS_XN;
constexpr size_t WS_SMETA = WS_XN + 65536;

__device__ __forceinline__ f32x16 mfma32(bf16x8 a, bf16x8 b, f32x16 c) { return __builtin_amdgcn_mfma_f32_32x32x16_bf16(a, b, c, 0, 0, 0); }
__device__ __forceinline__ float silu_f(float v) { return v / (1.f + __expf(-v)); }

template <int NP> struct ConvW { u32x4 raw[NP + 3]; };
template <int NP> __device__ __forceinline__ void convw_load(ConvW<NP>& ci, const bf16_t* xgc  , int b, int pos0) {
#pragma unroll
    for (int i = 0; i < NP + 3; ++i) { const int pos = pos0 - 3 + i; u32x4 v = (u32x4){0u, 0u, 0u, 0u};
        if (pos >= 0) v = *(const u32x4*)(xgc + (size_t)row_of(b, pos) * P_XG);
        ci.raw[i] = v; }
}
struct ConvWt { f32x4 w[4][2], cb[2]; };
__device__ __forceinline__ void convw_weights(ConvWt& cw, const Args& a, int ch) {
    cw.cb[0] = *(const f32x4*)(a.conv_ssd_b + ch); cw.cb[1] = *(const f32x4*)(a.conv_ssd_b + ch + 4);
#pragma unroll
    for (int wi = 0; wi < 4; ++wi) { cw.w[wi][0] = *(const f32x4*)(a.conv_ssd_w + wi * D_XBC + ch); cw.w[wi][1] = *(const f32x4*)(a.conv_ssd_w + wi * D_XBC + ch + 4); }
}
__device__ __forceinline__ float bfel(const u32x4& v, int c) { const unsigned w = (c >> 1) == 0 ? v.x : (c >> 1) == 1 ? v.y : (c >> 1) == 2 ? v.z : v.w; return (c & 1) ? bfhi(w) : bflo(w); }
template <int NP> __device__ __forceinline__ void convw_pos(const ConvW<NP>& ci, const ConvWt& cw, int s, float (&o)[8]) {
#pragma unroll
    for (int c = 0; c < 8; ++c) { const int q = c >> 2, e = c & 3;
        o[c] = silu_f(cw.cb[q][e] + cw.w[0][q][e] * bfel(ci.raw[s], c) + cw.w[1][q][e] * bfel(ci.raw[s + 1], c) + cw.w[2][q][e] * bfel(ci.raw[s + 2], c) + cw.w[3][q][e] * bfel(ci.raw[s + 3], c)); }
}
__device__ __forceinline__ void ssd_dt_acs(const Frame& F_, const Args& a, const bf16_t* PROJ, int b, int p0, int g, float* dat  ) {
    const Frame& F0 = F_;
    if (F0.wave < 6) {
        int lane_ = F0.lane; asm volatile("" : "+v"(lane_));
        Frame Fl = F0; Fl.lane = lane_;
        const Frame& F = Fl;
        const int h = g * 6 + F.wave; const float A = -__expf(a.a_log[h]), dtb = a.dt_bias[h];
        LAS float* dtL = (LAS float*)(F.lds + SL_DT) + F.wave * 128; LAS float* acL = (LAS float*)(F.lds + SL_ACS) + F.wave * 128;
        float dv[2], av[2];
#pragma unroll
        for (int hf = 0; hf < 2; ++hf) { const int pos = p0 + F.lane + 64 * hf; float d = 0.f;
            if (pos >= 0) { const float v = bf2f(PROJ[DT_OFF + (size_t)row_of(b, pos) * P_DT + h]) + dtb, t = __expf(-fabsf(v));
                d = fmaxf(v, 0.f) + (t < 1e-3f ? t * (1.f - 0.5f * t) : __logf(1.f + t)); }
            dv[hf] = d; av[hf] = d * A; }
#pragma unroll
        for (int o = 1; o < 64; o <<= 1) { const float t0 = __shfl_up(av[0], o), t1 = __shfl_up(av[1], o); if (F.lane >= o) { av[0] += t0; av[1] += t1; } }
        av[1] += __shfl(av[0], 63);
        dtL[F.lane] = dv[0]; dtL[F.lane + 64] = dv[1]; acL[F.lane] = av[0]; acL[F.lane + 64] = av[1];
        if (dat && F.lane == 63) dat[h] = __expf(av[1]);
    }
}

__device__ __forceinline__ void ssd_s1_unit(const Frame& F, const Args& a, int b, int c, int g) {
    const bf16_t* PROJ = (const bf16_t*)(a.ws + WS_PROJ);
    const int p0 = c == 0 ? -112 : NMETA + 128 * (c - 1), lr = F.lane & 31, hf = F.lane >> 5;
    __syncthreads();
    ssd_dt_acs(F, a, PROJ, b, p0, g, (float*)(a.ws + WS_DAT) + (size_t)(b * 17 + c) * HEADS);
    if (F.tid < 256) { const int chg = F.tid & 15, sr = F.tid >> 4, ch = D_SSD + g * 128 + 8 * chg;
        ConvW<8> ci; convw_load<8>(ci, PROJ + XG_OFF + g * XG_STRIDE + 384 + 8 * chg, b, p0 + 8 * sr); ConvWt cw; convw_weights(cw, a, ch);
        unsigned pk[8][4];
#pragma unroll
        for (int s2 = 0; s2 < 4; ++s2) { float o0[8], o1[8]; convw_pos<8>(ci, cw, 2 * s2, o0); convw_pos<8>(ci, cw, 2 * s2 + 1, o1);
#pragma unroll
            for (int c = 0; c < 8; ++c) pk[c][s2] = pk2(o0[c], o1[c]); }
#pragma unroll
        for (int c = 0; c < 8; ++c) *(LAS u32x4*)(F.lds + SL_C + ((8 * chg + c) * PITCH + 8 * sr) * 2) = (u32x4){pk[c][0], pk[c][1], pk[c][2], pk[c][3]}; }
    __syncthreads();
    const bf16_t* xg1 = PROJ + XG_OFF + g * XG_STRIDE + 8 * (F.tid & 7);
    ConvW<2> cin; convw_load<2>(cin, xg1, b, p0 + 2 * (F.tid >> 3));
#pragma unroll 1
    for (int hh = 0; hh < 6; ++hh) {
        const int h = g * 6 + hh, buf = hh & 1;
        {
            const int chg = F.tid & 7, sp = F.tid >> 3, ch = h * 64 + 8 * chg;
            const ConvW<2> ci = cin; ConvWt cw; convw_weights(cw, a, ch);
            if (hh < 5) convw_load<2>(cin, xg1 + (hh + 1) * 64, b, p0 + 2 * sp);
            const LAS float* dtL = (const LAS float*)(F.lds + SL_DT) + hh * 128; const LAS float* acL = (const LAS float*)(F.lds + SL_ACS) + hh * 128;
            const float aend = acL[127], w0 = dtL[2 * sp] * __expf(aend - acL[2 * sp]), w1 = dtL[2 * sp + 1] * __expf(aend - acL[2 * sp + 1]);
            float o0[8], o1[8]; convw_pos<2>(ci, cw, 0, o0); convw_pos<2>(ci, cw, 1, o1);
#pragma unroll
            for (int c = 0; c < 8; ++c) *(LAS unsigned*)(F.lds + SL_X + buf * 17408 + ((8 * chg + c) * PITCH + 2 * sp) * 2) = pk2(o0[c] * w0, o1[c] * w1);
        }
        __syncthreads();
        const int pb = F.wave >> 2, nb = F.wave & 3;
        f32x16 acc;
#pragma unroll
        for (int r = 0; r < 16; ++r) acc[r] = 0.f;
#pragma unroll
        for (int ks = 0; ks < 8; ++ks) {
            const bf16x8 af = *(const LAS bf16x8*)(F.lds + SL_C + ((32 * nb + lr) * PITCH + 16 * ks + 8 * hf) * 2);
            const bf16x8 bf = *(const LAS bf16x8*)(F.lds + SL_X + buf * 17408 + ((32 * pb + lr) * PITCH + 16 * ks + 8 * hf) * 2);
            acc = mfma32(af, bf, acc);
        }
        bf16_t* dst = c == 0 ? (bf16_t*)(a.ws + WS_SMETA) + (size_t)h * 8192 : (bf16_t*)a.out + ((size_t)(b * 16 + (c - 1)) * HEADS + h) * 8192;
        u32x4* d4 = (u32x4*)(dst + ((size_t)(pb * 4 + nb) * 64 + F.lane) * 16);
        u32x4 w0, w1; w0.x = pk2(acc[0], acc[1]); w0.y = pk2(acc[2], acc[3]); w0.z = pk2(acc[4], acc[5]); w0.w = pk2(acc[6], acc[7]);
        w1.x = pk2(acc[8], acc[9]); w1.y = pk2(acc[10], acc[11]); w1.z = pk2(acc[12], acc[13]); w1.w = pk2(acc[14], acc[15]);
        d4[0] = w0; d4[1] = w1;
    }
}
__device__ __forceinline__ void short_conv_all(const Frame& F, const Args& a) {
    bf16_t* PROJ = (bf16_t*)(a.ws + WS_PROJ);
    const size_t gt = (size_t)F.vcu * NTHREADS + F.tid, NT = (size_t)F.G * NTHREADS;
    for (size_t it = gt; it < (size_t)TR * (D_SC / 8); it += NT) {
        const int r = (int)(it / (D_SC / 8)), c0 = (int)(it % (D_SC / 8)) * 8, b = r / SEQ, pos = r % SEQ + NMETA;
        float accv[8];
#pragma unroll
        for (int j = 0; j < 8; ++j) accv[j] = 0.f;
#pragma unroll
        for (int w = 0; w < 3; ++w) { const int rr = row_of(b, pos - 2 + w);
            const u32x4 cc = *(const u32x4*)(PROJ + SC_OFF + (size_t)rr * P_SC + c0), xx = *(const u32x4*)(PROJ + SC_OFF + (size_t)rr * P_SC + 512 + c0);
            const unsigned cw[4] = {cc.x, cc.y, cc.z, cc.w}, xw[4] = {xx.x, xx.y, xx.z, xx.w};
#pragma unroll
            for (int j = 0; j < 4; ++j) { accv[2 * j] += a.conv_sc_w[w * D_SC + c0 + 2 * j] * (bflo(cw[j]) * bflo(xw[j])); accv[2 * j + 1] += a.conv_sc_w[w * D_SC + c0 + 2 * j + 1] * (bfhi(cw[j]) * bfhi(xw[j])); } }
        const u32x4 bb = *(const u32x4*)(PROJ + ZS_OFF + (size_t)r * P_ZS + 1536 + c0); const unsigned bw[4] = {bb.x, bb.y, bb.z, bb.w};
        u32x4 o; unsigned ow[4];
#pragma unroll
        for (int j = 0; j < 4; ++j) ow[j] = pk2(bflo(bw[j]) * accv[2 * j], bfhi(bw[j]) * accv[2 * j + 1]);
        o.x = ow[0]; o.y = ow[1]; o.z = ow[2]; o.w = ow[3];
        *(u32x4*)(PROJ + ZS_OFF + (size_t)r * P_ZS + 1536 + c0) = o;
    }
}
__device__ __forceinline__ void p2_ssd_states(const Frame& F, const Args& a) {
    short_conv_all(F, a);
    for (int u = F.vcu; u < 4 + BATCH * 15 * NG; u += F.G) {
        if (u < 4) ssd_s1_unit(F, a, 0, 0, u);
        else { const int v = u - 4; ssd_s1_unit(F, a, v / (15 * NG), 1 + (v / NG) % 15, v % NG); }
    }
}
__device__ __forceinline__ void p3_ssd_recur(const Frame& F, const Args& a) {
    const float* dat = (const float*)(a.ws + WS_DAT); const bf16_t* SM = (const bf16_t*)(a.ws + WS_SMETA); bf16_t* SF = (bf16_t*)a.out;
    for (int it = F.vcu; it < BATCH * HEADS * 1024 / NTHREADS; it += F.G) {
        const int idx = it * NTHREADS + F.tid, bh = idx >> 10, e8 = idx & 1023, b = bh / HEADS, h = bh % HEADS;
        u32x4 ld[15];
#pragma unroll
        for (int c = 1; c <= 15; ++c) ld[c - 1] = *(const u32x4*)(SF + ((size_t)(b * 16 + (c - 1)) * HEADS + h) * 8192 + e8 * 8);
        const u32x4 m = *(const u32x4*)(SM + (size_t)h * 8192 + e8 * 8);
        float cy[8] = {bflo(m.x), bfhi(m.x), bflo(m.y), bfhi(m.y), bflo(m.z), bfhi(m.z), bflo(m.w), bfhi(m.w)};
#pragma unroll
        for (int c = 1; c <= 16; ++c) {
            u32x4 o; o.x = pk2(cy[0], cy[1]); o.y = pk2(cy[2], cy[3]); o.z = pk2(cy[4], cy[5]); o.w = pk2(cy[6], cy[7]);
            *(u32x4*)(SF + ((size_t)(b * 16 + (c - 1)) * HEADS + h) * 8192 + e8 * 8) = o;
            if (c <= 15) { const float dA = dat[(size_t)(b * 17 + c) * HEADS + h]; const u32x4 t = ld[c - 1];
                cy[0] = cy[0] * dA + bflo(t.x); cy[1] = cy[1] * dA + bfhi(t.x); cy[2] = cy[2] * dA + bflo(t.y); cy[3] = cy[3] * dA + bfhi(t.y);
                cy[4] = cy[4] * dA + bflo(t.z); cy[5] = cy[5] * dA + bfhi(t.z); cy[6] = cy[6] * dA + bflo(t.w); cy[7] = cy[7] * dA + bfhi(t.w); }
        }
    }
}
__device__ __forceinline__ void ssd_s3_unit(const Frame& F, const Args& a, int b, int c, int g) {
    bf16_t* PROJ = (bf16_t*)(a.ws + WS_PROJ);
    const int p0 = NMETA + 128 * (c - 1), row0 = b * SEQ + 128 * (c - 1), lr = F.lane & 31, hf = F.lane >> 5;
    __syncthreads();
    ssd_dt_acs(F, a, PROJ, b, p0, g, nullptr);
    {   const int mat = F.tid >> 8, it = F.tid & 255, chg = it & 15, sr = it >> 4, ch = D_SSD + (mat ? 0 : 512) + g * 128 + 8 * chg;
        ConvW<8> ci; convw_load<8>(ci, PROJ + XG_OFF + g * XG_STRIDE + (mat ? 384 : 512) + 8 * chg, b, p0 + 8 * sr); ConvWt cw; convw_weights(cw, a, ch);
#pragma unroll
        for (int s = 0; s < 8; ++s) { float o[8]; convw_pos<8>(ci, cw, s, o);
            *(LAS u32x4*)(F.lds + (mat ? SL_B : SL_C) + ((8 * sr + s) * PITCH + 8 * chg) * 2) = (u32x4){pk2(o[0], o[1]), pk2(o[2], o[3]), pk2(o[4], o[5]), pk2(o[6], o[7])}; } }
    __syncthreads();
    constexpr unsigned SI_P = 0u | (0u << 2) | (1u << 4) | (0u << 6) | (1u << 8) | (2u << 10) | (0u << 12) | (1u << 14) | (2u << 16) | (3u << 18);
    constexpr unsigned LI_P = 0u | (1u << 2) | (1u << 4) | (2u << 6) | (2u << 8) | (2u << 10) | (3u << 12) | (3u << 14) | (3u << 16) | (3u << 18);
    const int nslot = F.wave < 2 ? 2 : 1;
    f32x16 cb[2];
#pragma unroll
    for (int sl = 0; sl < 2; ++sl) {
#pragma unroll
        for (int r = 0; r < 16; ++r) cb[sl][r] = 0.f;
        if (sl < nslot) { const int ti = F.wave + 8 * sl, si = (SI_P >> (2 * ti)) & 3, li = (LI_P >> (2 * ti)) & 3;
#pragma unroll
            for (int ks = 0; ks < 8; ++ks) {
                const bf16x8 af = *(const LAS bf16x8*)(F.lds + SL_B + ((32 * si + lr) * PITCH + 16 * ks + 8 * hf) * 2);
                const bf16x8 bf = *(const LAS bf16x8*)(F.lds + SL_C + ((32 * li + lr) * PITCH + 16 * ks + 8 * hf) * 2);
                cb[sl] = mfma32(af, bf, cb[sl]); } }
    }
    __syncthreads();
    const int pb = F.wave & 1, lio = F.wave >> 1;
    unsigned ypk[6][8];
#pragma unroll
    for (int i = 0; i < 6; ++i)
#pragma unroll
        for (int r = 0; r < 8; ++r) ypk[i][r] = 0u;
#pragma unroll 1
    for (int hh = 0; hh < 6; ++hh) {
        const int h = g * 6 + hh, buf = hh & 1, mofs = buf ? SL_B : SL_M0;
        const LAS float* dtL = (const LAS float*)(F.lds + SL_DT) + hh * 128; const LAS float* acL = (const LAS float*)(F.lds + SL_ACS) + hh * 128;
        const bf16_t* sp = (const bf16_t*)a.out + ((size_t)(b * 16 + (c - 1)) * HEADS + h) * 8192;
        {
            const int chg = F.tid & 7, spp = F.tid >> 3, ch = h * 64 + 8 * chg;
            ConvW<2> ci; convw_load<2>(ci, PROJ + XG_OFF + g * XG_STRIDE + hh * 64 + 8 * chg, b, p0 + 2 * spp); ConvWt cw; convw_weights(cw, a, ch);
            float o0[8], o1[8]; convw_pos<2>(ci, cw, 0, o0); convw_pos<2>(ci, cw, 1, o1);
#pragma unroll
            for (int cc = 0; cc < 8; ++cc) *(LAS unsigned*)(F.lds + SL_X + buf * 17408 + ((8 * chg + cc) * PITCH + 2 * spp) * 2) = pk2(o0[cc], o1[cc]);
        }
        u32x4 sf[4][2];
#pragma unroll
        for (int nb = 0; nb < 4; ++nb) { const u32x4* s4 = (const u32x4*)(sp + ((size_t)(pb * 4 + nb) * 64 + F.lane) * 16); sf[nb][0] = s4[0]; sf[nb][1] = s4[1]; }
        {
            const float Dh = a.d_skip[h];
#pragma unroll
            for (int sl = 0; sl < 2; ++sl) if (sl < nslot) { const int ti = F.wave + 8 * sl, si = (SI_P >> (2 * ti)) & 3, li = (LI_P >> (2 * ti)) & 3;
                const int l = 32 * li + lr; const float acl = acL[l];
#pragma unroll
                for (int q = 0; q < 4; ++q) { const int s0 = 32 * si + 8 * q + 4 * hf;
                    const f32x4 d4 = *(const LAS f32x4*)(dtL + s0), a4 = *(const LAS f32x4*)(acL + s0); float v[4];
#pragma unroll
                    for (int i = 0; i < 4; ++i) { const int s = s0 + i; float t = s <= l ? cb[sl][4 * q + i] * __expf(acl - a4[i]) * d4[i] : 0.f; if (s == l) t += Dh; v[i] = t; }
                    *(LAS u32x2*)(F.lds + mofs + (l * PITCH + s0) * 2) = (u32x2){pk2(v[0], v[1]), pk2(v[2], v[3])}; } }
        }
        f32x16 acc;
#pragma unroll
        for (int r = 0; r < 16; ++r) acc[r] = 0.f;
        {
#pragma unroll
            for (int nb = 0; nb < 4; ++nb) {
#pragma unroll
                for (int qp = 0; qp < 2; ++qp) { const LAS unsigned char* cp_ = F.lds + SL_C + ((32 * lio + lr) * PITCH + 32 * nb + 16 * qp + 4 * hf) * 2;
                    const u32x2 c0 = *(const LAS u32x2*)cp_, c1 = *(const LAS u32x2*)(cp_ + 16);
                    const u32x4 bfr = (u32x4){c0.x, c0.y, c1.x, c1.y};
                    acc = mfma32(__builtin_bit_cast(bf16x8, sf[nb][qp]), __builtin_bit_cast(bf16x8, bfr), acc); } }
            const float sc = __expf(acL[32 * lio + lr]);
#pragma unroll
            for (int r = 0; r < 16; ++r) acc[r] *= sc;
        }
        __syncthreads();
        for (int ks = 0; ks < 2 * (lio + 1); ++ks) {
            const bf16x8 af = *(const LAS bf16x8*)(F.lds + SL_X + buf * 17408 + ((32 * pb + lr) * PITCH + 16 * ks + 8 * hf) * 2);
            const bf16x8 bf = *(const LAS bf16x8*)(F.lds + mofs + ((32 * lio + lr) * PITCH + 16 * ks + 8 * hf) * 2);
            acc = mfma32(af, bf, acc);
        }
#pragma unroll
        for (int i = 0; i < 5; ++i)
#pragma unroll
            for (int r = 0; r < 8; ++r) ypk[i][r] = ypk[i + 1][r];
#pragma unroll
        for (int r = 0; r < 8; ++r) ypk[5][r] = pk2(acc[2 * r], acc[2 * r + 1]);
    }
    __syncthreads();
#pragma unroll
    for (int hh = 0; hh < 6; ++hh)
#pragma unroll
        for (int q = 0; q < 4; ++q) *(LAS u32x2*)(F.lds + SL_B + ((32 * lio + lr) * YPITCH + hh * 64 + 32 * pb + 8 * q + 4 * hf) * 2) = (u32x2){ypk[hh][2 * q], ypk[hh][2 * q + 1]};
    u32x2 zz2[4][6];
#pragma unroll
    for (int pass = 0; pass < 4; ++pass) { const int l = pass * 32 + F.wave * 4 + (F.lane >> 4), sub = F.lane & 15; const bf16_t* zr = PROJ + ZS_OFF + (size_t)(row0 + l) * P_ZS + g * 384;
#pragma unroll
        for (int k = 0; k < 6; ++k) zz2[pass][k] = *(const u32x2*)(zr + 4 * (sub + 16 * k)); }
    __syncthreads();
#pragma unroll
    for (int pass = 0; pass < 4; ++pass) {
        const int l = pass * 32 + F.wave * 4 + (F.lane >> 4), sub = F.lane & 15; bf16_t* zr = PROJ + ZS_OFF + (size_t)(row0 + l) * P_ZS + g * 384;
        float v[6][4]; float ss = 0.f;
#pragma unroll
        for (int k = 0; k < 6; ++k) { const int c0 = 4 * (sub + 16 * k); const u32x2 y2 = *(const LAS u32x2*)(F.lds + SL_B + (l * YPITCH + c0) * 2), z2 = zz2[pass][k];
            const float yy[4] = {bflo(y2.x), bfhi(y2.x), bflo(y2.y), bfhi(y2.y)}, zz[4] = {bflo(z2.x), bfhi(z2.x), bflo(z2.y), bfhi(z2.y)};
#pragma unroll
            for (int i = 0; i < 4; ++i) { v[k][i] = yy[i] * silu_f(zz[i]); ss += v[k][i] * v[k][i]; } }
        ss = row_sum16(ss);
        const float rstd = 1.0f / sqrtf(ss * (1.f / 384.f) + EPS);
#pragma unroll
        for (int k = 0; k < 6; ++k) { const int c0 = 4 * (sub + 16 * k); const f32x4 nw = *(const f32x4*)(a.ssd_norm_w + g * 384 + c0);
            *(u32x2*)(zr + c0) = (u32x2){pk2(v[k][0] * rstd * nw.x, v[k][1] * rstd * nw.y), pk2(v[k][2] * rstd * nw.z, v[k][3] * rstd * nw.w)}; }
    }
}
__device__ __forceinline__ void p4_ssd_out(const Frame& F, const Args& a) {
    for (int u = F.vcu; u < BATCH * 16 * NG; u += F.G) ssd_s3_unit(F, a, u / (16 * NG), 1 + (u / NG) % 16, u % NG);
}

__device__ __forceinline__ void p6_tables_rstd(const Frame& F, const Args& a) {
    const int gw = F.vcu * NWAVES + F.wave, NGW = F.G * NWAVES;
    {
        unsigned char* V8 = a.ws + WS_V8; float* SV = (float*)(a.ws + WS_SV);
        for (int r = gw; r < 2 * PK * PK; r += NGW) {
            const bool isv = r >= PK * PK; const int e = isv ? r - PK * PK : r;
            const f32x4* src = (const f32x4*)((isv ? a.expert_v : a.expert_u) + (size_t)e * D) + 4 * F.lane;
            f32x4 v[4];
#pragma unroll
            for (int j = 0; j < 4; ++j) v[j] = src[j];
            if (isv) {
                float amax = 0.f;
#pragma unroll
                for (int j = 0; j < 4; ++j) amax = fmaxf(amax, fmaxf(fmaxf(fabsf(v[j].x), fabsf(v[j].y)), fmaxf(fabsf(v[j].z), fabsf(v[j].w))));
#pragma unroll
                for (int o = 1; o < 64; o <<= 1) amax = fmaxf(amax, __shfl_xor(amax, o));
                const float sc = amax > 0.f ? amax * (1.0f / 440.0f) : 1.0f, inv = 1.0f / sc;
                u32x4 o4; unsigned ow[4];
#pragma unroll
                for (int j = 0; j < 4; ++j) { int p = 0; p = __builtin_amdgcn_cvt_pk_fp8_f32(v[j].x * inv, v[j].y * inv, p, false); p = __builtin_amdgcn_cvt_pk_fp8_f32(v[j].z * inv, v[j].w * inv, p, true); ow[j] = (unsigned)p; }
                o4.x = ow[0]; o4.y = ow[1]; o4.z = ow[2]; o4.w = ow[3];
                *(u32x4*)(V8 + ((size_t)(F.lane >> 3) * (PK * PK) + e) * 128 + 16 * (F.lane & 7)) = o4; if (F.lane == 0) SV[e] = sc;
            } else {
                const f32x4* gr = (const f32x4*)a.g_ffn + 4 * F.lane;
#pragma unroll
                for (int j = 0; j < 4; ++j) v[j] = v[j] * gr[j];
                u32x4* ub = (u32x4*)((bf16_t*)(a.ws + WS_UB) + (size_t)e * D) + 2 * F.lane;
                u32x4 b0, b1; b0.x = pk2(v[0].x, v[0].y); b0.y = pk2(v[0].z, v[0].w); b0.z = pk2(v[1].x, v[1].y); b0.w = pk2(v[1].z, v[1].w); b1.x = pk2(v[2].x, v[2].y); b1.y = pk2(v[2].z, v[2].w); b1.z = pk2(v[3].x, v[3].y); b1.w = pk2(v[3].z, v[3].w);
                ub[0] = b0; ub[1] = b1;
            }
        }
    }
    const bf16_t* H2b = (const bf16_t*)(a.ws + WS_XN); float* RSTD = (float*)(a.ws + WS_RSTD);
    for (int m = gw; m < TR; m += NGW) {
        const u32x4* xr = (const u32x4*)(H2b + (size_t)m * D) + 2 * F.lane; const u32x4 p = xr[0], q = xr[1]; const unsigned w[8] = {p.x, p.y, p.z, p.w, q.x, q.y, q.z, q.w};
        float s = 0.f;
#pragma unroll
        for (int j = 0; j < 8; ++j) { const float lo = bflo(w[j]), hi = bfhi(w[j]); s += lo * lo + hi * hi; }
        s = wave_sum(s);
        if (F.lane == 0) RSTD[m] = 1.0f / sqrtf(s * (1.f / D) + EPS);
    }
}

__device__ __forceinline__ unsigned ord_bits(float f) { const unsigned u = __builtin_bit_cast(unsigned, f); return u ^ ((u >> 31) ? 0xffffffffu : 0x80000000u); }
__device__ __forceinline__ float ord_val(unsigned o) { const unsigned u = (o & 0x80000000u) ? (o ^ 0x80000000u) : ~o; return __builtin_bit_cast(float, u); }
__device__ __forceinline__ void cex_desc(unsigned& x, unsigned& y) { const unsigned hi = x > y ? x : y, lo = x > y ? y : x; x = hi; y = lo; }
__device__ __forceinline__ void sort16_desc(unsigned (&v)[16]) {
#pragma unroll
    for (int k = 2; k <= 16; k <<= 1)
#pragma unroll
        for (int j = k >> 1; j > 0; j >>= 1)
#pragma unroll
            for (int i = 0; i < 16; ++i) { const int l = i ^ j; if (l > i) { if ((i & k) == 0) cex_desc(v[i], v[l]); else cex_desc(v[l], v[i]); } }
}
__device__ __forceinline__ void bitonic_merge16_desc(unsigned (&v)[16]) {
#pragma unroll
    for (int j = 8; j > 0; j >>= 1)
#pragma unroll
        for (int i = 0; i < 16; ++i) { const int l = i ^ j; if (l > i) cex_desc(v[i], v[l]); }
}
__device__ __forceinline__ void top16_merge(unsigned (&T)[16], const unsigned (&B)[16]) {
#pragma unroll
    for (int i = 0; i < 16; ++i) T[i] = T[i] > B[15 - i] ? T[i] : B[15 - i];
    bitonic_merge16_desc(T);
}
__device__ __forceinline__ void p8_topk_mfma(const Frame& F, const Args& a) {
    const bf16_t* Q = (const bf16_t*)(a.ws + WS_Q); int* EIDX = (int*)(a.ws + WS_EIDX); float* GATE = (float*)(a.ws + WS_GATE);
    const int lane = F.lane, lr = lane & 31, hf = lane >> 5;
    for (int task = F.vcu; task < PH * (TR / 1024); task += F.G) {
        const int h = task % PH, rng = task / PH;
        __syncthreads();
        {
            const f32x4* kp = (const f32x4*)(a.sub_keys + (size_t)h * 2 * PK * 128);
            for (int i = F.tid; i < 2 * PK * 128 / 4; i += NTHREADS) { const f32x4 v = kp[i]; const int row = i >> 5, c4 = (i & 31) * 4;
                *(LAS u32x2*)(F.lds + (row * PITCH + c4) * 2) = (u32x2){pk2(v.x, v.y), pk2(v.z, v.w)}; }
        }
        __syncthreads();
        for (int tile = F.wave; tile < 16; tile += NWAVES) {
            const int t0 = rng * 1024 + tile * 64;
            unsigned L0[16], L1[16];
#pragma unroll
            for (int i = 0; i < 16; ++i) { L0[i] = 0u; L1[i] = 0u; }
#pragma unroll 1
            for (int s = 0; s < 2; ++s) {
                unsigned TA[16], R[16];
#pragma unroll
                for (int i = 0; i < 16; ++i) { TA[i] = 0u; R[i] = 0u; }
#pragma unroll 1
                for (int th = 0; th < 2; ++th) {
                    bf16x8 qf[8];
                    const bf16_t* qp = Q + (size_t)(t0 + 32 * th + lr) * PQ + h * 256 + s * 128 + 8 * hf;
#pragma unroll
                    for (int ks = 0; ks < 8; ++ks) qf[ks] = *(const bf16x8*)(qp + 16 * ks);
                    unsigned T[16];
#pragma unroll
                    for (int i = 0; i < 16; ++i) T[i] = 0u;
#pragma unroll 1
                    for (int kb = 0; kb < 4; ++kb) {
                        f32x16 acc;
#pragma unroll
                        for (int r = 0; r < 16; ++r) acc[r] = 0.f;
#pragma unroll
                        for (int ks = 0; ks < 8; ++ks) { const bf16x8 af = *(const LAS bf16x8*)(F.lds + ((s * PK + 32 * kb + lr) * PITCH + 16 * ks + 8 * hf) * 2); acc = mfma32(af, qf[ks], acc); }
                        unsigned B[16];
#pragma unroll
                        for (int r = 0; r < 16; ++r) { const int k = 32 * kb + 8 * (r >> 2) + 4 * hf + (r & 3); B[r] = (ord_bits(acc[r]) & ~127u) | (unsigned)(127 - k); }
                        sort16_desc(B);
                        top16_merge(T, B);
                    }
                    unsigned P[16];
#pragma unroll
                    for (int i = 0; i < 16; ++i) { unsigned lo2, hi2; swap32_self(T[i], lo2, hi2); P[i] = hf ? lo2 : hi2; }
                    top16_merge(T, P);
#pragma unroll
                    for (int i = 0; i < 16; ++i) { R[i] = hf ? T[i] : TA[i]; TA[i] = T[i]; }
                }
#pragma unroll
                for (int i = 0; i < 16; ++i) { L0[i] = L1[i]; L1[i] = R[i]; }
            }
            const int t = t0 + lane;
            unsigned T[16];
            const float v00 = ord_val(L0[0] & ~127u);
#pragma unroll
            for (int j = 0; j < 16; ++j) T[j] = (ord_bits(v00 + ord_val(L1[j] & ~127u)) & ~255u) | (unsigned)(255 - j);
#pragma unroll
            for (int i = 1; i < 16; ++i)
#pragma unroll
                for (int j = 0; j < 16; ++j) if ((i + 1) * (j + 1) <= 16) {
                    const float sum = ord_val(L0[i] & ~127u) + ord_val(L1[j] & ~127u);
                    unsigned e = (ord_bits(sum) & ~255u) | (unsigned)(255 - (i * 16 + j));
#pragma unroll
                    for (int k = 0; k < 16; ++k) { const unsigned hi = T[k] > e ? T[k] : e; e = T[k] > e ? e : T[k]; T[k] = hi; }
                }
            float best[16]; int eid[16];
#pragma unroll
            for (int k = 0; k < 16; ++k) {
                best[k] = ord_val(T[k] & ~255u); const int pos = 255 - (int)(T[k] & 255u), pi = pos >> 4, pj = pos & 15;
                unsigned a0 = 0u, a1 = 0u;
#pragma unroll
                for (int i = 0; i < 16; ++i) { a0 = (pi == i) ? L0[i] : a0; a1 = (pj == i) ? L1[i] : a1; }
                eid[k] = (127 - (int)(a0 & 127u)) * PK + (127 - (int)(a1 & 127u));
            }
            const float rst = ((const float*)(a.ws + WS_RSTD))[t];
            float se = 0.f, ex[16];
#pragma unroll
            for (int k = 0; k < 16; ++k) { ex[k] = __expf((best[k] - best[0]) * rst); se += ex[k]; }
            const float inv = 1.f / se;
            int* ep = EIDX + (size_t)t * 128 + h * 16; float* gp = GATE + (size_t)t * 128 + h * 16;
#pragma unroll
            for (int k = 0; k < 16; k += 4) { *(int4*)(ep + k) = make_int4(eid[k], eid[k + 1], eid[k + 2], eid[k + 3]); *(f32x4*)(gp + k) = (f32x4){ex[k] * inv, ex[k + 1] * inv, ex[k + 2] * inv, ex[k + 3] * inv}; }
        }
    }
}

typedef __bf16 bf16x2_t __attribute__((ext_vector_type(2)));
__device__ __forceinline__ float dot2bf(unsigned w, unsigned x, float acc) { return __builtin_amdgcn_fdot2_f32_bf16(__builtin_bit_cast(bf16x2_t, w), __builtin_bit_cast(bf16x2_t, x), acc, false); }

__device__ __forceinline__ float shx32(float x, int lane) { unsigned a, b; swap32_self(__builtin_bit_cast(unsigned, x), a, b); return __builtin_bit_cast(float, (lane & 32) ? a : b); }
__device__ __forceinline__ float shx16(float x, int lane) { unsigned a, b; swap16_self(__builtin_bit_cast(unsigned, x), a, b); return __builtin_bit_cast(float, (lane & 16) ? a : b); }
template <int CTRL> __device__ __forceinline__ float dppf(float x) { return __builtin_bit_cast(float, __builtin_amdgcn_update_dpp(0, __builtin_bit_cast(int, x), CTRL, 0xF, 0xF, true)); }
__device__ __forceinline__ float shx8(float x) { return dppf<0x128>(x); }
__device__ __forceinline__ float shx4(float x, int) { return dppf<0x1B>(dppf<0x141>(x)); }

__device__ __forceinline__ float gelu_as(float v) {
    const float av = __builtin_fabsf(v), t = __builtin_amdgcn_rcpf(av * 0.2316418882f + 1.0f);
    float q = t * 0.5307027145f + (-0.7265760135f); q = q * t + 0.7107068705f; q = q * t + (-0.142248368f); q = q * t + 0.127414796f; q = q * t;
    const float e = __builtin_amdgcn_exp2f((v * v) * (-0.72134752044f));
    const float m = v * (q * e);
    return v < 0.f ? m : v - m;
}
__device__ __forceinline__ int rdlane(int v, int l) { return __builtin_amdgcn_readlane(v, l); }
__device__ __forceinline__ float rdlanef(float v, int l) { return __builtin_bit_cast(float, __builtin_amdgcn_readlane(__builtin_bit_cast(int, v), l)); }

struct PeerBatch { int l0, l1, l2, l3; u32x4 r[4][2]; };
__device__ __forceinline__ void peerA_take(unsigned long long& m, PeerBatch& B, const bf16_t* Ub, int lane, int ev) {
    B.l0 = __builtin_ctzll(m); m &= m - 1; B.l1 = B.l0; B.l2 = B.l0; B.l3 = B.l0;
    if (m) { B.l1 = __builtin_ctzll(m); m &= m - 1; if (m) { B.l2 = __builtin_ctzll(m); m &= m - 1; if (m) { B.l3 = __builtin_ctzll(m); m &= m - 1; } } }
    const unsigned e0 = (unsigned)rdlane(ev, B.l0), e1 = (unsigned)rdlane(ev, B.l1), e2 = (unsigned)rdlane(ev, B.l2), e3 = (unsigned)rdlane(ev, B.l3);
    const unsigned loff = (unsigned)lane * 32u;
    const char* r0 = (const char*)Ub + ((size_t)e0 << 11); const char* r1 = (const char*)Ub + ((size_t)e1 << 11); const char* r2 = (const char*)Ub + ((size_t)e2 << 11); const char* r3 = (const char*)Ub + ((size_t)e3 << 11);
    B.r[0][0] = *(const u32x4*)(r0 + loff); B.r[0][1] = *(const u32x4*)(r0 + loff + 16); B.r[1][0] = *(const u32x4*)(r1 + loff); B.r[1][1] = *(const u32x4*)(r1 + loff + 16);
    B.r[2][0] = *(const u32x4*)(r2 + loff); B.r[2][1] = *(const u32x4*)(r2 + loff + 16); B.r[3][0] = *(const u32x4*)(r3 + loff); B.r[3][1] = *(const u32x4*)(r3 + loff + 16);
}
__device__ __forceinline__ void peerA_finish(const PeerBatch& B, int lane, LAS float* dl  , const unsigned (&xp)[8]) {
#define DOT16(lo, hi) dot2bf((hi).w, xp[7], dot2bf((hi).z, xp[6], dot2bf((hi).y, xp[5], dot2bf((hi).x, xp[4], dot2bf((lo).w, xp[3], dot2bf((lo).z, xp[2], dot2bf((lo).y, xp[1], dot2bf((lo).x, xp[0], 0.f))))))))
    const float p0 = DOT16(B.r[0][0], B.r[0][1]), p1 = DOT16(B.r[1][0], B.r[1][1]), p2 = DOT16(B.r[2][0], B.r[2][1]), p3 = DOT16(B.r[3][0], B.r[3][1]);
#undef DOT16
    const bool hi5 = lane & 32, hi4 = lane & 16;
    const float k0 = hi5 ? p2 : p0, s0 = hi5 ? p0 : p2, k1 = hi5 ? p3 : p1, s1 = hi5 ? p1 : p3;
    const float t0 = k0 + shx32(s0, lane), t1 = k1 + shx32(s1, lane);
    const float k2 = hi4 ? t1 : t0, s2 = hi4 ? t0 : t1;
    const float d = row_sum16(k2 + shx16(s2, lane));
    const int sl0 = __builtin_amdgcn_readfirstlane(B.l0), sl1 = __builtin_amdgcn_readfirstlane(B.l1), sl2 = __builtin_amdgcn_readfirstlane(B.l2), sl3 = __builtin_amdgcn_readfirstlane(B.l3);
    const int slot = hi5 ? (hi4 ? sl3 : sl2) : (hi4 ? sl1 : sl0);
    if ((lane & 15) == 0) dl[slot] = d;
}
struct PeerGather8 { u32x4 vv[16]; float aw[16]; };
__device__ __forceinline__ void peerB8_gather(PeerGather8& G, const unsigned char* V8, int lane, int cs, const LAS int* ELt, const LAS float* ALt) {
    const int rg = lane >> 3, cl = lane & 7;
#pragma unroll
    for (int j = 0; j < 16; ++j) { const int e = ELt[8 * j + rg]; G.aw[j] = ALt[8 * j + rg];
        G.vv[j] = *(const u32x4*)(V8 + (((unsigned)(cs * PK * PK) + (unsigned)e) * 128u + (unsigned)(cl * 16))); }
}
__device__ __forceinline__ f32x2 peerB8_reduce(const PeerGather8& G, int lane) {
    f32x2 acc[8];
#pragma unroll
    for (int c = 0; c < 8; ++c) acc[c] = (f32x2){0.f, 0.f};
#pragma unroll
    for (int j = 0; j < 16; ++j) { const unsigned ww[4] = {G.vv[j].x, G.vv[j].y, G.vv[j].z, G.vv[j].w}; const f32x2 a2 = (f32x2){G.aw[j], G.aw[j]};
#pragma unroll
        for (int m = 0; m < 4; ++m) { acc[2 * m] += __builtin_amdgcn_cvt_pk_f32_fp8(ww[m], false) * a2; acc[2 * m + 1] += __builtin_amdgcn_cvt_pk_f32_fp8(ww[m], true) * a2; } }
    const bool b5 = lane & 32, b4 = lane & 16, b3 = lane & 8;
    f32x2 v4[4], v2[2];
#pragma unroll
    for (int c = 0; c < 4; ++c) { const f32x2 keep = b5 ? acc[c + 4] : acc[c], send = b5 ? acc[c] : acc[c + 4]; v4[c] = keep + (f32x2){shx32(send.x, lane), shx32(send.y, lane)}; }
#pragma unroll
    for (int c = 0; c < 2; ++c) { const f32x2 keep = b4 ? v4[c + 2] : v4[c], send = b4 ? v4[c] : v4[c + 2]; v2[c] = keep + (f32x2){shx16(send.x, lane), shx16(send.y, lane)}; }
    const f32x2 keep = b3 ? v2[1] : v2[0], send = b3 ? v2[0] : v2[1];
    return keep + (f32x2){shx8(send.x), shx8(send.y)};
}
#ifndef NSLICE
#define NSLICE 10
#endif
__device__ __forceinline__ int slice_of(int e) { return (e * NSLICE) >> 14; }
__device__ __forceinline__ void peerA_token2(const bf16_t* Ub, int lane, int s, int e0lo, int e0hi, LAS float* d0, const unsigned (&xp0)[8], int e1lo, int e1hi, LAS float* d1, const unsigned (&xp1)[8]) {
    unsigned long long m0 = __ballot(slice_of(e0lo) == s), m1 = __ballot(slice_of(e0hi) == s), m2 = __ballot(slice_of(e1lo) == s), m3 = __ballot(slice_of(e1hi) == s);
    while (m0 | m1 | m2 | m3) {
        const bool h0 = m0 != 0ull, h1 = m1 != 0ull, h2 = m2 != 0ull, h3 = m3 != 0ull;
        PeerBatch B0, B1, B2, B3;
        if (h0) peerA_take(m0, B0, Ub, lane, e0lo);
        if (h1) peerA_take(m1, B1, Ub, lane, e0hi);
        if (h2) peerA_take(m2, B2, Ub, lane, e1lo);
        if (h3) peerA_take(m3, B3, Ub, lane, e1hi);
        if (h0) peerA_finish(B0, lane, d0, xp0);
        if (h1) peerA_finish(B1, lane, d0 + 64, xp0);
        if (h2) peerA_finish(B2, lane, d1, xp1);
        if (h3) peerA_finish(B3, lane, d1 + 64, xp1);
    }
}

__device__ __forceinline__ void peerA_takeM(unsigned long long& mlo, unsigned long long& mhi, PeerBatch& B, const bf16_t* Ub, int lane, int elo, int ehi) {
    int sl[4]; unsigned ee[4];
#pragma unroll
    for (int j = 0; j < 4; ++j) {
        if (mlo) { const int l = __builtin_ctzll(mlo); mlo &= mlo - 1; sl[j] = l; ee[j] = (unsigned)rdlane(elo, l); }
        else if (mhi) { const int l = __builtin_ctzll(mhi); mhi &= mhi - 1; sl[j] = 64 + l; ee[j] = (unsigned)rdlane(ehi, l); }
        else { sl[j] = sl[0]; ee[j] = ee[0]; }
    }
    B.l0 = sl[0]; B.l1 = sl[1]; B.l2 = sl[2]; B.l3 = sl[3];
    const unsigned loff = (unsigned)lane * 32u;
    const char* r0 = (const char*)Ub + ((size_t)ee[0] << 11); const char* r1 = (const char*)Ub + ((size_t)ee[1] << 11); const char* r2 = (const char*)Ub + ((size_t)ee[2] << 11); const char* r3 = (const char*)Ub + ((size_t)ee[3] << 11);
    B.r[0][0] = *(const u32x4*)(r0 + loff); B.r[0][1] = *(const u32x4*)(r0 + loff + 16); B.r[1][0] = *(const u32x4*)(r1 + loff); B.r[1][1] = *(const u32x4*)(r1 + loff + 16);
    B.r[2][0] = *(const u32x4*)(r2 + loff); B.r[2][1] = *(const u32x4*)(r2 + loff + 16); B.r[3][0] = *(const u32x4*)(r3 + loff); B.r[3][1] = *(const u32x4*)(r3 + loff + 16);
}
struct PeerTok { int elo, ehi; unsigned xp[8]; };
__device__ __forceinline__ void peerA_load_tok(PeerTok& T, const bf16_t* H2b, const LAS int* ELt, int tok, int lane) {
    const u32x4* x0 = (const u32x4*)(H2b + (size_t)tok * D) + 2 * lane; const u32x4 xa = x0[0], xb = x0[1];
    T.xp[0] = xa.x; T.xp[1] = xa.y; T.xp[2] = xa.z; T.xp[3] = xa.w; T.xp[4] = xb.x; T.xp[5] = xb.y; T.xp[6] = xb.z; T.xp[7] = xb.w;
    T.elo = ELt[lane] & 0x3fff; T.ehi = ELt[64 + lane] & 0x3fff;
}
__device__ __forceinline__ void peerA_token4(const bf16_t* Ub, int lane, int s, const PeerTok& T0, const PeerTok& T1, const PeerTok& T2, const PeerTok& T3, LAS float* d  ) {
    unsigned long long a0 = __ballot(slice_of(T0.elo) == s), b0 = __ballot(slice_of(T0.ehi) == s), a1 = __ballot(slice_of(T1.elo) == s), b1 = __ballot(slice_of(T1.ehi) == s);
    unsigned long long a2 = __ballot(slice_of(T2.elo) == s), b2 = __ballot(slice_of(T2.ehi) == s), a3 = __ballot(slice_of(T3.elo) == s), b3 = __ballot(slice_of(T3.ehi) == s);
    while (a0 | b0 | a1 | b1 | a2 | b2 | a3 | b3) {
        const bool h0 = (a0 | b0) != 0ull, h1 = (a1 | b1) != 0ull, h2 = (a2 | b2) != 0ull, h3 = (a3 | b3) != 0ull;
        PeerBatch B0, B1, B2, B3;
        if (h0) peerA_takeM(a0, b0, B0, Ub, lane, T0.elo, T0.ehi);
        if (h1) peerA_takeM(a1, b1, B1, Ub, lane, T1.elo, T1.ehi);
        if (h2) peerA_takeM(a2, b2, B2, Ub, lane, T2.elo, T2.ehi);
        if (h3) peerA_takeM(a3, b3, B3, Ub, lane, T3.elo, T3.ehi);
        if (h0) peerA_finish(B0, lane, d, T0.xp);
        if (h1) peerA_finish(B1, lane, d + 128, T1.xp);
        if (h2) peerA_finish(B2, lane, d + 256, T2.xp);
        if (h3) peerA_finish(B3, lane, d + 384, T3.xp);
    }
}
__device__ __forceinline__ void p9_peer_hybrid(const Frame& F, const Args& a, float* dst) {
    const int* EIDX = (const int*)(a.ws + WS_EIDX); const float* GATE = (const float*)(a.ws + WS_GATE); const float* RSTD = (const float*)(a.ws + WS_RSTD);
    const bf16_t* Ub = (const bf16_t*)(a.ws + WS_UB); const unsigned char* V8 = a.ws + WS_V8; const float* SV = (const float*)(a.ws + WS_SV);
    bf16_t* H2b = (bf16_t*)(a.ws + WS_XN);
    const int gw = F.vcu * NWAVES + F.wave, lane = F.lane, tokb = gw * 16;
    LAS int* EL = (LAS int*)(F.lds + F.wave * 16384); LAS float* AL = (LAS float*)(F.lds + F.wave * 16384 + 8192);
#pragma unroll 4
    for (int ti = 0; ti < 16; ++ti) { const size_t o = (size_t)(tokb + ti) * 128;
        EL[ti * 128 + lane] = EIDX[o + lane] | (int)(f2bf(GATE[o + lane]) << 16); EL[ti * 128 + 64 + lane] = EIDX[o + 64 + lane] | (int)(f2bf(GATE[o + 64 + lane]) << 16); }
    const float myrs = RSTD[tokb + (lane & 15)];
#pragma unroll 1
    for (int s = 0; s < NSLICE; ++s) {
#pragma unroll 1
        for (int i = 0; i < 16; i += 4) { const int o = i * 128;
            PeerTok T0, T1, T2, T3;
            peerA_load_tok(T0, H2b, EL + o, tokb + i, lane); peerA_load_tok(T1, H2b, EL + o + 128, tokb + i + 1, lane); peerA_load_tok(T2, H2b, EL + o + 256, tokb + i + 2, lane); peerA_load_tok(T3, H2b, EL + o + 384, tokb + i + 3, lane);
            peerA_token4(Ub, lane, s, T0, T1, T2, T3, AL + o); }
    }
#pragma unroll 2
    for (int ti = 0; ti < 16; ++ti) { const float rs = rdlanef(myrs, ti);
#pragma unroll
        for (int hf = 0; hf < 2; ++hf) { const int k = ti * 128 + 64 * hf + lane; const int w = EL[k], e = w & 0x3fff; const float gate = __builtin_bit_cast(float, (unsigned)w & 0xffff0000u);
            AL[k] = gelu_as(AL[k] * rs) * gate * SV[e]; EL[k] = e; } }
    const int col = 16 * (lane & 7) + ((lane >> 5) & 1) * 8 + ((lane >> 4) & 1) * 4 + ((lane >> 3) & 1) * 2;
#pragma unroll 1
    for (int cs = 0; cs < 8; ++cs) {
        PeerGather8 G0, G1;
        peerB8_gather(G0, V8, lane, cs, EL, AL);
#pragma unroll 1
        for (int ti = 0; ti < 16; ti += 2) {
            unsigned* hp0 = (unsigned*)(H2b + (size_t)(tokb + ti) * D + cs * 128 + col); unsigned* hp1 = hp0 + D / 2; const unsigned h0 = *hp0, h1 = *hp1;
            peerB8_gather(G1, V8, lane, cs, EL + (ti + 1) * 128, AL + (ti + 1) * 128);
            { const f32x2 r = peerB8_reduce(G0, lane); *hp0 = pk2(bflo(h0) + r.x, bfhi(h0) + r.y); }
            if (ti + 2 < 16) peerB8_gather(G0, V8, lane, cs, EL + (ti + 2) * 128, AL + (ti + 2) * 128);
            { const f32x2 r = peerB8_reduce(G1, lane); *hp1 = pk2(bflo(h1) + r.x, bfhi(h1) + r.y); }
        }
    }
    asm volatile("s_waitcnt vmcnt(0)" ::: "memory");
    __builtin_amdgcn_fence(__ATOMIC_RELEASE, "workgroup"); __builtin_amdgcn_fence(__ATOMIC_ACQUIRE, "workgroup");
#pragma unroll 2
    for (int ti = 0; ti < 16; ++ti) {
        const u32x4* hr = (const u32x4*)(H2b + (size_t)(tokb + ti) * D) + 2 * lane; f32x4* orow = (f32x4*)(dst + (size_t)(tokb + ti) * D) + 4 * lane; const f32x4* gf = (const f32x4*)a.g_final + 4 * lane;
        const u32x4 p = hr[0], q = hr[1]; const unsigned w[8] = {p.x, p.y, p.z, p.w, q.x, q.y, q.z, q.w};
        float hv[16]; float s2 = 0.f;
#pragma unroll
        for (int j = 0; j < 8; ++j) { hv[2 * j] = bflo(w[j]); hv[2 * j + 1] = bfhi(w[j]); s2 += hv[2 * j] * hv[2 * j] + hv[2 * j + 1] * hv[2 * j + 1]; }
        const float rstd2 = 1.0f / sqrtf(wave_sum(s2) * (1.f / D) + EPS);
#pragma unroll
        for (int j = 0; j < 4; ++j) { const f32x4 g4 = gf[j]; orow[j] = (f32x4){hv[4 * j] * rstd2 * g4.x, hv[4 * j + 1] * rstd2 * g4.y, hv[4 * j + 2] * rstd2 * g4.z, hv[4 * j + 3] * rstd2 * g4.w}; }
    }
}

__global__ void __launch_bounds__(NTHREADS, 2) fwd(Args a) {
    extern __shared__ __attribute__((aligned(16))) unsigned char lds[];
    Frame F; F.lds = (LAS unsigned char*)lds; F.tid = threadIdx.x; F.lane = F.tid & 63; F.wave = __builtin_amdgcn_readfirstlane(F.tid >> 6);
    F.G = gridDim.x; { const int bx = blockIdx.x; F.vcu = (F.G % 8 == 0) ? (bx % 8) * (F.G / 8) + bx / 8 : bx; }
    volatile LAS unsigned* MISC = (volatile LAS unsigned*)(F.lds + LDSCTL_OFF);
    for (int u = F.tid; u < (LDS_BYTES - LDSCTL_OFF) / 4; u += NTHREADS) ((LAS unsigned*)(F.lds + LDSCTL_OFF))[u] = 0u;
    __syncthreads();
    XcdBarrier bar; bar.bar = (unsigned*)(a.ws + WS_CTL) + CW_BAR; bar.x = 0; bar.st = nullptr;
    if (N_LAUNCHES == 1) bar = xcd_barrier_post((unsigned*)(a.ws + WS_CTL) + CW_BAR, MISC + 8);
    const int lo = a.ph_lo, hi = a.ph_hi;
#define IN(k) (lo <= (k) && (k) < hi)
#define GEMM_CALL(EPI) pg8::gemm_phase<EPI, pg8::StaticOrder, true, true>(F.lds, g, S, E)
#define SEAM(k) do { if (IN(k) && IN((k) + 1)) xcd_barrier(bar); } while (0)
    bf16_t* PROJ = (bf16_t*)(a.ws + WS_PROJ);
#define GEMM_P1 { pg8::Gemm g{(const bf16_t*)(a.ws + WS_XN), (const bf16_t*)(a.ws + WS_WIN), ROWS_A, LDP, D, D, D}; pg8::StaticOrder S; S.init(ROWS_A, LDP, F.G, (int)blockIdx.x); pg8::EpiPanels E{PROJ}; GEMM_CALL(pg8::EpiPanels); }
#define GEMM_P5 { pg8::Gemm g{PROJ + ZS_OFF, (const bf16_t*)(a.ws + WS_WOUT), TR, D, D_MIX, P_ZS, D_MIX}; pg8::StaticOrder S; S.init(TR, D, F.G, (int)blockIdx.x); pg8::EpiResBf16 E{a.x, (bf16_t*)(a.ws + WS_XN), D}; GEMM_CALL(pg8::EpiResBf16); }
#define GEMM_P7 { pg8::Gemm g{(const bf16_t*)(a.ws + WS_XN), (const bf16_t*)(a.ws + WS_WQ), TR, PQ, D, D, D}; pg8::StaticOrder S; S.init(TR, PQ, F.G, (int)blockIdx.x); pg8::EpiBf16 E{(bf16_t*)(a.ws + WS_Q), PQ}; GEMM_CALL(pg8::EpiBf16); }
    if (IN(0)) { p0_prologue(F, a); } SEAM(0);
    if (IN(1)) { GEMM_P1 } SEAM(1);
    if (IN(2)) { p2_ssd_states(F, a); } SEAM(2);
    if (IN(3)) { p3_ssd_recur(F, a); } SEAM(3);
    if (IN(4)) { p4_ssd_out(F, a); } SEAM(4);
    if (IN(5)) { GEMM_P5 } SEAM(5);
    if (IN(6)) { p6_tables_rstd(F, a); } SEAM(6);
    if (IN(7)) { GEMM_P7 } SEAM(7);
    if (IN(8)) { p8_topk_mfma(F, a); } SEAM(8);
    if (IN(9)) { p9_peer_hybrid(F, a, a.out); }
#undef IN
#undef SEAM
}

extern "C" void kernel_launch(void* const* d_in, const int* in_sizes, int n_in, void* d_out, int out_size, void* d_ws, size_t ws_size, hipStream_t stream) {
    static int grid = 0;
    if (grid == 0) {
        if (n_in != 18 || out_size != TR * D || ws_size < WS_END) { fprintf(stderr, "kernel_launch: unexpected problem (n_in %d out %d ws %zu)\n", n_in, out_size, ws_size); grid = -1; return; }
        int dev = 0, cus = 0, per_cu = 0;
        if (hipGetDevice(&dev) != hipSuccess || hipDeviceGetAttribute(&cus, hipDeviceAttributeMultiprocessorCount, dev) != hipSuccess) { grid = -1; return; }
        if (hipFuncSetAttribute((const void*)fwd, hipFuncAttributeMaxDynamicSharedMemorySize, LDS_BYTES) != hipSuccess) { fprintf(stderr, "kernel_launch: hipFuncSetAttribute failed\n"); grid = -1; return; }
        if (hipOccupancyMaxActiveBlocksPerMultiprocessor(&per_cu, (const void*)fwd, NTHREADS, LDS_BYTES) != hipSuccess || per_cu < 1) fprintf(stderr, "kernel_launch: occupancy query says %d\n", per_cu);
        (void)hipGetLastError();
        grid = cus;
        if (grid * NWAVES * 16 != TR) { fprintf(stderr, "kernel_launch: built for 256 CUs (the expert phase deals 16 tokens to each of 2048 waves); this device has %d; nothing launched\n", cus); grid = -1; return; }
    }
    if (grid < 0) return;
    if (hipMemsetAsync((char*)d_ws + WS_CTL, 0, CTL_ZERO_BYTES, stream) != hipSuccess) return;
    Args a{};
    a.x = (const float*)d_in[0]; a.meta = (const float*)d_in[1]; a.g_mix = (const float*)d_in[2]; a.w_in = (const float*)d_in[3]; a.conv_ssd_w = (const float*)d_in[4]; a.conv_ssd_b = (const float*)d_in[5];
    a.dt_bias = (const float*)d_in[6]; a.a_log = (const float*)d_in[7]; a.d_skip = (const float*)d_in[8]; a.ssd_norm_w = (const float*)d_in[9]; a.conv_sc_w = (const float*)d_in[10]; a.w_out = (const float*)d_in[11];
    a.g_ffn = (const float*)d_in[12]; a.w_q = (const float*)d_in[13]; a.sub_keys = (const float*)d_in[14]; a.expert_u = (const float*)d_in[15]; a.expert_v = (const float*)d_in[16]; a.g_final = (const float*)d_in[17];
    a.out = (float*)d_out; a.ws = (unsigned char*)d_ws;
    if (N_LAUNCHES == 1) { a.ph_lo = 0; a.ph_hi = NPHASE; hipLaunchKernelGGL(fwd, dim3(grid), dim3(NTHREADS), LDS_BYTES, stream, a); }
    else for (int p = 0; p < NPHASE; ++p) { a.ph_lo = p; a.ph_hi = p + 1; hipLaunchKernelGGL(fwd, dim3(grid), dim3(NTHREADS), LDS_BYTES, stream, a); }
}
```
